# Optimizing an MI355X kernel written in HIP

```python
import math
import jax, jax.numpy as jnp
from jax import lax
import numpy as np

D_MODEL = 1024
BATCH = 2
SEQ = 8192
DEPTH = 1

CHUNK = 64
EPS = 1e-6
A_HEAD_DIM = 128
A_WIDTH = D_MODEL // 2
A_HEADS = A_WIDTH // A_HEAD_DIM
CONV_K = 4
B_HEAD_DIM = 64
B_WIDTH = D_MODEL - A_WIDTH
B_HEADS = B_WIDTH // B_HEAD_DIM
B_PREV_CHUNKS = 8
B_BAND = (B_PREV_CHUNKS + 1) * CHUNK
REL_CLIP = 128
MIX_WIDTH = A_WIDTH + B_WIDTH
OFF_A_QKV = 0
OFF_A_Z = 3 * A_WIDTH
OFF_A_ALPHA = 4 * A_WIDTH
OFF_A_BETA = OFF_A_ALPHA + A_HEADS
OFF_B_QKV = OFF_A_BETA + A_HEADS
IN_COLS = OFF_B_QKV + 3 * B_WIDTH
N_EXPERTS = 32
TOP_K = 4
D_EXPERT = D_MODEL
SWIGLU_ALPHA = 1.702
SWIGLU_LIMIT = 7.0
MOE_BLOCK = 256

kernel_name = 'hybrid_deltanet_chunkattn_moe_block'


def rms_norm(x, w):
    xf = x.astype(jnp.float32)
    y = xf * lax.rsqrt(jnp.mean(xf * xf, axis=-1, keepdims=True) + EPS)
    return (y * w.astype(jnp.float32)).astype(x.dtype)


def l2_norm(x):
    xf = x.astype(jnp.float32)
    return xf * lax.rsqrt(jnp.sum(xf * xf, axis=-1, keepdims=True) + EPS)


def causal_depthwise_conv(x, w):
    ch = x.shape[-1]
    return lax.conv_general_dilated(x, w[:, None, :].astype(x.dtype), window_strides=(1,),
                                    padding=[(CONV_K - 1, 0)],
                                    dimension_numbers=('NWC', 'WIO', 'NWC'),
                                    feature_group_count=ch)


def gated_delta_rule(q, k, v, g, beta):
    bsz, t_len, n_h, dk = q.shape
    dv = v.shape[-1]
    n_ch = t_len // CHUNK

    def to_chunks(t):
        t = t.astype(jnp.float32).reshape((bsz, n_ch, CHUNK, n_h) + t.shape[3:])
        return jnp.moveaxis(t, 3, 1)

    q = to_chunks(q) * (dk ** -0.5)
    k = to_chunks(k)
    v = to_chunks(v)
    beta = to_chunks(beta)
    g = jnp.cumsum(to_chunks(g), axis=-1)
    causal = jnp.tril(jnp.ones((CHUNK, CHUNK), dtype=bool))
    decay = jnp.exp(jnp.where(causal, g[..., :, None] - g[..., None, :], -jnp.inf))
    k_beta = k * beta[..., None]
    strict = jnp.tril(jnp.ones((CHUNK, CHUNK), jnp.float32), -1)
    lower = jnp.einsum('bhnid,bhnjd->bhnij', k_beta, k) * decay * strict
    eye = jnp.eye(CHUNK, dtype=jnp.float32)
    tmat = lax.linalg.triangular_solve(lower + eye, jnp.broadcast_to(eye, lower.shape),
                                       left_side=True, lower=True, unit_diagonal=True)
    u = tmat @ (v * beta[..., None])
    w = tmat @ (k_beta * jnp.exp(g)[..., None])
    attn = jnp.einsum('bhnid,bhnjd->bhnij', q, k) * decay
    q_dec = q * jnp.exp(g)[..., None]
    g_last = g[..., -1]
    k_dec = k * jnp.exp(g_last[..., None] - g)[..., None]

    def step(state, inp):
        u_n, w_n, attn_n, q_n, k_n, gl_n = inp
        v_new = u_n - w_n @ state
        out = q_n @ state + attn_n @ v_new
        state = state * jnp.exp(gl_n)[..., None, None] + jnp.swapaxes(k_n, -1, -2) @ v_new
        return state, out

    xs = tuple(jnp.moveaxis(t, 2, 0) for t in (u, w, attn, q_dec, k_dec, g_last))
    state0 = jnp.zeros((bsz, n_h, dk, dv), jnp.float32)
    _, out = lax.scan(step, state0, xs)
    return out.transpose(1, 0, 3, 2, 4).reshape(bsz, t_len, n_h, dv)


def chunk_band_attention(q, k, v, rel_bias):
    bsz, t_len, n_h, hd = q.shape
    n_ch = t_len // CHUNK
    qc = q.reshape(bsz, n_ch, CHUNK, n_h, hd)

    def band(t):
        t = t.reshape(bsz, n_ch, CHUNK, n_h, hd)
        t = jnp.pad(t, ((0, 0), (B_PREV_CHUNKS, 0), (0, 0), (0, 0), (0, 0)))
        return jnp.concatenate([t[:, s:s + n_ch] for s in range(B_PREV_CHUNKS + 1)], axis=2)

    kb, vb = band(k), band(v)
    q_off = jnp.arange(CHUNK)[:, None] + B_PREV_CHUNKS * CHUNK
    k_off = jnp.arange(B_BAND)[None, :]
    idx = jnp.clip(q_off - k_off, -REL_CLIP, REL_CLIP) + REL_CLIP
    bias = rel_bias[:, idx].astype(jnp.float32)
    valid = (jnp.arange(n_ch)[:, None] - B_PREV_CHUNKS + k_off // CHUNK) >= 0
    s = jnp.einsum('bnqhd,bnkhd->bnhqk', qc, kb).astype(jnp.float32) * (hd ** -0.5) + bias
    s = jnp.where(valid[None, :, None, None, :], s, -jnp.inf)
    p = jax.nn.softmax(s, axis=-1).astype(v.dtype)
    o = jnp.einsum('bnhqk,bnkhd->bnqhd', p, vb)
    return o.reshape(bsz, t_len, n_h * hd)


def hybrid_mixer(h, w_in, conv_w, a_log, dt_bias, a_norm_w, rel_bias, w_out):
    bsz, t_len, _ = h.shape
    proj = h @ w_in
    qkv_a = jax.nn.silu(causal_depthwise_conv(proj[..., OFF_A_QKV:OFF_A_Z], conv_w))
    q_a, k_a, v_a = [t.reshape(bsz, t_len, A_HEADS, A_HEAD_DIM) for t in jnp.split(qkv_a, 3, axis=-1)]
    z_a = proj[..., OFF_A_Z:OFF_A_ALPHA].reshape(bsz, t_len, A_HEADS, A_HEAD_DIM)
    g = -jnp.exp(a_log.astype(jnp.float32)) * jax.nn.softplus(
        proj[..., OFF_A_ALPHA:OFF_A_BETA].astype(jnp.float32) + dt_bias.astype(jnp.float32))
    beta = jax.nn.sigmoid(proj[..., OFF_A_BETA:OFF_B_QKV].astype(jnp.float32))
    o_a = gated_delta_rule(l2_norm(q_a), l2_norm(k_a), v_a, g, beta)
    o_a = (rms_norm(o_a, a_norm_w) * jax.nn.silu(z_a.astype(jnp.float32))).astype(h.dtype)
    o_a = o_a.reshape(bsz, t_len, A_WIDTH)
    q_b, k_b, v_b = [t.reshape(bsz, t_len, B_HEADS, B_HEAD_DIM)
                     for t in jnp.split(proj[..., OFF_B_QKV:], 3, axis=-1)]
    o_b = chunk_band_attention(q_b, k_b, v_b, rel_bias).astype(h.dtype)
    return jnp.concatenate([o_a, o_b], axis=-1) @ w_out


def moe_ffn(h, w_router, b_router, w_up, b_up, w_down, b_down):
    bsz, t_len, d = h.shape
    x = h.reshape(-1, d)
    n_tok = x.shape[0]
    logits = (x @ w_router + b_router).astype(jnp.float32)
    top_val, top_idx = lax.top_k(logits, TOP_K)
    gates = jax.nn.softmax(top_val, axis=-1)
    n_assign = n_tok * TOP_K
    flat_e = top_idx.reshape(-1)
    flat_tok = jnp.repeat(jnp.arange(n_tok, dtype=jnp.int32), TOP_K)
    flat_g = gates.reshape(-1)
    order = jnp.argsort(flat_e, stable=True)
    sorted_e = flat_e[order]
    counts = jnp.bincount(flat_e, length=N_EXPERTS)
    padded = (counts + MOE_BLOCK - 1) // MOE_BLOCK * MOE_BLOCK
    start = jnp.cumsum(counts) - counts
    pend = jnp.cumsum(padded)
    pstart = pend - padded
    dest = pstart[sorted_e] + (jnp.arange(n_assign) - start[sorted_e])
    n_blocks = -(-n_assign // MOE_BLOCK) + N_EXPERTS
    cap = n_blocks * MOE_BLOCK
    slot_tok = jnp.zeros((cap,), jnp.int32).at[dest].set(flat_tok[order])
    slot_g = jnp.zeros((cap,), jnp.float32).at[dest].set(flat_g[order])
    block_e = jnp.minimum(jnp.searchsorted(pend, jnp.arange(n_blocks) * MOE_BLOCK, side='right'),
                          N_EXPERTS - 1)
    xb = x[slot_tok].reshape(n_blocks, MOE_BLOCK, d)

    def expert_block(args):
        xe, e = args
        hu = xe @ w_up[e] + b_up[e]
        glu = jnp.minimum(hu[:, :D_EXPERT], SWIGLU_LIMIT)
        lin = jnp.clip(hu[:, D_EXPERT:], -SWIGLU_LIMIT, SWIGLU_LIMIT)
        act = glu * jax.nn.sigmoid(SWIGLU_ALPHA * glu) * (lin + 1)
        return act @ w_down[e] + b_down[e]

    yb = lax.map(expert_block, (xb, block_e))
    y = yb.reshape(cap, d) * slot_g[:, None].astype(yb.dtype)
    out = jnp.zeros((n_tok, d), y.dtype).at[slot_tok].add(y)
    return out.reshape(bsz, t_len, d)


def setup_inputs(seed: int = 0) -> dict:
    key = jax.random.key(seed)
    ks = jax.random.split(key, 18)
    f32 = jnp.float32
    L, D, E, F = DEPTH, D_MODEL, N_EXPERTS, D_EXPERT

    def nrm(k, shape, s):
        return jax.random.normal(k, shape, f32) * s

    dt = jnp.exp(jax.random.uniform(ks[8], (L, A_HEADS), f32, math.log(1e-3), math.log(1e-1)))
    return {
        'x': nrm(ks[0], (BATCH, SEQ, D), 1.0),
        'c': nrm(ks[1], (BATCH, D), 1.0),
        'w_ada': nrm(ks[2], (L, D, 6 * D), 0.5 * D ** -0.5),
        'b_ada': nrm(ks[3], (L, 6 * D), 0.02),
        'norm_w': 1.0 + nrm(ks[4], (L, 4, D), 0.02),
        'w_in': nrm(ks[5], (L, D, IN_COLS), D ** -0.5),
        'conv_w': nrm(ks[6], (L, CONV_K, 3 * A_WIDTH), CONV_K ** -0.5),
        'a_log': jnp.log(jax.random.uniform(ks[7], (L, A_HEADS), f32, 1.0, 16.0)),
        'dt_bias': dt + jnp.log(-jnp.expm1(-dt)),
        'a_norm_w': 1.0 + nrm(ks[9], (L, A_HEAD_DIM), 0.02),
        'rel_bias': nrm(ks[10], (L, B_HEADS, 2 * REL_CLIP + 1), 0.1),
        'w_out': nrm(ks[11], (L, MIX_WIDTH, D), MIX_WIDTH ** -0.5),
        'w_router': nrm(ks[12], (L, D, E), D ** -0.5),
        'b_router': nrm(ks[13], (L, E), 0.01),
        'w_up': nrm(ks[14], (L, E, D, 2 * F), D ** -0.5),
        'b_up': nrm(ks[15], (L, E, 2 * F), 0.01),
        'w_down': nrm(ks[16], (L, E, F, D), F ** -0.5),
        'b_down': nrm(ks[17], (L, E, D), 0.01),
    }


def reference(x, c, w_ada, b_ada, norm_w, w_in, conv_w, a_log, dt_bias, a_norm_w, rel_bias, w_out,
              w_router, b_router, w_up, b_up, w_down, b_down):
    for l in range(DEPTH):
        mod = jax.nn.silu(c) @ w_ada[l] + b_ada[l]
        sh1, sc1, ga1, sh2, sc2, ga2 = [m[:, None, :] for m in jnp.split(mod, 6, axis=-1)]
        h = rms_norm(x, norm_w[l, 0]) * (1 + sc1) + sh1
        y = hybrid_mixer(h, w_in[l], conv_w[l], a_log[l], dt_bias[l], a_norm_w[l], rel_bias[l], w_out[l])
        x = x + ga1 * rms_norm(y, norm_w[l, 1])
        h = rms_norm(x, norm_w[l, 2]) * (1 + sc2) + sh2
        y = moe_ffn(h, w_router[l], b_router[l], w_up[l], b_up[l], w_down[l], b_down[l])
        x = x + ga2 * rms_norm(y, norm_w[l, 3])
    return x
```

```cpp
#include <hip/hip_runtime.h>
#include <cstdio>
#include <cstdint>

#ifndef MK_ONE_LAUNCH
#define MK_ONE_LAUNCH 1
#endif

namespace pg8 {
#define PG8_LAS __attribute__((address_space(3)))
typedef unsigned short bf16_t;
typedef short bf16x8 __attribute__((ext_vector_type(8)));
typedef float f32x4 __attribute__((ext_vector_type(4)));
typedef unsigned u32x4 __attribute__((ext_vector_type(4)));
constexpr int BM = 256, BK = 64, HALF = 128, HTB = HALF * BK * 2, STAGE_BYTES = 8 * HTB, NXCD = 8, WGM = 8;

__host__ __device__ __forceinline__ int lds_byte(int r, int c) { const int st = (r >> 4) * 2 + (c >> 5), rr = r & 15, cc = c & 31, ob = rr * 64 + cc * 2; return st * 1024 + (ob ^ (((ob >> 9) & 1) << 5)); }
__host__ __device__ __forceinline__ void stage_rc(int b, int& R, int& C) { const int st = b / 1024, sb = b % 1024, swz = sb ^ (((sb >> 9) & 1) << 5); R = (st >> 1) * 16 + swz / 64; C = (st & 1) * 32 + (swz % 64) / 2; }
__host__ __device__ __forceinline__ int perm32(int rho) { const int n = rho >> 4, i = rho & 15; return 8 * (i >> 2) + 4 * n + (i & 3); }

struct Unit { int pm, pn; };
struct Gemm { const bf16_t* A; const bf16_t* Bt; int M, N, K; };

struct StaticOrder {
    int nM, nN, nwg, G, c;
    __host__ __device__ void init(int M, int N, int G_, int c_) { nM = M / BM; nN = N / BM; nwg = nM * nN; G = G_; c = c_; }
    __host__ __device__ bool next(int i, Unit& u) const {
        const long L = (long)i * G + c; if (L >= nwg) return false;
        int wgid = (int)L; { const int q = nwg / NXCD, r = nwg % NXCD, xcd = wgid % NXCD, off = wgid / NXCD; wgid = (xcd < r ? xcd * (q + 1) : r * (q + 1) + (xcd - r) * q) + off; }
        const int nig = WGM * nN, gid = wgid / nig, fm = gid * WGM, gsz = (nM - fm) < WGM ? (nM - fm) : WGM;
        u.pm = fm + ((wgid % nig) % gsz); u.pn = (wgid % nig) / gsz; return true;
    }
    __device__ __forceinline__ size_t boff(const Unit&) const { return 0; }
    const int* rowidx = nullptr;
};
struct MoeOrder : StaticOrder {
    const PG8_LAS int* tile_e; size_t estride;
    __device__ __forceinline__ size_t boff(const Unit& u) const { return (size_t)tile_e[u.pm] * estride; }
};

typedef int v8i_t __attribute__((ext_vector_type(8)));
typedef int v4i_t __attribute__((ext_vector_type(4)));
__device__ __forceinline__ v8i_t cat8(bf16x8 lo, bf16x8 hi) { const v4i_t a = __builtin_bit_cast(v4i_t, lo), b = __builtin_bit_cast(v4i_t, hi); return __builtin_shufflevector(a, b, 0, 1, 2, 3, 4, 5, 6, 7); }
__device__ __forceinline__ unsigned pk4_fp8(float a, float b, float c, float d) {
    a = fminf(fmaxf(a, -448.f), 448.f); b = fminf(fmaxf(b, -448.f), 448.f); c = fminf(fmaxf(c, -448.f), 448.f); d = fminf(fmaxf(d, -448.f), 448.f);
    int w = 0; w = __builtin_amdgcn_cvt_pk_fp8_f32(a, b, w, false); w = __builtin_amdgcn_cvt_pk_fp8_f32(c, d, w, true); return (unsigned)w; }
__device__ __forceinline__ unsigned cvt_pk_bf16(float lo, float hi) { unsigned r; asm volatile("v_cvt_pk_bf16_f32 %0, %1, %2" : "=v"(r) : "v"(lo), "v"(hi)); return r; }

struct EpiF32 {
    static constexpr bool PERM = false;
    float* C; int ldc;
    __device__ __forceinline__ void operator()(const f32x4 (&acc)[2][2][4][2], const Unit& u, int wr, int wc, int fr, int fq) const {
        const int row0 = u.pm * BM + wr * 64 + fr, col0 = u.pn * BM + wc * 32 + 4 * fq;
#pragma unroll
        for (int ai = 0; ai < 2; ++ai)
#pragma unroll
            for (int m = 0; m < 4; ++m) { float* rowp = C + (size_t)(row0 + ai * HALF + m * 16) * ldc + col0;
#pragma unroll
                for (int bj = 0; bj < 2; ++bj)
#pragma unroll
                    for (int n = 0; n < 2; ++n) *(f32x4*)(rowp + bj * HALF + n * 16) = acc[ai][bj][m][n]; }
    }
};
struct EpiBf16 {
    static constexpr bool PERM = true;
    bf16_t* O; int ldc; const float* bias; const PG8_LAS int* tile_e; int bstride; float scale;
    __device__ __forceinline__ void operator()(const f32x4 (&acc)[2][2][4][2], const Unit& u, int wr, int wc, int fr, int fq) const {
        const int row0 = u.pm * BM + wr * 64 + fr; const int col0 = u.pn * BM + wc * 32 + 8 * fq;
        f32x4 bv[2][2];
        const float* bp = bias ? bias + (size_t)tile_e[u.pm] * bstride + col0 : nullptr;
#pragma unroll
        for (int bj = 0; bj < 2; ++bj)
#pragma unroll
            for (int n = 0; n < 2; ++n) bv[bj][n] = bias ? *(const f32x4*)(bp + bj * HALF + 4 * n) : (f32x4){0.f, 0.f, 0.f, 0.f};
#pragma unroll
        for (int ai = 0; ai < 2; ++ai)
#pragma unroll
            for (int m = 0; m < 4; ++m) { bf16_t* rowp = O + (size_t)(row0 + ai * HALF + m * 16) * ldc + col0;
#pragma unroll
                for (int bj = 0; bj < 2; ++bj) { f32x4 v0 = acc[ai][bj][m][0] * scale + bv[bj][0], v1 = acc[ai][bj][m][1] * scale + bv[bj][1];
                    u32x4 w; w.x = cvt_pk_bf16(v0[0], v0[1]); w.y = cvt_pk_bf16(v0[2], v0[3]); w.z = cvt_pk_bf16(v1[0], v1[1]); w.w = cvt_pk_bf16(v1[2], v1[3]);
                    *(u32x4*)(rowp + bj * HALF) = w; } }
    }
};
struct EpiSwiGLU {
    static constexpr bool PERM = true;
    unsigned char* O; const float* b_up; const PG8_LAS int* tile_e; float scale;
    __device__ __forceinline__ float act1(float g, float l) const {
        g = fminf(g, 7.0f); l = fminf(fmaxf(l, -7.0f), 7.0f);
        const float s = __builtin_amdgcn_rcpf(1.0f + __expf(-1.702f * g));
        return g * s * (l + 1.0f);
    }
    __device__ __forceinline__ void operator()(const f32x4 (&acc)[2][2][4][2], const Unit& u, int wr, int wc, int fr, int fq) const {
        const int row0 = u.pm * BM + wr * 64 + fr; const int cin = wc * 32 + 8 * fq;
        const float* bg = b_up + (size_t)tile_e[u.pm] * 2048 + 128 * u.pn + cin;
        f32x4 bgv[2], blv[2];
#pragma unroll
        for (int n = 0; n < 2; ++n) { bgv[n] = *(const f32x4*)(bg + 4 * n); blv[n] = *(const f32x4*)(bg + 1024 + 4 * n); }
#pragma unroll
        for (int ai = 0; ai < 2; ++ai)
#pragma unroll
            for (int m = 0; m < 4; ++m) { unsigned char* rowp = O + (size_t)(row0 + ai * HALF + m * 16) * 1024 + 128 * u.pn + cin;
                const f32x4 g0 = acc[ai][0][m][0] * scale + bgv[0], g1 = acc[ai][0][m][1] * scale + bgv[1], l0 = acc[ai][1][m][0] * scale + blv[0], l1 = acc[ai][1][m][1] * scale + blv[1];
                unsigned w0 = pk4_fp8(act1(g0[0], l0[0]), act1(g0[1], l0[1]), act1(g0[2], l0[2]), act1(g0[3], l0[3]));
                unsigned w1 = pk4_fp8(act1(g1[0], l1[0]), act1(g1[1], l1[1]), act1(g1[2], l1[2]), act1(g1[3], l1[3]));
                typedef unsigned u32x2_t __attribute__((ext_vector_type(2)));
                *(u32x2_t*)rowp = (u32x2_t){w0, w1}; }
    }
};

template <class Epi, class Sched, bool ALIGN_EPI = false, bool SP2 = false, bool F8 = false, bool GATHER = false>
__device__ __forceinline__ void gemm_phase(PG8_LAS unsigned char* lds, const Gemm g, const Sched& S, const Epi& E, const int tid) {
    const int wid = __builtin_amdgcn_readfirstlane(tid >> 6), lane = tid & 63, wr = wid >> 2, wc = wid & 3, fr = lane & 15, fq = lane >> 4;
    constexpr int ES = F8 ? 1 : 2;
    const int K = g.K, nt = K * ES / 128;
    unsigned voffA[2], voffB[2]; int gR[2], gC[2];
#pragma unroll
    for (int i = 0; i < 2; ++i) { int R, C; stage_rc(tid * 16 + i * 8192, R, C); const int Rb = Epi::PERM ? ((R & ~31) + perm32(R & 31)) : R; gR[i] = R; gC[i] = C * 2;
        voffA[i] = (unsigned)(R * K * ES + C * 2); voffB[i] = (unsigned)(Rb * K * ES + C * 2); }
    unsigned vAc0[2] = {0u, 0u}, vAc1[2] = {0u, 0u}, vAn0[2] = {0u, 0u}, vAn1[2] = {0u, 0u};
#define PG8_GIDX(dst0, dst1, u_) do { _Pragma("unroll") for (int _i = 0; _i < 2; ++_i) { \
        dst0[_i] = (unsigned)S.rowidx[(u_).pm * BM + gR[_i]] * (unsigned)(K * ES) + (unsigned)gC[_i]; dst1[_i] = (unsigned)S.rowidx[(u_).pm * BM + HALF + gR[_i]] * (unsigned)(K * ES) + (unsigned)gC[_i]; } } while (0)
    const size_t kstep = (size_t)(BK * 2);
    const size_t hstep = (size_t)HALF * K * ES;
    const size_t tstep = 2 * hstep;
    const unsigned ldsw = (unsigned)wid * 1024u;
    const int aoff = lds_byte(wr * 64 + fr, fq * 8), boff = lds_byte(wc * 32 + fr, fq * 8);
#define PG8_SA(b, h) (((b) * 2 + (h)) * HTB)
#define PG8_SB(b, h) ((4 + (b) * 2 + (h)) * HTB)
#define PG8_STAGE(bufoff, gbase, voff) do { _Pragma("unroll") for (int _i = 0; _i < 2; ++_i) \
        __builtin_amdgcn_global_load_lds((const unsigned*)((const char*)(gbase) + (voff)[_i]), (PG8_LAS unsigned*)(lds + (bufoff) + ldsw + _i * 8192), 16, 0, 0); } while (0)
#define PG8_STAGE_A(bufoff, ptr_, half_, koff_, nxt_) do { if constexpr (GATHER) { _Pragma("unroll") for (int _i = 0; _i < 2; ++_i) { \
            const unsigned vo_ = (half_) ? ((nxt_) ? vAn1[_i] : vAc1[_i]) : ((nxt_) ? vAn0[_i] : vAc0[_i]); \
            __builtin_amdgcn_global_load_lds((const unsigned*)((const char*)g.A + (koff_) + vo_), (PG8_LAS unsigned*)(lds + (bufoff) + ldsw + _i * 8192), 16, 0, 0); } } \
        else PG8_STAGE(bufoff, ptr_, voffA); } while (0)
#define PG8_LDA(dst, b, h) do { _Pragma("unroll") for (int m = 0; m < 4; ++m) _Pragma("unroll") for (int k = 0; k < 2; ++k) dst[m][k] = *(const PG8_LAS bf16x8*)(lds + PG8_SA(b, h) + aoff + m * 2048 + k * 1024); } while (0)
#define PG8_LDB(dst, b, h) do { _Pragma("unroll") for (int n = 0; n < 2; ++n) _Pragma("unroll") for (int k = 0; k < 2; ++k) dst[n][k] = *(const PG8_LAS bf16x8*)(lds + PG8_SB(b, h) + boff + n * 2048 + k * 1024); } while (0)
#define PG8_MMA(ai, bj, At, Bt) do { __builtin_amdgcn_s_setprio(1); _Pragma("unroll") for (int m = 0; m < 4; ++m) _Pragma("unroll") for (int n = 0; n < 2; ++n) { \
        if constexpr (F8) { asm volatile("v_mfma_scale_f32_16x16x128_f8f6f4 %0, %1, %2, %0, %3, %3 op_sel_hi:[0,0,0]" : "+v"(acc[ai][bj][m][n]) : "v"(cat8(Bt[n][0], Bt[n][1])), "v"(cat8(At[m][0], At[m][1])), "v"(0x7f7f7f7f)); } \
        else { _Pragma("unroll") for (int k = 0; k < 2; ++k) acc[ai][bj][m][n] = __builtin_amdgcn_mfma_f32_16x16x32_bf16(Bt[n][k], At[m][k], acc[ai][bj][m][n], 0, 0, 0); } } \
        __builtin_amdgcn_s_setprio(0); } while (0)
#define PG8_WAIT_V(n) asm volatile("s_waitcnt vmcnt(" #n ")" ::: "memory")
#define PG8_WAIT_L(n) asm volatile("s_waitcnt lgkmcnt(" #n ")" ::: "memory")
#define PG8_BAR __builtin_amdgcn_s_barrier()
#define PG8_SCHED __builtin_amdgcn_sched_barrier(0)
    Unit cur, nxt; int ui = 0;
    if (!S.next(0, cur)) return;
    f32x4 acc[2][2][4][2];
#pragma unroll
    for (int a = 0; a < 2; ++a)
#pragma unroll
        for (int b = 0; b < 2; ++b)
#pragma unroll
            for (int m = 0; m < 4; ++m)
#pragma unroll
                for (int n = 0; n < 2; ++n) acc[a][b][m][n] = (f32x4){0.f, 0.f, 0.f, 0.f};
    bf16x8 At[4][2], B0[2][2], B1[2][2];
    const char* cA = (const char*)g.A + (size_t)cur.pm * tstep; const char* cB = (const char*)g.Bt + S.boff(cur) + (size_t)cur.pn * tstep;
    if constexpr (GATHER) { PG8_GIDX(vAc0, vAc1, cur); }
    if constexpr (SP2) {
        PG8_STAGE(PG8_SB(0, 0), cB, voffB); PG8_STAGE(PG8_SB(0, 1), cB + hstep, voffB); PG8_STAGE_A(PG8_SA(0, 0), cA, 0, 0, false); PG8_STAGE_A(PG8_SA(0, 1), cA + hstep, 1, 0, false);
        if (wr == 1) PG8_BAR;
        PG8_WAIT_V(2); PG8_BAR;
        PG8_STAGE(PG8_SB(1, 0), cB + kstep, voffB); PG8_STAGE_A(PG8_SA(1, 0), cA + kstep, 0, kstep, false); PG8_STAGE(PG8_SB(1, 1), cB + hstep + kstep, voffB);
        PG8_WAIT_V(6); PG8_BAR;
    } else {
        PG8_STAGE(PG8_SB(0, 0), cB, voffB); PG8_STAGE(PG8_SA(0, 0), cA, voffA); PG8_STAGE(PG8_SB(0, 1), cB + hstep, voffB); PG8_STAGE(PG8_SA(0, 1), cA + hstep, voffA);
        if (wr == 1) PG8_BAR;
        PG8_WAIT_V(4); PG8_BAR;
        PG8_STAGE(PG8_SB(1, 0), cB + kstep, voffB); PG8_STAGE(PG8_SA(1, 0), cA + kstep, voffA); PG8_STAGE(PG8_SB(1, 1), cB + hstep + kstep, voffB);
        PG8_WAIT_V(6); PG8_BAR;
    }
    for (;;) {
        const bool has_next = S.next(ui + 1, nxt);
        const char* nA = has_next ? (const char*)g.A + (size_t)nxt.pm * tstep : cA; const char* nB = has_next ? (const char*)g.Bt + S.boff(nxt) + (size_t)nxt.pn * tstep : cB;
        if constexpr (GATHER) {
            if (has_next) { if (wid == 0) __builtin_amdgcn_global_load_lds((const unsigned*)(S.rowidx + (size_t)nxt.pm * BM + lane * 4), (PG8_LAS unsigned*)(lds + 131072 + ((ui + 1) & 1) * 1024), 16, 0, 0); }
            else { vAn0[0] = vAc0[0]; vAn0[1] = vAc0[1]; vAn1[0] = vAc1[0]; vAn1[1] = vAc1[1]; } }
        for (int t = 0; t < nt; t += 2) {
            const bool last = (t == nt - 2);
            const char* a1 = cA + (size_t)(t + 1) * kstep;
            const char* a2 = last ? nA : cA + (size_t)(t + 2) * kstep; const char* b2 = last ? nB : cB + (size_t)(t + 2) * kstep;
            const char* a3 = a2 + kstep; const char* b3 = b2 + kstep;
            const size_t ko1 = (size_t)(t + 1) * kstep, ko2 = last ? 0 : (size_t)(t + 2) * kstep, ko3 = ko2 + kstep;
            if constexpr (GATHER) { if (last && has_next) { const PG8_LAS int* ix_ = (const PG8_LAS int*)(lds + 131072 + ((ui + 1) & 1) * 1024);
#pragma unroll
                for (int _i = 0; _i < 2; ++_i) { vAn0[_i] = (unsigned)ix_[gR[_i]] * (unsigned)(K * ES) + (unsigned)gC[_i]; vAn1[_i] = (unsigned)ix_[HALF + gR[_i]] * (unsigned)(K * ES) + (unsigned)gC[_i]; } } }
            if constexpr (SP2) {
            PG8_LDB(B0, 0, 0); PG8_LDB(B1, 0, 1); PG8_SCHED; PG8_LDA(At, 0, 0); PG8_STAGE_A(PG8_SA(1, 1), a1 + hstep, 1, ko1, false);
            PG8_WAIT_V(8); PG8_WAIT_L(0); PG8_BAR; PG8_MMA(0, 0, At, B0); PG8_MMA(0, 1, At, B1); PG8_BAR; PG8_SCHED;
            PG8_LDA(At, 0, 1); PG8_STAGE(PG8_SB(0, 0), b2, voffB); PG8_STAGE(PG8_SB(0, 1), b2 + hstep, voffB); PG8_STAGE_A(PG8_SA(0, 0), a2, 0, ko2, last);
            PG8_WAIT_V(8); PG8_WAIT_L(0); PG8_BAR; PG8_MMA(1, 0, At, B0); PG8_MMA(1, 1, At, B1); PG8_BAR; PG8_SCHED;
            PG8_LDB(B0, 1, 0); PG8_LDB(B1, 1, 1); PG8_SCHED; PG8_LDA(At, 1, 0); PG8_STAGE_A(PG8_SA(0, 1), a2 + hstep, 1, ko2, last);
            PG8_WAIT_V(8); PG8_WAIT_L(0); PG8_BAR; PG8_MMA(0, 0, At, B0); PG8_MMA(0, 1, At, B1); PG8_BAR; PG8_SCHED;
            PG8_LDA(At, 1, 1); PG8_STAGE(PG8_SB(1, 0), b3, voffB); PG8_STAGE(PG8_SB(1, 1), b3 + hstep, voffB); PG8_STAGE_A(PG8_SA(1, 0), a3, 0, ko3, last);
            PG8_WAIT_V(8); PG8_WAIT_L(0); PG8_BAR; PG8_MMA(1, 0, At, B0); PG8_MMA(1, 1, At, B1); PG8_BAR; PG8_SCHED;
            } else {
            PG8_LDB(B0, 0, 0); PG8_SCHED; PG8_LDA(At, 0, 0); PG8_STAGE(PG8_SA(1, 1), a1 + hstep, voffA);
            PG8_WAIT_L(8); PG8_BAR; PG8_WAIT_L(0); PG8_MMA(0, 0, At, B0); PG8_BAR; PG8_SCHED;
            PG8_LDB(B1, 0, 1); PG8_STAGE(PG8_SB(0, 0), b2, voffB);
            PG8_BAR; PG8_WAIT_L(0); PG8_MMA(0, 1, At, B1); PG8_BAR;
            PG8_LDA(At, 0, 1); PG8_STAGE(PG8_SA(0, 0), a2, voffA);
            PG8_BAR; PG8_WAIT_L(0); PG8_MMA(1, 0, At, B0); PG8_BAR; PG8_SCHED;
            PG8_STAGE(PG8_SB(0, 1), b2 + hstep, voffB);
            PG8_WAIT_V(6); PG8_BAR; PG8_MMA(1, 1, At, B1); PG8_BAR;
            PG8_LDB(B0, 1, 0); PG8_SCHED; PG8_LDA(At, 1, 0); PG8_STAGE(PG8_SA(0, 1), a2 + hstep, voffA);
            PG8_WAIT_L(8); PG8_BAR; PG8_WAIT_L(0); PG8_MMA(0, 0, At, B0); PG8_BAR; PG8_SCHED;
            PG8_LDB(B1, 1, 1); PG8_STAGE(PG8_SB(1, 0), b3, voffB);
            PG8_BAR; PG8_WAIT_L(0); PG8_MMA(0, 1, At, B1); PG8_BAR;
            PG8_LDA(At, 1, 1); PG8_STAGE(PG8_SA(1, 0), a3, voffA);
            PG8_BAR; PG8_WAIT_L(0); PG8_MMA(1, 0, At, B0); PG8_BAR; PG8_SCHED;
            PG8_STAGE(PG8_SB(1, 1), b3 + hstep, voffB);
            PG8_WAIT_V(6); PG8_BAR; PG8_MMA(1, 1, At, B1); PG8_BAR;
            }
        }
        if constexpr (ALIGN_EPI) { if (wr == 0) PG8_BAR; }
        E(acc, cur, wr, wc, fr, fq);
        if (!has_next) break;
#pragma unroll
        for (int a = 0; a < 2; ++a)
#pragma unroll
            for (int b = 0; b < 2; ++b)
#pragma unroll
                for (int m = 0; m < 4; ++m)
#pragma unroll
                    for (int n = 0; n < 2; ++n) acc[a][b][m][n] = (f32x4){0.f, 0.f, 0.f, 0.f};
        cur = nxt; cA = nA; cB = nB; ++ui;
        if constexpr (GATHER) { vAc0[0] = vAn0[0]; vAc0[1] = vAn0[1]; vAc1[0] = vAn1[0]; vAc1[1] = vAn1[1]; }
        if constexpr (ALIGN_EPI) { if (wr == 1) PG8_BAR; }
    }
    PG8_WAIT_V(0);
    if constexpr (!ALIGN_EPI) { if (wr == 0) PG8_BAR; }
    PG8_BAR;
#undef PG8_SA
#undef PG8_SB
#undef PG8_STAGE
#undef PG8_LDA
#undef PG8_STAGE_A
#undef PG8_GIDX
#undef PG8_LDB
#undef PG8_MMA
#undef PG8_WAIT_V
#undef PG8_WAIT_L
#undef PG8_BAR
#undef PG8_SCHED
}
}

constexpr int NWAVES = 8, NTHR = 512;
constexpr int BATCH = 2, T = 8192, D = 1024, NTOK = BATCH * T;
constexpr int IN_COLS = 3592, PCOLS = 3584;
constexpr int NE = 32, NASSIGN = NTOK * 4, MAXTILES = NASSIGN / 256 + NE;
constexpr float EPS = 1e-6f;

constexpr size_t MiB = 1u << 20;
constexpr size_t WS_CTL = 0, CTL_ZERO_BYTES = 1 * MiB;
constexpr size_t WS_MOD = 1 * MiB;
constexpr size_t WS_G = WS_MOD + 64 * 1024;
constexpr size_t WS_BETA = WS_G + 256 * 1024;
constexpr size_t WS_GL = WS_BETA + 256 * 1024;
constexpr size_t WS_AE = WS_GL + 64 * 1024;
constexpr size_t WS_AP = WS_AE + 256 * 1024;
constexpr size_t WS_AG = WS_AP + 256 * 1024;
constexpr size_t WS_AS = WS_AG + 256 * 1024;
constexpr size_t WS_WG = WS_AS + 256 * 1024;
constexpr size_t WS_STOK = WS_WG + 64 * 1024;
constexpr size_t WS_WIN = 8 * MiB;
constexpr size_t WS_WOUT = 16 * MiB;
constexpr size_t WS_WUP = 20 * MiB;
constexpr size_t WS_WDN = 148 * MiB;
constexpr size_t WS_H = 212 * MiB;
constexpr size_t WS_PROJ = 244 * MiB;
constexpr size_t WS_U = 356 * MiB;
constexpr size_t WS_OPS = 388 * MiB;
constexpr int OPS_BYTES = 57344;
constexpr size_t WS_QF = 444 * MiB, WS_KF = 460 * MiB, WS_VTF = 476 * MiB;
constexpr size_t WS_OSCAN = 500 * MiB;
constexpr size_t WS_OMIX = 532 * MiB;
constexpr size_t WS_Y = 564 * MiB;
constexpr size_t WS_XG = 244 * MiB;
constexpr size_t WS_ACT = 388 * MiB;
constexpr size_t WS_ZS = 628 * MiB;
constexpr size_t WS_SEG = 644 * MiB;
constexpr size_t WS_SST = 652 * MiB;
constexpr size_t WS_SEGP = 656 * MiB;
constexpr size_t WS_END = 660 * MiB;
constexpr int CW_CNT = 64;
constexpr int CW_SEGA = 1024, CW_SEGB = 2048;
constexpr int CW_BAR = 4096;
constexpr int CW_HIST = 16384;

constexpr int LDS_BYTES = 163840, MISC_OFF = 161792;

#define GAS __attribute__((address_space(1)))
#define LAS __attribute__((address_space(3)))
typedef unsigned short bf16;
typedef unsigned v4u __attribute__((ext_vector_type(4)));
typedef unsigned v2u __attribute__((ext_vector_type(2)));
typedef float f32x4 __attribute__((ext_vector_type(4)));
typedef LAS float ldsf;
#define RLX_AGENT __ATOMIC_RELAXED, __HIP_MEMORY_SCOPE_AGENT
__device__ __forceinline__ unsigned f2bf(float f) { unsigned u = __builtin_bit_cast(unsigned, f); return (u + 0x7fffu + ((u >> 16) & 1u)) >> 16; }
__device__ __forceinline__ unsigned pk2(float lo, float hi) { return f2bf(lo) | (f2bf(hi) << 16); }
__device__ __forceinline__ float bf2f(unsigned h) { return __builtin_bit_cast(float, h << 16); }
__device__ __forceinline__ float bflo(unsigned w) { return __builtin_bit_cast(float, w << 16); }
__device__ __forceinline__ float bfhi(unsigned w) { return __builtin_bit_cast(float, w & 0xffff0000u); }
template <int CTRL, int ROWMASK> __device__ __forceinline__ float dppf(float v) {
    return __builtin_bit_cast(float, __builtin_amdgcn_update_dpp(0, __builtin_bit_cast(int, v), CTRL, ROWMASK, 0xF, false)); }
__device__ __forceinline__ float wave_sum(float v) {
    v += dppf<0x111, 0xF>(v); v += dppf<0x112, 0xF>(v); v += dppf<0x114, 0xF>(v); v += dppf<0x118, 0xF>(v);
    v += dppf<0x142, 0xA>(v); v += dppf<0x143, 0xC>(v);
    return __builtin_bit_cast(float, __builtin_amdgcn_readlane(__builtin_bit_cast(int, v), 63));
}
__device__ __forceinline__ float xchg32(float send, int lane) { const unsigned u = __builtin_bit_cast(unsigned, send); const auto r_ = __builtin_amdgcn_permlane32_swap(u, u, false, false); return __builtin_bit_cast(float, lane < 32 ? r_[1] : r_[0]); }
__device__ __forceinline__ float xchg16(float send, int lane) { const unsigned u = __builtin_bit_cast(unsigned, send); const auto r_ = __builtin_amdgcn_permlane16_swap(u, u, false, false); return __builtin_bit_cast(float, (lane & 16) ? r_[0] : r_[1]); }
template <int CTRL> __device__ __forceinline__ float dppx(float v) { return __builtin_bit_cast(float, __builtin_amdgcn_update_dpp(0, __builtin_bit_cast(int, v), CTRL, 0xF, 0xF, false)); }
template <int CTRL, int ROWMASK> __device__ __forceinline__ float dppf_o(float v, float old) { return __builtin_bit_cast(float, __builtin_amdgcn_update_dpp(__builtin_bit_cast(int, old), __builtin_bit_cast(int, v), CTRL, ROWMASK, 0xF, false)); }
template <int CTRL, int ROWMASK> __device__ __forceinline__ int dppi_o(int v, int old) { return __builtin_amdgcn_update_dpp(old, v, CTRL, ROWMASK, 0xF, false); }
__device__ __forceinline__ float wave_max(float v) {
    const float ni = -3.4e38f;
    v = fmaxf(v, dppf_o<0x111, 0xF>(v, ni)); v = fmaxf(v, dppf_o<0x112, 0xF>(v, ni)); v = fmaxf(v, dppf_o<0x114, 0xF>(v, ni)); v = fmaxf(v, dppf_o<0x118, 0xF>(v, ni));
    v = fmaxf(v, dppf_o<0x142, 0xA>(v, ni)); v = fmaxf(v, dppf_o<0x143, 0xC>(v, ni));
    return __builtin_bit_cast(float, __builtin_amdgcn_readlane(__builtin_bit_cast(int, v), 63));
}
__device__ __forceinline__ int wave_min_i(int v) {
    const int mi = 0x7fffffff;
    v = min(v, dppi_o<0x111, 0xF>(v, mi)); v = min(v, dppi_o<0x112, 0xF>(v, mi)); v = min(v, dppi_o<0x114, 0xF>(v, mi)); v = min(v, dppi_o<0x118, 0xF>(v, mi));
    v = min(v, dppi_o<0x142, 0xA>(v, mi)); v = min(v, dppi_o<0x143, 0xC>(v, mi));
    return __builtin_amdgcn_readlane(v, 63);
}
__device__ __forceinline__ float siluf(float x) { return x * __builtin_amdgcn_rcpf(1.0f + __builtin_amdgcn_exp2f(-1.4426950408889634f * x)); }
typedef float f32x16 __attribute__((ext_vector_type(16)));
typedef short bf16x8 __attribute__((ext_vector_type(8)));
typedef float f32x2_t __attribute__((ext_vector_type(2)));
typedef __bf16 bf16x2_t __attribute__((ext_vector_type(2)));
__device__ __forceinline__ unsigned cvtpk(float lo, float hi) { f32x2_t v = {lo, hi}; bf16x2_t b = __builtin_convertvector(v, bf16x2_t); return __builtin_bit_cast(unsigned, b); }
__device__ __forceinline__ bf16x8 pack8(const f32x16& x, int s) {
    v4u p; p.x = cvtpk(x[8 * s], x[8 * s + 1]); p.y = cvtpk(x[8 * s + 2], x[8 * s + 3]); p.z = cvtpk(x[8 * s + 4], x[8 * s + 5]); p.w = cvtpk(x[8 * s + 6], x[8 * s + 7]);
    return __builtin_bit_cast(bf16x8, p);
}
__device__ __forceinline__ int crow(int q, int h) { return (q & 3) + 8 * (q >> 2) + 4 * h; }
#define MFMA32(a, b, c) __builtin_amdgcn_mfma_f32_32x32x16_bf16((a), (b), (c), 0, 0, 0)

#define XB_TMO      128
#define XB_XCNT(j)  (256  + 64 * (j))
#define XB_XSUB(j)  (1280 + 64 * (j))
#define XB_XGEN(j)  (2304 + 64 * (j))
#define XB_TOP      3328
#define XB_TOPGEN   3392
#define XCD_BAR_WORDS 3456
#define XB_SPIN_CAP (1u << 22)
__device__ __forceinline__ unsigned xb_ld(unsigned* p)              { return __hip_atomic_load(p, __ATOMIC_RELAXED, __HIP_MEMORY_SCOPE_AGENT); }
__device__ __forceinline__ unsigned xb_add(unsigned* p, unsigned v) { return __hip_atomic_fetch_add(p, v, __ATOMIC_RELAXED, __HIP_MEMORY_SCOPE_AGENT); }
__device__ __forceinline__ unsigned xb_xcc_id() { return (unsigned)__builtin_amdgcn_s_getreg((3 << 11) | 20) & 0xFu; }
#define XB_SPIN(cond, bar) do { unsigned _sp = 0; while (cond) { __builtin_amdgcn_s_sleep(1); \
    if ((++_sp & 255u) == 0u) { if (xb_ld(&(bar)[XB_TMO])) break; if (_sp > XB_SPIN_CAP) { atomicAdd(&(bar)[XB_TMO], 1u); break; } } } } while (0)
struct XcdBarrier { unsigned* bar; unsigned x; volatile LAS unsigned* st; };
__device__ __forceinline__ XcdBarrier xcd_barrier_post(unsigned* bar, volatile LAS unsigned* st) {
    XcdBarrier b; b.bar = bar; b.x = xb_xcc_id(); b.st = st;
    if (threadIdx.x == 0) (void)xb_add(&bar[XB_XCNT(b.x)], 1u);
    return b;
}
__device__ __forceinline__ void xcd_barrier_complete(unsigned* bar, unsigned x, unsigned& nloc, unsigned& nx) {
    const unsigned G = gridDim.x * gridDim.y * gridDim.z;
    unsigned sum, cnt, mine, sp = 0u;
    for (;;) {
        sum = 0u; cnt = 0u; mine = 0u;
#pragma unroll
        for (unsigned j = 0; j < 16; ++j) { const unsigned c = xb_ld(&bar[XB_XCNT(j)]); sum += c; cnt += (c > 0u) ? 1u : 0u; mine = (j == x) ? c : mine; }
        if (sum == G) break;
        __builtin_amdgcn_s_sleep(1);
        if ((++sp & 255u) == 0u) { if (xb_ld(&bar[XB_TMO])) break; if (sp > XB_SPIN_CAP) { atomicAdd(&bar[XB_TMO], 1u); break; } }
    }
    nloc = mine > 0u ? mine : 1u; nx = cnt > 0u ? cnt : 1u;
}
__device__ __forceinline__ void xcd_barrier(const XcdBarrier& b, const int tid) {
    asm volatile("s_waitcnt vmcnt(0)" ::: "memory");
    __syncthreads();
    if (tid == 0) {
        unsigned* bar = b.bar;
        __builtin_amdgcn_s_waitcnt(0);
        unsigned nloc = b.st[0], nx = b.st[1];
        if (nloc == 0u) { xcd_barrier_complete(bar, b.x, nloc, nx); b.st[0] = nloc; b.st[1] = nx; }
        const unsigned old = xb_add(&bar[XB_XSUB(b.x)], 1u);
        const unsigned gen = old / nloc;
        if (old + 1u == (gen + 1u) * nloc) {
            __builtin_amdgcn_fence(__ATOMIC_RELEASE, "agent");
            asm volatile("s_waitcnt vmcnt(0)" ::: "memory");
            const unsigned og = xb_add(&bar[XB_TOP], 1u);
            const unsigned tg = og / nx;
            if (og + 1u == (tg + 1u) * nx) xb_add(&bar[XB_TOPGEN], 1u);
            else XB_SPIN(xb_ld(&bar[XB_TOPGEN]) == tg, bar);
            __builtin_amdgcn_fence(__ATOMIC_ACQUIRE, "agent");
            xb_add(&bar[XB_XGEN(b.x)], 1u);
            asm volatile("s_waitcnt vmcnt(0)" ::: "memory");
        } else {
            XB_SPIN(xb_ld(&bar[XB_XGEN(b.x)]) == gen, bar);
            __builtin_amdgcn_fence(__ATOMIC_ACQUIRE, "agent");
            asm volatile("s_waitcnt vmcnt(0)" ::: "memory");
        }
    }
    __syncthreads();
}

struct Args {
    const float* in[18]; float* out; unsigned char* ws; int ph_lo, ph_hi, li, pad;
};
enum { I_X = 0, I_C, I_WADA, I_BADA, I_NORMW, I_WIN, I_CONVW, I_ALOG, I_DTB, I_ANW, I_RELB, I_WOUT, I_WR, I_BR, I_WUP, I_BUP, I_WDN, I_BDN };

__device__ __forceinline__ int map_row(int mode, int n) {
    if (mode == 0) return n < 2048 ? n : (n < 2056 ? -1 : n - 8);
    if (mode == 2) { const int j = n & 1023, half = n >> 10; return (j >> 7) * 256 + half * 128 + (j & 127); }
    return n;
}
__device__ __forceinline__ void transpose_item(const float* W, int K, int N, bf16* WT, int mode, ldsf* scr, int item, int lane) {
    const int nblk = (N + 31) / 32, kb = item / nblk, nb = item % nblk, k0 = 64 * kb, n0 = 32 * nb;
    const int nn = n0 + (lane & 31);
#pragma unroll 8
    for (int i = 0; i < 32; ++i) { const int kk = 2 * i + (lane >> 5); scr[kk * 33 + (lane & 31)] = (nn < N) ? W[(size_t)(k0 + kk) * N + nn] : 0.f; }
    asm volatile("s_waitcnt lgkmcnt(0)" ::: "memory");
    const int c = lane & 7;
#pragma unroll
    for (int j = 0; j < 4; ++j) { const int nl = (lane >> 3) + 8 * j; const int n = n0 + nl; const ldsf* s = scr + (8 * c) * 33 + nl;
        const int row = (n < N) ? map_row(mode, n) : -1;
        v4u o; o.x = pk2(s[0 * 33], s[1 * 33]); o.y = pk2(s[2 * 33], s[3 * 33]); o.z = pk2(s[4 * 33], s[5 * 33]); o.w = pk2(s[6 * 33], s[7 * 33]);
        if (row >= 0) *(v4u*)(WT + (size_t)row * K + k0 + 8 * c) = o; }
    asm volatile("s_waitcnt lgkmcnt(0)" ::: "memory");
}
__device__ __forceinline__ void transpose_item8(const float* W, int K, int N, unsigned char* WT, int mode, ldsf* scr, int item, int lane) {
    const int nblk = N / 32, kb = item / nblk, nb = item % nblk, k0 = 64 * kb, n0 = 32 * nb;
#pragma unroll 8
    for (int i = 0; i < 32; ++i) { const int kk = 2 * i + (lane >> 5); scr[kk * 33 + (lane & 31)] = __builtin_nontemporal_load(W + (size_t)(k0 + kk) * N + n0 + (lane & 31)); }
    asm volatile("s_waitcnt lgkmcnt(0)" ::: "memory");
    const int nl = lane >> 1, kh = lane & 1; const ldsf* sp = scr + (32 * kh) * 33 + nl;
    const int row = map_row(mode, n0 + nl);
    v4u o0, o1;
    o0.x = pg8::pk4_fp8(sp[0 * 33] * 32.f, sp[1 * 33] * 32.f, sp[2 * 33] * 32.f, sp[3 * 33] * 32.f);     o0.y = pg8::pk4_fp8(sp[4 * 33] * 32.f, sp[5 * 33] * 32.f, sp[6 * 33] * 32.f, sp[7 * 33] * 32.f);
    o0.z = pg8::pk4_fp8(sp[8 * 33] * 32.f, sp[9 * 33] * 32.f, sp[10 * 33] * 32.f, sp[11 * 33] * 32.f);   o0.w = pg8::pk4_fp8(sp[12 * 33] * 32.f, sp[13 * 33] * 32.f, sp[14 * 33] * 32.f, sp[15 * 33] * 32.f);
    o1.x = pg8::pk4_fp8(sp[16 * 33] * 32.f, sp[17 * 33] * 32.f, sp[18 * 33] * 32.f, sp[19 * 33] * 32.f); o1.y = pg8::pk4_fp8(sp[20 * 33] * 32.f, sp[21 * 33] * 32.f, sp[22 * 33] * 32.f, sp[23 * 33] * 32.f);
    o1.z = pg8::pk4_fp8(sp[24 * 33] * 32.f, sp[25 * 33] * 32.f, sp[26 * 33] * 32.f, sp[27 * 33] * 32.f); o1.w = pg8::pk4_fp8(sp[28 * 33] * 32.f, sp[29 * 33] * 32.f, sp[30 * 33] * 32.f, sp[31 * 33] * 32.f);
    unsigned char* dst = WT + (size_t)row * K + k0 + 32 * kh;
    __builtin_nontemporal_store(o0, (v4u*)dst); __builtin_nontemporal_store(o1, (v4u*)(dst + 16));
    asm volatile("s_waitcnt lgkmcnt(0)" ::: "memory");
}
__device__ __forceinline__ void mod_item(const float* c, const float* w_ada, const float* b_ada, float* mod, int item, ldsf* red, int tid, int lane, int wave) {
    const int j0 = item * 24;
    float a0[24], a1[24];
#pragma unroll
    for (int k = 0; k < 24; ++k) { a0[k] = 0.f; a1[k] = 0.f; }
#pragma unroll
    for (int rr = 0; rr < 2; ++rr) {
        const int d = tid + rr * 512;
        const float s0 = siluf(c[d]), s1 = siluf(c[1024 + d]);
        const f32x4* wp = (const f32x4*)(w_ada + (size_t)d * 6144 + j0);
#pragma unroll
        for (int q = 0; q < 6; ++q) { const f32x4 w = wp[q];
#pragma unroll
            for (int e = 0; e < 4; ++e) { a0[4 * q + e] += s0 * w[e]; a1[4 * q + e] += s1 * w[e]; } }
    }
#pragma unroll
    for (int k = 0; k < 24; ++k) { a0[k] = wave_sum(a0[k]); a1[k] = wave_sum(a1[k]); }
    if (lane == 0) {
#pragma unroll
        for (int k = 0; k < 24; ++k) { red[wave * 48 + k] = a0[k]; red[wave * 48 + 24 + k] = a1[k]; }
    }
    __syncthreads();
    if (tid < 48) { float s = 0.f;
#pragma unroll
        for (int w = 0; w < 8; ++w) s += red[w * 48 + tid];
        const int b = tid / 24, k = tid % 24; mod[b * 6144 + j0 + k] = s + b_ada[j0 + k]; }
    __syncthreads();
}

#define SB() __builtin_amdgcn_sched_barrier(0)
#define GI_W(mt, t2, s2) ((((mt) * 4 + (t2)) * 2) + (s2))
#define GI_Q(mt, t2, s2) (16 + (((mt) * 4 + (t2)) * 2) + (s2))
#define GI_K(t2, mt, s2) (32 + (((t2) * 2 + (mt)) * 2) + (s2))
#define GI_A(mt, mp, s2) (48 + (((mt) * 2 + (mp)) * 2) + (s2))
#define FRAG(f_) (*(const LAS bf16x8*)(Bf + (f_) * 1024))
#define LD_WQ(dst, t2, s2) do { dst[0] = FRAG(GI_W(0, t2, s2)); dst[1] = FRAG(GI_Q(0, t2, s2)); dst[2] = FRAG(GI_W(1, t2, s2)); dst[3] = FRAG(GI_Q(1, t2, s2)); } while (0)
#define MM_WQ(src, t2, s2) do { const bf16x8 sb_ = pack8(S[t2], s2); VN[0] = MFMA32(src[0], sb_, VN[0]); O[0] = MFMA32(src[1], sb_, O[0]); VN[1] = MFMA32(src[2], sb_, VN[1]); O[1] = MFMA32(src[3], sb_, O[1]); } while (0)
#define LD_AT(dst, s2) do { dst[0] = FRAG(GI_A(0, 0, s2)); dst[1] = FRAG(GI_A(1, 0, s2)); dst[2] = FRAG(GI_A(1, 1, s2)); } while (0)
#define MM_AT(src, s2) do { O[0] = MFMA32(src[0], vb[0][s2], O[0]); O[1] = MFMA32(src[1], vb[0][s2], O[1]); O[1] = MFMA32(src[2], vb[1][s2], O[1]); } while (0)
#define LD_K(dst, t2) do { dst[0] = FRAG(GI_K(t2, 0, 0)); dst[1] = FRAG(GI_K(t2, 0, 1)); dst[2] = FRAG(GI_K(t2, 1, 0)); dst[3] = FRAG(GI_K(t2, 1, 1)); } while (0)
#define MM_K(src, t2) do { S[t2] = MFMA32(src[0], vb[0][0], S[t2]); S[t2] = MFMA32(src[1], vb[0][1], S[t2]); S[t2] = MFMA32(src[2], vb[1][0], S[t2]); S[t2] = MFMA32(src[3], vb[1][1], S[t2]); } while (0)
#define SCALE_S(t2) do { _Pragma("unroll") for (int q_ = 0; q_ < 16; ++q_) S[t2][q_] *= egl; } while (0)
__device__ __forceinline__ void scan_step(const int n, f32x16 (&S)[4], v4u (&UC)[4], v4u (&UN)[4], const float egl, float& egl_next,
                                          LAS unsigned char* lds, const float* Uf, const float* glp, const int wave, const int lane, const int stg_off, const int stg_row) {
    const int r = lane & 31, h = lane >> 5;
    asm volatile("s_waitcnt lgkmcnt(0)" ::: "memory"); __builtin_amdgcn_s_barrier(); asm volatile("" ::: "memory");
    if (n + 1 < 128) {
        const v4u* up = (const v4u*)((const unsigned char*)Uf + (size_t)(n + 1) * 16384) + (wave * 4) * 64 + lane;
#pragma unroll
        for (int f = 0; f < 4; ++f) UN[f] = up[f * 64];
        egl_next = glp[n + 1];
    }
    SB();
    f32x16 VN[2];
#pragma unroll
    for (int mt = 0; mt < 2; ++mt)
#pragma unroll
        for (int q8 = 0; q8 < 2; ++q8) { const v4u u = UC[mt * 2 + q8];
            VN[mt][8 * q8 + 0] = bflo(u.x); VN[mt][8 * q8 + 1] = bfhi(u.x); VN[mt][8 * q8 + 2] = bflo(u.y); VN[mt][8 * q8 + 3] = bfhi(u.y);
            VN[mt][8 * q8 + 4] = bflo(u.z); VN[mt][8 * q8 + 5] = bfhi(u.z); VN[mt][8 * q8 + 6] = bflo(u.w); VN[mt][8 * q8 + 7] = bfhi(u.w); }
    const LAS unsigned char* Bf = lds + (n & 1) * OPS_BYTES + lane * 16;
    f32x16 O[2];
#pragma unroll
    for (int mt = 0; mt < 2; ++mt)
#pragma unroll
        for (int q = 0; q < 16; ++q) O[mt][q] = 0.f;
    bf16x8 fA[4], fB[4], vb[2][2];
    LD_WQ(fA, 0, 0); SB();
    LD_WQ(fB, 0, 1); SB(); MM_WQ(fA, 0, 0); SB();
    LD_WQ(fA, 1, 0); SB(); MM_WQ(fB, 0, 1); SCALE_S(0); SB();
    LD_WQ(fB, 1, 1); SB(); MM_WQ(fA, 1, 0); SB();
    LD_WQ(fA, 2, 0); SB(); MM_WQ(fB, 1, 1); SCALE_S(1); SB();
    LD_WQ(fB, 2, 1); SB(); MM_WQ(fA, 2, 0); SB();
    LD_WQ(fA, 3, 0); SB(); MM_WQ(fB, 2, 1); SCALE_S(2); SB();
    LD_WQ(fB, 3, 1); SB(); MM_WQ(fA, 3, 0); SB();
    LD_AT(fA, 0); SB(); MM_WQ(fB, 3, 1); SCALE_S(3); SB();
#pragma unroll
    for (int mt = 0; mt < 2; ++mt)
#pragma unroll
        for (int s2 = 0; s2 < 2; ++s2) vb[mt][s2] = pack8(VN[mt], s2);
    LD_AT(fB, 1); SB(); MM_AT(fA, 0); SB();
    LD_K(fA, 0); SB(); MM_AT(fB, 1); SB();
    {
        LAS unsigned short* sp = (LAS unsigned short*)(lds + stg_off + (n & 1) * (64 * stg_row)) + 32 * wave + r;
#pragma unroll
        for (int mt = 0; mt < 2; ++mt)
#pragma unroll
            for (int q = 0; q < 16; q += 2) { const unsigned w = cvtpk(O[mt][q], O[mt][q + 1]);
                sp[(32 * mt + crow(q, h)) * (stg_row / 2)] = (unsigned short)(w & 0xffffu); sp[(32 * mt + crow(q + 1, h)) * (stg_row / 2)] = (unsigned short)(w >> 16); }
    }
    asm volatile("s_waitcnt lgkmcnt(0)" ::: "memory"); __builtin_amdgcn_s_barrier(); asm volatile("" ::: "memory");
    LD_K(fB, 1); SB(); MM_K(fA, 0); SB();
    LD_K(fA, 2); SB(); MM_K(fB, 1); SB();
    LD_K(fB, 3); SB(); MM_K(fA, 2); SB();
    MM_K(fB, 3); SB();
}
#undef FRAG

__device__ __forceinline__ int opq(int v) { asm volatile("" : "+v"(v)); return v; }
typedef const __attribute__((address_space(4))) Args* kargp_t;
__device__ __forceinline__ kargp_t karg_ptr() { kargp_t p = (kargp_t)__builtin_amdgcn_kernarg_segment_ptr(); asm volatile("" : "+s"(p)); return p; }
__global__ void __launch_bounds__(NTHR, 2) mk_fwd(Args kargs) {
    extern __shared__ __attribute__((aligned(16))) unsigned char lds_raw[];
    LAS unsigned char* lds = (LAS unsigned char*)lds_raw;
    volatile LAS unsigned* MISC = (volatile LAS unsigned*)(lds + MISC_OFF);
    const int wave = __builtin_amdgcn_readfirstlane((int)threadIdx.x >> 6);
    const int G = gridDim.x; const int bx = blockIdx.x; const int vcu = (G % 8 == 0) ? (bx % 8) * (G / 8) + bx / 8 : bx;
    const int gw = vcu * NWAVES + wave, NGW = G * NWAVES;
    if (threadIdx.x < 128) MISC[threadIdx.x] = 0u;
    __syncthreads();
    XcdBarrier bar; bar.bar = (unsigned*)(kargs.ws + WS_CTL) + CW_BAR; bar.x = 0; bar.st = nullptr;
#if MK_ONE_LAUNCH
    bar = xcd_barrier_post((unsigned*)(kargs.ws + WS_CTL) + CW_BAR + kargs.li * XCD_BAR_WORDS, MISC + 8);
#define GRID_BAR() xcd_barrier(bar, tid)
#else
#define GRID_BAR() do {} while (0)
#endif
    const int lo = kargs.ph_lo, hi = kargs.ph_hi;
#ifndef PH_MASK
#define PH_MASK 0xFFFF
#endif
#define IN(k) ((((PH_MASK) >> (k)) & 1) && lo <= (k) && (k) < hi)
#define BOTH(k) (IN(k) && IN((k) + 1))

#define args (*ap_)
#define P_WS (args.ws)
#define ctl ((unsigned*)(P_WS + WS_CTL))
#define Xp (args.in[I_X])
#define OUTp (args.out)
#define MODp ((float*)(P_WS + WS_MOD))
#define gbuf ((float*)(P_WS + WS_G))
#define betabuf ((float*)(P_WS + WS_BETA))
#define glbuf ((float*)(P_WS + WS_GL))
#define asg_e ((int*)(P_WS + WS_AE))
#define asg_p ((int*)(P_WS + WS_AP))
#define asg_g ((float*)(P_WS + WS_AG))
#define asg_s ((int*)(P_WS + WS_AS))
#define WinT ((bf16*)(P_WS + WS_WIN))
#define WoutT ((bf16*)(P_WS + WS_WOUT))
#define WupT ((bf16*)(P_WS + WS_WUP))
#define WdnT ((bf16*)(P_WS + WS_WDN))
#define hbuf ((bf16*)(P_WS + WS_H))
#define projb ((bf16*)(P_WS + WS_PROJ))
#define Ub ((float*)(P_WS + WS_U))
#define opsb (P_WS + WS_OPS)
#define zsb ((bf16*)(P_WS + WS_ZS))
#define qfb (P_WS + WS_QF)
#define kfb (P_WS + WS_KF)
#define vtfb (P_WS + WS_VTF)
#define omix ((bf16*)(P_WS + WS_OMIX))
#define ybuf ((float*)(P_WS + WS_Y))
#define xg ((bf16*)(P_WS + WS_XG))
#define actb ((bf16*)(P_WS + WS_ACT))
#define yslot ((bf16*)(P_WS + WS_XG))

    if (IN(0)) {
        const int lane = (int)__builtin_amdgcn_mbcnt_hi(~0u, __builtin_amdgcn_mbcnt_lo(~0u, 0u)), tid = wave * 64 + lane; const kargp_t ap_ = karg_ptr();
        ldsf* scr = (ldsf*)(lds + wave * 16384);
        constexpr int I_IN = 16 * 113, I_OUT = 16 * 32;
        constexpr int NITEMS = I_IN + I_OUT;
        for (int it = gw; it < NITEMS; it += NGW) {
            int r = it;
            if (r < I_IN) { transpose_item(args.in[I_WIN], D, IN_COLS, WinT, 0, scr, r, lane); continue; } r -= I_IN;
            transpose_item(args.in[I_WOUT], D, D, WoutT, 1, scr, r, lane);
        }
        __syncthreads();
        for (int idx = bx * NTHR + tid; idx < 8192; idx += G * NTHR) { const int col = idx >> 3, k = idx & 7; ((float*)(P_WS + WS_WG))[k * 1024 + col] = args.in[I_WIN][(size_t)col * IN_COLS + 2048 + k]; }
        for (int it = bx; it < 256; it += G) mod_item(args.in[I_C], args.in[I_WADA], args.in[I_BADA], MODp, it, (ldsf*)lds, tid, lane, wave);
        if (BOTH(0)) GRID_BAR();
    }

    if (IN(1)) {
        const int lane = (int)__builtin_amdgcn_mbcnt_hi(~0u, __builtin_amdgcn_mbcnt_lo(~0u, 0u)), tid = wave * 64 + lane; const kargp_t ap_ = karg_ptr();
        ldsf* wg = (ldsf*)lds;
        const float* w_in = args.in[I_WIN];
        for (int idx = tid; idx < 2048; idx += NTHR) *((LAS f32x4*)wg + idx) = *((const f32x4*)(P_WS + WS_WG) + idx);
        __syncthreads();
        const float* nw0 = args.in[I_NORMW];
        const float dtb = args.in[I_DTB][lane & 3], alg = -expf(args.in[I_ALOG][lane & 3]);
        f32x4 vnx[4];
#pragma unroll
        for (int j = 0; j < 4; ++j) vnx[j] = *((const f32x4*)(Xp + (size_t)gw * D) + lane + 64 * j);
        for (int bb = 0; bb < BATCH; ++bb) {
            f32x4 av[4], shv[4];
#pragma unroll
            for (int j = 0; j < 4; ++j) { const int col = 4 * lane + 256 * j; const f32x4 nw = *(const f32x4*)(nw0 + col), sc = *(const f32x4*)(MODp + bb * 6144 + 1024 + col); shv[j] = *(const f32x4*)(MODp + bb * 6144 + col);
#pragma unroll
                for (int e = 0; e < 4; ++e) av[j][e] = nw[e] * (1.0f + sc[e]); }
            for (int r = gw + bb * (NTOK / BATCH); r < (bb + 1) * (NTOK / BATCH); r += NGW) {
                f32x4 v[4]; float ss = 0.f;
#pragma unroll
                for (int j = 0; j < 4; ++j) { v[j] = vnx[j]; ss += (v[j].x * v[j].x + v[j].y * v[j].y) + (v[j].z * v[j].z + v[j].w * v[j].w); }
                __builtin_amdgcn_sched_barrier(0);
                if (r + NGW < NTOK) {
#pragma unroll
                    for (int j = 0; j < 4; ++j) vnx[j] = *((const f32x4*)(Xp + (size_t)(r + NGW) * D) + lane + 64 * j);
                }
                __builtin_amdgcn_sched_barrier(0);
                const float rstd = rsqrtf(wave_sum(ss) * (1.0f / D) + EPS);
                float al[8];
#pragma unroll
                for (int k = 0; k < 8; ++k) al[k] = 0.f;
                v2u ov[4];
#pragma unroll
                for (int j = 0; j < 4; ++j) {
                    const int col = 4 * lane + 256 * j;
                    f32x4 h;
#pragma unroll
                    for (int e = 0; e < 4; ++e) h[e] = v[j][e] * rstd * av[j][e] + shv[j][e];
                    ov[j].x = pk2(h[0], h[1]); ov[j].y = pk2(h[2], h[3]);
#pragma unroll
                    for (int k = 0; k < 8; ++k) { const f32x4 w = *(const LAS f32x4*)(wg + k * 1024 + col); al[k] += (h[0] * w[0] + h[1] * w[1]) + (h[2] * w[2] + h[3] * w[3]); }
                }
#pragma unroll
                for (int j = 0; j < 4; ++j) *(v2u*)(hbuf + (size_t)r * D + 4 * lane + 256 * j) = ov[j];
#pragma unroll
                for (int k = 0; k < 8; ++k) al[k] = wave_sum(al[k]);
                if (lane < 4) {
                    const float aa = lane == 0 ? al[0] : (lane == 1 ? al[1] : (lane == 2 ? al[2] : al[3]));
                    const float ab = lane == 0 ? al[4] : (lane == 1 ? al[5] : (lane == 2 ? al[6] : al[7]));
                    const float xx = aa + dtb;
                    const float sp = xx > 20.f ? xx : log1pf(expf(xx));
                    gbuf[r * 4 + lane] = alg * sp;
                    betabuf[r * 4 + lane] = 1.0f / (1.0f + expf(-ab));
                }
            }
        }
        if (BOTH(1)) GRID_BAR();
    }

    if (IN(2)) {
        const int lane = (int)__builtin_amdgcn_mbcnt_hi(~0u, __builtin_amdgcn_mbcnt_lo(~0u, 0u)), tid = wave * 64 + lane; const kargp_t ap_ = karg_ptr();
        pg8::Gemm g{hbuf, WinT, NTOK, PCOLS, D}; pg8::StaticOrder S; S.init(NTOK, PCOLS, G, bx);
        pg8::EpiBf16 E{projb, PCOLS, nullptr, nullptr, 0, 1.0f};
        pg8::gemm_phase<pg8::EpiBf16, pg8::StaticOrder, true, true>(lds, g, S, E, tid);
        if (BOTH(2)) GRID_BAR();
    }

    if (IN(3)) {
        const int lane = (int)__builtin_amdgcn_mbcnt_hi(~0u, __builtin_amdgcn_mbcnt_lo(~0u, 0u)), tid = wave * 64 + lane; const kargp_t ap_ = karg_ptr();
        ldsf* qs = (ldsf*)lds; ldsf* ks = qs + 64 * 129; ldsf* vs = ks + 64 * 129; ldsf* Wsm = vs + 64 * 129; ldsf* Ls = Wsm + 64 * 129;
        constexpr int LSTR = 68;
        constexpr int RAW_OFF = 4 * 64 * 129 * 3;
        ldsf* gc = (ldsf*)(lds + 151296); ldsf* bt = gc + 64; ldsf* eg = bt + 64; ldsf* ekd = eg + 64;
        const float* conv_w = args.in[I_CONVW];
        const int r = lane & 31, h = lane >> 5;
        for (int item = (args.pad & 1) ? 1024 : bx; item < 1024; item += G) {
            const int bh = item >> 7, n = item & 127, b = bh >> 2, hh = bh & 3;
            const size_t row0 = (size_t)b * T + n * 64;
            unsigned char* ops = opsb + (size_t)item * OPS_BYTES;
            {
#pragma unroll
                for (int jp = 0; jp < 7; ++jp) {
                    const int p = wave + 8 * jp;
                    if (p < 51) {
                        int sg = 4 * p + (lane >> 4); sg = sg > 200 ? 200 : sg;
                        const int rw = sg / 3, wh = sg - 3 * rw; int tt = n * 64 + rw - 3; tt = tt < 0 ? 0 : tt;
                        __builtin_amdgcn_global_load_lds((const unsigned*)(projb + ((size_t)b * T + tt) * PCOLS + wh * 512 + hh * 128 + (lane & 15) * 8), (LAS unsigned*)(lds + RAW_OFF + p * 1024), 16, 0, 0);
                    }
                }
#pragma unroll
                for (int o = 0; o < 2; ++o) {
                    const int idx = tid + NTHR * o, i = idx >> 4, d0 = (idx & 15) * 8;
                    const v4u zw = *(const v4u*)(projb + ((size_t)b * T + n * 64 + i) * PCOLS + 1536 + hh * 128 + d0);
                    const f32x4 wa = *(const f32x4*)(args.in[I_ANW] + d0), wb = *(const f32x4*)(args.in[I_ANW] + d0 + 4);
                    v4u ow; ow.x = cvtpk(wa[0] * siluf(bflo(zw.x)), wa[1] * siluf(bfhi(zw.x))); ow.y = cvtpk(wa[2] * siluf(bflo(zw.y)), wa[3] * siluf(bfhi(zw.y)));
                    ow.z = cvtpk(wb[0] * siluf(bflo(zw.z)), wb[1] * siluf(bfhi(zw.z))); ow.w = cvtpk(wb[2] * siluf(bflo(zw.w)), wb[3] * siluf(bfhi(zw.w)));
                    *(v4u*)(zsb + ((size_t)b * T + n * 64 + i) * 512 + hh * 128 + d0) = ow;
                }
                asm volatile("s_waitcnt vmcnt(0)" ::: "memory");
                __syncthreads();
#pragma unroll 2
                for (int o = 0; o < 6; ++o) {
                    const int idx = tid + NTHR * o, i = idx / 48, c8 = idx - 48 * i, which = c8 >> 4, d0 = (c8 & 15) * 8, gch = which * 512 + hh * 128 + d0;
                    const LAS unsigned char* rp = lds + RAW_OFF + i * 768 + which * 256 + d0 * 2;
                    float acc[8];
#pragma unroll
                    for (int e = 0; e < 8; ++e) acc[e] = 0.f;
#pragma unroll
                    for (int tap = 0; tap < 4; ++tap) {
                        const v4u xw = *(const LAS v4u*)(rp + tap * 768);
                        const f32x4 wa = *(const f32x4*)(conv_w + tap * 1536 + gch), wb = *(const f32x4*)(conv_w + tap * 1536 + gch + 4);
                        const float msk = (n * 64 + i - 3 + tap) >= 0 ? 1.0f : 0.0f;
                        acc[0] += msk * wa[0] * bflo(xw.x); acc[1] += msk * wa[1] * bfhi(xw.x); acc[2] += msk * wa[2] * bflo(xw.y); acc[3] += msk * wa[3] * bfhi(xw.y);
                        acc[4] += msk * wb[0] * bflo(xw.z); acc[5] += msk * wb[1] * bfhi(xw.z); acc[6] += msk * wb[2] * bflo(xw.w); acc[7] += msk * wb[3] * bfhi(xw.w);
                    }
                    ldsf* dst = (which == 0 ? qs : (which == 1 ? ks : vs)) + i * 129 + d0;
#pragma unroll
                    for (int e = 0; e < 8; ++e) dst[e] = siluf(acc[e]);
                }
            }
            if (wave == 7) {
                float gv = gbuf[(row0 + lane) * 4 + hh];
#pragma unroll
                for (int o = 1; o < 64; o <<= 1) { const float t2 = __shfl_up(gv, o); if (lane >= o) gv += t2; }
                const float glast = __shfl(gv, 63);
                gc[lane] = gv; eg[lane] = expf(gv); bt[lane] = betabuf[(row0 + lane) * 4 + hh]; ekd[lane] = expf(glast - gv);
                if (lane == 0) glbuf[item] = expf(glast);
            }
            __syncthreads();
            if (((args.pad >> 2) & 7) == 1) continue;
            for (int i = wave; i < 64; i += NWAVES) {
                const float q0 = qs[i * 129 + lane], q1 = qs[i * 129 + 64 + lane], k0 = ks[i * 129 + lane], k1 = ks[i * 129 + 64 + lane];
                const float sq = rsqrtf(wave_sum(q0 * q0 + q1 * q1) + EPS) * 0.08838834764831845f, sk = rsqrtf(wave_sum(k0 * k0 + k1 * k1) + EPS);
                qs[i * 129 + lane] = q0 * sq; qs[i * 129 + 64 + lane] = q1 * sq; ks[i * 129 + lane] = k0 * sk; ks[i * 129 + 64 + lane] = k1 * sk;
            }
            __syncthreads();
            if (((args.pad >> 2) & 7) == 2) continue;
            {
                const int which = wave >> 2, ta = (wave >> 1) & 1, tb = wave & 1;
                if (tb <= ta) {
                    f32x16 acc;
#pragma unroll
                    for (int q = 0; q < 16; ++q) acc[q] = 0.f;
                    const ldsf* Ap = ks + (32 * (which == 0 ? ta : tb) + r) * 129 + 8 * h;
                    const ldsf* Bp = (which == 0 ? ks + (32 * tb + r) * 129 : qs + (32 * ta + r) * 129) + 8 * h;
#pragma unroll 4
                    for (int k = 0; k < 8; ++k) {
                        v4u pa, pb;
                        pa.x = cvtpk(Ap[16 * k + 0], Ap[16 * k + 1]); pa.y = cvtpk(Ap[16 * k + 2], Ap[16 * k + 3]); pa.z = cvtpk(Ap[16 * k + 4], Ap[16 * k + 5]); pa.w = cvtpk(Ap[16 * k + 6], Ap[16 * k + 7]);
                        pb.x = cvtpk(Bp[16 * k + 0], Bp[16 * k + 1]); pb.y = cvtpk(Bp[16 * k + 2], Bp[16 * k + 3]); pb.z = cvtpk(Bp[16 * k + 4], Bp[16 * k + 5]); pb.w = cvtpk(Bp[16 * k + 6], Bp[16 * k + 7]);
                        acc = MFMA32(__builtin_bit_cast(bf16x8, pa), __builtin_bit_cast(bf16x8, pb), acc);
                    }
                    if (which == 0) {
                        const int j = 32 * tb + r; const float gj = gc[j];
#pragma unroll
                        for (int q = 0; q < 16; ++q) { const int i = 32 * ta + crow(q, h); Ls[i * LSTR + j] = (j < i) ? bt[i] * acc[q] * __expf(gc[i] - gj) : 0.f; }
                    } else {
                        const int i = 32 * ta + r; const float gi = gc[i];
#pragma unroll
                        for (int q = 0; q < 16; ++q) { const int j = 32 * tb + crow(q, h); acc[q] = (j <= i) ? acc[q] * __expf(gi - gc[j]) : 0.f; }
#pragma unroll
                        for (int s2 = 0; s2 < 2; ++s2) *(bf16x8*)(ops + (48 + (ta * 2 + tb) * 2 + s2) * 1024 + lane * 16) = pack8(acc, s2);
                    }
                }
            }
            __syncthreads();
            if (((args.pad >> 2) & 7) == 3) continue;
            if (wave < 4) {
                const int d = tid & 127; const bool isw = tid >= 128;
                int z; asm volatile("v_mov_b32 %0, 0" : "=v"(z));
                const ldsf* Lz = Ls + z; const ldsf* btz = bt + z; const ldsf* egz = eg + z;
                float xr[32];
                const ldsf* srcx = (isw ? ks : vs) + d;
                ldsf* dst = (isw ? Wsm : vs) + d;
#pragma unroll
                for (int i = 0; i < 32; ++i) { const float e_ = egz[i]; xr[i] = srcx[i * 129] * btz[i] * (isw ? e_ : 1.0f); }
#pragma unroll
                for (int i = 32; i < 64; ++i) { const float e_ = egz[i]; dst[i * 129] = srcx[i * 129] * btz[i] * (isw ? e_ : 1.0f); }
#pragma unroll
                for (int i = 1; i < 32; ++i) {
                    float s0 = xr[i], s1 = 0.f;
#pragma unroll
                    for (int j4 = 0; j4 < (i + 3) / 4; ++j4) {
                        const f32x4 l = *(const LAS f32x4*)(Lz + i * LSTR + 4 * j4);
                        s0 -= l[0] * xr[4 * j4]; s1 -= l[1] * xr[4 * j4 + 1]; s0 -= l[2] * xr[4 * j4 + 2]; s1 -= l[3] * xr[4 * j4 + 3];
                    }
                    xr[i] = s0 + s1;
                    asm volatile("" ::: "memory");
                }
#pragma unroll
                for (int i = 0; i < 32; ++i) dst[i * 129] = xr[i];
            } else {
#pragma unroll 1
                for (int ff = 0; ff < 8; ++ff) {
                    const int f = (wave - 4) * 8 + ff;
                    v4u p; float v8[8];
                    if (f < 16) { const int mt = f >> 3, t2 = (f >> 1) & 3, s2 = f & 1; const int i = 32 * mt + r; const float e = eg[i];
#pragma unroll
                        for (int j = 0; j < 8; ++j) v8[j] = qs[i * 129 + 32 * t2 + 16 * s2 + 8 * (j >> 2) + 4 * h + (j & 3)] * e;
                    } else { const int g2 = f - 16, t2 = g2 >> 2, mt = (g2 >> 1) & 1, s2 = g2 & 1; const int d = 32 * t2 + r;
#pragma unroll
                        for (int j = 0; j < 8; ++j) { const int i = 32 * mt + 16 * s2 + 8 * (j >> 2) + 4 * h + (j & 3); v8[j] = ks[i * 129 + d] * ekd[i]; }
                    }
                    p.x = cvtpk(v8[0], v8[1]); p.y = cvtpk(v8[2], v8[3]); p.z = cvtpk(v8[4], v8[5]); p.w = cvtpk(v8[6], v8[7]);
                    *(v4u*)(ops + (16 + f) * 1024 + lane * 16) = p;
                }
            }
            __syncthreads();
            {
                ldsf* X = (wave < 4) ? vs + 32 * wave : Wsm + 32 * (wave - 4);
                f32x16 acc;
#pragma unroll
                for (int q = 0; q < 16; ++q) acc[q] = X[(32 + crow(q, h)) * 129 + r];
                const ldsf* Ap = Ls + (32 + r) * LSTR + h;
                const ldsf* Bp = X + h * 129 + r;
#pragma unroll 8
                for (int k = 0; k < 16; ++k) acc = __builtin_amdgcn_mfma_f32_32x32x2f32(-Ap[2 * k], Bp[(2 * k) * 129], acc, 0, 0, 0);
#pragma unroll
                for (int q = 0; q < 16; ++q) X[(32 + crow(q, h)) * 129 + r] = acc[q];
            }
            __syncthreads();
            if (wave < 4) {
                const int d = tid & 127; const bool isw = tid >= 128;
                int z; asm volatile("v_mov_b32 %0, 0" : "=v"(z));
                const ldsf* Lz = Ls + z;
                ldsf* dst = (isw ? Wsm : vs) + d;
                float xr[32];
#pragma unroll
                for (int i = 0; i < 32; ++i) xr[i] = dst[(32 + i) * 129];
#pragma unroll
                for (int i = 1; i < 32; ++i) {
                    float s0 = xr[i], s1 = 0.f;
#pragma unroll
                    for (int j4 = 0; j4 < (i + 3) / 4; ++j4) {
                        const f32x4 l = *(const LAS f32x4*)(Lz + (32 + i) * LSTR + 32 + 4 * j4);
                        s0 -= l[0] * xr[4 * j4]; s1 -= l[1] * xr[4 * j4 + 1]; s0 -= l[2] * xr[4 * j4 + 2]; s1 -= l[3] * xr[4 * j4 + 3];
                    }
                    xr[i] = s0 + s1;
                    asm volatile("" ::: "memory");
                }
#pragma unroll
                for (int i = 0; i < 32; ++i) dst[(32 + i) * 129] = xr[i];
            }
            __syncthreads();
            if (((args.pad >> 2) & 7) == 4) continue;
#pragma unroll
            for (int o = 0; o < 2; ++o) {
                const int idx8 = tid + NTHR * o, l2 = idx8 & 63, q8 = (idx8 >> 6) & 1, mt = (idx8 >> 7) & 1, w = idx8 >> 8;
                const int c = 32 * w + (l2 & 31), hh2 = l2 >> 5;
                float u8[8];
#pragma unroll
                for (int e = 0; e < 8; ++e) u8[e] = vs[(32 * mt + crow(8 * q8 + e, hh2)) * 129 + c];
                v4u p; p.x = cvtpk(u8[0], u8[1]); p.y = cvtpk(u8[2], u8[3]); p.z = cvtpk(u8[4], u8[5]); p.w = cvtpk(u8[6], u8[7]);
                *(v4u*)((unsigned char*)Ub + (size_t)item * 16384 + idx8 * 16) = p;
            }
#pragma unroll
            for (int ff = 0; ff < 2; ++ff) {
                const int f = wave * 2 + ff, mt = f >> 3, t2 = (f >> 1) & 3, s2 = f & 1; const int i = 32 * mt + r;
                float v8[8];
#pragma unroll
                for (int j = 0; j < 8; ++j) v8[j] = -Wsm[i * 129 + 32 * t2 + 16 * s2 + 8 * (j >> 2) + 4 * h + (j & 3)];
                v4u p; p.x = cvtpk(v8[0], v8[1]); p.y = cvtpk(v8[2], v8[3]); p.z = cvtpk(v8[4], v8[5]); p.w = cvtpk(v8[6], v8[7]);
                *(v4u*)(ops + f * 1024 + lane * 16) = p;
            }
            __syncthreads();
        }
        {
            const int r = lane & 31, h = lane >> 5;
            for (int it = (args.pad & 2) ? 2048 : gw; it < 2048; it += NGW) {
                const int c = it & 127, hh = (it >> 7) & 7, b = it >> 10;
                const bf16* base = projb + ((size_t)b * T + c * 64) * PCOLS + hh * 64;
#pragma unroll
                for (int kb2 = 0; kb2 < 2; ++kb2)
#pragma unroll
                    for (int ks = 0; ks < 4; ++ks) {
                        const bf16* rp = base + (size_t)(32 * kb2 + r) * PCOLS + 16 * ks + 8 * h;
                        *(v4u*)(qfb + (size_t)it * 8192 + (kb2 * 4 + ks) * 1024 + lane * 16) = *(const v4u*)(rp + 2048);
                        *(v4u*)(kfb + (size_t)it * 8192 + (kb2 * 4 + ks) * 1024 + lane * 16) = *(const v4u*)(rp + 2560);
                    }
#pragma unroll
                for (int dt = 0; dt < 2; ++dt)
#pragma unroll
                    for (int kb2 = 0; kb2 < 2; ++kb2)
#pragma unroll
                        for (int s2 = 0; s2 < 2; ++s2) {
                            unsigned short e8[8];
#pragma unroll
                            for (int j = 0; j < 8; ++j) e8[j] = base[(size_t)(32 * kb2 + 16 * s2 + 8 * (j >> 2) + 4 * h + (j & 3)) * PCOLS + 3072 + 32 * dt + r];
                            v4u p; p.x = e8[0] | ((unsigned)e8[1] << 16); p.y = e8[2] | ((unsigned)e8[3] << 16); p.z = e8[4] | ((unsigned)e8[5] << 16); p.w = e8[6] | ((unsigned)e8[7] << 16);
                            *(v4u*)(vtfb + (size_t)it * 8192 + ((dt * 2 + kb2) * 2 + s2) * 1024 + lane * 16) = p;
                        }
            }
        }
        if (BOTH(3)) GRID_BAR();
    }

    if (IN(4)) {
        const int lane = (int)__builtin_amdgcn_mbcnt_hi(~0u, __builtin_amdgcn_mbcnt_lo(~0u, 0u)), tid = wave * 64 + lane; const kargp_t ap_ = karg_ptr();
        if (bx < 64) {
            constexpr int SEGC = 16;
            const int bh = bx & 7, seg = bx >> 3, b = bh >> 2, hh = bh & 3;
            const int r = lane & 31, h = lane >> 5;
            const int c0 = seg * SEGC;
#define SCAN_BAR() do { asm volatile("s_waitcnt lgkmcnt(0)" ::: "memory"); __builtin_amdgcn_s_barrier(); asm volatile("" ::: "memory"); } while (0)
#define FRAG(f_) (*(const LAS bf16x8*)(Bf + (f_) * 1024))
            {
                const unsigned char* ops = opsb + (size_t)(bh * 128 + c0) * OPS_BYTES;
                const float* Uf = (const float*)((const unsigned char*)Ub + (size_t)(bh * 128 + c0) * 16384);
                float* segp = (float*)(args.ws + WS_SEG) + (size_t)(bh * 8 + seg) * 32768;
                ldsf* egls = (ldsf*)(lds + 4 * 32768);
                if (tid < SEGC) egls[tid] = glbuf[bh * 128 + c0 + tid];
                const int pbase = (wave < 6) ? (wave - 4) * 8 : 32 + (wave - 6) * 8, fbase = (wave - 4) * 8;
#define A_DMA(n_) do { const unsigned char* src_ = ops + (size_t)(n_) * OPS_BYTES + pbase * 1024 + lane * 16; \
                _Pragma("unroll") for (int p_ = 0; p_ < 8; ++p_) __builtin_amdgcn_global_load_lds((const unsigned*)(src_ + p_ * 1024), (LAS unsigned*)(lds + ((n_) & 3) * 32768 + (fbase + p_) * 1024), 16, 0, 0); } while (0)
                f32x16 S[4]; v4u Ur[4];
#pragma unroll
                for (int t2 = 0; t2 < 4; ++t2)
#pragma unroll
                    for (int q = 0; q < 16; ++q) S[t2][q] = (wave >= 4 && (32 * t2 + crow(q, h)) == (32 * (wave - 4) + r)) ? 1.0f : 0.0f;
#pragma unroll
                for (int f = 0; f < 4; ++f) Ur[f] = (v4u){0u, 0u, 0u, 0u};
                if (wave < 4) {
#pragma unroll
                    for (int f = 0; f < 4; ++f) Ur[f] = *((const v4u*)Uf + (wave * 4 + f) * 64 + lane);
                } else { A_DMA(0); A_DMA(1); A_DMA(2); }
                for (int n = 0; n < SEGC; ++n) {
                    if (wave >= 4) { if (n <= SEGC - 3) asm volatile("s_waitcnt vmcnt(16)" ::: "memory"); else if (n == SEGC - 2) asm volatile("s_waitcnt vmcnt(8)" ::: "memory"); else asm volatile("s_waitcnt vmcnt(0)" ::: "memory"); }
                    SCAN_BAR();
                    if (wave >= 4 && n + 3 < SEGC) A_DMA(n + 3);
                    const LAS unsigned char* Bf = lds + (n & 3) * 32768 + lane * 16;
                    f32x16 VN[2];
#pragma unroll
                    for (int mt = 0; mt < 2; ++mt)
#pragma unroll
                        for (int q8 = 0; q8 < 2; ++q8) { const v4u u = Ur[mt * 2 + q8];
                            VN[mt][8 * q8 + 0] = bflo(u.x); VN[mt][8 * q8 + 1] = bfhi(u.x); VN[mt][8 * q8 + 2] = bflo(u.y); VN[mt][8 * q8 + 3] = bfhi(u.y);
                            VN[mt][8 * q8 + 4] = bflo(u.z); VN[mt][8 * q8 + 5] = bfhi(u.z); VN[mt][8 * q8 + 6] = bflo(u.w); VN[mt][8 * q8 + 7] = bfhi(u.w); }
                    if (wave < 4 && n + 1 < SEGC) {
                        const v4u* up = (const v4u*)((const unsigned char*)Uf + (size_t)(n + 1) * 16384) + (wave * 4) * 64 + lane;
#pragma unroll
                        for (int f = 0; f < 4; ++f) Ur[f] = up[f * 64];
                    }
                    const float egl = egls[n];
#pragma unroll
                    for (int t2 = 0; t2 < 4; ++t2)
#pragma unroll
                        for (int s2 = 0; s2 < 2; ++s2) {
                            const bf16x8 sb = pack8(S[t2], s2);
#pragma unroll
                            for (int mt = 0; mt < 2; ++mt) VN[mt] = MFMA32(FRAG((mt * 4 + t2) * 2 + s2), sb, VN[mt]);
                        }
                    bf16x8 vb[2][2];
#pragma unroll
                    for (int mt = 0; mt < 2; ++mt)
#pragma unroll
                        for (int s2 = 0; s2 < 2; ++s2) vb[mt][s2] = pack8(VN[mt], s2);
#pragma unroll
                    for (int t2 = 0; t2 < 4; ++t2) {
#pragma unroll
                        for (int q = 0; q < 16; ++q) S[t2][q] *= egl;
#pragma unroll
                        for (int mt = 0; mt < 2; ++mt)
#pragma unroll
                            for (int s2 = 0; s2 < 2; ++s2) S[t2] = MFMA32(FRAG(16 + (t2 * 2 + mt) * 2 + s2), vb[mt][s2], S[t2]);
                    }
                }
#undef A_DMA
                if (wave < 4) {
#pragma unroll
                    for (int t2 = 0; t2 < 4; ++t2)
#pragma unroll
                        for (int q = 0; q < 16; ++q) segp[((wave * 4 + t2) * 16 + q) * 64 + lane] = S[t2][q];
                } else {
                    unsigned short* pp = (unsigned short*)(args.ws + WS_SEGP) + (size_t)(bh * 8 + seg) * 16384 + (((wave - 4) * 2 + (r >> 4)) * 64 + 32 * ((r >> 3) & 1)) * 8 + (r & 7);
#pragma unroll
                    for (int t2 = 0; t2 < 4; ++t2)
#pragma unroll
                        for (int q = 0; q < 16; ++q) pp[(t2 * 8 * 64 + crow(q, h)) * 8] = (unsigned short)f2bf(S[t2][q]);
                }
            }
            asm volatile("s_waitcnt vmcnt(0)" ::: "memory");
            __syncthreads();
            if (tid == 0) { __builtin_amdgcn_fence(__ATOMIC_RELEASE, "agent"); asm volatile("s_waitcnt vmcnt(0)" ::: "memory"); __hip_atomic_fetch_add(ctl + CW_SEGA + 64 * bh, 1u, RLX_AGENT); }
            if (seg == 0) {
                if (tid == 0) { unsigned sp_ = 0; while (__hip_atomic_load(ctl + CW_SEGA + 64 * bh, RLX_AGENT) < 8u) { __builtin_amdgcn_s_sleep(4); if (++sp_ > (1u << 24)) break; }
                    __builtin_amdgcn_fence(__ATOMIC_ACQUIRE, "agent"); asm volatile("s_waitcnt vmcnt(0)" ::: "memory"); }
                __syncthreads();
                constexpr int ST_ROW = 272, ST_BYTES = 128 * ST_ROW;
                const int nt = wave & 3, mt0 = 2 * (wave >> 2);
                const float* seg0 = (const float*)(args.ws + WS_SEG) + (size_t)(bh * 8) * 32768;
                const unsigned char* pa0 = args.ws + WS_SEGP + (size_t)(bh * 8) * 32768 + lane * 16;
                float* sst0 = (float*)(args.ws + WS_SST) + (size_t)(bh * 8) * 16384;
#define PB_LOADA(dst, k_) do { const unsigned char* pk_ = pa0 + (size_t)(k_) * 32768; \
                    _Pragma("unroll") for (int i_ = 0; i_ < 2; ++i_) _Pragma("unroll") for (int f_ = 0; f_ < 8; ++f_) dst[i_ * 8 + f_] = *(const bf16x8*)(pk_ + (((mt0 + i_) * 4) * 2 + f_) * 1024); } while (0)
#define PB_ITER(k_, Acur, Anext) do { \
                    if ((k_) + 1 <= 6) PB_LOADA(Anext, (k_) + 1); \
                    const float* sk_ = seg0 + (size_t)(k_) * 32768; \
                    f32x16 z0_[2], Z_[2]; \
                    _Pragma("unroll") for (int i_ = 0; i_ < 2; ++i_) _Pragma("unroll") for (int q_ = 0; q_ < 16; ++q_) { z0_[i_][q_] = sk_[((nt * 4 + mt0 + i_) * 16 + q_) * 64 + lane]; Z_[i_][q_] = 0.f; } \
                    if ((k_) > 0) { const LAS unsigned char* stc_ = lds + ((k_) & 1) * ST_BYTES + (32 * nt + r) * ST_ROW + 16 * h; \
                        _Pragma("unroll") for (int f_ = 0; f_ < 8; ++f_) { const bf16x8 bfr_ = *(const LAS bf16x8*)(stc_ + (16 * f_) * 2); \
                            Z_[0] = MFMA32(Acur[f_], bfr_, Z_[0]); Z_[1] = MFMA32(Acur[8 + f_], bfr_, Z_[1]); } } \
                    float* so_ = sst0 + (size_t)((k_) + 1) * 16384; \
                    LAS unsigned char* stn_ = lds + (((k_) + 1) & 1) * ST_BYTES + (32 * nt + r) * ST_ROW; \
                    _Pragma("unroll") for (int i_ = 0; i_ < 2; ++i_) { \
                        _Pragma("unroll") for (int q_ = 0; q_ < 16; ++q_) { Z_[i_][q_] += z0_[i_][q_]; so_[((nt * 4 + mt0 + i_) * 16 + q_) * 64 + lane] = Z_[i_][q_]; } \
                        _Pragma("unroll") for (int q_ = 0; q_ < 16; q_ += 2) *(LAS unsigned*)(stn_ + (32 * (mt0 + i_) + crow(q_, h)) * 2) = cvtpk(Z_[i_][q_], Z_[i_][q_ + 1]); } \
                    SCAN_BAR(); } while (0)
                bf16x8 Aa[16], Ab[16];
#pragma unroll
                for (int f = 0; f < 16; ++f) { Aa[f] = (bf16x8){0, 0, 0, 0, 0, 0, 0, 0}; Ab[f] = Aa[f]; }
                PB_ITER(0, Ab, Aa);
                PB_ITER(1, Aa, Ab);
                PB_ITER(2, Ab, Aa);
                PB_ITER(3, Aa, Ab);
                PB_ITER(4, Ab, Aa);
                PB_ITER(5, Aa, Ab);
                PB_ITER(6, Ab, Aa);
#undef PB_ITER
#undef PB_LOADA
                asm volatile("s_waitcnt vmcnt(0)" ::: "memory");
                __syncthreads();
                if (tid == 0) { __builtin_amdgcn_fence(__ATOMIC_RELEASE, "agent"); asm volatile("s_waitcnt vmcnt(0)" ::: "memory"); __hip_atomic_store(ctl + CW_SEGB + 64 * bh, 1u, RLX_AGENT); }
            }
            if (tid == 0) { unsigned sp_ = 0; while (__hip_atomic_load(ctl + CW_SEGB + 64 * bh, RLX_AGENT) == 0u) { __builtin_amdgcn_s_sleep(4); if (++sp_ > (1u << 24)) break; }
                __builtin_amdgcn_fence(__ATOMIC_ACQUIRE, "agent"); asm volatile("s_waitcnt vmcnt(0)" ::: "memory"); }
            __syncthreads();
#undef FRAG
            const kargp_t ap2_ = karg_ptr();
            const unsigned char* ops = ((*ap2_).ws + WS_OPS) + (size_t)(bh * 128 + c0) * OPS_BYTES;
            const float* Uf = (const float*)((const unsigned char*)((*ap2_).ws + WS_U) + (size_t)(bh * 128 + c0) * 16384);
            const float* sstp = (const float*)((*ap2_).ws + WS_SST) + (size_t)(bh * 8 + seg) * 16384;
#define SCAN_DMA(n_, buf_) do { const unsigned char* src_ = ops + (size_t)(n_) * OPS_BYTES + ((wave - 4) * 14) * 1024 + lane * 16; \
            _Pragma("unroll") for (int p_ = 0; p_ < 14; ++p_) __builtin_amdgcn_global_load_lds((const unsigned*)(src_ + p_ * 1024), (LAS unsigned*)(lds + (buf_) * OPS_BYTES + ((wave - 4) * 14 + p_) * 1024), 16, 0, 0); } while (0)
            constexpr int STG_OFF = 2 * OPS_BYTES, STG_ROW = 272, STG_BYTES = 64 * STG_ROW;
            if (wave < 4) {
                f32x16 S[4]; v4u Ur[4];
#pragma unroll
                for (int t2 = 0; t2 < 4; ++t2)
#pragma unroll
                    for (int q = 0; q < 16; ++q) S[t2][q] = (seg > 0) ? sstp[((wave * 4 + t2) * 16 + q) * 64 + lane] : 0.f;
#pragma unroll
                for (int f = 0; f < 4; ++f) Ur[f] = *((const v4u*)Uf + (wave * 4 + f) * 64 + lane);
                const float* glp = glbuf + bh * 128 + c0;
                float eglr = glp[0];
                for (int n = 0; n < SEGC; ++n) {
                    SCAN_BAR();
                    const LAS unsigned char* Bf = lds + (n & 1) * OPS_BYTES + lane * 16;
#define FRAG(f_) (*(const LAS bf16x8*)(Bf + (f_) * 1024))
                    f32x16 VN[2], O[2];
#pragma unroll
                    for (int mt = 0; mt < 2; ++mt)
#pragma unroll
                        for (int q8 = 0; q8 < 2; ++q8) { const v4u u = Ur[mt * 2 + q8];
                            VN[mt][8 * q8 + 0] = bflo(u.x); VN[mt][8 * q8 + 1] = bfhi(u.x); VN[mt][8 * q8 + 2] = bflo(u.y); VN[mt][8 * q8 + 3] = bfhi(u.y);
                            VN[mt][8 * q8 + 4] = bflo(u.z); VN[mt][8 * q8 + 5] = bfhi(u.z); VN[mt][8 * q8 + 6] = bflo(u.w); VN[mt][8 * q8 + 7] = bfhi(u.w); }
                    const float egl = eglr;
                    if (n + 1 < SEGC) {
                        const v4u* up = (const v4u*)((const unsigned char*)Uf + (size_t)(n + 1) * 16384) + (wave * 4) * 64 + lane;
#pragma unroll
                        for (int f = 0; f < 4; ++f) Ur[f] = up[f * 64];
                        eglr = glp[n + 1];
                    }
#pragma unroll
                    for (int mt = 0; mt < 2; ++mt)
#pragma unroll
                        for (int q = 0; q < 16; ++q) O[mt][q] = 0.f;
#pragma unroll
                    for (int t2 = 0; t2 < 4; ++t2)
#pragma unroll
                        for (int s2 = 0; s2 < 2; ++s2) {
                            const bf16x8 sb = pack8(S[t2], s2);
#pragma unroll
                            for (int mt = 0; mt < 2; ++mt) {
                                VN[mt] = MFMA32(FRAG((mt * 4 + t2) * 2 + s2), sb, VN[mt]);
                                O[mt] = MFMA32(FRAG(16 + (mt * 4 + t2) * 2 + s2), sb, O[mt]);
                            }
                        }
                    bf16x8 vb[2][2];
#pragma unroll
                    for (int mt = 0; mt < 2; ++mt)
#pragma unroll
                        for (int s2 = 0; s2 < 2; ++s2) vb[mt][s2] = pack8(VN[mt], s2);
#pragma unroll
                    for (int s2 = 0; s2 < 2; ++s2) {
                        O[0] = MFMA32(FRAG(48 + 0 * 2 + s2), vb[0][s2], O[0]);
                        O[1] = MFMA32(FRAG(48 + 2 * 2 + s2), vb[0][s2], O[1]);
                        O[1] = MFMA32(FRAG(48 + 3 * 2 + s2), vb[1][s2], O[1]);
                    }
                    {
                        LAS unsigned short* sp = (LAS unsigned short*)(lds + STG_OFF + (n & 1) * STG_BYTES) + 32 * wave + r;
#pragma unroll
                        for (int mt = 0; mt < 2; ++mt)
#pragma unroll
                            for (int q = 0; q < 16; q += 2) { const unsigned w = cvtpk(O[mt][q], O[mt][q + 1]);
                                sp[(32 * mt + crow(q, h)) * (STG_ROW / 2)] = (unsigned short)(w & 0xffffu); sp[(32 * mt + crow(q + 1, h)) * (STG_ROW / 2)] = (unsigned short)(w >> 16); }
                    }
                    SCAN_BAR();
#pragma unroll
                    for (int t2 = 0; t2 < 4; ++t2) {
#pragma unroll
                        for (int q = 0; q < 16; ++q) S[t2][q] *= egl;
#pragma unroll
                        for (int mt = 0; mt < 2; ++mt)
#pragma unroll
                            for (int s2 = 0; s2 < 2; ++s2) S[t2] = MFMA32(FRAG(32 + (t2 * 2 + mt) * 2 + s2), vb[mt][s2], S[t2]);
                    }
#undef FRAG
                }
                SCAN_BAR();
            } else {
                const int w4 = wave - 4, row = 16 * w4 + (lane >> 2), qt = lane & 3;
                const bf16* zp = zsb + ((size_t)b * T + c0 * 64 + row) * 512 + hh * 128 + qt * 32;
                bf16* op = omix + ((size_t)b * T + c0 * 64 + row) * D + hh * 128 + qt * 32;
                SCAN_DMA(0, 0);
                asm volatile("s_waitcnt vmcnt(0)" ::: "memory");
                v4u zr[4];
#pragma unroll
                for (int k = 0; k < 4; ++k) zr[k] = *(const v4u*)(zp + 8 * k);
                unsigned pfacc = 0u, pf0 = 0u, pf1 = 0u;
                for (int n = 0; n <= SEGC; ++n) {
                    SCAN_BAR();
                    if (n < SEGC - 1) SCAN_DMA(n + 1, (n + 1) & 1);
                    asm volatile("" ::: "memory");
                    if (n < SEGC - 2) {
                        const unsigned char* pf = ops + (size_t)(n + 2) * OPS_BYTES + (w4 * 112 + lane) * 128;
                        pfacc += pf0 + pf1; pf0 = *(const unsigned*)pf; pf1 = (lane < 48) ? *(const unsigned*)(pf + 64 * 128) : 0u;
                    }
                    asm volatile("" ::: "memory");
                    if (n < SEGC) SCAN_BAR();
                    if (n > 0) {
                        const LAS unsigned char* sp = lds + STG_OFF + ((n - 1) & 1) * STG_BYTES + row * STG_ROW + qt * 64;
                        v4u ov[4]; float ss = 0.f;
#pragma unroll
                        for (int k = 0; k < 4; ++k) { ov[k] = *(const LAS v4u*)(sp + 16 * k);
                            const float a0 = bflo(ov[k].x), a1 = bfhi(ov[k].x), a2 = bflo(ov[k].y), a3 = bfhi(ov[k].y), a4 = bflo(ov[k].z), a5 = bfhi(ov[k].z), a6 = bflo(ov[k].w), a7 = bfhi(ov[k].w);
                            ss += (a0 * a0 + a1 * a1) + (a2 * a2 + a3 * a3) + (a4 * a4 + a5 * a5) + (a6 * a6 + a7 * a7); }
                        ss += __shfl_xor(ss, 1); ss += __shfl_xor(ss, 2);
                        const float rstd = rsqrtf(ss * (1.0f / 128.0f) + EPS);
                        bf16* o2 = op + (size_t)(n - 1) * 64 * D;
#pragma unroll
                        for (int k = 0; k < 4; ++k) {
                            v4u w;
                            w.x = cvtpk(bflo(ov[k].x) * rstd * bflo(zr[k].x), bfhi(ov[k].x) * rstd * bfhi(zr[k].x));
                            w.y = cvtpk(bflo(ov[k].y) * rstd * bflo(zr[k].y), bfhi(ov[k].y) * rstd * bfhi(zr[k].y));
                            w.z = cvtpk(bflo(ov[k].z) * rstd * bflo(zr[k].z), bfhi(ov[k].z) * rstd * bfhi(zr[k].z));
                            w.w = cvtpk(bflo(ov[k].w) * rstd * bflo(zr[k].w), bfhi(ov[k].w) * rstd * bfhi(zr[k].w));
                            *(v4u*)(o2 + 8 * k) = w;
                        }
                    }
                    asm volatile("" ::: "memory");
                    if (n >= 1 && n < SEGC) {
#pragma unroll
                        for (int k = 0; k < 4; ++k) zr[k] = *(const v4u*)(zp + (size_t)n * 64 * 512 + 8 * k);
                    }
                    asm volatile("" ::: "memory");
                    if (n < SEGC) { if (n == 0 || n >= SEGC - 2) asm volatile("s_waitcnt vmcnt(0)" ::: "memory"); else asm volatile("s_waitcnt vmcnt(10)" ::: "memory"); }
                }
                if (pfacc == 0x12345679u) glbuf[1024 + lane] = 1.0f;
            }
#undef SCAN_DMA
#undef SCAN_BAR
        } else {
            const float* relb = args.in[I_RELB];
            ldsf* rbl = (ldsf*)lds;
            for (int idx = tid; idx < 8 * 257; idx += NTHR) rbl[idx] = relb[idx] * 1.4426950408889634f;
            __syncthreads();
            const int r = lane & 31, h = lane >> 5;
            const int AW = (G - 64) * NWAVES, aw = (bx - 64) * NWAVES + wave;
            for (int task = aw; task < 4096; task += AW) {
                const int qh = task & 1, hh = (task >> 1) & 7, n = (task >> 4) & 127, b = task >> 11;
                const int bhc = (b * 8 + hh) * 128;
                bf16x8 qf[4];
#pragma unroll
                for (int ks = 0; ks < 4; ++ks) qf[ks] = *(const bf16x8*)(qfb + (size_t)(bhc + n) * 8192 + (qh * 4 + ks) * 1024 + lane * 16);
                f32x16 OT[2];
#pragma unroll
                for (int dt = 0; dt < 2; ++dt)
#pragma unroll
                    for (int q = 0; q < 16; ++q) OT[dt][q] = 0.f;
                float m = -1e30f, l = 0.f;
                const float c0 = rbl[hh * 257 + 256];
                const int iq = 32 * qh + r;
                const int cb0 = (n >= 8) ? 0 : 8 - n;
                for (int blk = cb0 * 2; blk < 18; ++blk) {
                    const int cb = blk >> 1, kb2 = blk & 1, cidx = n - 8 + cb;
                    const unsigned char* kp = kfb + (size_t)(bhc + cidx) * 8192 + (kb2 * 4) * 1024 + lane * 16;
                    const unsigned char* vp = vtfb + (size_t)(bhc + cidx) * 8192 + lane * 16;
                    bf16x8 kf[4], vf[2][2];
#pragma unroll
                    for (int ks = 0; ks < 4; ++ks) kf[ks] = *(const bf16x8*)(kp + ks * 1024);
#pragma unroll
                    for (int dt = 0; dt < 2; ++dt)
#pragma unroll
                        for (int s2 = 0; s2 < 2; ++s2) vf[dt][s2] = *(const bf16x8*)(vp + ((dt * 2 + kb2) * 2 + s2) * 1024);
                    f32x16 st;
#pragma unroll
                    for (int q = 0; q < 16; ++q) st[q] = 0.f;
#pragma unroll
                    for (int ks = 0; ks < 4; ++ks) st = MFMA32(kf[ks], qf[ks], st);
                    if (cb >= 6) {
                        const int kpos0 = cb * 64 + 32 * kb2;
#pragma unroll
                        for (int q = 0; q < 16; ++q) { int rel = iq + 512 - (kpos0 + crow(q, h)); rel = rel > 128 ? 128 : rel; st[q] = st[q] * 0.18033688011112042f + rbl[hh * 257 + rel + 128]; }
                    } else {
#pragma unroll
                        for (int q = 0; q < 16; ++q) st[q] = st[q] * 0.18033688011112042f + c0;
                    }
                    float bm = st[0];
#pragma unroll
                    for (int q = 1; q < 16; ++q) bm = fmaxf(bm, st[q]);
                    bm = fmaxf(bm, __shfl_xor(bm, 32));
                    const float mn = fmaxf(m, bm);
                    if (__any(mn > m)) {
                        const float corr = __builtin_amdgcn_exp2f(m - mn);
                        l *= corr;
#pragma unroll
                        for (int dt = 0; dt < 2; ++dt)
#pragma unroll
                            for (int q = 0; q < 16; ++q) OT[dt][q] *= corr;
                        m = mn;
                    }
                    float ps = 0.f;
#pragma unroll
                    for (int q = 0; q < 16; ++q) { st[q] = __builtin_amdgcn_exp2f(st[q] - m); ps += st[q]; }
                    ps += __shfl_xor(ps, 32);
                    l += ps;
                    const bf16x8 p0 = pack8(st, 0), p1 = pack8(st, 1);
#pragma unroll
                    for (int dt = 0; dt < 2; ++dt) { OT[dt] = MFMA32(vf[dt][0], p0, OT[dt]); OT[dt] = MFMA32(vf[dt][1], p1, OT[dt]); }
                }
                const float inv = 1.0f / l;
                bf16* op = omix + ((size_t)b * T + n * 64 + iq) * D + 512 + hh * 64;
#pragma unroll
                for (int dt = 0; dt < 2; ++dt)
#pragma unroll
                    for (int q4 = 0; q4 < 4; ++q4) {
                        v2u w; w.x = cvtpk(OT[dt][4 * q4] * inv, OT[dt][4 * q4 + 1] * inv); w.y = cvtpk(OT[dt][4 * q4 + 2] * inv, OT[dt][4 * q4 + 3] * inv);
                        *(v2u*)(op + 32 * dt + 8 * q4 + 4 * h) = w;
                    }
            }
            __syncthreads();
            {
                ldsf* scr = (ldsf*)(lds + wave * 16384);
                constexpr int I_UP1 = 16 * 64, I_DN1 = 16 * 32;
                for (int it = aw; it < NE * (I_UP1 + I_DN1); it += AW) {
                    int r2 = it;
                    if (r2 < NE * I_UP1) { const int e = r2 / I_UP1; transpose_item8(args.in[I_WUP] + (size_t)e * D * 2048, D, 2048, (unsigned char*)WupT + (size_t)e * 2048 * D, 2, scr, r2 % I_UP1, lane); continue; } r2 -= NE * I_UP1;
                    { const int e = r2 / I_DN1; transpose_item8(args.in[I_WDN] + (size_t)e * D * D, D, D, (unsigned char*)WdnT + (size_t)e * D * D, 1, scr, r2 % I_DN1, lane); }
                }
            }
        }
        if (BOTH(4)) GRID_BAR();
    }


    if (IN(6)) {
        const int lane = (int)__builtin_amdgcn_mbcnt_hi(~0u, __builtin_amdgcn_mbcnt_lo(~0u, 0u)), tid = wave * 64 + lane; const kargp_t ap_ = karg_ptr();
        pg8::Gemm g{omix, WoutT, NTOK, D, D}; pg8::StaticOrder S; S.init(NTOK, D, G, bx);
        pg8::EpiF32 E{ybuf, D};
        pg8::gemm_phase<pg8::EpiF32, pg8::StaticOrder, false, true>(lds, g, S, E, tid);
        if (BOTH(6)) GRID_BAR();
    }

    if (IN(7)) {
        const int lane = (int)__builtin_amdgcn_mbcnt_hi(~0u, __builtin_amdgcn_mbcnt_lo(~0u, 0u)), tid = wave * 64 + lane; const kargp_t ap_ = karg_ptr();
        ldsf* wrT = (ldsf*)lds;
        const float* w_r = args.in[I_WR];
#pragma unroll 4
        for (int it = 0; it < 64; ++it) { const int idx = tid + it * NTHR, col = idx >> 5, e = idx & 31; wrT[e * 1024 + col] = w_r[idx]; }
        LAS int* lcnt = (LAS int*)(lds + 131072);
        if (tid < 32) lcnt[tid] = 0;
        __syncthreads();
        const float* nw1 = args.in[I_NORMW] + 1024; const float* nw2 = args.in[I_NORMW] + 2048; const float* b_r = args.in[I_BR];
        f32x4 ynx[4], xnx[4];
#pragma unroll
        for (int j = 0; j < 4; ++j) { ynx[j] = *((const f32x4*)(ybuf + (size_t)gw * D) + lane + 64 * j); xnx[j] = *((const f32x4*)(Xp + (size_t)gw * D) + lane + 64 * j); }
        for (int bb = 0; bb < BATCH; ++bb) {
        f32x4 g1v[4], a2v[4], sh2v[4];
#pragma unroll
        for (int j = 0; j < 4; ++j) { const int col = 4 * lane + 256 * j;
            const f32x4 n1 = *(const f32x4*)(nw1 + col), ga = *(const f32x4*)(MODp + bb * 6144 + 2048 + col), n2 = *(const f32x4*)(nw2 + col), sc = *(const f32x4*)(MODp + bb * 6144 + 4096 + col);
            sh2v[j] = *(const f32x4*)(MODp + bb * 6144 + 3072 + col);
#pragma unroll
            for (int e = 0; e < 4; ++e) { g1v[j][e] = ga[e] * n1[e]; a2v[j][e] = n2[e] * (1.0f + sc[e]); } }
        for (int r = gw + bb * (NTOK / BATCH); r < (bb + 1) * (NTOK / BATCH); r += NGW) {
            f32x4 v[4], xv4[4]; float ss = 0.f;
#pragma unroll
            for (int j = 0; j < 4; ++j) { v[j] = ynx[j]; xv4[j] = xnx[j]; ss += (v[j].x * v[j].x + v[j].y * v[j].y) + (v[j].z * v[j].z + v[j].w * v[j].w); }
            __builtin_amdgcn_sched_barrier(0);
            if (r + NGW < NTOK) {
#pragma unroll
                for (int j = 0; j < 4; ++j) { ynx[j] = *((const f32x4*)(ybuf + (size_t)(r + NGW) * D) + lane + 64 * j); xnx[j] = *((const f32x4*)(Xp + (size_t)(r + NGW) * D) + lane + 64 * j); }
            }
            __builtin_amdgcn_sched_barrier(0);
            const float rstd1 = rsqrtf(wave_sum(ss) * (1.0f / D) + EPS);
            float ss2 = 0.f;
#pragma unroll
            for (int j = 0; j < 4; ++j) {
#pragma unroll
                for (int e = 0; e < 4; ++e) { v[j][e] = xv4[j][e] + g1v[j][e] * (v[j][e] * rstd1); ss2 += v[j][e] * v[j][e]; }
            }
            const float rstd2 = rsqrtf(wave_sum(ss2) * (1.0f / D) + EPS);
            f32x4 hv[4]; unsigned h8[4];
#pragma unroll
            for (int j = 0; j < 4; ++j) {
#pragma unroll
                for (int e = 0; e < 4; ++e) hv[j][e] = v[j][e] * rstd2 * a2v[j][e] + sh2v[j][e];
                h8[j] = pg8::pk4_fp8(hv[j][0], hv[j][1], hv[j][2], hv[j][3]);
            }
#pragma unroll
            for (int j = 0; j < 4; ++j) { const int col = 4 * lane + 256 * j; *(f32x4*)(OUTp + (size_t)r * D + col) = v[j]; *(unsigned*)((unsigned char*)hbuf + (size_t)r * D + col) = h8[j]; }
            float pe[32];
#pragma unroll
            for (int e = 0; e < 32; ++e) {
                float p = 0.f;
#pragma unroll
                for (int j = 0; j < 4; ++j) { const f32x4 w = *(const LAS f32x4*)(wrT + e * 1024 + 4 * lane + 256 * j); p += (hv[j][0] * w[0] + hv[j][1] * w[1]) + (hv[j][2] * w[2] + hv[j][3] * w[3]); }
                pe[e] = p;
                if ((e & 1) == 1) asm volatile("" ::: "memory");
            }
            float r16[16];
            { const bool up = lane >= 32;
#pragma unroll
              for (int e = 0; e < 16; ++e) { const float send = up ? pe[e] : pe[e + 16], keep = up ? pe[e + 16] : pe[e]; r16[e] = keep + xchg32(send, lane); } }
            float r8[8];
            { const bool up = (lane & 16) != 0;
#pragma unroll
              for (int e = 0; e < 8; ++e) { const float send = up ? r16[e] : r16[e + 8], keep = up ? r16[e + 8] : r16[e]; r8[e] = keep + xchg16(send, lane); } }
            float r4[4];
            { const bool up = (lane & 8) != 0;
#pragma unroll
              for (int e = 0; e < 4; ++e) { const float send = up ? r8[e] : r8[e + 4], keep = up ? r8[e + 4] : r8[e]; r4[e] = keep + dppx<0x128>(send); } }
            float r2[2];
            { const bool up = (lane & 4) != 0;
#pragma unroll
              for (int e = 0; e < 2; ++e) { const float send = up ? r4[e] : r4[e + 2], keep = up ? r4[e + 2] : r4[e]; r2[e] = keep + __shfl_xor(send, 4); } }
            float r1;
            { const bool up = (lane & 2) != 0; const float send = up ? r2[0] : r2[1], keep = up ? r2[1] : r2[0]; r1 = keep + dppx<0x4E>(send); }
            r1 += dppx<0xB1>(r1);
            const int eid = ((lane >> 5) << 4) | (((lane >> 4) & 1) << 3) | (((lane >> 3) & 1) << 2) | (((lane >> 2) & 1) << 1) | ((lane >> 1) & 1);
            float mylg = r1 + b_r[eid];
            int se[4]; float sv[4];
#pragma unroll
            for (int k = 0; k < 4; ++k) {
                const float bv = wave_max(mylg); const int bi = wave_min_i(mylg == bv ? eid : 99);
                se[k] = bi; sv[k] = bv;
                if (eid == bi) mylg = -3.0e38f;
            }
            const float e1 = __expf(sv[1] - sv[0]), e2 = __expf(sv[2] - sv[0]), e3 = __expf(sv[3] - sv[0]);
            const float inv = 1.0f / (1.0f + e1 + e2 + e3);
            if (lane < 4 && !(args.pad & 32)) {
                const int mye = lane == 0 ? se[0] : (lane == 1 ? se[1] : (lane == 2 ? se[2] : se[3]));
                const float myg = (lane == 0 ? 1.0f : (lane == 1 ? e1 : (lane == 2 ? e2 : e3))) * inv;
                const unsigned pos = atomicAdd((unsigned*)lcnt + mye, 1u);
                asg_e[r * 4 + lane] = mye; asg_p[r * 4 + lane] = (int)pos; asg_g[r * 4 + lane] = myg;
            }
        }
        }
        __syncthreads();
        if (tid < 32) ((int*)(ctl + CW_HIST))[vcu * 32 + tid] = lcnt[tid];
        if (BOTH(7)) GRID_BAR();
    }

    LAS int* pst = (LAS int*)(lds + MISC_OFF + 512);
    LAS int* tile_e = (LAS int*)(lds + MISC_OFF + 768);
    LAS int* wbase = (LAS int*)(lds + MISC_OFF + 384);
    if (hi > 8 && lo <= 10) {
        const kargp_t ap_ = karg_ptr();
        const int tix = wave * 64 + (int)__builtin_amdgcn_mbcnt_hi(~0u, __builtin_amdgcn_mbcnt_lo(~0u, 0u));
        {
            LAS int* tmp = (LAS int*)lds;
            const int e = tix & 31, part = tix >> 5; int tot = 0, bef = 0;
            const int* hist = (const int*)(ctl + CW_HIST);
            for (int bb = part; bb < G; bb += 16) { const int c = hist[bb * 32 + e]; tot += c; bef += (bb < vcu) ? c : 0; }
            tmp[part * 32 + e] = tot; tmp[512 + part * 32 + e] = bef;
            __syncthreads();
            if (tix < 32) { int t2 = 0, b2 = 0;
#pragma unroll
                for (int p = 0; p < 16; ++p) { t2 += tmp[p * 32 + tix]; b2 += tmp[512 + p * 32 + tix]; }
                tmp[1024 + tix] = t2; wbase[tix] = b2; ((LAS int*)(lds + MISC_OFF + 1920))[tix] = t2; }
            __syncthreads();
            if (tix == 0) { int run = 0, rt = 0;
                for (int e2 = 0; e2 < NE; ++e2) { pst[e2] = run; const int c = tmp[1024 + e2]; const int nt = (c + 255) >> 8; for (int t2 = 0; t2 < nt; ++t2) tile_e[rt++] = e2; run += nt * 256; }
                pst[32] = run; }
        }
        __syncthreads();
    }
    const int nslots = (hi > 8 && lo <= 10) ? pst[32] : 0;

    if (IN(8)) {
        const int lane = (int)__builtin_amdgcn_mbcnt_hi(~0u, __builtin_amdgcn_mbcnt_lo(~0u, 0u)), tid = wave * 64 + lane; const kargp_t ap_ = karg_ptr();
        {
            int* stok = (int*)(P_WS + WS_STOK);
            for (int r = gw; r < NTOK; r += NGW) {
                if (lane < 4) { const int a = r * 4 + lane; const int e = asg_e[a], pos = asg_p[a]; const int slot = pst[e] + wbase[e] + pos; asg_s[a] = slot; stok[slot] = r; }
            }
            if (bx < NE) {
                const int c = ((LAS int*)(lds + MISC_OFF + 1920))[bx], pad = (c + 255) & ~255;
                for (int s2 = c + tid; s2 < pad; s2 += NTHR) stok[pst[bx] + s2] = 0;
            }
        }
        if (BOTH(8)) GRID_BAR();
    }

    if (IN(9)) {
        const int lane = (int)__builtin_amdgcn_mbcnt_hi(~0u, __builtin_amdgcn_mbcnt_lo(~0u, 0u)), tid = wave * 64 + lane; const kargp_t ap_ = karg_ptr();
        pg8::Gemm g{hbuf, WupT, nslots, 2048, D}; pg8::MoeOrder S; S.init(nslots, 2048, G, bx); S.tile_e = tile_e; S.estride = (size_t)2048 * D; S.rowidx = (const int*)(P_WS + WS_STOK);
        pg8::EpiSwiGLU E{(unsigned char*)actb, args.in[I_BUP], tile_e, 1.0f / 32.0f};
        pg8::gemm_phase<pg8::EpiSwiGLU, pg8::MoeOrder, true, true, true, true>(lds, g, S, E, tid);
        if (BOTH(9)) GRID_BAR();
    }

    if (IN(10)) {
        const int lane = (int)__builtin_amdgcn_mbcnt_hi(~0u, __builtin_amdgcn_mbcnt_lo(~0u, 0u)), tid = wave * 64 + lane; const kargp_t ap_ = karg_ptr();
        pg8::Gemm g{actb, WdnT, nslots, D, D}; pg8::MoeOrder S; S.init(nslots, D, G, bx); S.tile_e = tile_e; S.estride = (size_t)D * D;
        pg8::EpiBf16 E{yslot, D, args.in[I_BDN], tile_e, D, 1.0f / 32.0f};
        pg8::gemm_phase<pg8::EpiBf16, pg8::MoeOrder, true, true, true>(lds, g, S, E, tid);
        if (BOTH(10)) GRID_BAR();
    }

    if (IN(11)) {
        const int lane = (int)__builtin_amdgcn_mbcnt_hi(~0u, __builtin_amdgcn_mbcnt_lo(~0u, 0u)), tid = wave * 64 + lane; const kargp_t ap_ = karg_ptr();
        const float* nw3 = args.in[I_NORMW] + 3072;
        int sln[4]; float gtn[4];
#pragma unroll
        for (int k = 0; k < 4; ++k) { sln[k] = asg_s[gw * 4 + k]; gtn[k] = asg_g[gw * 4 + k]; }
        v2u ywn[4][4]; f32x4 xon[4]; float gtc[4];
#pragma unroll
        for (int k = 0; k < 4; ++k) { gtc[k] = gtn[k];
#pragma unroll
            for (int j = 0; j < 4; ++j) ywn[k][j] = *(const v2u*)(yslot + (size_t)sln[k] * D + 4 * lane + 256 * j); }
#pragma unroll
        for (int j = 0; j < 4; ++j) xon[j] = *(const f32x4*)(OUTp + (size_t)gw * D + 4 * lane + 256 * j);
        if (gw + NGW < NTOK) {
#pragma unroll
            for (int k = 0; k < 4; ++k) { sln[k] = asg_s[(gw + NGW) * 4 + k]; gtn[k] = asg_g[(gw + NGW) * 4 + k]; }
        }
        for (int bb = 0; bb < BATCH; ++bb) {
        f32x4 g3v[4];
#pragma unroll
        for (int j = 0; j < 4; ++j) { const int col = 4 * lane + 256 * j; const f32x4 n3 = *(const f32x4*)(nw3 + col), ga = *(const f32x4*)(MODp + bb * 6144 + 5120 + col);
#pragma unroll
            for (int e = 0; e < 4; ++e) g3v[j][e] = ga[e] * n3[e]; }
        for (int r = gw + bb * (NTOK / BATCH); r < (bb + 1) * (NTOK / BATCH); r += NGW) {
            v2u yw[4][4]; f32x4 xo[4]; float gt[4];
#pragma unroll
            for (int k = 0; k < 4; ++k) { gt[k] = gtc[k];
#pragma unroll
                for (int j = 0; j < 4; ++j) yw[k][j] = ywn[k][j]; }
#pragma unroll
            for (int j = 0; j < 4; ++j) xo[j] = xon[j];
            __builtin_amdgcn_sched_barrier(0);
            if (r + NGW < NTOK) {
#pragma unroll
                for (int k = 0; k < 4; ++k) { gtc[k] = gtn[k];
#pragma unroll
                    for (int j = 0; j < 4; ++j) ywn[k][j] = *(const v2u*)(yslot + (size_t)sln[k] * D + 4 * lane + 256 * j); }
#pragma unroll
                for (int j = 0; j < 4; ++j) xon[j] = *(const f32x4*)(OUTp + (size_t)(r + NGW) * D + 4 * lane + 256 * j);
                if (r + 2 * NGW < NTOK) {
#pragma unroll
                    for (int k = 0; k < 4; ++k) { sln[k] = asg_s[(r + 2 * NGW) * 4 + k]; gtn[k] = asg_g[(r + 2 * NGW) * 4 + k]; }
                }
            }
            __builtin_amdgcn_sched_barrier(0);
            f32x4 acc[4];
#pragma unroll
            for (int j = 0; j < 4; ++j) { acc[j] = (f32x4){0.f, 0.f, 0.f, 0.f};
#pragma unroll
                for (int k = 0; k < 4; ++k) { acc[j][0] += gt[k] * bflo(yw[k][j].x); acc[j][1] += gt[k] * bfhi(yw[k][j].x); acc[j][2] += gt[k] * bflo(yw[k][j].y); acc[j][3] += gt[k] * bfhi(yw[k][j].y); } }
            float ss = 0.f;
#pragma unroll
            for (int j = 0; j < 4; ++j) ss += (acc[j][0] * acc[j][0] + acc[j][1] * acc[j][1]) + (acc[j][2] * acc[j][2] + acc[j][3] * acc[j][3]);
            const float rstd = rsqrtf(wave_sum(ss) * (1.0f / D) + EPS);
#pragma unroll
            for (int j = 0; j < 4; ++j) {
                const int col = 4 * lane + 256 * j;
                f32x4 xv = xo[j];
#pragma unroll
                for (int e = 0; e < 4; ++e) xv[e] += g3v[j][e] * (acc[j][e] * rstd);
                if (!(args.pad & 32)) *(f32x4*)(OUTp + (size_t)r * D + col) = xv;
            }
        }
        }
    }
#undef IN
#undef BOTH
}

#undef P_WS
#undef ctl
#undef Xp
#undef OUTp
#undef MODp
#undef gbuf
#undef betabuf
#undef glbuf
#undef asg_e
#undef asg_p
#undef asg_g
#undef asg_s
#undef WinT
#undef WoutT
#undef WupT
#undef WdnT
#undef hbuf
#undef projb
#undef Ub
#undef opsb
#undef zsb
#undef qfb
#undef kfb
#undef vtfb
#undef omix
#undef ybuf
#undef xg
#undef actb
#undef yslot
#undef args
constexpr int NPHASES = 12;

extern "C" void kernel_launch(void* const* d_in, const int* in_sizes, int n_in, void* d_out, int out_size, void* d_ws, size_t ws_size, hipStream_t stream) {
    static int grid = 0;
    if (grid == 0) {
        if (n_in != 18 || out_size != NTOK * D || ws_size < WS_END) { fprintf(stderr, "kernel_launch: unexpected shapes (n_in %d out %d ws %zu)\n", n_in, out_size, ws_size); grid = -1; return; }
        int dev = 0, cus = 0, per_cu = 0;
        if (hipGetDevice(&dev) != hipSuccess || hipDeviceGetAttribute(&cus, hipDeviceAttributeMultiprocessorCount, dev) != hipSuccess) { grid = -1; return; }
        if (hipFuncSetAttribute((const void*)mk_fwd, hipFuncAttributeMaxDynamicSharedMemorySize, LDS_BYTES) != hipSuccess) { fprintf(stderr, "kernel_launch: hipFuncSetAttribute failed\n"); grid = -1; return; }
        if (hipOccupancyMaxActiveBlocksPerMultiprocessor(&per_cu, (const void*)mk_fwd, NTHR, LDS_BYTES) != hipSuccess || per_cu < 1) { fprintf(stderr, "kernel_launch: occupancy query says %d blocks per CU\n", per_cu); grid = -1; return; }
        (void)hipGetLastError();
        grid = cus;
    }
    if (grid < 0) return;
    (void)hipMemsetAsync((char*)d_ws + WS_CTL, 0, CTL_ZERO_BYTES, stream);
    Args a{};
    for (int i = 0; i < 18; ++i) a.in[i] = (const float*)d_in[i];
    a.out = (float*)d_out; a.ws = (unsigned char*)d_ws;
#if MK_ONE_LAUNCH
#ifndef PROBE_PHASE
#define PROBE_PHASE -1
#endif
#ifndef PROBE_SUB
#define PROBE_SUB 0
#endif
    if (PROBE_PHASE >= 0) {
        const int k = PROBE_PHASE;
        a.ph_lo = 0; a.ph_hi = k + 1; a.li = 0; hipLaunchKernelGGL(mk_fwd, dim3(grid), dim3(NTHR), LDS_BYTES, stream, a);
        a.ph_lo = k; a.ph_hi = k + 1; a.li = 1; a.pad = (k == 7 || k == 11) ? 32 : PROBE_SUB; hipLaunchKernelGGL(mk_fwd, dim3(grid), dim3(NTHR), LDS_BYTES, stream, a); a.pad = 0;
        if (k + 1 < NPHASES) { a.ph_lo = k + 1; a.ph_hi = NPHASES; a.li = 2; hipLaunchKernelGGL(mk_fwd, dim3(grid), dim3(NTHR), LDS_BYTES, stream, a); }
        return;
    }
    a.ph_lo = 0; a.ph_hi = NPHASES; a.li = 0;
    hipLaunchKernelGGL(mk_fwd, dim3(grid), dim3(NTHR), LDS_BYTES, stream, a);
#else
    for (int p = 0; p < NPHASES; ++p) { a.ph_lo = p; a.ph_hi = p + 1; a.li = p; hipLaunchKernelGGL(mk_fwd, dim3(grid), dim3(NTHR), LDS_BYTES, stream, a); }
#endif
}
```

```cpp
#include <hip/hip_runtime.h>
#include <cstdio>
#include <cstdint>

#ifndef MK_ONE_LAUNCH
#define MK_ONE_LAUNCH 1
#endif

namespace pg8 {
#define PG8_LAS __attribute__((address_space(3)))
typedef unsigned short bf16_t;
typedef short bf16x8 __attribute__((ext_vector_type(8)));
typedef float f32x4 __attribute__((ext_vector_type(4)));
typedef unsigned u32x4 __attribute__((ext_vector_type(4)));
constexpr int BM = 256, BK = 64, HALF = 128, HTB = HALF * BK * 2, STAGE_BYTES = 8 * HTB, NXCD = 8, WGM = 8;

__host__ __device__ __forceinline__ int lds_byte(int r, int c) { const int st = (r >> 4) * 2 + (c >> 5), rr = r & 15, cc = c & 31, ob = rr * 64 + cc * 2; return st * 1024 + (ob ^ (((ob >> 9) & 1) << 5)); }
__host__ __device__ __forceinline__ void stage_rc(int b, int& R, int& C) { const int st = b / 1024, sb = b % 1024, swz = sb ^ (((sb >> 9) & 1) << 5); R = (st >> 1) * 16 + swz / 64; C = (st & 1) * 32 + (swz % 64) / 2; }
__host__ __device__ __forceinline__ int perm32(int rho) { const int n = rho >> 4, i = rho & 15; return 8 * (i >> 2) + 4 * n + (i & 3); }

struct Unit { int pm, pn; };
struct Gemm { const bf16_t* A; const bf16_t* Bt; int M, N, K; };

struct StaticOrder {
    int nM, nN, nwg, G, c;
    __host__ __device__ void init(int M, int N, int G_, int c_) { nM = M / BM; nN = N / BM; nwg = nM * nN; G = G_; c = c_; }
    __host__ __device__ bool next(int i, Unit& u) const {
        const long L = (long)i * G + c; if (L >= nwg) return false;
        int wgid = (int)L; { const int q = nwg / NXCD, r = nwg % NXCD, xcd = wgid % NXCD, off = wgid / NXCD; wgid = (xcd < r ? xcd * (q + 1) : r * (q + 1) + (xcd - r) * q) + off; }
        const int nig = WGM * nN, gid = wgid / nig, fm = gid * WGM, gsz = (nM - fm) < WGM ? (nM - fm) : WGM;
        u.pm = fm + ((wgid % nig) % gsz); u.pn = (wgid % nig) / gsz; return true;
    }
    __device__ __forceinline__ size_t boff(const Unit&) const { return 0; }
    const int* rowidx = nullptr;
};
struct MoeOrder : StaticOrder {
    const PG8_LAS int* tile_e; size_t estride;
    __device__ __forceinline__ size_t boff(const Unit& u) const { return (size_t)tile_e[u.pm] * estride; }
};

typedef int v8i_t __attribute__((ext_vector_type(8)));
typedef int v4i_t __attribute__((ext_vector_type(4)));
__device__ __forceinline__ v8i_t cat8(bf16x8 lo, bf16x8 hi) { const v4i_t a = __builtin_bit_cast(v4i_t, lo), b = __builtin_bit_cast(v4i_t, hi); return __builtin_shufflevector(a, b, 0, 1, 2, 3, 4, 5, 6, 7); }
__device__ __forceinline__ unsigned pk4_fp8(float a, float b, float c, float d) {
    a = fminf(fmaxf(a, -448.f), 448.f); b = fminf(fmaxf(b, -448.f), 448.f); c = fminf(fmaxf(c, -448.f), 448.f); d = fminf(fmaxf(d, -448.f), 448.f);
    int w = 0; w = __builtin_amdgcn_cvt_pk_fp8_f32(a, b, w, false); w = __builtin_amdgcn_cvt_pk_fp8_f32(c, d, w, true); return (unsigned)w; }
__device__ __forceinline__ unsigned cvt_pk_bf16(float lo, float hi) { unsigned r; asm volatile("v_cvt_pk_bf16_f32 %0, %1, %2" : "=v"(r) : "v"(lo), "v"(hi)); return r; }

struct EpiF32 {
    static constexpr bool PERM = false;
    float* C; int ldc;
    __device__ __forceinline__ void operator()(const f32x4 (&acc)[2][2][4][2], const Unit& u, int wr, int wc, int fr, int fq) const {
        const int row0 = u.pm * BM + wr * 64 + fr, col0 = u.pn * BM + wc * 32 + 4 * fq;
#pragma unroll
        for (int ai = 0; ai < 2; ++ai)
#pragma unroll
            for (int m = 0; m < 4; ++m) { float* rowp = C + (size_t)(row0 + ai * HALF + m * 16) * ldc + col0;
#pragma unroll
                for (int bj = 0; bj < 2; ++bj)
#pragma unroll
                    for (int n = 0; n < 2; ++n) *(f32x4*)(rowp + bj * HALF + n * 16) = acc[ai][bj][m][n]; }
    }
};
struct EpiBf16 {
    static constexpr bool PERM = true;
    bf16_t* O; int ldc; const float* bias; const PG8_LAS int* tile_e; int bstride; float scale;
    __device__ __forceinline__ void operator()(const f32x4 (&acc)[2][2][4][2], const Unit& u, int wr, int wc, int fr, int fq) const {
        const int row0 = u.pm * BM + wr * 64 + fr; const int col0 = u.pn * BM + wc * 32 + 8 * fq;
        f32x4 bv[2][2];
        const float* bp = bias ? bias + (size_t)tile_e[u.pm] * bstride + col0 : nullptr;
#pragma unroll
        for (int bj = 0; bj < 2; ++bj)
#pragma unroll
            for (int n = 0; n < 2; ++n) bv[bj][n] = bias ? *(const f32x4*)(bp + bj * HALF + 4 * n) : (f32x4){0.f, 0.f, 0.f, 0.f};
#pragma unroll
        for (int ai = 0; ai < 2; ++ai)
#pragma unroll
            for (int m = 0; m < 4; ++m) { bf16_t* rowp = O + (size_t)(row0 + ai * HALF + m * 16) * ldc + col0;
#pragma unroll
                for (int bj = 0; bj < 2; ++bj) { f32x4 v0 = acc[ai][bj][m][0] * scale + bv[bj][0], v1 = acc[ai][bj][m][1] * scale + bv[bj][1];
                    u32x4 w; w.x = cvt_pk_bf16(v0[0], v0[1]); w.y = cvt_pk_bf16(v0[2], v0[3]); w.z = cvt_pk_bf16(v1[0], v1[1]); w.w = cvt_pk_bf16(v1[2], v1[3]);
                    *(u32x4*)(rowp + bj * HALF) = w; } }
    }
};
struct EpiSwiGLU {
    static constexpr bool PERM = true;
    unsigned char* O; const float* b_up; const PG8_LAS int* tile_e; float scale;
    __device__ __forceinline__ float act1(float g, float l) const {
        g = fminf(g, 7.0f); l = fminf(fmaxf(l, -7.0f), 7.0f);
        const float s = __builtin_amdgcn_rcpf(1.0f + __expf(-1.702f * g));
        return g * s * (l + 1.0f);
    }
    __device__ __forceinline__ void operator()(const f32x4 (&acc)[2][2][4][2], const Unit& u, int wr, int wc, int fr, int fq) const {
        const int row0 = u.pm * BM + wr * 64 + fr; const int cin = wc * 32 + 8 * fq;
        const float* bg = b_up + (size_t)tile_e[u.pm] * 2048 + 128 * u.pn + cin;
        f32x4 bgv[2], blv[2];
#pragma unroll
        for (int n = 0; n < 2; ++n) { bgv[n] = *(const f32x4*)(bg + 4 * n); blv[n] = *(const f32x4*)(bg + 1024 + 4 * n); }
#pragma unroll
        for (int ai = 0; ai < 2; ++ai)
#pragma unroll
            for (int m = 0; m < 4; ++m) { unsigned char* rowp = O + (size_t)(row0 + ai * HALF + m * 16) * 1024 + 128 * u.pn + cin;
                const f32x4 g0 = acc[ai][0][m][0] * scale + bgv[0], g1 = acc[ai][0][m][1] * scale + bgv[1], l0 = acc[ai][1][m][0] * scale + blv[0], l1 = acc[ai][1][m][1] * scale + blv[1];
                unsigned w0 = pk4_fp8(act1(g0[0], l0[0]), act1(g0[1], l0[1]), act1(g0[2], l0[2]), act1(g0[3], l0[3]));
                unsigned w1 = pk4_fp8(act1(g1[0], l1[0]), act1(g1[1], l1[1]), act1(g1[2], l1[2]), act1(g1[3], l1[3]));
                typedef unsigned u32x2_t __attribute__((ext_vector_type(2)));
                *(u32x2_t*)rowp = (u32x2_t){w0, w1}; }
    }
};

template <class Epi, class Sched, bool ALIGN_EPI = false, bool SP2 = false, bool F8 = false, bool GATHER = false>
__device__ __forceinline__ void gemm_phase(PG8_LAS unsigned char* lds, const Gemm g, const Sched& S, const Epi& E, const int tid) {
    const int wid = __builtin_amdgcn_readfirstlane(tid >> 6), lane = tid & 63, wr = wid >> 2, wc = wid & 3, fr = lane & 15, fq = lane >> 4;
    constexpr int ES = F8 ? 1 : 2;
    const int K = g.K, nt = K * ES / 128;
    unsigned voffA[2], voffB[2]; int gR[2], gC[2];
#pragma unroll
    for (int i = 0; i < 2; ++i) { int R, C; stage_rc(tid * 16 + i * 8192, R, C); const int Rb = Epi::PERM ? ((R & ~31) + perm32(R & 31)) : R; gR[i] = R; gC[i] = C * 2;
        voffA[i] = (unsigned)(R * K * ES + C * 2); voffB[i] = (unsigned)(Rb * K * ES + C * 2); }
    unsigned vAc0[2] = {0u, 0u}, vAc1[2] = {0u, 0u}, vAn0[2] = {0u, 0u}, vAn1[2] = {0u, 0u};
#define PG8_GIDX(dst0, dst1, u_) do { _Pragma("unroll") for (int _i = 0; _i < 2; ++_i) { \
        dst0[_i] = (unsigned)S.rowidx[(u_).pm * BM + gR[_i]] * (unsigned)(K * ES) + (unsigned)gC[_i]; dst1[_i] = (unsigned)S.rowidx[(u_).pm * BM + HALF + gR[_i]] * (unsigned)(K * ES) + (unsigned)gC[_i]; } } while (0)
    const size_t kstep = (size_t)(BK * 2);
    const size_t hstep = (size_t)HALF * K * ES;
    const size_t tstep = 2 * hstep;
    const unsigned ldsw = (unsigned)wid * 1024u;
    const int aoff = lds_byte(wr * 64 + fr, fq * 8), boff = lds_byte(wc * 32 + fr, fq * 8);
#define PG8_SA(b, h) (((b) * 2 + (h)) * HTB)
#define PG8_SB(b, h) ((4 + (b) * 2 + (h)) * HTB)
#define PG8_STAGE(bufoff, gbase, voff) do { _Pragma("unroll") for (int _i = 0; _i < 2; ++_i) \
        __builtin_amdgcn_global_load_lds((const unsigned*)((const char*)(gbase) + (voff)[_i]), (PG8_LAS unsigned*)(lds + (bufoff) + ldsw + _i * 8192), 16, 0, 0); } while (0)
#define PG8_STAGE_A(bufoff, ptr_, half_, koff_, nxt_) do { if constexpr (GATHER) { _Pragma("unroll") for (int _i = 0; _i < 2; ++_i) { \
            const unsigned vo_ = (half_) ? ((nxt_) ? vAn1[_i] : vAc1[_i]) : ((nxt_) ? vAn0[_i] : vAc0[_i]); \
            __builtin_amdgcn_global_load_lds((const unsigned*)((const char*)g.A + (koff_) + vo_), (PG8_LAS unsigned*)(lds + (bufoff) + ldsw + _i * 8192), 16, 0, 0); } } \
        else PG8_STAGE(bufoff, ptr_, voffA); } while (0)
#define PG8_LDA(dst, b, h) do { _Pragma("unroll") for (int m = 0; m < 4; ++m) _Pragma("unroll") for (int k = 0; k < 2; ++k) dst[m][k] = *(const PG8_LAS bf16x8*)(lds + PG8_SA(b, h) + aoff + m * 2048 + k * 1024); } while (0)
#define PG8_LDB(dst, b, h) do { _Pragma("unroll") for (int n = 0; n < 2; ++n) _Pragma("unroll") for (int k = 0; k < 2; ++k) dst[n][k] = *(const PG8_LAS bf16x8*)(lds + PG8_SB(b, h) + boff + n * 2048 + k * 1024); } while (0)
#define PG8_MMA(ai, bj, At, Bt) do { __builtin_amdgcn_s_setprio(1); _Pragma("unroll") for (int m = 0; m < 4; ++m) _Pragma("unroll") for (int n = 0; n < 2; ++n) { \
        if constexpr (F8) { asm volatile("v_mfma_scale_f32_16x16x128_f8f6f4 %0, %1, %2, %0, %3, %3 op_sel_hi:[0,0,0]" : "+v"(acc[ai][bj][m][n]) : "v"(cat8(Bt[n][0], Bt[n][1])), "v"(cat8(At[m][0], At[m][1])), "v"(0x7f7f7f7f)); } \
        else { _Pragma("unroll") for (int k = 0; k < 2; ++k) acc[ai][bj][m][n] = __builtin_amdgcn_mfma_f32_16x16x32_bf16(Bt[n][k], At[m][k], acc[ai][bj][m][n], 0, 0, 0); } } \
        __builtin_amdgcn_s_setprio(0); } while (0)
#define PG8_WAIT_V(n) asm volatile("s_waitcnt vmcnt(" #n ")" ::: "memory")
#define PG8_WAIT_L(n) asm volatile("s_waitcnt lgkmcnt(" #n ")" ::: "memory")
#define PG8_BAR __builtin_amdgcn_s_barrier()
#define PG8_SCHED __builtin_amdgcn_sched_barrier(0)
    Unit cur, nxt; int ui = 0;
    if (!S.next(0, cur)) return;
    f32x4 acc[2][2][4][2];
#pragma unroll
    for (int a = 0; a < 2; ++a)
#pragma unroll
        for (int b = 0; b < 2; ++b)
#pragma unroll
            for (int m = 0; m < 4; ++m)
#pragma unroll
                for (int n = 0; n < 2; ++n) acc[a][b][m][n] = (f32x4){0.f, 0.f, 0.f, 0.f};
    bf16x8 At[4][2], B0[2][2], B1[2][2];
    const char* cA = (const char*)g.A + (size_t)cur.pm * tstep; const char* cB = (const char*)g.Bt + S.boff(cur) + (size_t)cur.pn * tstep;
    if constexpr (GATHER) { PG8_GIDX(vAc0, vAc1, cur); }
    if constexpr (SP2) {
        PG8_STAGE(PG8_SB(0, 0), cB, voffB); PG8_STAGE(PG8_SB(0, 1), cB + hstep, voffB); PG8_STAGE_A(PG8_SA(0, 0), cA, 0, 0, false); PG8_STAGE_A(PG8_SA(0, 1), cA + hstep, 1, 0, false);
        if (wr == 1) PG8_BAR;
        PG8_WAIT_V(2); PG8_BAR;
        PG8_STAGE(PG8_SB(1, 0), cB + kstep, voffB); PG8_STAGE_A(PG8_SA(1, 0), cA + kstep, 0, kstep, false); PG8_STAGE(PG8_SB(1, 1), cB + hstep + kstep, voffB);
        PG8_WAIT_V(6); PG8_BAR;
    } else {
        PG8_STAGE(PG8_SB(0, 0), cB, voffB); PG8_STAGE(PG8_SA(0, 0), cA, voffA); PG8_STAGE(PG8_SB(0, 1), cB + hstep, voffB); PG8_STAGE(PG8_SA(0, 1), cA + hstep, voffA);
        if (wr == 1) PG8_BAR;
        PG8_WAIT_V(4); PG8_BAR;
        PG8_STAGE(PG8_SB(1, 0), cB + kstep, voffB); PG8_STAGE(PG8_SA(1, 0), cA + kstep, voffA); PG8_STAGE(PG8_SB(1, 1), cB + hstep + kstep, voffB);
        PG8_WAIT_V(6); PG8_BAR;
    }
    for (;;) {
        const bool has_next = S.next(ui + 1, nxt);
        const char* nA = has_next ? (const char*)g.A + (size_t)nxt.pm * tstep : cA; const char* nB = has_next ? (const char*)g.Bt + S.boff(nxt) + (size_t)nxt.pn * tstep : cB;
        if constexpr (GATHER) {
            if (has_next) { if (wid == 0) __builtin_amdgcn_global_load_lds((const unsigned*)(S.rowidx + (size_t)nxt.pm * BM + lane * 4), (PG8_LAS unsigned*)(lds + 131072 + ((ui + 1) & 1) * 1024), 16, 0, 0); }
            else { vAn0[0] = vAc0[0]; vAn0[1] = vAc0[1]; vAn1[0] = vAc1[0]; vAn1[1] = vAc1[1]; } }
        for (int t = 0; t < nt; t += 2) {
            const bool last = (t == nt - 2);
            const char* a1 = cA + (size_t)(t + 1) * kstep;
            const char* a2 = last ? nA : cA + (size_t)(t + 2) * kstep; const char* b2 = last ? nB : cB + (size_t)(t + 2) * kstep;
            const char* a3 = a2 + kstep; const char* b3 = b2 + kstep;
            const size_t ko1 = (size_t)(t + 1) * kstep, ko2 = last ? 0 : (size_t)(t + 2) * kstep, ko3 = ko2 + kstep;
            if constexpr (GATHER) { if (last && has_next) { const PG8_LAS int* ix_ = (const PG8_LAS int*)(lds + 131072 + ((ui + 1) & 1) * 1024);
#pragma unroll
                for (int _i = 0; _i < 2; ++_i) { vAn0[_i] = (unsigned)ix_[gR[_i]] * (unsigned)(K * ES) + (unsigned)gC[_i]; vAn1[_i] = (unsigned)ix_[HALF + gR[_i]] * (unsigned)(K * ES) + (unsigned)gC[_i]; } } }
            if constexpr (SP2) {
            PG8_LDB(B0, 0, 0); PG8_LDB(B1, 0, 1); PG8_SCHED; PG8_LDA(At, 0, 0); PG8_STAGE_A(PG8_SA(1, 1), a1 + hstep, 1, ko1, false);
            PG8_WAIT_V(8); PG8_WAIT_L(0); PG8_BAR; PG8_MMA(0, 0, At, B0); PG8_MMA(0, 1, At, B1); PG8_BAR; PG8_SCHED;
            PG8_LDA(At, 0, 1); PG8_STAGE(PG8_SB(0, 0), b2, voffB); PG8_STAGE(PG8_SB(0, 1), b2 + hstep, voffB); PG8_STAGE_A(PG8_SA(0, 0), a2, 0, ko2, last);
            PG8_WAIT_V(8); PG8_WAIT_L(0); PG8_BAR; PG8_MMA(1, 0, At, B0); PG8_MMA(1, 1, At, B1); PG8_BAR; PG8_SCHED;
            PG8_LDB(B0, 1, 0); PG8_LDB(B1, 1, 1); PG8_SCHED; PG8_LDA(At, 1, 0); PG8_STAGE_A(PG8_SA(0, 1), a2 + hstep, 1, ko2, last);
            PG8_WAIT_V(8); PG8_WAIT_L(0); PG8_BAR; PG8_MMA(0, 0, At, B0); PG8_MMA(0, 1, At, B1); PG8_BAR; PG8_SCHED;
            PG8_LDA(At, 1, 1); PG8_STAGE(PG8_SB(1, 0), b3, voffB); PG8_STAGE(PG8_SB(1, 1), b3 + hstep, voffB); PG8_STAGE_A(PG8_SA(1, 0), a3, 0, ko3, last);
            PG8_WAIT_V(8); PG8_WAIT_L(0); PG8_BAR; PG8_MMA(1, 0, At, B0); PG8_MMA(1, 1, At, B1); PG8_BAR; PG8_SCHED;
            } else {
            PG8_LDB(B0, 0, 0); PG8_SCHED; PG8_LDA(At, 0, 0); PG8_STAGE(PG8_SA(1, 1), a1 + hstep, voffA);
            PG8_WAIT_L(8); PG8_BAR; PG8_WAIT_L(0); PG8_MMA(0, 0, At, B0); PG8_BAR; PG8_SCHED;
            PG8_LDB(B1, 0, 1); PG8_STAGE(PG8_SB(0, 0), b2, voffB);
            PG8_BAR; PG8_WAIT_L(0); PG8_MMA(0, 1, At, B1); PG8_BAR;
            PG8_LDA(At, 0, 1); PG8_STAGE(PG8_SA(0, 0), a2, voffA);
            PG8_BAR; PG8_WAIT_L(0); PG8_MMA(1, 0, At, B0); PG8_BAR; PG8_SCHED;
            PG8_STAGE(PG8_SB(0, 1), b2 + hstep, voffB);
            PG8_WAIT_V(6); PG8_BAR; PG8_MMA(1, 1, At, B1); PG8_BAR;
            PG8_LDB(B0, 1, 0); PG8_SCHED; PG8_LDA(At, 1, 0); PG8_STAGE(PG8_SA(0, 1), a2 + hstep, voffA);
            PG8_WAIT_L(8); PG8_BAR; PG8_WAIT_L(0); PG8_MMA(0, 0, At, B0); PG8_BAR; PG8_SCHED;
            PG8_LDB(B1, 1, 1); PG8_STAGE(PG8_SB(1, 0), b3, voffB);
            PG8_BAR; PG8_WAIT_L(0); PG8_MMA(0, 1, At, B1); PG8_BAR;
            PG8_LDA(At, 1, 1); PG8_STAGE(PG8_SA(1, 0), a3, voffA);
            PG8_BAR; PG8_WAIT_L(0); PG8_MMA(1, 0, At, B0); PG8_BAR; PG8_SCHED;
            PG8_STAGE(PG8_SB(1, 1), b3 + hstep, voffB);
            PG8_WAIT_V(6); PG8_BAR; PG8_MMA(1, 1, At, B1); PG8_BAR;
            }
        }
        if constexpr (ALIGN_EPI) { if (wr == 0) PG8_BAR; }
        E(acc, cur, wr, wc, fr, fq);
        if (!has_next) break;
#pragma unroll
        for (int a = 0; a < 2; ++a)
#pragma unroll
            for (int b = 0; b < 2; ++b)
#pragma unroll
                for (int m = 0; m < 4; ++m)
#pragma unroll
                    for (int n = 0; n < 2; ++n) acc[a][b][m][n] = (f32x4){0.f, 0.f, 0.f, 0.f};
        cur = nxt; cA = nA; cB = nB; ++ui;
        if constexpr (GATHER) { vAc0[0] = vAn0[0]; vAc0[1] = vAn0[1]; vAc1[0] = vAn1[0]; vAc1[1] = vAn1[1]; }
        if constexpr (ALIGN_EPI) { if (wr == 1) PG8_BAR; }
    }
    PG8_WAIT_V(0);
    if constexpr (!ALIGN_EPI) { if (wr == 0) PG8_BAR; }
    PG8_BAR;
#undef PG8_SA
#undef PG8_SB
#undef PG8_STAGE
#undef PG8_LDA
#undef PG8_STAGE_A
#undef PG8_GIDX
#undef PG8_LDB
#undef PG8_MMA
#undef PG8_WAIT_V
#undef PG8_WAIT_L
#undef PG8_BAR
#undef PG8_SCHED
}
}

constexpr int NWAVES = 8, NTHR = 512;
constexpr int BATCH = 2, T = 8192, D = 1024, NTOK = BATCH * T;
constexpr int IN_COLS = 3592, PCOLS = 3584;
constexpr int NE = 32, NASSIGN = NTOK * 4, MAXTILES = NASSIGN / 256 + NE;
constexpr float EPS = 1e-6f;

constexpr size_t MiB = 1u << 20;
constexpr size_t WS_CTL = 0, CTL_ZERO_BYTES = 1 * MiB;
constexpr size_t WS_MOD = 1 * MiB;
constexpr size_t WS_G = WS_MOD + 64 * 1024;
constexpr size_t WS_BETA = WS_G + 256 * 1024;
constexpr size_t WS_GL = WS_BETA + 256 * 1024;
constexpr size_t WS_AE = WS_GL + 64 * 1024;
constexpr size_t WS_AP = WS_AE + 256 * 1024;
constexpr size_t WS_AG = WS_AP + 256 * 1024;
constexpr size_t WS_AS = WS_AG + 256 * 1024;
constexpr size_t WS_WG = WS_AS + 256 * 1024;
constexpr size_t WS_STOK = WS_WG + 64 * 1024;
constexpr size_t WS_WIN = 8 * MiB;
constexpr size_t WS_WOUT = 16 * MiB;
constexpr size_t WS_WUP = 20 * MiB;
constexpr size_t WS_WDN = 148 * MiB;
constexpr size_t WS_H = 212 * MiB;
constexpr size_t WS_PROJ = 244 * MiB;
constexpr size_t WS_U = 356 * MiB;
constexpr size_t WS_OPS = 388 * MiB;
constexpr int OPS_BYTES = 57344;
constexpr size_t WS_QF = 444 * MiB, WS_KF = 460 * MiB, WS_VTF = 476 * MiB;
constexpr size_t WS_OSCAN = 500 * MiB;
constexpr size_t WS_OMIX = 532 * MiB;
constexpr size_t WS_Y = 564 * MiB;
constexpr size_t WS_XG = 244 * MiB;
constexpr size_t WS_ACT = 388 * MiB;
constexpr size_t WS_ZS = 628 * MiB;
constexpr size_t WS_SEG = 644 * MiB;
constexpr size_t WS_SST = 652 * MiB;
constexpr size_t WS_SEGP = 656 * MiB;
constexpr size_t WS_END = 660 * MiB;
constexpr int CW_CNT = 64;
constexpr int CW_SEGA = 1024, CW_SEGB = 2048;
constexpr int CW_BAR = 4096;
constexpr int CW_HIST = 16384;

constexpr int LDS_BYTES = 163840, MISC_OFF = 161792;

#define GAS __attribute__((address_space(1)))
#define LAS __attribute__((address_space(3)))
typedef unsigned short bf16;
typedef unsigned v4u __attribute__((ext_vector_type(4)));
typedef unsigned v2u __attribute__((ext_vector_type(2)));
typedef float f32x4 __attribute__((ext_vector_type(4)));
typedef LAS float ldsf;
#define RLX_AGENT __ATOMIC_RELAXED, __HIP_MEMORY_SCOPE_AGENT
__device__ __forceinline__ unsigned f2bf(float f) { unsigned u = __builtin_bit_cast(unsigned, f); return (u + 0x7fffu + ((u >> 16) & 1u)) >> 16; }
__device__ __forceinline__ unsigned pk2(float lo, float hi) { return f2bf(lo) | (f2bf(hi) << 16); }
__device__ __forceinline__ float bf2f(unsigned h) { return __builtin_bit_cast(float, h << 16); }
__device__ __forceinline__ float bflo(unsigned w) { return __builtin_bit_cast(float, w << 16); }
__device__ __forceinline__ float bfhi(unsigned w) { return __builtin_bit_cast(float, w & 0xffff0000u); }
template <int CTRL, int ROWMASK> __device__ __forceinline__ float dppf(float v) {
    return __builtin_bit_cast(float, __builtin_amdgcn_update_dpp(0, __builtin_bit_cast(int, v), CTRL, ROWMASK, 0xF, false)); }
__device__ __forceinline__ float wave_sum(float v) {
    v += dppf<0x111, 0xF>(v); v += dppf<0x112, 0xF>(v); v += dppf<0x114, 0xF>(v); v += dppf<0x118, 0xF>(v);
    v += dppf<0x142, 0xA>(v); v += dppf<0x143, 0xC>(v);
    return __builtin_bit_cast(float, __builtin_amdgcn_readlane(__builtin_bit_cast(int, v), 63));
}
__device__ __forceinline__ float xchg32(float send, int lane) { const unsigned u = __builtin_bit_cast(unsigned, send); const auto r_ = __builtin_amdgcn_permlane32_swap(u, u, false, false); return __builtin_bit_cast(float, lane < 32 ? r_[1] : r_[0]); }
__device__ __forceinline__ float xchg16(float send, int lane) { const unsigned u = __builtin_bit_cast(unsigned, send); const auto r_ = __builtin_amdgcn_permlane16_swap(u, u, false, false); return __builtin_bit_cast(float, (lane & 16) ? r_[0] : r_[1]); }
template <int CTRL> __device__ __forceinline__ float dppx(float v) { return __builtin_bit_cast(float, __builtin_amdgcn_update_dpp(0, __builtin_bit_cast(int, v), CTRL, 0xF, 0xF, false)); }
template <int CTRL, int ROWMASK> __device__ __forceinline__ float dppf_o(float v, float old) { return __builtin_bit_cast(float, __builtin_amdgcn_update_dpp(__builtin_bit_cast(int, old), __builtin_bit_cast(int, v), CTRL, ROWMASK, 0xF, false)); }
template <int CTRL, int ROWMASK> __device__ __forceinline__ int dppi_o(int v, int old) { return __builtin_amdgcn_update_dpp(old, v, CTRL, ROWMASK, 0xF, false); }
__device__ __forceinline__ float wave_max(float v) {
    const float ni = -3.4e38f;
    v = fmaxf(v, dppf_o<0x111, 0xF>(v, ni)); v = fmaxf(v, dppf_o<0x112, 0xF>(v, ni)); v = fmaxf(v, dppf_o<0x114, 0xF>(v, ni)); v = fmaxf(v, dppf_o<0x118, 0xF>(v, ni));
    v = fmaxf(v, dppf_o<0x142, 0xA>(v, ni)); v = fmaxf(v, dppf_o<0x143, 0xC>(v, ni));
    return __builtin_bit_cast(float, __builtin_amdgcn_readlane(__builtin_bit_cast(int, v), 63));
}
__device__ __forceinline__ int wave_min_i(int v) {
    const int mi = 0x7fffffff;
    v = min(v, dppi_o<0x111, 0xF>(v, mi)); v = min(v, dppi_o<0x112, 0xF>(v, mi)); v = min(v, dppi_o<0x114, 0xF>(v, mi)); v = min(v, dppi_o<0x118, 0xF>(v, mi));
    v = min(v, dppi_o<0x142, 0xA>(v, mi)); v = min(v, dppi_o<0x143, 0xC>(v, mi));
    return __builtin_amdgcn_readlane(v, 63);
}
__device__ __forceinline__ float siluf(float x) { return x * __builtin_amdgcn_rcpf(1.0f + __builtin_amdgcn_exp2f(-1.4426950408889634f * x)); }
typedef float f32x16 __attribute__((ext_vector_type(16)));
typedef short bf16x8 __attribute__((ext_vector_type(8)));
typedef float f32x2_t __attribute__((ext_vector_type(2)));
typedef __bf16 bf16x2_t __attribute__((ext_vector_type(2)));
__device__ __forceinline__ unsigned cvtpk(float lo, float hi) { f32x2_t v = {lo, hi}; bf16x2_t b = __builtin_convertvector(v, bf16x2_t); return __builtin_bit_cast(unsigned, b); }
__device__ __forceinline__ bf16x8 pack8(const f32x16& x, int s) {
    v4u p; p.x = cvtpk(x[8 * s], x[8 * s + 1]); p.y = cvtpk(x[8 * s + 2], x[8 * s + 3]); p.z = cvtpk(x[8 * s + 4], x[8 * s + 5]); p.w = cvtpk(x[8 * s + 6], x[8 * s + 7]);
    return __builtin_bit_cast(bf16x8, p);
}
__device__ __forceinline__ int crow(int q, int h) { return (q & 3) + 8 * (q >> 2) + 4 * h; }
#define MFMA32(a, b, c) __builtin_amdgcn_mfma_f32_32x32x16_bf16((a), (b), (c), 0, 0, 0)

#define XB_TMO      128
#define XB_XCNT(j)  (256  + 64 * (j))
#define XB_XSUB(j)  (1280 + 64 * (j))
#define XB_XGEN(j)  (2304 + 64 * (j))
#define XB_TOP      3328
#define XB_TOPGEN   3392
#define XCD_BAR_WORDS 3456
#define XB_SPIN_CAP (1u << 22)
__device__ __forceinline__ unsigned xb_ld(unsigned* p)              { return __hip_atomic_load(p, __ATOMIC_RELAXED, __HIP_MEMORY_SCOPE_AGENT); }
__device__ __forceinline__ unsigned xb_add(unsigned* p, unsigned v) { return __hip_atomic_fetch_add(p, v, __ATOMIC_RELAXED, __HIP_MEMORY_SCOPE_AGENT); }
__device__ __forceinline__ unsigned xb_xcc_id() { return (unsigned)__builtin_amdgcn_s_getreg((3 << 11) | 20) & 0xFu; }
#define XB_SPIN(cond, bar) do { unsigned _sp = 0; while (cond) { __builtin_amdgcn_s_sleep(1); \
    if ((++_sp & 255u) == 0u) { if (xb_ld(&(bar)[XB_TMO])) break; if (_sp > XB_SPIN_CAP) { atomicAdd(&(bar)[XB_TMO], 1u); break; } } } } while (0)
struct XcdBarrier { unsigned* bar; unsigned x; volatile LAS unsigned* st; };
__device__ __forceinline__ XcdBarrier xcd_barrier_post(unsigned* bar, volatile LAS unsigned* st) {
    XcdBarrier b; b.bar = bar; b.x = xb_xcc_id(); b.st = st;
    if (threadIdx.x == 0) (void)xb_add(&bar[XB_XCNT(b.x)], 1u);
    return b;
}
__device__ __forceinline__ void xcd_barrier_complete(unsigned* bar, unsigned x, unsigned& nloc, unsigned& nx) {
    const unsigned G = gridDim.x * gridDim.y * gridDim.z;
    unsigned sum, cnt, mine, sp = 0u;
    for (;;) {
        sum = 0u; cnt = 0u; mine = 0u;
#pragma unroll
        for (unsigned j = 0; j < 16; ++j) { const unsigned c = xb_ld(&bar[XB_XCNT(j)]); sum += c; cnt += (c > 0u) ? 1u : 0u; mine = (j == x) ? c : mine; }
        if (sum == G) break;
        __builtin_amdgcn_s_sleep(1);
        if ((++sp & 255u) == 0u) { if (xb_ld(&bar[XB_TMO])) break; if (sp > XB_SPIN_CAP) { atomicAdd(&bar[XB_TMO], 1u); break; } }
    }
    nloc = mine > 0u ? mine : 1u; nx = cnt > 0u ? cnt : 1u;
}
__device__ __forceinline__ void xcd_barrier(const XcdBarrier& b, const int tid) {
    asm volatile("s_waitcnt vmcnt(0)" ::: "memory");
    __syncthreads();
    if (tid == 0) {
        unsigned* bar = b.bar;
        __builtin_amdgcn_s_waitcnt(0);
        unsigned nloc = b.st[0], nx = b.st[1];
        if (nloc == 0u) { xcd_barrier_complete(bar, b.x, nloc, nx); b.st[0] = nloc; b.st[1] = nx; }
        const unsigned old = xb_add(&bar[XB_XSUB(b.x)], 1u);
        const unsigned gen = old / nloc;
        if (old + 1u == (gen + 1u) * nloc) {
            __builtin_amdgcn_fence(__ATOMIC_RELEASE, "agent");
            asm volatile("s_waitcnt vmcnt(0)" ::: "memory");
            const unsigned og = xb_add(&bar[XB_TOP], 1u);
            const unsigned tg = og / nx;
            if (og + 1u == (tg + 1u) * nx) xb_add(&bar[XB_TOPGEN], 1u);
            else XB_SPIN(xb_ld(&bar[XB_TOPGEN]) == tg, bar);
            __builtin_amdgcn_fence(__ATOMIC_ACQUIRE, "agent");
            xb_add(&bar[XB_XGEN(b.x)], 1u);
            asm volatile("s_waitcnt vmcnt(0)" ::: "memory");
        } else {
            XB_SPIN(xb_ld(&bar[XB_XGEN(b.x)]) == gen, bar);
            __builtin_amdgcn_fence(__ATOMIC_ACQUIRE, "agent");
            asm volatile("s_waitcnt vmcnt(0)" ::: "memory");
        }
    }
    __syncthreads();
}

struct Args {
    const float* in[18]; float* out; unsigned char* ws; int ph_lo, ph_hi, li, pad;
};
enum { I_X = 0, I_C, I_WADA, I_BADA, I_NORMW, I_WIN, I_CONVW, I_ALOG, I_DTB, I_ANW, I_RELB, I_WOUT, I_WR, I_BR, I_WUP, I_BUP, I_WDN, I_BDN };

__device__ __forceinline__ int map_row(int mode, int n) {
    if (mode == 0) return n < 2048 ? n : (n < 2056 ? -1 : n - 8);
    if (mode == 2) { const int j = n & 1023, half = n >> 10; return (j >> 7) * 256 + half * 128 + (j & 127); }
    return n;
}
__device__ __forceinline__ void transpose_item(const float* W, int K, int N, bf16* WT, int mode, ldsf* scr, int item, int lane) {
    const int nblk = (N + 31) / 32, kb = item / nblk, nb = item % nblk, k0 = 64 * kb, n0 = 32 * nb;
    const int nn = n0 + (lane & 31);
#pragma unroll 8
    for (int i = 0; i < 32; ++i) { const int kk = 2 * i + (lane >> 5); scr[kk * 33 + (lane & 31)] = (nn < N) ? W[(size_t)(k0 + kk) * N + nn] : 0.f; }
    asm volatile("s_waitcnt lgkmcnt(0)" ::: "memory");
    const int c = lane & 7;
#pragma unroll
    for (int j = 0; j < 4; ++j) { const int nl = (lane >> 3) + 8 * j; const int n = n0 + nl; const ldsf* s = scr + (8 * c) * 33 + nl;
        const int row = (n < N) ? map_row(mode, n) : -1;
        v4u o; o.x = pk2(s[0 * 33], s[1 * 33]); o.y = pk2(s[2 * 33], s[3 * 33]); o.z = pk2(s[4 * 33], s[5 * 33]); o.w = pk2(s[6 * 33], s[7 * 33]);
        if (row >= 0) *(v4u*)(WT + (size_t)row * K + k0 + 8 * c) = o; }
    asm volatile("s_waitcnt lgkmcnt(0)" ::: "memory");
}
__device__ __forceinline__ void transpose_item8(const float* W, int K, int N, unsigned char* WT, int mode, ldsf* scr, int item, int lane) {
    const int nblk = N / 32, kb = item / nblk, nb = item % nblk, k0 = 64 * kb, n0 = 32 * nb;
#pragma unroll 8
    for (int i = 0; i < 32; ++i) { const int kk = 2 * i + (lane >> 5); scr[kk * 33 + (lane & 31)] = __builtin_nontemporal_load(W + (size_t)(k0 + kk) * N + n0 + (lane & 31)); }
    asm volatile("s_waitcnt lgkmcnt(0)" ::: "memory");
    const int nl = lane >> 1, kh = lane & 1; const ldsf* sp = scr + (32 * kh) * 33 + nl;
    const int row = map_row(mode, n0 + nl);
    v4u o0, o1;
    o0.x = pg8::pk4_fp8(sp[0 * 33] * 32.f, sp[1 * 33] * 32.f, sp[2 * 33] * 32.f, sp[3 * 33] * 32.f);     o0.y = pg8::pk4_fp8(sp[4 * 33] * 32.f, sp[5 * 33] * 32.f, sp[6 * 33] * 32.f, sp[7 * 33] * 32.f);
    o0.z = pg8::pk4_fp8(sp[8 * 33] * 32.f, sp[9 * 33] * 32.f, sp[10 * 33] * 32.f, sp[11 * 33] * 32.f);   o0.w = pg8::pk4_fp8(sp[12 * 33] * 32.f, sp[13 * 33] * 32.f, sp[14 * 33] * 32.f, sp[15 * 33] * 32.f);
    o1.x = pg8::pk4_fp8(sp[16 * 33] * 32.f, sp[17 * 33] * 32.f, sp[18 * 33] * 32.f, sp[19 * 33] * 32.f); o1.y = pg8::pk4_fp8(sp[20 * 33] * 32.f, sp[21 * 33] * 32.f, sp[22 * 33] * 32.f, sp[23 * 33] * 32.f);
    o1.z = pg8::pk4_fp8(sp[24 * 33] * 32.f, sp[25 * 33] * 32.f, sp[26 * 33] * 32.f, sp[27 * 33] * 32.f); o1.w = pg8::pk4_fp8(sp[28 * 33] * 32.f, sp[29 * 33] * 32.f, sp[30 * 33] * 32.f, sp[31 * 33] * 32.f);
    unsigned char* dst = WT + (size_t)row * K + k0 + 32 * kh;
    __builtin_nontemporal_store(o0, (v4u*)dst); __builtin_nontemporal_store(o1, (v4u*)(dst + 16));
    asm volatile("s_waitcnt lgkmcnt(0)" ::: "memory");
}
__device__ __forceinline__ void mod_item(const float* c, const float* w_ada, const float* b_ada, float* mod, int item, ldsf* red, int tid, int lane, int wave) {
    const int j0 = item * 24;
    float a0[24], a1[24];
#pragma unroll
    for (int k = 0; k < 24; ++k) { a0[k] = 0.f; a1[k] = 0.f; }
#pragma unroll
    for (int rr = 0; rr < 2; ++rr) {
        const int d = tid + rr * 512;
        const float s0 = siluf(c[d]), s1 = siluf(c[1024 + d]);
        const f32x4* wp = (const f32x4*)(w_ada + (size_t)d * 6144 + j0);
#pragma unroll
        for (int q = 0; q < 6; ++q) { const f32x4 w = wp[q];
#pragma unroll
            for (int e = 0; e < 4; ++e) { a0[4 * q + e] += s0 * w[e]; a1[4 * q + e] += s1 * w[e]; } }
    }
#pragma unroll
    for (int k = 0; k < 24; ++k) { a0[k] = wave_sum(a0[k]); a1[k] = wave_sum(a1[k]); }
    if (lane == 0) {
#pragma unroll
        for (int k = 0; k < 24; ++k) { red[wave * 48 + k] = a0[k]; red[wave * 48 + 24 + k] = a1[k]; }
    }
    __syncthreads();
    if (tid < 48) { float s = 0.f;
#pragma unroll
        for (int w = 0; w < 8; ++w) s += red[w * 48 + tid];
        const int b = tid / 24, k = tid % 24; mod[b * 6144 + j0 + k] = s + b_ada[j0 + k]; }
    __syncthreads();
}

#define SB() __builtin_amdgcn_sched_barrier(0)
#define GI_W(mt, t2, s2) ((((mt) * 4 + (t2)) * 2) + (s2))
#define GI_Q(mt, t2, s2) (16 + (((mt) * 4 + (t2)) * 2) + (s2))
#define GI_K(t2, mt, s2) (32 + (((t2) * 2 + (mt)) * 2) + (s2))
#define GI_A(mt, mp, s2) (48 + (((mt) * 2 + (mp)) * 2) + (s2))
#define FRAG(f_) (*(const LAS bf16x8*)(Bf + (f_) * 1024))
#define LD_WQ(dst, t2, s2) do { dst[0] = FRAG(GI_W(0, t2, s2)); dst[1] = FRAG(GI_Q(0, t2, s2)); dst[2] = FRAG(GI_W(1, t2, s2)); dst[3] = FRAG(GI_Q(1, t2, s2)); } while (0)
#define MM_WQ(src, t2, s2) do { const bf16x8 sb_ = pack8(S[t2], s2); VN[0] = MFMA32(src[0], sb_, VN[0]); O[0] = MFMA32(src[1], sb_, O[0]); VN[1] = MFMA32(src[2], sb_, VN[1]); O[1] = MFMA32(src[3], sb_, O[1]); } while (0)
#define LD_AT(dst, s2) do { dst[0] = FRAG(GI_A(0, 0, s2)); dst[1] = FRAG(GI_A(1, 0, s2)); dst[2] = FRAG(GI_A(1, 1, s2)); } while (0)
#define MM_AT(src, s2) do { O[0] = MFMA32(src[0], vb[0][s2], O[0]); O[1] = MFMA32(src[1], vb[0][s2], O[1]); O[1] = MFMA32(src[2], vb[1][s2], O[1]); } while (0)
#define LD_K(dst, t2) do { dst[0] = FRAG(GI_K(t2, 0, 0)); dst[1] = FRAG(GI_K(t2, 0, 1)); dst[2] = FRAG(GI_K(t2, 1, 0)); dst[3] = FRAG(GI_K(t2, 1, 1)); } while (0)
#define MM_K(src, t2) do { S[t2] = MFMA32(src[0], vb[0][0], S[t2]); S[t2] = MFMA32(src[1], vb[0][1], S[t2]); S[t2] = MFMA32(src[2], vb[1][0], S[t2]); S[t2] = MFMA32(src[3], vb[1][1], S[t2]); } while (0)
#define SCALE_S(t2) do { _Pragma("unroll") for (int q_ = 0; q_ < 16; ++q_) S[t2][q_] *= egl; } while (0)
__device__ __forceinline__ void scan_step(const int n, f32x16 (&S)[4], v4u (&UC)[4], v4u (&UN)[4], const float egl, float& egl_next,
                                          LAS unsigned char* lds, const float* Uf, const float* glp, const int wave, const int lane, const int stg_off, const int stg_row) {
    const int r = lane & 31, h = lane >> 5;
    asm volatile("s_waitcnt lgkmcnt(0)" ::: "memory"); __builtin_amdgcn_s_barrier(); asm volatile("" ::: "memory");
    if (n + 1 < 128) {
        const v4u* up = (const v4u*)((const unsigned char*)Uf + (size_t)(n + 1) * 16384) + (wave * 4) * 64 + lane;
#pragma unroll
        for (int f = 0; f < 4; ++f) UN[f] = up[f * 64];
        egl_next = glp[n + 1];
    }
    SB();
    f32x16 VN[2];
#pragma unroll
    for (int mt = 0; mt < 2; ++mt)
#pragma unroll
        for (int q8 = 0; q8 < 2; ++q8) { const v4u u = UC[mt * 2 + q8];
            VN[mt][8 * q8 + 0] = bflo(u.x); VN[mt][8 * q8 + 1] = bfhi(u.x); VN[mt][8 * q8 + 2] = bflo(u.y); VN[mt][8 * q8 + 3] = bfhi(u.y);
            VN[mt][8 * q8 + 4] = bflo(u.z); VN[mt][8 * q8 + 5] = bfhi(u.z); VN[mt][8 * q8 + 6] = bflo(u.w); VN[mt][8 * q8 + 7] = bfhi(u.w); }
    const LAS unsigned char* Bf = lds + (n & 1) * OPS_BYTES + lane * 16;
    f32x16 O[2];
#pragma unroll
    for (int mt = 0; mt < 2; ++mt)
#pragma unroll
        for (int q = 0; q < 16; ++q) O[mt][q] = 0.f;
    bf16x8 fA[4], fB[4], vb[2][2];
    LD_WQ(fA, 0, 0); SB();
    LD_WQ(fB, 0, 1); SB(); MM_WQ(fA, 0, 0); SB();
    LD_WQ(fA, 1, 0); SB(); MM_WQ(fB, 0, 1); SCALE_S(0); SB();
    LD_WQ(fB, 1, 1); SB(); MM_WQ(fA, 1, 0); SB();
    LD_WQ(fA, 2, 0); SB(); MM_WQ(fB, 1, 1); SCALE_S(1); SB();
    LD_WQ(fB, 2, 1); SB(); MM_WQ(fA, 2, 0); SB();
    LD_WQ(fA, 3, 0); SB(); MM_WQ(fB, 2, 1); SCALE_S(2); SB();
    LD_WQ(fB, 3, 1); SB(); MM_WQ(fA, 3, 0); SB();
    LD_AT(fA, 0); SB(); MM_WQ(fB, 3, 1); SCALE_S(3); SB();
#pragma unroll
    for (int mt = 0; mt < 2; ++mt)
#pragma unroll
        for (int s2 = 0; s2 < 2; ++s2) vb[mt][s2] = pack8(VN[mt], s2);
    LD_AT(fB, 1); SB(); MM_AT(fA, 0); SB();
    LD_K(fA, 0); SB(); MM_AT(fB, 1); SB();
    {
        LAS unsigned short* sp = (LAS unsigned short*)(lds + stg_off + (n & 1) * (64 * stg_row)) + 32 * wave + r;
#pragma unroll
        for (int mt = 0; mt < 2; ++mt)
#pragma unroll
            for (int q = 0; q < 16; q += 2) { const unsigned w = cvtpk(O[mt][q], O[mt][q + 1]);
                sp[(32 * mt + crow(q, h)) * (stg_row / 2)] = (unsigned short)(w & 0xffffu); sp[(32 * mt + crow(q + 1, h)) * (stg_row / 2)] = (unsigned short)(w >> 16); }
    }
    asm volatile("s_waitcnt lgkmcnt(0)" ::: "memory"); __builtin_amdgcn_s_barrier(); asm volatile("" ::: "memory");
    LD_K(fB, 1); SB(); MM_K(fA, 0); SB();
    LD_K(fA, 2); SB(); MM_K(fB, 1); SB();
    LD_K(fB, 3); SB(); MM_K(fA, 2); SB();
    MM_K(fB, 3); SB();
}
#undef FRAG

__device__ __forceinline__ int opq(int v) { asm volatile("" : "+v"(v)); return v; }
typedef const __attribute__((address_space(4))) Args* kargp_t;
__device__ __forceinline__ kargp_t karg_ptr() { kargp_t p = (kargp_t)__builtin_amdgcn_kernarg_segment_ptr(); asm volatile("" : "+s"(p)); return p; }
__global__ void __launch_bounds__(NTHR, 2) mk_fwd(Args kargs) {
    extern __shared__ __attribute__((aligned(16))) unsigned char lds_raw[];
    LAS unsigned char* lds = (LAS unsigned char*)lds_raw;
    volatile LAS unsigned* MISC = (volatile LAS unsigned*)(lds + MISC_OFF);
    const int wave = __builtin_amdgcn_readfirstlane((int)threadIdx.x >> 6);
    const int G = gridDim.x; const int bx = blockIdx.x; const int vcu = (G % 8 == 0) ? (bx % 8) * (G / 8) + bx / 8 : bx;
    const int gw = vcu * NWAVES + wave, NGW = G * NWAVES;
    if (threadIdx.x < 128) MISC[threadIdx.x] = 0u;
    __syncthreads();
    XcdBarrier bar; bar.bar = (unsigned*)(kargs.ws + WS_CTL) + CW_BAR; bar.x = 0; bar.st = nullptr;
#if MK_ONE_LAUNCH
    bar = xcd_barrier_post((unsigned*)(kargs.ws + WS_CTL) + CW_BAR + kargs.li * XCD_BAR_WORDS, MISC + 8);
#define GRID_BAR() xcd_barrier(bar, tid)
#else
#define GRID_BAR() do {} while (0)
#endif
    const int lo = kargs.ph_lo, hi = kargs.ph_hi;
#ifndef PH_MASK
#define PH_MASK 0xFFFF
#endif
#define IN(k) ((((PH_MASK) >> (k)) & 1) && lo <= (k) && (k) < hi)
#define BOTH(k) (IN(k) && IN((k) + 1))

#define args (*ap_)
#define P_WS (args.ws)
#define ctl ((unsigned*)(P_WS + WS_CTL))
#define Xp (args.in[I_X])
#define OUTp (args.out)
#define MODp ((float*)(P_WS + WS_MOD))
#define gbuf ((float*)(P_WS + WS_G))
#define betabuf ((float*)(P_WS + WS_BETA))
#define glbuf ((float*)(P_WS + WS_GL))
#define asg_e ((int*)(P_WS + WS_AE))
#define asg_p ((int*)(P_WS + WS_AP))
#define asg_g ((float*)(P_WS + WS_AG))
#define asg_s ((int*)(P_WS + WS_AS))
#define WinT ((bf16*)(P_WS + WS_WIN))
#define WoutT ((bf16*)(P_WS + WS_WOUT))
#define WupT ((bf16*)(P_WS + WS_WUP))
#define WdnT ((bf16*)(P_WS + WS_WDN))
#define hbuf ((bf16*)(P_WS + WS_H))
#define projb ((bf16*)(P_WS + WS_PROJ))
#define Ub ((float*)(P_WS + WS_U))
#define opsb (P_WS + WS_OPS)
#define zsb ((bf16*)(P_WS + WS_ZS))
#define qfb (P_WS + WS_QF)
#define kfb (P_WS + WS_KF)
#define vtfb (P_WS + WS_VTF)
#define omix ((bf16*)(P_WS + WS_OMIX))
#define ybuf ((bf16*)(P_WS + WS_Y))
#define xg ((bf16*)(P_WS + WS_XG))
#define actb ((bf16*)(P_WS + WS_ACT))
#define yslot ((bf16*)(P_WS + WS_XG))

    if (IN(0)) {
        const int lane = (int)__builtin_amdgcn_mbcnt_hi(~0u, __builtin_amdgcn_mbcnt_lo(~0u, 0u)), tid = wave * 64 + lane; const kargp_t ap_ = karg_ptr();
        ldsf* scr = (ldsf*)(lds + wave * 16384);
        constexpr int I_IN = 16 * 113, I_OUT = 16 * 32;
        constexpr int NITEMS = I_IN + I_OUT;
        for (int it = gw; it < NITEMS; it += NGW) {
            int r = it;
            if (r < I_IN) { transpose_item(args.in[I_WIN], D, IN_COLS, WinT, 0, scr, r, lane); continue; } r -= I_IN;
            transpose_item(args.in[I_WOUT], D, D, WoutT, 1, scr, r, lane);
        }
        __syncthreads();
        for (int idx = bx * NTHR + tid; idx < 8192; idx += G * NTHR) { const int col = idx >> 3, k = idx & 7; ((float*)(P_WS + WS_WG))[k * 1024 + col] = args.in[I_WIN][(size_t)col * IN_COLS + 2048 + k]; }
        for (int it = bx; it < 256; it += G) mod_item(args.in[I_C], args.in[I_WADA], args.in[I_BADA], MODp, it, (ldsf*)lds, tid, lane, wave);
        if (BOTH(0)) GRID_BAR();
    }

    if (IN(1)) {
        const int lane = (int)__builtin_amdgcn_mbcnt_hi(~0u, __builtin_amdgcn_mbcnt_lo(~0u, 0u)), tid = wave * 64 + lane; const kargp_t ap_ = karg_ptr();
        ldsf* wg = (ldsf*)lds;
        const float* w_in = args.in[I_WIN];
        for (int idx = tid; idx < 2048; idx += NTHR) *((LAS f32x4*)wg + idx) = *((const f32x4*)(P_WS + WS_WG) + idx);
        __syncthreads();
        const float* nw0 = args.in[I_NORMW];
        const float dtb = args.in[I_DTB][lane & 3], alg = -expf(args.in[I_ALOG][lane & 3]);
        f32x4 vnx[4];
#pragma unroll
        for (int j = 0; j < 4; ++j) vnx[j] = *((const f32x4*)(Xp + (size_t)gw * D) + lane + 64 * j);
        for (int bb = 0; bb < BATCH; ++bb) {
            f32x4 av[4], shv[4];
#pragma unroll
            for (int j = 0; j < 4; ++j) { const int col = 4 * lane + 256 * j; const f32x4 nw = *(const f32x4*)(nw0 + col), sc = *(const f32x4*)(MODp + bb * 6144 + 1024 + col); shv[j] = *(const f32x4*)(MODp + bb * 6144 + col);
#pragma unroll
                for (int e = 0; e < 4; ++e) av[j][e] = nw[e] * (1.0f + sc[e]); }
            for (int r = gw + bb * (NTOK / BATCH); r < (bb + 1) * (NTOK / BATCH); r += NGW) {
                f32x4 v[4]; float ss = 0.f;
#pragma unroll
                for (int j = 0; j < 4; ++j) { v[j] = vnx[j]; ss += (v[j].x * v[j].x + v[j].y * v[j].y) + (v[j].z * v[j].z + v[j].w * v[j].w); }
                __builtin_amdgcn_sched_barrier(0);
                if (r + NGW < NTOK) {
#pragma unroll
                    for (int j = 0; j < 4; ++j) vnx[j] = *((const f32x4*)(Xp + (size_t)(r + NGW) * D) + lane + 64 * j);
                }
                __builtin_amdgcn_sched_barrier(0);
                const float rstd = rsqrtf(wave_sum(ss) * (1.0f / D) + EPS);
                float al[8];
#pragma unroll
                for (int k = 0; k < 8; ++k) al[k] = 0.f;
                v2u ov[4];
#pragma unroll
                for (int j = 0; j < 4; ++j) {
                    const int col = 4 * lane + 256 * j;
                    f32x4 h;
#pragma unroll
                    for (int e = 0; e < 4; ++e) h[e] = v[j][e] * rstd * av[j][e] + shv[j][e];
                    ov[j].x = pk2(h[0], h[1]); ov[j].y = pk2(h[2], h[3]);
#pragma unroll
                    for (int k = 0; k < 8; ++k) { const f32x4 w = *(const LAS f32x4*)(wg + k * 1024 + col); al[k] += (h[0] * w[0] + h[1] * w[1]) + (h[2] * w[2] + h[3] * w[3]); }
                }
#pragma unroll
                for (int j = 0; j < 4; ++j) *(v2u*)(hbuf + (size_t)r * D + 4 * lane + 256 * j) = ov[j];
#pragma unroll
                for (int k = 0; k < 8; ++k) al[k] = wave_sum(al[k]);
                if (lane < 4) {
                    const float aa = lane == 0 ? al[0] : (lane == 1 ? al[1] : (lane == 2 ? al[2] : al[3]));
                    const float ab = lane == 0 ? al[4] : (lane == 1 ? al[5] : (lane == 2 ? al[6] : al[7]));
                    const float xx = aa + dtb;
                    const float sp = xx > 20.f ? xx : log1pf(expf(xx));
                    gbuf[r * 4 + lane] = alg * sp;
                    betabuf[r * 4 + lane] = 1.0f / (1.0f + expf(-ab));
                }
            }
        }
        if (BOTH(1)) GRID_BAR();
    }

    if (IN(2)) {
        const int lane = (int)__builtin_amdgcn_mbcnt_hi(~0u, __builtin_amdgcn_mbcnt_lo(~0u, 0u)), tid = wave * 64 + lane; const kargp_t ap_ = karg_ptr();
        pg8::Gemm g{hbuf, WinT, NTOK, PCOLS, D}; pg8::StaticOrder S; S.init(NTOK, PCOLS, G, bx);
        pg8::EpiBf16 E{projb, PCOLS, nullptr, nullptr, 0, 1.0f};
        pg8::gemm_phase<pg8::EpiBf16, pg8::StaticOrder, true, true>(lds, g, S, E, tid);
        if (BOTH(2)) GRID_BAR();
    }

    if (IN(3)) {
        const int lane = (int)__builtin_amdgcn_mbcnt_hi(~0u, __builtin_amdgcn_mbcnt_lo(~0u, 0u)), tid = wave * 64 + lane; const kargp_t ap_ = karg_ptr();
        ldsf* qs = (ldsf*)lds; ldsf* ks = qs + 64 * 129; ldsf* vs = ks + 64 * 129; ldsf* Wsm = vs + 64 * 129; ldsf* Ls = Wsm + 64 * 129;
        constexpr int LSTR = 68;
        constexpr int RAW_OFF = 4 * 64 * 129 * 3;
        ldsf* gc = (ldsf*)(lds + 151296); ldsf* bt = gc + 64; ldsf* eg = bt + 64; ldsf* ekd = eg + 64;
        const float* conv_w = args.in[I_CONVW];
        const int r = lane & 31, h = lane >> 5;
        for (int item = (args.pad & 1) ? 1024 : bx; item < 1024; item += G) {
            const int bh = item >> 7, n = item & 127, b = bh >> 2, hh = bh & 3;
            const size_t row0 = (size_t)b * T + n * 64;
            unsigned char* ops = opsb + (size_t)item * OPS_BYTES;
            {
#pragma unroll
                for (int jp = 0; jp < 7; ++jp) {
                    const int p = wave + 8 * jp;
                    if (p < 51) {
                        int sg = 4 * p + (lane >> 4); sg = sg > 200 ? 200 : sg;
                        const int rw = sg / 3, wh = sg - 3 * rw; int tt = n * 64 + rw - 3; tt = tt < 0 ? 0 : tt;
                        __builtin_amdgcn_global_load_lds((const unsigned*)(projb + ((size_t)b * T + tt) * PCOLS + wh * 512 + hh * 128 + (lane & 15) * 8), (LAS unsigned*)(lds + RAW_OFF + p * 1024), 16, 0, 0);
                    }
                }
#pragma unroll
                for (int o = 0; o < 2; ++o) {
                    const int idx = tid + NTHR * o, i = idx >> 4, d0 = (idx & 15) * 8;
                    const v4u zw = *(const v4u*)(projb + ((size_t)b * T + n * 64 + i) * PCOLS + 1536 + hh * 128 + d0);
                    const f32x4 wa = *(const f32x4*)(args.in[I_ANW] + d0), wb = *(const f32x4*)(args.in[I_ANW] + d0 + 4);
                    v4u ow; ow.x = cvtpk(wa[0] * siluf(bflo(zw.x)), wa[1] * siluf(bfhi(zw.x))); ow.y = cvtpk(wa[2] * siluf(bflo(zw.y)), wa[3] * siluf(bfhi(zw.y)));
                    ow.z = cvtpk(wb[0] * siluf(bflo(zw.z)), wb[1] * siluf(bfhi(zw.z))); ow.w = cvtpk(wb[2] * siluf(bflo(zw.w)), wb[3] * siluf(bfhi(zw.w)));
                    *(v4u*)(zsb + ((size_t)b * T + n * 64 + i) * 512 + hh * 128 + d0) = ow;
                }
                asm volatile("s_waitcnt vmcnt(0)" ::: "memory");
                __syncthreads();
#pragma unroll 2
                for (int o = 0; o < 6; ++o) {
                    const int idx = tid + NTHR * o, i = idx / 48, c8 = idx - 48 * i, which = c8 >> 4, d0 = (c8 & 15) * 8, gch = which * 512 + hh * 128 + d0;
                    const LAS unsigned char* rp = lds + RAW_OFF + i * 768 + which * 256 + d0 * 2;
                    float acc[8];
#pragma unroll
                    for (int e = 0; e < 8; ++e) acc[e] = 0.f;
#pragma unroll
                    for (int tap = 0; tap < 4; ++tap) {
                        const v4u xw = *(const LAS v4u*)(rp + tap * 768);
                        const f32x4 wa = *(const f32x4*)(conv_w + tap * 1536 + gch), wb = *(const f32x4*)(conv_w + tap * 1536 + gch + 4);
                        const float msk = (n * 64 + i - 3 + tap) >= 0 ? 1.0f : 0.0f;
                        acc[0] += msk * wa[0] * bflo(xw.x); acc[1] += msk * wa[1] * bfhi(xw.x); acc[2] += msk * wa[2] * bflo(xw.y); acc[3] += msk * wa[3] * bfhi(xw.y);
                        acc[4] += msk * wb[0] * bflo(xw.z); acc[5] += msk * wb[1] * bfhi(xw.z); acc[6] += msk * wb[2] * bflo(xw.w); acc[7] += msk * wb[3] * bfhi(xw.w);
                    }
                    ldsf* dst = (which == 0 ? qs : (which == 1 ? ks : vs)) + i * 129 + d0;
#pragma unroll
                    for (int e = 0; e < 8; ++e) dst[e] = siluf(acc[e]);
                }
            }
            if (wave == 7) {
                float gv = gbuf[(row0 + lane) * 4 + hh];
#pragma unroll
                for (int o = 1; o < 64; o <<= 1) { const float t2 = __shfl_up(gv, o); if (lane >= o) gv += t2; }
                const float glast = __shfl(gv, 63);
                gc[lane] = gv; eg[lane] = expf(gv); bt[lane] = betabuf[(row0 + lane) * 4 + hh]; ekd[lane] = expf(glast - gv);
                if (lane == 0) glbuf[item] = expf(glast);
            }
            __syncthreads();
            if (((args.pad >> 2) & 7) == 1) continue;
            for (int i = wave; i < 64; i += NWAVES) {
                const float q0 = qs[i * 129 + lane], q1 = qs[i * 129 + 64 + lane], k0 = ks[i * 129 + lane], k1 = ks[i * 129 + 64 + lane];
                const float sq = rsqrtf(wave_sum(q0 * q0 + q1 * q1) + EPS) * 0.08838834764831845f, sk = rsqrtf(wave_sum(k0 * k0 + k1 * k1) + EPS);
                qs[i * 129 + lane] = q0 * sq; qs[i * 129 + 64 + lane] = q1 * sq; ks[i * 129 + lane] = k0 * sk; ks[i * 129 + 64 + lane] = k1 * sk;
            }
            __syncthreads();
            if (((args.pad >> 2) & 7) == 2) continue;
            {
                const int which = wave >> 2, ta = (wave >> 1) & 1, tb = wave & 1;
                if (tb <= ta) {
                    f32x16 acc;
#pragma unroll
                    for (int q = 0; q < 16; ++q) acc[q] = 0.f;
                    const ldsf* Ap = ks + (32 * (which == 0 ? ta : tb) + r) * 129 + 8 * h;
                    const ldsf* Bp = (which == 0 ? ks + (32 * tb + r) * 129 : qs + (32 * ta + r) * 129) + 8 * h;
#pragma unroll 4
                    for (int k = 0; k < 8; ++k) {
                        v4u pa, pb;
                        pa.x = cvtpk(Ap[16 * k + 0], Ap[16 * k + 1]); pa.y = cvtpk(Ap[16 * k + 2], Ap[16 * k + 3]); pa.z = cvtpk(Ap[16 * k + 4], Ap[16 * k + 5]); pa.w = cvtpk(Ap[16 * k + 6], Ap[16 * k + 7]);
                        pb.x = cvtpk(Bp[16 * k + 0], Bp[16 * k + 1]); pb.y = cvtpk(Bp[16 * k + 2], Bp[16 * k + 3]); pb.z = cvtpk(Bp[16 * k + 4], Bp[16 * k + 5]); pb.w = cvtpk(Bp[16 * k + 6], Bp[16 * k + 7]);
                        acc = MFMA32(__builtin_bit_cast(bf16x8, pa), __builtin_bit_cast(bf16x8, pb), acc);
                    }
                    if (which == 0) {
                        const int j = 32 * tb + r; const float gj = gc[j];
#pragma unroll
                        for (int q = 0; q < 16; ++q) { const int i = 32 * ta + crow(q, h); Ls[i * LSTR + j] = (j < i) ? bt[i] * acc[q] * __expf(gc[i] - gj) : 0.f; }
                    } else {
                        const int i = 32 * ta + r; const float gi = gc[i];
#pragma unroll
                        for (int q = 0; q < 16; ++q) { const int j = 32 * tb + crow(q, h); acc[q] = (j <= i) ? acc[q] * __expf(gi - gc[j]) : 0.f; }
#pragma unroll
                        for (int s2 = 0; s2 < 2; ++s2) *(bf16x8*)(ops + (48 + (ta * 2 + tb) * 2 + s2) * 1024 + lane * 16) = pack8(acc, s2);
                    }
                }
            }
            __syncthreads();
            if (((args.pad >> 2) & 7) == 3) continue;
            if (wave < 4) {
                const int d = tid & 127; const bool isw = tid >= 128;
                int z; asm volatile("v_mov_b32 %0, 0" : "=v"(z));
                const ldsf* Lz = Ls + z; const ldsf* btz = bt + z; const ldsf* egz = eg + z;
                float xr[32];
                const ldsf* srcx = (isw ? ks : vs) + d;
                ldsf* dst = (isw ? Wsm : vs) + d;
#pragma unroll
                for (int i = 0; i < 32; ++i) { const float e_ = egz[i]; xr[i] = srcx[i * 129] * btz[i] * (isw ? e_ : 1.0f); }
#pragma unroll
                for (int i = 32; i < 64; ++i) { const float e_ = egz[i]; dst[i * 129] = srcx[i * 129] * btz[i] * (isw ? e_ : 1.0f); }
#pragma unroll
                for (int i = 1; i < 32; ++i) {
                    float s0 = xr[i], s1 = 0.f;
#pragma unroll
                    for (int j4 = 0; j4 < (i + 3) / 4; ++j4) {
                        const f32x4 l = *(const LAS f32x4*)(Lz + i * LSTR + 4 * j4);
                        s0 -= l[0] * xr[4 * j4]; s1 -= l[1] * xr[4 * j4 + 1]; s0 -= l[2] * xr[4 * j4 + 2]; s1 -= l[3] * xr[4 * j4 + 3];
                    }
                    xr[i] = s0 + s1;
                    asm volatile("" ::: "memory");
                }
#pragma unroll
                for (int i = 0; i < 32; ++i) dst[i * 129] = xr[i];
            } else {
#pragma unroll 1
                for (int ff = 0; ff < 8; ++ff) {
                    const int f = (wave - 4) * 8 + ff;
                    v4u p; float v8[8];
                    if (f < 16) { const int mt = f >> 3, t2 = (f >> 1) & 3, s2 = f & 1; const int i = 32 * mt + r; const float e = eg[i];
#pragma unroll
                        for (int j = 0; j < 8; ++j) v8[j] = qs[i * 129 + 32 * t2 + 16 * s2 + 8 * (j >> 2) + 4 * h + (j & 3)] * e;
                    } else { const int g2 = f - 16, t2 = g2 >> 2, mt = (g2 >> 1) & 1, s2 = g2 & 1; const int d = 32 * t2 + r;
#pragma unroll
                        for (int j = 0; j < 8; ++j) { const int i = 32 * mt + 16 * s2 + 8 * (j >> 2) + 4 * h + (j & 3); v8[j] = ks[i * 129 + d] * ekd[i]; }
                    }
                    p.x = cvtpk(v8[0], v8[1]); p.y = cvtpk(v8[2], v8[3]); p.z = cvtpk(v8[4], v8[5]); p.w = cvtpk(v8[6], v8[7]);
                    *(v4u*)(ops + (16 + f) * 1024 + lane * 16) = p;
                }
            }
            __syncthreads();
            {
                ldsf* X = (wave < 4) ? vs + 32 * wave : Wsm + 32 * (wave - 4);
                f32x16 acc;
#pragma unroll
                for (int q = 0; q < 16; ++q) acc[q] = X[(32 + crow(q, h)) * 129 + r];
                const ldsf* Ap = Ls + (32 + r) * LSTR + h;
                const ldsf* Bp = X + h * 129 + r;
#pragma unroll 8
                for (int k = 0; k < 16; ++k) acc = __builtin_amdgcn_mfma_f32_32x32x2f32(-Ap[2 * k], Bp[(2 * k) * 129], acc, 0, 0, 0);
#pragma unroll
                for (int q = 0; q < 16; ++q) X[(32 + crow(q, h)) * 129 + r] = acc[q];
            }
            __syncthreads();
            if (wave < 4) {
                const int d = tid & 127; const bool isw = tid >= 128;
                int z; asm volatile("v_mov_b32 %0, 0" : "=v"(z));
                const ldsf* Lz = Ls + z;
                ldsf* dst = (isw ? Wsm : vs) + d;
                float xr[32];
#pragma unroll
                for (int i = 0; i < 32; ++i) xr[i] = dst[(32 + i) * 129];
#pragma unroll
                for (int i = 1; i < 32; ++i) {
                    float s0 = xr[i], s1 = 0.f;
#pragma unroll
                    for (int j4 = 0; j4 < (i + 3) / 4; ++j4) {
                        const f32x4 l = *(const LAS f32x4*)(Lz + (32 + i) * LSTR + 32 + 4 * j4);
                        s0 -= l[0] * xr[4 * j4]; s1 -= l[1] * xr[4 * j4 + 1]; s0 -= l[2] * xr[4 * j4 + 2]; s1 -= l[3] * xr[4 * j4 + 3];
                    }
                    xr[i] = s0 + s1;
                    asm volatile("" ::: "memory");
                }
#pragma unroll
                for (int i = 0; i < 32; ++i) dst[(32 + i) * 129] = xr[i];
            }
            __syncthreads();
            if (((args.pad >> 2) & 7) == 4) continue;
#pragma unroll
            for (int o = 0; o < 2; ++o) {
                const int idx8 = tid + NTHR * o, l2 = idx8 & 63, q8 = (idx8 >> 6) & 1, mt = (idx8 >> 7) & 1, w = idx8 >> 8;
                const int c = 32 * w + (l2 & 31), hh2 = l2 >> 5;
                float u8[8];
#pragma unroll
                for (int e = 0; e < 8; ++e) u8[e] = vs[(32 * mt + crow(8 * q8 + e, hh2)) * 129 + c];
                v4u p; p.x = cvtpk(u8[0], u8[1]); p.y = cvtpk(u8[2], u8[3]); p.z = cvtpk(u8[4], u8[5]); p.w = cvtpk(u8[6], u8[7]);
                *(v4u*)((unsigned char*)Ub + (size_t)item * 16384 + idx8 * 16) = p;
            }
#pragma unroll
            for (int ff = 0; ff < 2; ++ff) {
                const int f = wave * 2 + ff, mt = f >> 3, t2 = (f >> 1) & 3, s2 = f & 1; const int i = 32 * mt + r;
                float v8[8];
#pragma unroll
                for (int j = 0; j < 8; ++j) v8[j] = -Wsm[i * 129 + 32 * t2 + 16 * s2 + 8 * (j >> 2) + 4 * h + (j & 3)];
                v4u p; p.x = cvtpk(v8[0], v8[1]); p.y = cvtpk(v8[2], v8[3]); p.z = cvtpk(v8[4], v8[5]); p.w = cvtpk(v8[6], v8[7]);
                *(v4u*)(ops + f * 1024 + lane * 16) = p;
            }
            __syncthreads();
        }
        {
            const int r = lane & 31, h = lane >> 5;
            for (int it = (args.pad & 2) ? 2048 : gw; it < 2048; it += NGW) {
                const int c = it & 127, hh = (it >> 7) & 7, b = it >> 10;
                const bf16* base = projb + ((size_t)b * T + c * 64) * PCOLS + hh * 64;
#pragma unroll
                for (int kb2 = 0; kb2 < 2; ++kb2)
#pragma unroll
                    for (int ks = 0; ks < 4; ++ks) {
                        const bf16* rp = base + (size_t)(32 * kb2 + r) * PCOLS + 16 * ks + 8 * h;
                        *(v4u*)(qfb + (size_t)it * 8192 + (kb2 * 4 + ks) * 1024 + lane * 16) = *(const v4u*)(rp + 2048);
                        *(v4u*)(kfb + (size_t)it * 8192 + (kb2 * 4 + ks) * 1024 + lane * 16) = *(const v4u*)(rp + 2560);
                    }
#pragma unroll
                for (int dt = 0; dt < 2; ++dt)
#pragma unroll
                    for (int kb2 = 0; kb2 < 2; ++kb2)
#pragma unroll
                        for (int s2 = 0; s2 < 2; ++s2) {
                            unsigned short e8[8];
#pragma unroll
                            for (int j = 0; j < 8; ++j) e8[j] = base[(size_t)(32 * kb2 + 16 * s2 + 8 * (j >> 2) + 4 * h + (j & 3)) * PCOLS + 3072 + 32 * dt + r];
                            v4u p; p.x = e8[0] | ((unsigned)e8[1] << 16); p.y = e8[2] | ((unsigned)e8[3] << 16); p.z = e8[4] | ((unsigned)e8[5] << 16); p.w = e8[6] | ((unsigned)e8[7] << 16);
                            *(v4u*)(vtfb + (size_t)it * 8192 + ((dt * 2 + kb2) * 2 + s2) * 1024 + lane * 16) = p;
                        }
            }
        }
        if (BOTH(3)) GRID_BAR();
    }

    if (IN(4)) {
        const int lane = (int)__builtin_amdgcn_mbcnt_hi(~0u, __builtin_amdgcn_mbcnt_lo(~0u, 0u)), tid = wave * 64 + lane; const kargp_t ap_ = karg_ptr();
        if (bx < 64) {
            constexpr int SEGC = 16;
            const int bh = bx & 7, seg = bx >> 3, b = bh >> 2, hh = bh & 3;
            const int r = lane & 31, h = lane >> 5;
            const int c0 = seg * SEGC;
#define SCAN_BAR() do { asm volatile("s_waitcnt lgkmcnt(0)" ::: "memory"); __builtin_amdgcn_s_barrier(); asm volatile("" ::: "memory"); } while (0)
#define FRAG(f_) (*(const LAS bf16x8*)(Bf + (f_) * 1024))
            {
                const unsigned char* ops = opsb + (size_t)(bh * 128 + c0) * OPS_BYTES;
                const float* Uf = (const float*)((const unsigned char*)Ub + (size_t)(bh * 128 + c0) * 16384);
                float* segp = (float*)(args.ws + WS_SEG) + (size_t)(bh * 8 + seg) * 32768;
                ldsf* egls = (ldsf*)(lds + 4 * 32768);
                if (tid < SEGC) egls[tid] = glbuf[bh * 128 + c0 + tid];
                const int pbase = (wave < 6) ? (wave - 4) * 8 : 32 + (wave - 6) * 8, fbase = (wave - 4) * 8;
#define A_DMA(n_) do { const unsigned char* src_ = ops + (size_t)(n_) * OPS_BYTES + pbase * 1024 + lane * 16; \
                _Pragma("unroll") for (int p_ = 0; p_ < 8; ++p_) __builtin_amdgcn_global_load_lds((const unsigned*)(src_ + p_ * 1024), (LAS unsigned*)(lds + ((n_) & 3) * 32768 + (fbase + p_) * 1024), 16, 0, 0); } while (0)
                f32x16 S[4]; v4u Ur[4];
#pragma unroll
                for (int t2 = 0; t2 < 4; ++t2)
#pragma unroll
                    for (int q = 0; q < 16; ++q) S[t2][q] = (wave >= 4 && (32 * t2 + crow(q, h)) == (32 * (wave - 4) + r)) ? 1.0f : 0.0f;
#pragma unroll
                for (int f = 0; f < 4; ++f) Ur[f] = (v4u){0u, 0u, 0u, 0u};
                if (wave < 4) {
#pragma unroll
                    for (int f = 0; f < 4; ++f) Ur[f] = *((const v4u*)Uf + (wave * 4 + f) * 64 + lane);
                } else { A_DMA(0); A_DMA(1); A_DMA(2); }
                for (int n = 0; n < SEGC; ++n) {
                    if (wave >= 4) { if (n <= SEGC - 3) asm volatile("s_waitcnt vmcnt(16)" ::: "memory"); else if (n == SEGC - 2) asm volatile("s_waitcnt vmcnt(8)" ::: "memory"); else asm volatile("s_waitcnt vmcnt(0)" ::: "memory"); }
                    SCAN_BAR();
                    if (wave >= 4 && n + 3 < SEGC) A_DMA(n + 3);
                    const LAS unsigned char* Bf = lds + (n & 3) * 32768 + lane * 16;
                    f32x16 VN[2];
#pragma unroll
                    for (int mt = 0; mt < 2; ++mt)
#pragma unroll
                        for (int q8 = 0; q8 < 2; ++q8) { const v4u u = Ur[mt * 2 + q8];
                            VN[mt][8 * q8 + 0] = bflo(u.x); VN[mt][8 * q8 + 1] = bfhi(u.x); VN[mt][8 * q8 + 2] = bflo(u.y); VN[mt][8 * q8 + 3] = bfhi(u.y);
                            VN[mt][8 * q8 + 4] = bflo(u.z); VN[mt][8 * q8 + 5] = bfhi(u.z); VN[mt][8 * q8 + 6] = bflo(u.w); VN[mt][8 * q8 + 7] = bfhi(u.w); }
                    if (wave < 4 && n + 1 < SEGC) {
                        const v4u* up = (const v4u*)((const unsigned char*)Uf + (size_t)(n + 1) * 16384) + (wave * 4) * 64 + lane;
#pragma unroll
                        for (int f = 0; f < 4; ++f) Ur[f] = up[f * 64];
                    }
                    const float egl = egls[n];
#pragma unroll
                    for (int t2 = 0; t2 < 4; ++t2)
#pragma unroll
                        for (int s2 = 0; s2 < 2; ++s2) {
                            const bf16x8 sb = pack8(S[t2], s2);
#pragma unroll
                            for (int mt = 0; mt < 2; ++mt) VN[mt] = MFMA32(FRAG((mt * 4 + t2) * 2 + s2), sb, VN[mt]);
                        }
                    bf16x8 vb[2][2];
#pragma unroll
                    for (int mt = 0; mt < 2; ++mt)
#pragma unroll
                        for (int s2 = 0; s2 < 2; ++s2) vb[mt][s2] = pack8(VN[mt], s2);
#pragma unroll
                    for (int t2 = 0; t2 < 4; ++t2) {
#pragma unroll
                        for (int q = 0; q < 16; ++q) S[t2][q] *= egl;
#pragma unroll
                        for (int mt = 0; mt < 2; ++mt)
#pragma unroll
                            for (int s2 = 0; s2 < 2; ++s2) S[t2] = MFMA32(FRAG(16 + (t2 * 2 + mt) * 2 + s2), vb[mt][s2], S[t2]);
                    }
                }
#undef A_DMA
                if (wave < 4) {
#pragma unroll
                    for (int t2 = 0; t2 < 4; ++t2)
#pragma unroll
                        for (int q = 0; q < 16; ++q) segp[((wave * 4 + t2) * 16 + q) * 64 + lane] = S[t2][q];
                } else {
                    unsigned short* pp = (unsigned short*)(args.ws + WS_SEGP) + (size_t)(bh * 8 + seg) * 16384 + (((wave - 4) * 2 + (r >> 4)) * 64 + 32 * ((r >> 3) & 1)) * 8 + (r & 7);
#pragma unroll
                    for (int t2 = 0; t2 < 4; ++t2)
#pragma unroll
                        for (int q = 0; q < 16; ++q) pp[(t2 * 8 * 64 + crow(q, h)) * 8] = (unsigned short)f2bf(S[t2][q]);
                }
            }
            asm volatile("s_waitcnt vmcnt(0)" ::: "memory");
            __syncthreads();
            if (tid == 0) { __builtin_amdgcn_fence(__ATOMIC_RELEASE, "agent"); asm volatile("s_waitcnt vmcnt(0)" ::: "memory"); __hip_atomic_fetch_add(ctl + CW_SEGA + 64 * bh, 1u, RLX_AGENT); }
            if (seg == 0) {
                if (tid == 0) { unsigned sp_ = 0; while (__hip_atomic_load(ctl + CW_SEGA + 64 * bh, RLX_AGENT) < 8u) { __builtin_amdgcn_s_sleep(4); if (++sp_ > (1u << 24)) break; }
                    __builtin_amdgcn_fence(__ATOMIC_ACQUIRE, "agent"); asm volatile("s_waitcnt vmcnt(0)" ::: "memory"); }
                __syncthreads();
                constexpr int ST_ROW = 272, ST_BYTES = 128 * ST_ROW;
                const int nt = wave & 3, mt0 = 2 * (wave >> 2);
                const float* seg0 = (const float*)(args.ws + WS_SEG) + (size_t)(bh * 8) * 32768;
                const unsigned char* pa0 = args.ws + WS_SEGP + (size_t)(bh * 8) * 32768 + lane * 16;
                float* sst0 = (float*)(args.ws + WS_SST) + (size_t)(bh * 8) * 16384;
#define PB_LOADA(dst, k_) do { const unsigned char* pk_ = pa0 + (size_t)(k_) * 32768; \
                    _Pragma("unroll") for (int i_ = 0; i_ < 2; ++i_) _Pragma("unroll") for (int f_ = 0; f_ < 8; ++f_) dst[i_ * 8 + f_] = *(const bf16x8*)(pk_ + (((mt0 + i_) * 4) * 2 + f_) * 1024); } while (0)
#define PB_ITER(k_, Acur, Anext) do { \
                    if ((k_) + 1 <= 6) PB_LOADA(Anext, (k_) + 1); \
                    const float* sk_ = seg0 + (size_t)(k_) * 32768; \
                    f32x16 z0_[2], Z_[2]; \
                    _Pragma("unroll") for (int i_ = 0; i_ < 2; ++i_) _Pragma("unroll") for (int q_ = 0; q_ < 16; ++q_) { z0_[i_][q_] = sk_[((nt * 4 + mt0 + i_) * 16 + q_) * 64 + lane]; Z_[i_][q_] = 0.f; } \
                    if ((k_) > 0) { const LAS unsigned char* stc_ = lds + ((k_) & 1) * ST_BYTES + (32 * nt + r) * ST_ROW + 16 * h; \
                        _Pragma("unroll") for (int f_ = 0; f_ < 8; ++f_) { const bf16x8 bfr_ = *(const LAS bf16x8*)(stc_ + (16 * f_) * 2); \
                            Z_[0] = MFMA32(Acur[f_], bfr_, Z_[0]); Z_[1] = MFMA32(Acur[8 + f_], bfr_, Z_[1]); } } \
                    float* so_ = sst0 + (size_t)((k_) + 1) * 16384; \
                    LAS unsigned char* stn_ = lds + (((k_) + 1) & 1) * ST_BYTES + (32 * nt + r) * ST_ROW; \
                    _Pragma("unroll") for (int i_ = 0; i_ < 2; ++i_) { \
                        _Pragma("unroll") for (int q_ = 0; q_ < 16; ++q_) { Z_[i_][q_] += z0_[i_][q_]; so_[((nt * 4 + mt0 + i_) * 16 + q_) * 64 + lane] = Z_[i_][q_]; } \
                        _Pragma("unroll") for (int q_ = 0; q_ < 16; q_ += 2) *(LAS unsigned*)(stn_ + (32 * (mt0 + i_) + crow(q_, h)) * 2) = cvtpk(Z_[i_][q_], Z_[i_][q_ + 1]); } \
                    SCAN_BAR(); } while (0)
                bf16x8 Aa[16], Ab[16];
#pragma unroll
                for (int f = 0; f < 16; ++f) { Aa[f] = (bf16x8){0, 0, 0, 0, 0, 0, 0, 0}; Ab[f] = Aa[f]; }
                PB_ITER(0, Ab, Aa);
                PB_ITER(1, Aa, Ab);
                PB_ITER(2, Ab, Aa);
                PB_ITER(3, Aa, Ab);
                PB_ITER(4, Ab, Aa);
                PB_ITER(5, Aa, Ab);
                PB_ITER(6, Ab, Aa);
#undef PB_ITER
#undef PB_LOADA
                asm volatile("s_waitcnt vmcnt(0)" ::: "memory");
                __syncthreads();
                if (tid == 0) { __builtin_amdgcn_fence(__ATOMIC_RELEASE, "agent"); asm volatile("s_waitcnt vmcnt(0)" ::: "memory"); __hip_atomic_store(ctl + CW_SEGB + 64 * bh, 1u, RLX_AGENT); }
            }
            if (tid == 0) { unsigned sp_ = 0; while (__hip_atomic_load(ctl + CW_SEGB + 64 * bh, RLX_AGENT) == 0u) { __builtin_amdgcn_s_sleep(4); if (++sp_ > (1u << 24)) break; }
                __builtin_amdgcn_fence(__ATOMIC_ACQUIRE, "agent"); asm volatile("s_waitcnt vmcnt(0)" ::: "memory"); }
            __syncthreads();
#undef FRAG
            const kargp_t ap2_ = karg_ptr();
            const unsigned char* ops = ((*ap2_).ws + WS_OPS) + (size_t)(bh * 128 + c0) * OPS_BYTES;
            const float* Uf = (const float*)((const unsigned char*)((*ap2_).ws + WS_U) + (size_t)(bh * 128 + c0) * 16384);
            const float* sstp = (const float*)((*ap2_).ws + WS_SST) + (size_t)(bh * 8 + seg) * 16384;
#define SCAN_DMA(n_, buf_) do { const unsigned char* src_ = ops + (size_t)(n_) * OPS_BYTES + ((wave - 4) * 14) * 1024 + lane * 16; \
            _Pragma("unroll") for (int p_ = 0; p_ < 14; ++p_) __builtin_amdgcn_global_load_lds((const unsigned*)(src_ + p_ * 1024), (LAS unsigned*)(lds + (buf_) * OPS_BYTES + ((wave - 4) * 14 + p_) * 1024), 16, 0, 0); } while (0)
            constexpr int STG_OFF = 2 * OPS_BYTES, STG_ROW = 272, STG_BYTES = 64 * STG_ROW;
            if (wave < 4) {
                f32x16 S[4]; v4u Ur[4];
#pragma unroll
                for (int t2 = 0; t2 < 4; ++t2)
#pragma unroll
                    for (int q = 0; q < 16; ++q) S[t2][q] = (seg > 0) ? sstp[((wave * 4 + t2) * 16 + q) * 64 + lane] : 0.f;
#pragma unroll
                for (int f = 0; f < 4; ++f) Ur[f] = *((const v4u*)Uf + (wave * 4 + f) * 64 + lane);
                const float* glp = glbuf + bh * 128 + c0;
                float eglr = glp[0];
                for (int n = 0; n < SEGC; ++n) {
                    SCAN_BAR();
                    const LAS unsigned char* Bf = lds + (n & 1) * OPS_BYTES + lane * 16;
#define FRAG(f_) (*(const LAS bf16x8*)(Bf + (f_) * 1024))
                    f32x16 VN[2], O[2];
#pragma unroll
                    for (int mt = 0; mt < 2; ++mt)
#pragma unroll
                        for (int q8 = 0; q8 < 2; ++q8) { const v4u u = Ur[mt * 2 + q8];
                            VN[mt][8 * q8 + 0] = bflo(u.x); VN[mt][8 * q8 + 1] = bfhi(u.x); VN[mt][8 * q8 + 2] = bflo(u.y); VN[mt][8 * q8 + 3] = bfhi(u.y);
                            VN[mt][8 * q8 + 4] = bflo(u.z); VN[mt][8 * q8 + 5] = bfhi(u.z); VN[mt][8 * q8 + 6] = bflo(u.w); VN[mt][8 * q8 + 7] = bfhi(u.w); }
                    const float egl = eglr;
                    if (n + 1 < SEGC) {
                        const v4u* up = (const v4u*)((const unsigned char*)Uf + (size_t)(n + 1) * 16384) + (wave * 4) * 64 + lane;
#pragma unroll
                        for (int f = 0; f < 4; ++f) Ur[f] = up[f * 64];
                        eglr = glp[n + 1];
                    }
#pragma unroll
                    for (int mt = 0; mt < 2; ++mt)
#pragma unroll
                        for (int q = 0; q < 16; ++q) O[mt][q] = 0.f;
#pragma unroll
                    for (int t2 = 0; t2 < 4; ++t2)
#pragma unroll
                        for (int s2 = 0; s2 < 2; ++s2) {
                            const bf16x8 sb = pack8(S[t2], s2);
#pragma unroll
                            for (int mt = 0; mt < 2; ++mt) {
                                VN[mt] = MFMA32(FRAG((mt * 4 + t2) * 2 + s2), sb, VN[mt]);
                                O[mt] = MFMA32(FRAG(16 + (mt * 4 + t2) * 2 + s2), sb, O[mt]);
                            }
                        }
                    bf16x8 vb[2][2];
#pragma unroll
                    for (int mt = 0; mt < 2; ++mt)
#pragma unroll
                        for (int s2 = 0; s2 < 2; ++s2) vb[mt][s2] = pack8(VN[mt], s2);
#pragma unroll
                    for (int s2 = 0; s2 < 2; ++s2) {
                        O[0] = MFMA32(FRAG(48 + 0 * 2 + s2), vb[0][s2], O[0]);
                        O[1] = MFMA32(FRAG(48 + 2 * 2 + s2), vb[0][s2], O[1]);
                        O[1] = MFMA32(FRAG(48 + 3 * 2 + s2), vb[1][s2], O[1]);
                    }
                    {
                        LAS unsigned short* sp = (LAS unsigned short*)(lds + STG_OFF + (n & 1) * STG_BYTES) + 32 * wave + r;
#pragma unroll
                        for (int mt = 0; mt < 2; ++mt)
#pragma unroll
                            for (int q = 0; q < 16; q += 2) { const unsigned w = cvtpk(O[mt][q], O[mt][q + 1]);
                                sp[(32 * mt + crow(q, h)) * (STG_ROW / 2)] = (unsigned short)(w & 0xffffu); sp[(32 * mt + crow(q + 1, h)) * (STG_ROW / 2)] = (unsigned short)(w >> 16); }
                    }
                    SCAN_BAR();
#pragma unroll
                    for (int t2 = 0; t2 < 4; ++t2) {
#pragma unroll
                        for (int q = 0; q < 16; ++q) S[t2][q] *= egl;
#pragma unroll
                        for (int mt = 0; mt < 2; ++mt)
#pragma unroll
                            for (int s2 = 0; s2 < 2; ++s2) S[t2] = MFMA32(FRAG(32 + (t2 * 2 + mt) * 2 + s2), vb[mt][s2], S[t2]);
                    }
#undef FRAG
                }
                SCAN_BAR();
            } else {
                const int w4 = wave - 4, row = 16 * w4 + (lane >> 2), qt = lane & 3;
                const bf16* zp = zsb + ((size_t)b * T + c0 * 64 + row) * 512 + hh * 128 + qt * 32;
                bf16* op = omix + ((size_t)b * T + c0 * 64 + row) * D + hh * 128 + qt * 32;
                SCAN_DMA(0, 0);
                asm volatile("s_waitcnt vmcnt(0)" ::: "memory");
                v4u zr[4];
#pragma unroll
                for (int k = 0; k < 4; ++k) zr[k] = *(const v4u*)(zp + 8 * k);
                unsigned pfacc = 0u, pf0 = 0u, pf1 = 0u;
                for (int n = 0; n <= SEGC; ++n) {
                    SCAN_BAR();
                    if (n < SEGC - 1) SCAN_DMA(n + 1, (n + 1) & 1);
                    asm volatile("" ::: "memory");
                    if (n < SEGC - 2) {
                        const unsigned char* pf = ops + (size_t)(n + 2) * OPS_BYTES + (w4 * 112 + lane) * 128;
                        pfacc += pf0 + pf1; pf0 = *(const unsigned*)pf; pf1 = (lane < 48) ? *(const unsigned*)(pf + 64 * 128) : 0u;
                    }
                    asm volatile("" ::: "memory");
                    if (n < SEGC) SCAN_BAR();
                    if (n > 0) {
                        const LAS unsigned char* sp = lds + STG_OFF + ((n - 1) & 1) * STG_BYTES + row * STG_ROW + qt * 64;
                        v4u ov[4]; float ss = 0.f;
#pragma unroll
                        for (int k = 0; k < 4; ++k) { ov[k] = *(const LAS v4u*)(sp + 16 * k);
                            const float a0 = bflo(ov[k].x), a1 = bfhi(ov[k].x), a2 = bflo(ov[k].y), a3 = bfhi(ov[k].y), a4 = bflo(ov[k].z), a5 = bfhi(ov[k].z), a6 = bflo(ov[k].w), a7 = bfhi(ov[k].w);
                            ss += (a0 * a0 + a1 * a1) + (a2 * a2 + a3 * a3) + (a4 * a4 + a5 * a5) + (a6 * a6 + a7 * a7); }
                        ss += __shfl_xor(ss, 1); ss += __shfl_xor(ss, 2);
                        const float rstd = rsqrtf(ss * (1.0f / 128.0f) + EPS);
                        bf16* o2 = op + (size_t)(n - 1) * 64 * D;
#pragma unroll
                        for (int k = 0; k < 4; ++k) {
                            v4u w;
                            w.x = cvtpk(bflo(ov[k].x) * rstd * bflo(zr[k].x), bfhi(ov[k].x) * rstd * bfhi(zr[k].x));
                            w.y = cvtpk(bflo(ov[k].y) * rstd * bflo(zr[k].y), bfhi(ov[k].y) * rstd * bfhi(zr[k].y));
                            w.z = cvtpk(bflo(ov[k].z) * rstd * bflo(zr[k].z), bfhi(ov[k].z) * rstd * bfhi(zr[k].z));
                            w.w = cvtpk(bflo(ov[k].w) * rstd * bflo(zr[k].w), bfhi(ov[k].w) * rstd * bfhi(zr[k].w));
                            *(v4u*)(o2 + 8 * k) = w;
                        }
                    }
                    asm volatile("" ::: "memory");
                    if (n >= 1 && n < SEGC) {
#pragma unroll
                        for (int k = 0; k < 4; ++k) zr[k] = *(const v4u*)(zp + (size_t)n * 64 * 512 + 8 * k);
                    }
                    asm volatile("" ::: "memory");
                    if (n < SEGC) { if (n == 0 || n >= SEGC - 2) asm volatile("s_waitcnt vmcnt(0)" ::: "memory"); else asm volatile("s_waitcnt vmcnt(10)" ::: "memory"); }
                }
                if (pfacc == 0x12345679u) glbuf[1024 + lane] = 1.0f;
            }
#undef SCAN_DMA
#undef SCAN_BAR
        } else {
            const float* relb = args.in[I_RELB];
            ldsf* rbl = (ldsf*)lds;
            for (int idx = tid; idx < 8 * 257; idx += NTHR) rbl[idx] = relb[idx] * 1.4426950408889634f;
            __syncthreads();
            const int r = lane & 31, h = lane >> 5;
            const int AW = (G - 64) * NWAVES, aw = (bx - 64) * NWAVES + wave;
            for (int task = aw; task < 4096; task += AW) {
                const int qh = task & 1, hh = (task >> 1) & 7, n = (task >> 4) & 127, b = task >> 11;
                const int bhc = (b * 8 + hh) * 128;
                bf16x8 qf[4];
#pragma unroll
                for (int ks = 0; ks < 4; ++ks) qf[ks] = *(const bf16x8*)(qfb + (size_t)(bhc + n) * 8192 + (qh * 4 + ks) * 1024 + lane * 16);
                f32x16 OT[2];
#pragma unroll
                for (int dt = 0; dt < 2; ++dt)
#pragma unroll
                    for (int q = 0; q < 16; ++q) OT[dt][q] = 0.f;
                float m = -1e30f, l = 0.f;
                const float c0 = rbl[hh * 257 + 256];
                const int iq = 32 * qh + r;
                const int cb0 = (n >= 8) ? 0 : 8 - n;
                for (int blk = cb0 * 2; blk < 18; ++blk) {
                    const int cb = blk >> 1, kb2 = blk & 1, cidx = n - 8 + cb;
                    const unsigned char* kp = kfb + (size_t)(bhc + cidx) * 8192 + (kb2 * 4) * 1024 + lane * 16;
                    const unsigned char* vp = vtfb + (size_t)(bhc + cidx) * 8192 + lane * 16;
                    bf16x8 kf[4], vf[2][2];
#pragma unroll
                    for (int ks = 0; ks < 4; ++ks) kf[ks] = *(const bf16x8*)(kp + ks * 1024);
#pragma unroll
                    for (int dt = 0; dt < 2; ++dt)
#pragma unroll
                        for (int s2 = 0; s2 < 2; ++s2) vf[dt][s2] = *(const bf16x8*)(vp + ((dt * 2 + kb2) * 2 + s2) * 1024);
                    f32x16 st;
#pragma unroll
                    for (int q = 0; q < 16; ++q) st[q] = 0.f;
#pragma unroll
                    for (int ks = 0; ks < 4; ++ks) st = MFMA32(kf[ks], qf[ks], st);
                    if (cb >= 6) {
                        const int kpos0 = cb * 64 + 32 * kb2;
#pragma unroll
                        for (int q = 0; q < 16; ++q) { int rel = iq + 512 - (kpos0 + crow(q, h)); rel = rel > 128 ? 128 : rel; st[q] = st[q] * 0.18033688011112042f + rbl[hh * 257 + rel + 128]; }
                    } else {
#pragma unroll
                        for (int q = 0; q < 16; ++q) st[q] = st[q] * 0.18033688011112042f + c0;
                    }
                    float bm = st[0];
#pragma unroll
                    for (int q = 1; q < 16; ++q) bm = fmaxf(bm, st[q]);
                    bm = fmaxf(bm, __shfl_xor(bm, 32));
                    const float mn = fmaxf(m, bm);
                    if (__any(mn > m)) {
                        const float corr = __builtin_amdgcn_exp2f(m - mn);
                        l *= corr;
#pragma unroll
                        for (int dt = 0; dt < 2; ++dt)
#pragma unroll
                            for (int q = 0; q < 16; ++q) OT[dt][q] *= corr;
                        m = mn;
                    }
                    float ps = 0.f;
#pragma unroll
                    for (int q = 0; q < 16; ++q) { st[q] = __builtin_amdgcn_exp2f(st[q] - m); ps += st[q]; }
                    ps += __shfl_xor(ps, 32);
                    l += ps;
                    const bf16x8 p0 = pack8(st, 0), p1 = pack8(st, 1);
#pragma unroll
                    for (int dt = 0; dt < 2; ++dt) { OT[dt] = MFMA32(vf[dt][0], p0, OT[dt]); OT[dt] = MFMA32(vf[dt][1], p1, OT[dt]); }
                }
                const float inv = 1.0f / l;
                bf16* op = omix + ((size_t)b * T + n * 64 + iq) * D + 512 + hh * 64;
#pragma unroll
                for (int dt = 0; dt < 2; ++dt)
#pragma unroll
                    for (int q4 = 0; q4 < 4; ++q4) {
                        v2u w; w.x = cvtpk(OT[dt][4 * q4] * inv, OT[dt][4 * q4 + 1] * inv); w.y = cvtpk(OT[dt][4 * q4 + 2] * inv, OT[dt][4 * q4 + 3] * inv);
                        *(v2u*)(op + 32 * dt + 8 * q4 + 4 * h) = w;
                    }
            }
            __syncthreads();
            {
                ldsf* scr = (ldsf*)(lds + wave * 16384);
                constexpr int I_UP1 = 16 * 64, I_DN1 = 16 * 32;
                for (int it = aw; it < NE * (I_UP1 + I_DN1); it += AW) {
                    int r2 = it;
                    if (r2 < NE * I_UP1) { const int e = r2 / I_UP1; transpose_item8(args.in[I_WUP] + (size_t)e * D * 2048, D, 2048, (unsigned char*)WupT + (size_t)e * 2048 * D, 2, scr, r2 % I_UP1, lane); continue; } r2 -= NE * I_UP1;
                    { const int e = r2 / I_DN1; transpose_item8(args.in[I_WDN] + (size_t)e * D * D, D, D, (unsigned char*)WdnT + (size_t)e * D * D, 1, scr, r2 % I_DN1, lane); }
                }
            }
        }
        if (BOTH(4)) GRID_BAR();
    }


    if (IN(6)) {
        const int lane = (int)__builtin_amdgcn_mbcnt_hi(~0u, __builtin_amdgcn_mbcnt_lo(~0u, 0u)), tid = wave * 64 + lane; const kargp_t ap_ = karg_ptr();
        pg8::Gemm g{omix, WoutT, NTOK, D, D}; pg8::StaticOrder S; S.init(NTOK, D, G, bx);
        pg8::EpiBf16 E{ybuf, D, nullptr, nullptr, 0, 1.0f};
        pg8::gemm_phase<pg8::EpiBf16, pg8::StaticOrder, true, true>(lds, g, S, E, tid);
        if (BOTH(6)) GRID_BAR();
    }

    if (IN(7)) {
        const int lane = (int)__builtin_amdgcn_mbcnt_hi(~0u, __builtin_amdgcn_mbcnt_lo(~0u, 0u)), tid = wave * 64 + lane; const kargp_t ap_ = karg_ptr();
        ldsf* wrT = (ldsf*)lds;
        const float* w_r = args.in[I_WR];
#pragma unroll 4
        for (int it = 0; it < 64; ++it) { const int idx = tid + it * NTHR, col = idx >> 5, e = idx & 31; wrT[e * 1024 + col] = w_r[idx]; }
        LAS int* lcnt = (LAS int*)(lds + 131072);
        if (tid < 32) lcnt[tid] = 0;
        __syncthreads();
        const float* nw1 = args.in[I_NORMW] + 1024; const float* nw2 = args.in[I_NORMW] + 2048; const float* b_r = args.in[I_BR];
        typedef unsigned u32x2_t __attribute__((ext_vector_type(2)));
        u32x2_t ynx[4]; f32x4 xnx[4];
#pragma unroll
        for (int j = 0; j < 4; ++j) { ynx[j] = *((const u32x2_t*)(ybuf + (size_t)gw * D) + lane + 64 * j); xnx[j] = *((const f32x4*)(Xp + (size_t)gw * D) + lane + 64 * j); }
        for (int bb = 0; bb < BATCH; ++bb) {
        f32x4 g1v[4], a2v[4], sh2v[4];
#pragma unroll
        for (int j = 0; j < 4; ++j) { const int col = 4 * lane + 256 * j;
            const f32x4 n1 = *(const f32x4*)(nw1 + col), ga = *(const f32x4*)(MODp + bb * 6144 + 2048 + col), n2 = *(const f32x4*)(nw2 + col), sc = *(const f32x4*)(MODp + bb * 6144 + 4096 + col);
            sh2v[j] = *(const f32x4*)(MODp + bb * 6144 + 3072 + col);
#pragma unroll
            for (int e = 0; e < 4; ++e) { g1v[j][e] = ga[e] * n1[e]; a2v[j][e] = n2[e] * (1.0f + sc[e]); } }
        for (int r = gw + bb * (NTOK / BATCH); r < (bb + 1) * (NTOK / BATCH); r += NGW) {
            f32x4 v[4], xv4[4]; float ss = 0.f;
#pragma unroll
            for (int j = 0; j < 4; ++j) { v[j] = (f32x4){__uint_as_float(ynx[j].x << 16), __uint_as_float(ynx[j].x & 0xffff0000u), __uint_as_float(ynx[j].y << 16), __uint_as_float(ynx[j].y & 0xffff0000u)}; xv4[j] = xnx[j]; ss += (v[j].x * v[j].x + v[j].y * v[j].y) + (v[j].z * v[j].z + v[j].w * v[j].w); }
            __builtin_amdgcn_sched_barrier(0);
            if (r + NGW < NTOK) {
#pragma unroll
                for (int j = 0; j < 4; ++j) { ynx[j] = *((const u32x2_t*)(ybuf + (size_t)(r + NGW) * D) + lane + 64 * j); xnx[j] = *((const f32x4*)(Xp + (size_t)(r + NGW) * D) + lane + 64 * j); }
            }
            __builtin_amdgcn_sched_barrier(0);
            const float rstd1 = rsqrtf(wave_sum(ss) * (1.0f / D) + EPS);
            float ss2 = 0.f;
#pragma unroll
            for (int j = 0; j < 4; ++j) {
#pragma unroll
                for (int e = 0; e < 4; ++e) { v[j][e] = xv4[j][e] + g1v[j][e] * (v[j][e] * rstd1); ss2 += v[j][e] * v[j][e]; }
            }
            const float rstd2 = rsqrtf(wave_sum(ss2) * (1.0f / D) + EPS);
            f32x4 hv[4]; unsigned h8[4];
#pragma unroll
            for (int j = 0; j < 4; ++j) {
#pragma unroll
                for (int e = 0; e < 4; ++e) hv[j][e] = v[j][e] * rstd2 * a2v[j][e] + sh2v[j][e];
                h8[j] = pg8::pk4_fp8(hv[j][0], hv[j][1], hv[j][2], hv[j][3]);
            }
#pragma unroll
            for (int j = 0; j < 4; ++j) { const int col = 4 * lane + 256 * j; *(f32x4*)(OUTp + (size_t)r * D + col) = v[j]; *(unsigned*)((unsigned char*)hbuf + (size_t)r * D + col) = h8[j]; }
            float pe[32];
#pragma unroll
            for (int e = 0; e < 32; ++e) {
                float p = 0.f;
#pragma unroll
                for (int j = 0; j < 4; ++j) { const f32x4 w = *(const LAS f32x4*)(wrT + e * 1024 + 4 * lane + 256 * j); p += (hv[j][0] * w[0] + hv[j][1] * w[1]) + (hv[j][2] * w[2] + hv[j][3] * w[3]); }
                pe[e] = p;
                if ((e & 1) == 1) asm volatile("" ::: "memory");
            }
            float r16[16];
            { const bool up = lane >= 32;
#pragma unroll
              for (int e = 0; e < 16; ++e) { const float send = up ? pe[e] : pe[e + 16], keep = up ? pe[e + 16] : pe[e]; r16[e] = keep + xchg32(send, lane); } }
            float r8[8];
            { const bool up = (lane & 16) != 0;
#pragma unroll
              for (int e = 0; e < 8; ++e) { const float send = up ? r16[e] : r16[e + 8], keep = up ? r16[e + 8] : r16[e]; r8[e] = keep + xchg16(send, lane); } }
            float r4[4];
            { const bool up = (lane & 8) != 0;
#pragma unroll
              for (int e = 0; e < 4; ++e) { const float send = up ? r8[e] : r8[e + 4], keep = up ? r8[e + 4] : r8[e]; r4[e] = keep + dppx<0x128>(send); } }
            float r2[2];
            { const bool up = (lane & 4) != 0;
#pragma unroll
              for (int e = 0; e < 2; ++e) { const float send = up ? r4[e] : r4[e + 2], keep = up ? r4[e + 2] : r4[e]; r2[e] = keep + __shfl_xor(send, 4); } }
            float r1;
            { const bool up = (lane & 2) != 0; const float send = up ? r2[0] : r2[1], keep = up ? r2[1] : r2[0]; r1 = keep + dppx<0x4E>(send); }
            r1 += dppx<0xB1>(r1);
            const int eid = ((lane >> 5) << 4) | (((lane >> 4) & 1) << 3) | (((lane >> 3) & 1) << 2) | (((lane >> 2) & 1) << 1) | ((lane >> 1) & 1);
            float mylg = r1 + b_r[eid];
            int se[4]; float sv[4];
#pragma unroll
            for (int k = 0; k < 4; ++k) {
                const float bv = wave_max(mylg); const int bi = wave_min_i(mylg == bv ? eid : 99);
                se[k] = bi; sv[k] = bv;
                if (eid == bi) mylg = -3.0e38f;
            }
            const float e1 = __expf(sv[1] - sv[0]), e2 = __expf(sv[2] - sv[0]), e3 = __expf(sv[3] - sv[0]);
            const float inv = 1.0f / (1.0f + e1 + e2 + e3);
            if (lane < 4 && !(args.pad & 32)) {
                const int mye = lane == 0 ? se[0] : (lane == 1 ? se[1] : (lane == 2 ? se[2] : se[3]));
                const float myg = (lane == 0 ? 1.0f : (lane == 1 ? e1 : (lane == 2 ? e2 : e3))) * inv;
                const unsigned pos = atomicAdd((unsigned*)lcnt + mye, 1u);
                asg_e[r * 4 + lane] = mye; asg_p[r * 4 + lane] = (int)pos; asg_g[r * 4 + lane] = myg;
            }
        }
        }
        __syncthreads();
        if (tid < 32) ((int*)(ctl + CW_HIST))[vcu * 32 + tid] = lcnt[tid];
        if (BOTH(7)) GRID_BAR();
    }

    LAS int* pst = (LAS int*)(lds + MISC_OFF + 512);
    LAS int* tile_e = (LAS int*)(lds + MISC_OFF + 768);
    LAS int* wbase = (LAS int*)(lds + MISC_OFF + 384);
    if (hi > 8 && lo <= 10) {
        const kargp_t ap_ = karg_ptr();
        const int tix = wave * 64 + (int)__builtin_amdgcn_mbcnt_hi(~0u, __builtin_amdgcn_mbcnt_lo(~0u, 0u));
        {
            LAS int* tmp = (LAS int*)lds;
            const int e = tix & 31, part = tix >> 5; int tot = 0, bef = 0;
            const int* hist = (const int*)(ctl + CW_HIST);
            for (int bb = part; bb < G; bb += 16) { const int c = hist[bb * 32 + e]; tot += c; bef += (bb < vcu) ? c : 0; }
            tmp[part * 32 + e] = tot; tmp[512 + part * 32 + e] = bef;
            __syncthreads();
            if (tix < 32) { int t2 = 0, b2 = 0;
#pragma unroll
                for (int p = 0; p < 16; ++p) { t2 += tmp[p * 32 + tix]; b2 += tmp[512 + p * 32 + tix]; }
                tmp[1024 + tix] = t2; wbase[tix] = b2; ((LAS int*)(lds + MISC_OFF + 1920))[tix] = t2; }
            __syncthreads();
            if (tix == 0) { int run = 0, rt = 0;
                for (int e2 = 0; e2 < NE; ++e2) { pst[e2] = run; const int c = tmp[1024 + e2]; const int nt = (c + 255) >> 8; for (int t2 = 0; t2 < nt; ++t2) tile_e[rt++] = e2; run += nt * 256; }
                pst[32] = run; }
        }
        __syncthreads();
    }
    const int nslots = (hi > 8 && lo <= 10) ? pst[32] : 0;

    if (IN(8)) {
        const int lane = (int)__builtin_amdgcn_mbcnt_hi(~0u, __builtin_amdgcn_mbcnt_lo(~0u, 0u)), tid = wave * 64 + lane; const kargp_t ap_ = karg_ptr();
        {
            int* stok = (int*)(P_WS + WS_STOK);
            for (int r = gw; r < NTOK; r += NGW) {
                if (lane < 4) { const int a = r * 4 + lane; const int e = asg_e[a], pos = asg_p[a]; const int slot = pst[e] + wbase[e] + pos; asg_s[a] = slot; stok[slot] = r; }
            }
            if (bx < NE) {
                const int c = ((LAS int*)(lds + MISC_OFF + 1920))[bx], pad = (c + 255) & ~255;
                for (int s2 = c + tid; s2 < pad; s2 += NTHR) stok[pst[bx] + s2] = 0;
            }
        }
        if (BOTH(8)) GRID_BAR();
    }

    if (IN(9)) {
        const int lane = (int)__builtin_amdgcn_mbcnt_hi(~0u, __builtin_amdgcn_mbcnt_lo(~0u, 0u)), tid = wave * 64 + lane; const kargp_t ap_ = karg_ptr();
        pg8::Gemm g{hbuf, WupT, nslots, 2048, D}; pg8::MoeOrder S; S.init(nslots, 2048, G, bx); S.tile_e = tile_e; S.estride = (size_t)2048 * D; S.rowidx = (const int*)(P_WS + WS_STOK);
        pg8::EpiSwiGLU E{(unsigned char*)actb, args.in[I_BUP], tile_e, 1.0f / 32.0f};
        pg8::gemm_phase<pg8::EpiSwiGLU, pg8::MoeOrder, true, true, true, true>(lds, g, S, E, tid);
        if (BOTH(9)) GRID_BAR();
    }

    if (IN(10)) {
        const int lane = (int)__builtin_amdgcn_mbcnt_hi(~0u, __builtin_amdgcn_mbcnt_lo(~0u, 0u)), tid = wave * 64 + lane; const kargp_t ap_ = karg_ptr();
        pg8::Gemm g{actb, WdnT, nslots, D, D}; pg8::MoeOrder S; S.init(nslots, D, G, bx); S.tile_e = tile_e; S.estride = (size_t)D * D;
        pg8::EpiBf16 E{yslot, D, args.in[I_BDN], tile_e, D, 1.0f / 32.0f};
        pg8::gemm_phase<pg8::EpiBf16, pg8::MoeOrder, true, true, true>(lds, g, S, E, tid);
        if (BOTH(10)) GRID_BAR();
    }

    if (IN(11)) {
        const int lane = (int)__builtin_amdgcn_mbcnt_hi(~0u, __builtin_amdgcn_mbcnt_lo(~0u, 0u)), tid = wave * 64 + lane; const kargp_t ap_ = karg_ptr();
        const float* nw3 = args.in[I_NORMW] + 3072;
        int sln[4]; float gtn[4];
#pragma unroll
        for (int k = 0; k < 4; ++k) { sln[k] = asg_s[gw * 4 + k]; gtn[k] = asg_g[gw * 4 + k]; }
        v2u ywn[4][4]; f32x4 xon[4]; float gtc[4];
#pragma unroll
        for (int k = 0; k < 4; ++k) { gtc[k] = gtn[k];
#pragma unroll
            for (int j = 0; j < 4; ++j) ywn[k][j] = *(const v2u*)(yslot + (size_t)sln[k] * D + 4 * lane + 256 * j); }
#pragma unroll
        for (int j = 0; j < 4; ++j) xon[j] = *(const f32x4*)(OUTp + (size_t)gw * D + 4 * lane + 256 * j);
        if (gw + NGW < NTOK) {
#pragma unroll
            for (int k = 0; k < 4; ++k) { sln[k] = asg_s[(gw + NGW) * 4 + k]; gtn[k] = asg_g[(gw + NGW) * 4 + k]; }
        }
        for (int bb = 0; bb < BATCH; ++bb) {
        f32x4 g3v[4];
#pragma unroll
        for (int j = 0; j < 4; ++j) { const int col = 4 * lane + 256 * j; const f32x4 n3 = *(const f32x4*)(nw3 + col), ga = *(const f32x4*)(MODp + bb * 6144 + 5120 + col);
#pragma unroll
            for (int e = 0; e < 4; ++e) g3v[j][e] = ga[e] * n3[e]; }
        for (int r = gw + bb * (NTOK / BATCH); r < (bb + 1) * (NTOK / BATCH); r += NGW) {
            v2u yw[4][4]; f32x4 xo[4]; float gt[4];
#pragma unroll
            for (int k = 0; k < 4; ++k) { gt[k] = gtc[k];
#pragma unroll
                for (int j = 0; j < 4; ++j) yw[k][j] = ywn[k][j]; }
#pragma unroll
            for (int j = 0; j < 4; ++j) xo[j] = xon[j];
            __builtin_amdgcn_sched_barrier(0);
            if (r + NGW < NTOK) {
#pragma unroll
                for (int k = 0; k < 4; ++k) { gtc[k] = gtn[k];
#pragma unroll
                    for (int j = 0; j < 4; ++j) ywn[k][j] = *(const v2u*)(yslot + (size_t)sln[k] * D + 4 * lane + 256 * j); }
#pragma unroll
                for (int j = 0; j < 4; ++j) xon[j] = *(const f32x4*)(OUTp + (size_t)(r + NGW) * D + 4 * lane + 256 * j);
                if (r + 2 * NGW < NTOK) {
#pragma unroll
                    for (int k = 0; k < 4; ++k) { sln[k] = asg_s[(r + 2 * NGW) * 4 + k]; gtn[k] = asg_g[(r + 2 * NGW) * 4 + k]; }
                }
            }
            __builtin_amdgcn_sched_barrier(0);
            f32x4 acc[4];
#pragma unroll
            for (int j = 0; j < 4; ++j) { acc[j] = (f32x4){0.f, 0.f, 0.f, 0.f};
#pragma unroll
                for (int k = 0; k < 4; ++k) { acc[j][0] += gt[k] * bflo(yw[k][j].x); acc[j][1] += gt[k] * bfhi(yw[k][j].x); acc[j][2] += gt[k] * bflo(yw[k][j].y); acc[j][3] += gt[k] * bfhi(yw[k][j].y); } }
            float ss = 0.f;
#pragma unroll
            for (int j = 0; j < 4; ++j) ss += (acc[j][0] * acc[j][0] + acc[j][1] * acc[j][1]) + (acc[j][2] * acc[j][2] + acc[j][3] * acc[j][3]);
            const float rstd = rsqrtf(wave_sum(ss) * (1.0f / D) + EPS);
#pragma unroll
            for (int j = 0; j < 4; ++j) {
                const int col = 4 * lane + 256 * j;
                f32x4 xv = xo[j];
#pragma unroll
                for (int e = 0; e < 4; ++e) xv[e] += g3v[j][e] * (acc[j][e] * rstd);
                if (!(args.pad & 32)) *(f32x4*)(OUTp + (size_t)r * D + col) = xv;
            }
        }
        }
    }
#undef IN
#undef BOTH
}

#undef P_WS
#undef ctl
#undef Xp
#undef OUTp
#undef MODp
#undef gbuf
#undef betabuf
#undef glbuf
#undef asg_e
#undef asg_p
#undef asg_g
#undef asg_s
#undef WinT
#undef WoutT
#undef WupT
#undef WdnT
#undef hbuf
#undef projb
#undef Ub
#undef opsb
#undef zsb
#undef qfb
#undef kfb
#undef vtfb
#undef omix
#undef ybuf
#undef xg
#undef actb
#undef yslot
#undef args
constexpr int NPHASES = 12;

extern "C" void kernel_launch(void* const* d_in, const int* in_sizes, int n_in, void* d_out, int out_size, void* d_ws, size_t ws_size, hipStream_t stream) {
    static int grid = 0;
    if (grid == 0) {
        if (n_in != 18 || out_size != NTOK * D || ws_size < WS_END) { fprintf(stderr, "kernel_launch: unexpected shapes (n_in %d out %d ws %zu)\n", n_in, out_size, ws_size); grid = -1; return; }
        int dev = 0, cus = 0, per_cu = 0;
        if (hipGetDevice(&dev) != hipSuccess || hipDeviceGetAttribute(&cus, hipDeviceAttributeMultiprocessorCount, dev) != hipSuccess) { grid = -1; return; }
        if (hipFuncSetAttribute((const void*)mk_fwd, hipFuncAttributeMaxDynamicSharedMemorySize, LDS_BYTES) != hipSuccess) { fprintf(stderr, "kernel_launch: hipFuncSetAttribute failed\n"); grid = -1; return; }
        if (hipOccupancyMaxActiveBlocksPerMultiprocessor(&per_cu, (const void*)mk_fwd, NTHR, LDS_BYTES) != hipSuccess || per_cu < 1) { fprintf(stderr, "kernel_launch: occupancy query says %d blocks per CU\n", per_cu); grid = -1; return; }
        (void)hipGetLastError();
        grid = cus;
    }
    if (grid < 0) return;
    (void)hipMemsetAsync((char*)d_ws + WS_CTL, 0, CTL_ZERO_BYTES, stream);
    Args a{};
    for (int i = 0; i < 18; ++i) a.in[i] = (const float*)d_in[i];
    a.out = (float*)d_out; a.ws = (unsigned char*)d_ws;
#if MK_ONE_LAUNCH
#ifndef PROBE_PHASE
#define PROBE_PHASE -1
#endif
#ifndef PROBE_SUB
#define PROBE_SUB 0
#endif
    if (PROBE_PHASE >= 0) {
        const int k = PROBE_PHASE;
        a.ph_lo = 0; a.ph_hi = k + 1; a.li = 0; hipLaunchKernelGGL(mk_fwd, dim3(grid), dim3(NTHR), LDS_BYTES, stream, a);
        a.ph_lo = k; a.ph_hi = k + 1; a.li = 1; a.pad = (k == 7 || k == 11) ? 32 : PROBE_SUB; hipLaunchKernelGGL(mk_fwd, dim3(grid), dim3(NTHR), LDS_BYTES, stream, a); a.pad = 0;
        if (k + 1 < NPHASES) { a.ph_lo = k + 1; a.ph_hi = NPHASES; a.li = 2; hipLaunchKernelGGL(mk_fwd, dim3(grid), dim3(NTHR), LDS_BYTES, stream, a); }
        return;
    }
    a.ph_lo = 0; a.ph_hi = NPHASES; a.li = 0;
    hipLaunchKernelGGL(mk_fwd, dim3(grid), dim3(NTHR), LDS_BYTES, stream, a);
#else
    for (int p = 0; p < NPHASES; ++p) { a.ph_lo = p; a.ph_hi = p + 1; a.li = p; hipLaunchKernelGGL(mk_fwd, dim3(grid), dim3(NTHR), LDS_BYTES, stream, a); }
#endif
}
```

```cpp
#include <hip/hip_runtime.h>
#include <cstdio>
#include <cstdint>

#ifndef MK_ONE_LAUNCH
#define MK_ONE_LAUNCH 1
#endif

namespace pg8 {
#define PG8_LAS __attribute__((address_space(3)))
typedef unsigned short bf16_t;
typedef short bf16x8 __attribute__((ext_vector_type(8)));
typedef float f32x4 __attribute__((ext_vector_type(4)));
typedef unsigned u32x4 __attribute__((ext_vector_type(4)));
constexpr int BM = 256, BK = 64, HALF = 128, HTB = HALF * BK * 2, STAGE_BYTES = 8 * HTB, NXCD = 8, WGM = 8;

__host__ __device__ __forceinline__ int lds_byte(int r, int c) { const int st = (r >> 4) * 2 + (c >> 5), rr = r & 15, cc = c & 31, ob = rr * 64 + cc * 2; return st * 1024 + (ob ^ (((ob >> 9) & 1) << 5)); }
__host__ __device__ __forceinline__ void stage_rc(int b, int& R, int& C) { const int st = b / 1024, sb = b % 1024, swz = sb ^ (((sb >> 9) & 1) << 5); R = (st >> 1) * 16 + swz / 64; C = (st & 1) * 32 + (swz % 64) / 2; }
__host__ __device__ __forceinline__ int perm32(int rho) { const int n = rho >> 4, i = rho & 15; return 8 * (i >> 2) + 4 * n + (i & 3); }

struct Unit { int pm, pn; };
struct Gemm { const bf16_t* A; const bf16_t* Bt; int M, N, K; };

struct StaticOrder {
    int nM, nN, nwg, G, c;
    __host__ __device__ void init(int M, int N, int G_, int c_) { nM = M / BM; nN = N / BM; nwg = nM * nN; G = G_; c = c_; }
    __host__ __device__ bool next(int i, Unit& u) const {
        const long L = (long)i * G + c; if (L >= nwg) return false;
        int wgid = (int)L; { const int q = nwg / NXCD, r = nwg % NXCD, xcd = wgid % NXCD, off = wgid / NXCD; wgid = (xcd < r ? xcd * (q + 1) : r * (q + 1) + (xcd - r) * q) + off; }
        const int nig = WGM * nN, gid = wgid / nig, fm = gid * WGM, gsz = (nM - fm) < WGM ? (nM - fm) : WGM;
        u.pm = fm + ((wgid % nig) % gsz); u.pn = (wgid % nig) / gsz; return true;
    }
    __device__ __forceinline__ size_t boff(const Unit&) const { return 0; }
    const int* rowidx = nullptr;
};
struct MoeOrder : StaticOrder {
    const PG8_LAS int* tile_e; size_t estride;
    __device__ __forceinline__ size_t boff(const Unit& u) const { return (size_t)tile_e[u.pm] * estride; }
};

typedef int v8i_t __attribute__((ext_vector_type(8)));
typedef int v4i_t __attribute__((ext_vector_type(4)));
__device__ __forceinline__ v8i_t cat8(bf16x8 lo, bf16x8 hi) { const v4i_t a = __builtin_bit_cast(v4i_t, lo), b = __builtin_bit_cast(v4i_t, hi); return __builtin_shufflevector(a, b, 0, 1, 2, 3, 4, 5, 6, 7); }
__device__ __forceinline__ unsigned pk4_fp8(float a, float b, float c, float d) {
    a = fminf(fmaxf(a, -448.f), 448.f); b = fminf(fmaxf(b, -448.f), 448.f); c = fminf(fmaxf(c, -448.f), 448.f); d = fminf(fmaxf(d, -448.f), 448.f);
    int w = 0; w = __builtin_amdgcn_cvt_pk_fp8_f32(a, b, w, false); w = __builtin_amdgcn_cvt_pk_fp8_f32(c, d, w, true); return (unsigned)w; }
__device__ __forceinline__ unsigned cvt_pk_bf16(float lo, float hi) { unsigned r; asm volatile("v_cvt_pk_bf16_f32 %0, %1, %2" : "=v"(r) : "v"(lo), "v"(hi)); return r; }

struct EpiF32 {
    static constexpr bool PERM = false;
    float* C; int ldc;
    __device__ __forceinline__ void operator()(const f32x4 (&acc)[2][2][4][2], const Unit& u, int wr, int wc, int fr, int fq) const {
        const int row0 = u.pm * BM + wr * 64 + fr, col0 = u.pn * BM + wc * 32 + 4 * fq;
#pragma unroll
        for (int ai = 0; ai < 2; ++ai)
#pragma unroll
            for (int m = 0; m < 4; ++m) { float* rowp = C + (size_t)(row0 + ai * HALF + m * 16) * ldc + col0;
#pragma unroll
                for (int bj = 0; bj < 2; ++bj)
#pragma unroll
                    for (int n = 0; n < 2; ++n) *(f32x4*)(rowp + bj * HALF + n * 16) = acc[ai][bj][m][n]; }
    }
};
struct EpiBf16 {
    static constexpr bool PERM = true;
    bf16_t* O; int ldc; const float* bias; const PG8_LAS int* tile_e; int bstride; float scale;
    __device__ __forceinline__ void operator()(const f32x4 (&acc)[2][2][4][2], const Unit& u, int wr, int wc, int fr, int fq) const {
        const int row0 = u.pm * BM + wr * 64 + fr; const int col0 = u.pn * BM + wc * 32 + 8 * fq;
        f32x4 bv[2][2];
        const float* bp = bias ? bias + (size_t)tile_e[u.pm] * bstride + col0 : nullptr;
#pragma unroll
        for (int bj = 0; bj < 2; ++bj)
#pragma unroll
            for (int n = 0; n < 2; ++n) bv[bj][n] = bias ? *(const f32x4*)(bp + bj * HALF + 4 * n) : (f32x4){0.f, 0.f, 0.f, 0.f};
#pragma unroll
        for (int ai = 0; ai < 2; ++ai)
#pragma unroll
            for (int m = 0; m < 4; ++m) { bf16_t* rowp = O + (size_t)(row0 + ai * HALF + m * 16) * ldc + col0;
#pragma unroll
                for (int bj = 0; bj < 2; ++bj) { f32x4 v0 = acc[ai][bj][m][0] * scale + bv[bj][0], v1 = acc[ai][bj][m][1] * scale + bv[bj][1];
                    u32x4 w; w.x = cvt_pk_bf16(v0[0], v0[1]); w.y = cvt_pk_bf16(v0[2], v0[3]); w.z = cvt_pk_bf16(v1[0], v1[1]); w.w = cvt_pk_bf16(v1[2], v1[3]);
                    *(u32x4*)(rowp + bj * HALF) = w; } }
    }
};
struct EpiSwiGLU {
    static constexpr bool PERM = true;
    unsigned char* O; const float* b_up; const PG8_LAS int* tile_e; float scale;
    __device__ __forceinline__ float act1(float g, float l) const {
        g = fminf(g, 7.0f); l = fminf(fmaxf(l, -7.0f), 7.0f);
        const float s = __builtin_amdgcn_rcpf(1.0f + __expf(-1.702f * g));
        return g * s * (l + 1.0f);
    }
    __device__ __forceinline__ void operator()(const f32x4 (&acc)[2][2][4][2], const Unit& u, int wr, int wc, int fr, int fq) const {
        const int row0 = u.pm * BM + wr * 64 + fr; const int cin = wc * 32 + 8 * fq;
        const float* bg = b_up + (size_t)tile_e[u.pm] * 2048 + 128 * u.pn + cin;
        f32x4 bgv[2], blv[2];
#pragma unroll
        for (int n = 0; n < 2; ++n) { bgv[n] = *(const f32x4*)(bg + 4 * n); blv[n] = *(const f32x4*)(bg + 1024 + 4 * n); }
#pragma unroll
        for (int ai = 0; ai < 2; ++ai)
#pragma unroll
            for (int m = 0; m < 4; ++m) { unsigned char* rowp = O + (size_t)(row0 + ai * HALF + m * 16) * 1024 + 128 * u.pn + cin;
                const f32x4 g0 = acc[ai][0][m][0] * scale + bgv[0], g1 = acc[ai][0][m][1] * scale + bgv[1], l0 = acc[ai][1][m][0] * scale + blv[0], l1 = acc[ai][1][m][1] * scale + blv[1];
                unsigned w0 = pk4_fp8(act1(g0[0], l0[0]), act1(g0[1], l0[1]), act1(g0[2], l0[2]), act1(g0[3], l0[3]));
                unsigned w1 = pk4_fp8(act1(g1[0], l1[0]), act1(g1[1], l1[1]), act1(g1[2], l1[2]), act1(g1[3], l1[3]));
                typedef unsigned u32x2_t __attribute__((ext_vector_type(2)));
                *(u32x2_t*)rowp = (u32x2_t){w0, w1}; }
    }
};

template <class Epi, class Sched, bool ALIGN_EPI = false, bool SP2 = false, bool F8 = false, bool GATHER = false>
__device__ __forceinline__ void gemm_phase(PG8_LAS unsigned char* lds, const Gemm g, const Sched& S, const Epi& E, const int tid) {
    const int wid = __builtin_amdgcn_readfirstlane(tid >> 6), lane = tid & 63, wr = wid >> 2, wc = wid & 3, fr = lane & 15, fq = lane >> 4;
    constexpr int ES = F8 ? 1 : 2;
    const int K = g.K, nt = K * ES / 128;
    unsigned voffA[2], voffB[2]; int gR[2], gC[2];
#pragma unroll
    for (int i = 0; i < 2; ++i) { int R, C; stage_rc(tid * 16 + i * 8192, R, C); const int Rb = Epi::PERM ? ((R & ~31) + perm32(R & 31)) : R; gR[i] = R; gC[i] = C * 2;
        voffA[i] = (unsigned)(R * K * ES + C * 2); voffB[i] = (unsigned)(Rb * K * ES + C * 2); }
    unsigned vAc0[2] = {0u, 0u}, vAc1[2] = {0u, 0u}, vAn0[2] = {0u, 0u}, vAn1[2] = {0u, 0u};
#define PG8_GIDX(dst0, dst1, u_) do { _Pragma("unroll") for (int _i = 0; _i < 2; ++_i) { \
        dst0[_i] = (unsigned)S.rowidx[(u_).pm * BM + gR[_i]] * (unsigned)(K * ES) + (unsigned)gC[_i]; dst1[_i] = (unsigned)S.rowidx[(u_).pm * BM + HALF + gR[_i]] * (unsigned)(K * ES) + (unsigned)gC[_i]; } } while (0)
    const size_t kstep = (size_t)(BK * 2);
    const size_t hstep = (size_t)HALF * K * ES;
    const size_t tstep = 2 * hstep;
    const unsigned ldsw = (unsigned)wid * 1024u;
    const int aoff = lds_byte(wr * 64 + fr, fq * 8), boff = lds_byte(wc * 32 + fr, fq * 8);
#define PG8_SA(b, h) (((b) * 2 + (h)) * HTB)
#define PG8_SB(b, h) ((4 + (b) * 2 + (h)) * HTB)
#define PG8_STAGE(bufoff, gbase, voff) do { _Pragma("unroll") for (int _i = 0; _i < 2; ++_i) \
        __builtin_amdgcn_global_load_lds((const unsigned*)((const char*)(gbase) + (voff)[_i]), (PG8_LAS unsigned*)(lds + (bufoff) + ldsw + _i * 8192), 16, 0, 0); } while (0)
#define PG8_STAGE_A(bufoff, ptr_, half_, koff_, nxt_) do { if constexpr (GATHER) { _Pragma("unroll") for (int _i = 0; _i < 2; ++_i) { \
            const unsigned vo_ = (half_) ? ((nxt_) ? vAn1[_i] : vAc1[_i]) : ((nxt_) ? vAn0[_i] : vAc0[_i]); \
            __builtin_amdgcn_global_load_lds((const unsigned*)((const char*)g.A + (koff_) + vo_), (PG8_LAS unsigned*)(lds + (bufoff) + ldsw + _i * 8192), 16, 0, 0); } } \
        else PG8_STAGE(bufoff, ptr_, voffA); } while (0)
#define PG8_LDA(dst, b, h) do { _Pragma("unroll") for (int m = 0; m < 4; ++m) _Pragma("unroll") for (int k = 0; k < 2; ++k) dst[m][k] = *(const PG8_LAS bf16x8*)(lds + PG8_SA(b, h) + aoff + m * 2048 + k * 1024); } while (0)
#define PG8_LDB(dst, b, h) do { _Pragma("unroll") for (int n = 0; n < 2; ++n) _Pragma("unroll") for (int k = 0; k < 2; ++k) dst[n][k] = *(const PG8_LAS bf16x8*)(lds + PG8_SB(b, h) + boff + n * 2048 + k * 1024); } while (0)
#define PG8_MMA(ai, bj, At, Bt) do { __builtin_amdgcn_s_setprio(1); _Pragma("unroll") for (int m = 0; m < 4; ++m) _Pragma("unroll") for (int n = 0; n < 2; ++n) { \
        if constexpr (F8) { asm volatile("v_mfma_scale_f32_16x16x128_f8f6f4 %0, %1, %2, %0, %3, %3 op_sel_hi:[0,0,0]" : "+v"(acc[ai][bj][m][n]) : "v"(cat8(Bt[n][0], Bt[n][1])), "v"(cat8(At[m][0], At[m][1])), "v"(0x7f7f7f7f)); } \
        else { _Pragma("unroll") for (int k = 0; k < 2; ++k) acc[ai][bj][m][n] = __builtin_amdgcn_mfma_f32_16x16x32_bf16(Bt[n][k], At[m][k], acc[ai][bj][m][n], 0, 0, 0); } } \
        __builtin_amdgcn_s_setprio(0); } while (0)
#define PG8_WAIT_V(n) asm volatile("s_waitcnt vmcnt(" #n ")" ::: "memory")
#define PG8_WAIT_L(n) asm volatile("s_waitcnt lgkmcnt(" #n ")" ::: "memory")
#define PG8_BAR __builtin_amdgcn_s_barrier()
#define PG8_SCHED __builtin_amdgcn_sched_barrier(0)
    Unit cur, nxt; int ui = 0;
    if (!S.next(0, cur)) return;
    f32x4 acc[2][2][4][2];
#pragma unroll
    for (int a = 0; a < 2; ++a)
#pragma unroll
        for (int b = 0; b < 2; ++b)
#pragma unroll
            for (int m = 0; m < 4; ++m)
#pragma unroll
                for (int n = 0; n < 2; ++n) acc[a][b][m][n] = (f32x4){0.f, 0.f, 0.f, 0.f};
    bf16x8 At[4][2], B0[2][2], B1[2][2];
    const char* cA = (const char*)g.A + (size_t)cur.pm * tstep; const char* cB = (const char*)g.Bt + S.boff(cur) + (size_t)cur.pn * tstep;
    if constexpr (GATHER) { PG8_GIDX(vAc0, vAc1, cur); }
    if constexpr (SP2) {
        PG8_STAGE(PG8_SB(0, 0), cB, voffB); PG8_STAGE(PG8_SB(0, 1), cB + hstep, voffB); PG8_STAGE_A(PG8_SA(0, 0), cA, 0, 0, false); PG8_STAGE_A(PG8_SA(0, 1), cA + hstep, 1, 0, false);
        if (wr == 1) PG8_BAR;
        PG8_WAIT_V(2); PG8_BAR;
        PG8_STAGE(PG8_SB(1, 0), cB + kstep, voffB); PG8_STAGE_A(PG8_SA(1, 0), cA + kstep, 0, kstep, false); PG8_STAGE(PG8_SB(1, 1), cB + hstep + kstep, voffB);
        PG8_WAIT_V(6); PG8_BAR;
    } else {
        PG8_STAGE(PG8_SB(0, 0), cB, voffB); PG8_STAGE(PG8_SA(0, 0), cA, voffA); PG8_STAGE(PG8_SB(0, 1), cB + hstep, voffB); PG8_STAGE(PG8_SA(0, 1), cA + hstep, voffA);
        if (wr == 1) PG8_BAR;
        PG8_WAIT_V(4); PG8_BAR;
        PG8_STAGE(PG8_SB(1, 0), cB + kstep, voffB); PG8_STAGE(PG8_SA(1, 0), cA + kstep, voffA); PG8_STAGE(PG8_SB(1, 1), cB + hstep + kstep, voffB);
        PG8_WAIT_V(6); PG8_BAR;
    }
    for (;;) {
        const bool has_next = S.next(ui + 1, nxt);
        const char* nA = has_next ? (const char*)g.A + (size_t)nxt.pm * tstep : cA; const char* nB = has_next ? (const char*)g.Bt + S.boff(nxt) + (size_t)nxt.pn * tstep : cB;
        if constexpr (GATHER) {
            if (has_next) { if (wid == 0) __builtin_amdgcn_global_load_lds((const unsigned*)(S.rowidx + (size_t)nxt.pm * BM + lane * 4), (PG8_LAS unsigned*)(lds + 131072 + ((ui + 1) & 1) * 1024), 16, 0, 0); }
            else { vAn0[0] = vAc0[0]; vAn0[1] = vAc0[1]; vAn1[0] = vAc1[0]; vAn1[1] = vAc1[1]; } }
        for (int t = 0; t < nt; t += 2) {
            const bool last = (t == nt - 2);
            const char* a1 = cA + (size_t)(t + 1) * kstep;
            const char* a2 = last ? nA : cA + (size_t)(t + 2) * kstep; const char* b2 = last ? nB : cB + (size_t)(t + 2) * kstep;
            const char* a3 = a2 + kstep; const char* b3 = b2 + kstep;
            const size_t ko1 = (size_t)(t + 1) * kstep, ko2 = last ? 0 : (size_t)(t + 2) * kstep, ko3 = ko2 + kstep;
            if constexpr (GATHER) { if (last && has_next) { const PG8_LAS int* ix_ = (const PG8_LAS int*)(lds + 131072 + ((ui + 1) & 1) * 1024);
#pragma unroll
                for (int _i = 0; _i < 2; ++_i) { vAn0[_i] = (unsigned)ix_[gR[_i]] * (unsigned)(K * ES) + (unsigned)gC[_i]; vAn1[_i] = (unsigned)ix_[HALF + gR[_i]] * (unsigned)(K * ES) + (unsigned)gC[_i]; } } }
            if constexpr (SP2) {
            PG8_LDB(B0, 0, 0); PG8_LDB(B1, 0, 1); PG8_SCHED; PG8_LDA(At, 0, 0); PG8_STAGE_A(PG8_SA(1, 1), a1 + hstep, 1, ko1, false);
            PG8_WAIT_V(8); PG8_WAIT_L(0); PG8_BAR; PG8_MMA(0, 0, At, B0); PG8_MMA(0, 1, At, B1); PG8_BAR; PG8_SCHED;
            PG8_LDA(At, 0, 1); PG8_STAGE(PG8_SB(0, 0), b2, voffB); PG8_STAGE(PG8_SB(0, 1), b2 + hstep, voffB); PG8_STAGE_A(PG8_SA(0, 0), a2, 0, ko2, last);
            PG8_WAIT_V(8); PG8_WAIT_L(0); PG8_BAR; PG8_MMA(1, 0, At, B0); PG8_MMA(1, 1, At, B1); PG8_BAR; PG8_SCHED;
            PG8_LDB(B0, 1, 0); PG8_LDB(B1, 1, 1); PG8_SCHED; PG8_LDA(At, 1, 0); PG8_STAGE_A(PG8_SA(0, 1), a2 + hstep, 1, ko2, last);
            PG8_WAIT_V(8); PG8_WAIT_L(0); PG8_BAR; PG8_MMA(0, 0, At, B0); PG8_MMA(0, 1, At, B1); PG8_BAR; PG8_SCHED;
            PG8_LDA(At, 1, 1); PG8_STAGE(PG8_SB(1, 0), b3, voffB); PG8_STAGE(PG8_SB(1, 1), b3 + hstep, voffB); PG8_STAGE_A(PG8_SA(1, 0), a3, 0, ko3, last);
            PG8_WAIT_V(8); PG8_WAIT_L(0); PG8_BAR; PG8_MMA(1, 0, At, B0); PG8_MMA(1, 1, At, B1); PG8_BAR; PG8_SCHED;
            } else {
            PG8_LDB(B0, 0, 0); PG8_SCHED; PG8_LDA(At, 0, 0); PG8_STAGE(PG8_SA(1, 1), a1 + hstep, voffA);
            PG8_WAIT_L(8); PG8_BAR; PG8_WAIT_L(0); PG8_MMA(0, 0, At, B0); PG8_BAR; PG8_SCHED;
            PG8_LDB(B1, 0, 1); PG8_STAGE(PG8_SB(0, 0), b2, voffB);
            PG8_BAR; PG8_WAIT_L(0); PG8_MMA(0, 1, At, B1); PG8_BAR;
            PG8_LDA(At, 0, 1); PG8_STAGE(PG8_SA(0, 0), a2, voffA);
            PG8_BAR; PG8_WAIT_L(0); PG8_MMA(1, 0, At, B0); PG8_BAR; PG8_SCHED;
            PG8_STAGE(PG8_SB(0, 1), b2 + hstep, voffB);
            PG8_WAIT_V(6); PG8_BAR; PG8_MMA(1, 1, At, B1); PG8_BAR;
            PG8_LDB(B0, 1, 0); PG8_SCHED; PG8_LDA(At, 1, 0); PG8_STAGE(PG8_SA(0, 1), a2 + hstep, voffA);
            PG8_WAIT_L(8); PG8_BAR; PG8_WAIT_L(0); PG8_MMA(0, 0, At, B0); PG8_BAR; PG8_SCHED;
            PG8_LDB(B1, 1, 1); PG8_STAGE(PG8_SB(1, 0), b3, voffB);
            PG8_BAR; PG8_WAIT_L(0); PG8_MMA(0, 1, At, B1); PG8_BAR;
            PG8_LDA(At, 1, 1); PG8_STAGE(PG8_SA(1, 0), a3, voffA);
            PG8_BAR; PG8_WAIT_L(0); PG8_MMA(1, 0, At, B0); PG8_BAR; PG8_SCHED;
            PG8_STAGE(PG8_SB(1, 1), b3 + hstep, voffB);
            PG8_WAIT_V(6); PG8_BAR; PG8_MMA(1, 1, At, B1); PG8_BAR;
            }
        }
        if constexpr (ALIGN_EPI) { if (wr == 0) PG8_BAR; }
        E(acc, cur, wr, wc, fr, fq);
        if (!has_next) break;
#pragma unroll
        for (int a = 0; a < 2; ++a)
#pragma unroll
            for (int b = 0; b < 2; ++b)
#pragma unroll
                for (int m = 0; m < 4; ++m)
#pragma unroll
                    for (int n = 0; n < 2; ++n) acc[a][b][m][n] = (f32x4){0.f, 0.f, 0.f, 0.f};
        cur = nxt; cA = nA; cB = nB; ++ui;
        if constexpr (GATHER) { vAc0[0] = vAn0[0]; vAc0[1] = vAn0[1]; vAc1[0] = vAn1[0]; vAc1[1] = vAn1[1]; }
        if constexpr (ALIGN_EPI) { if (wr == 1) PG8_BAR; }
    }
    PG8_WAIT_V(0);
    if constexpr (!ALIGN_EPI) { if (wr == 0) PG8_BAR; }
    PG8_BAR;
#undef PG8_SA
#undef PG8_SB
#undef PG8_STAGE
#undef PG8_LDA
#undef PG8_STAGE_A
#undef PG8_GIDX
#undef PG8_LDB
#undef PG8_MMA
#undef PG8_WAIT_V
#undef PG8_WAIT_L
#undef PG8_BAR
#undef PG8_SCHED
}
}

constexpr int NWAVES = 8, NTHR = 512;
constexpr int BATCH = 2, T = 8192, D = 1024, NTOK = BATCH * T;
constexpr int IN_COLS = 3592, PCOLS = 3584;
constexpr int NE = 32, NASSIGN = NTOK * 4, MAXTILES = NASSIGN / 256 + NE;
constexpr float EPS = 1e-6f;

constexpr size_t MiB = 1u << 20;
constexpr size_t WS_CTL = 0, CTL_ZERO_BYTES = 1 * MiB;
constexpr size_t WS_MOD = 1 * MiB;
constexpr size_t WS_G = WS_MOD + 64 * 1024;
constexpr size_t WS_BETA = WS_G + 256 * 1024;
constexpr size_t WS_GL = WS_BETA + 256 * 1024;
constexpr size_t WS_AE = WS_GL + 64 * 1024;
constexpr size_t WS_AP = WS_AE + 256 * 1024;
constexpr size_t WS_AG = WS_AP + 256 * 1024;
constexpr size_t WS_AS = WS_AG + 256 * 1024;
constexpr size_t WS_WG = WS_AS + 256 * 1024;
constexpr size_t WS_STOK = WS_WG + 64 * 1024;
constexpr size_t WS_WR = 4 * MiB;
constexpr size_t WS_WIN = 8 * MiB;
constexpr size_t WS_WOUT = 16 * MiB;
constexpr size_t WS_WUP = 20 * MiB;
constexpr size_t WS_WDN = 148 * MiB;
constexpr size_t WS_H = 212 * MiB;
constexpr size_t WS_PROJ = 244 * MiB;
constexpr size_t WS_U = 356 * MiB;
constexpr size_t WS_OPS = 388 * MiB;
constexpr int OPS_BYTES = 57344;
constexpr size_t WS_QF = 444 * MiB, WS_KF = 460 * MiB, WS_VTF = 476 * MiB;
constexpr size_t WS_OSCAN = 500 * MiB;
constexpr size_t WS_OMIX = 532 * MiB;
constexpr size_t WS_Y = 564 * MiB;
constexpr size_t WS_XG = 244 * MiB;
constexpr size_t WS_ACT = 388 * MiB;
constexpr size_t WS_ZS = 628 * MiB;
constexpr size_t WS_SEG = 644 * MiB;
constexpr size_t WS_SST = 652 * MiB;
constexpr size_t WS_SEGP = 656 * MiB;
constexpr size_t WS_END = 660 * MiB;
constexpr int CW_CNT = 64;
constexpr int CW_SEGA = 1024, CW_SEGB = 2048;
constexpr int CW_BAR = 4096;
constexpr int CW_HIST = 16384;

constexpr int LDS_BYTES = 163840, MISC_OFF = 161792;

#define GAS __attribute__((address_space(1)))
#define LAS __attribute__((address_space(3)))
typedef unsigned short bf16;
typedef unsigned v4u __attribute__((ext_vector_type(4)));
typedef unsigned v2u __attribute__((ext_vector_type(2)));
typedef float f32x4 __attribute__((ext_vector_type(4)));
typedef LAS float ldsf;
#define RLX_AGENT __ATOMIC_RELAXED, __HIP_MEMORY_SCOPE_AGENT
__device__ __forceinline__ unsigned f2bf(float f) { unsigned u = __builtin_bit_cast(unsigned, f); return (u + 0x7fffu + ((u >> 16) & 1u)) >> 16; }
__device__ __forceinline__ unsigned pk2(float lo, float hi) { return f2bf(lo) | (f2bf(hi) << 16); }
__device__ __forceinline__ float bf2f(unsigned h) { return __builtin_bit_cast(float, h << 16); }
__device__ __forceinline__ float bflo(unsigned w) { return __builtin_bit_cast(float, w << 16); }
__device__ __forceinline__ float bfhi(unsigned w) { return __builtin_bit_cast(float, w & 0xffff0000u); }
template <int CTRL, int ROWMASK> __device__ __forceinline__ float dppf(float v) {
    return __builtin_bit_cast(float, __builtin_amdgcn_update_dpp(0, __builtin_bit_cast(int, v), CTRL, ROWMASK, 0xF, false)); }
__device__ __forceinline__ float wave_sum(float v) {
    v += dppf<0x111, 0xF>(v); v += dppf<0x112, 0xF>(v); v += dppf<0x114, 0xF>(v); v += dppf<0x118, 0xF>(v);
    v += dppf<0x142, 0xA>(v); v += dppf<0x143, 0xC>(v);
    return __builtin_bit_cast(float, __builtin_amdgcn_readlane(__builtin_bit_cast(int, v), 63));
}
__device__ __forceinline__ float xchg32(float send, int lane) { const unsigned u = __builtin_bit_cast(unsigned, send); const auto r_ = __builtin_amdgcn_permlane32_swap(u, u, false, false); return __builtin_bit_cast(float, lane < 32 ? r_[1] : r_[0]); }
__device__ __forceinline__ float xchg16(float send, int lane) { const unsigned u = __builtin_bit_cast(unsigned, send); const auto r_ = __builtin_amdgcn_permlane16_swap(u, u, false, false); return __builtin_bit_cast(float, (lane & 16) ? r_[0] : r_[1]); }
template <int CTRL> __device__ __forceinline__ float dppx(float v) { return __builtin_bit_cast(float, __builtin_amdgcn_update_dpp(0, __builtin_bit_cast(int, v), CTRL, 0xF, 0xF, false)); }
template <int CTRL, int ROWMASK> __device__ __forceinline__ float dppf_o(float v, float old) { return __builtin_bit_cast(float, __builtin_amdgcn_update_dpp(__builtin_bit_cast(int, old), __builtin_bit_cast(int, v), CTRL, ROWMASK, 0xF, false)); }
template <int CTRL, int ROWMASK> __device__ __forceinline__ int dppi_o(int v, int old) { return __builtin_amdgcn_update_dpp(old, v, CTRL, ROWMASK, 0xF, false); }
__device__ __forceinline__ float wave_max(float v) {
    const float ni = -3.4e38f;
    v = fmaxf(v, dppf_o<0x111, 0xF>(v, ni)); v = fmaxf(v, dppf_o<0x112, 0xF>(v, ni)); v = fmaxf(v, dppf_o<0x114, 0xF>(v, ni)); v = fmaxf(v, dppf_o<0x118, 0xF>(v, ni));
    v = fmaxf(v, dppf_o<0x142, 0xA>(v, ni)); v = fmaxf(v, dppf_o<0x143, 0xC>(v, ni));
    return __builtin_bit_cast(float, __builtin_amdgcn_readlane(__builtin_bit_cast(int, v), 63));
}
__device__ __forceinline__ int wave_min_i(int v) {
    const int mi = 0x7fffffff;
    v = min(v, dppi_o<0x111, 0xF>(v, mi)); v = min(v, dppi_o<0x112, 0xF>(v, mi)); v = min(v, dppi_o<0x114, 0xF>(v, mi)); v = min(v, dppi_o<0x118, 0xF>(v, mi));
    v = min(v, dppi_o<0x142, 0xA>(v, mi)); v = min(v, dppi_o<0x143, 0xC>(v, mi));
    return __builtin_amdgcn_readlane(v, 63);
}
__device__ __forceinline__ float siluf(float x) { return x * __builtin_amdgcn_rcpf(1.0f + __builtin_amdgcn_exp2f(-1.4426950408889634f * x)); }
typedef float f32x16 __attribute__((ext_vector_type(16)));
typedef short bf16x8 __attribute__((ext_vector_type(8)));
typedef float f32x2_t __attribute__((ext_vector_type(2)));
typedef __bf16 bf16x2_t __attribute__((ext_vector_type(2)));
__device__ __forceinline__ unsigned cvtpk(float lo, float hi) { f32x2_t v = {lo, hi}; bf16x2_t b = __builtin_convertvector(v, bf16x2_t); return __builtin_bit_cast(unsigned, b); }
__device__ __forceinline__ bf16x8 pack8(const f32x16& x, int s) {
    v4u p; p.x = cvtpk(x[8 * s], x[8 * s + 1]); p.y = cvtpk(x[8 * s + 2], x[8 * s + 3]); p.z = cvtpk(x[8 * s + 4], x[8 * s + 5]); p.w = cvtpk(x[8 * s + 6], x[8 * s + 7]);
    return __builtin_bit_cast(bf16x8, p);
}
__device__ __forceinline__ int crow(int q, int h) { return (q & 3) + 8 * (q >> 2) + 4 * h; }
#define MFMA32(a, b, c) __builtin_amdgcn_mfma_f32_32x32x16_bf16((a), (b), (c), 0, 0, 0)

#define XB_TMO      128
#define XB_XCNT(j)  (256  + 64 * (j))
#define XB_XSUB(j)  (1280 + 64 * (j))
#define XB_XGEN(j)  (2304 + 64 * (j))
#define XB_TOP      3328
#define XB_TOPGEN   3392
#define XCD_BAR_WORDS 3456
#define XB_SPIN_CAP (1u << 22)
__device__ __forceinline__ unsigned xb_ld(unsigned* p)              { return __hip_atomic_load(p, __ATOMIC_RELAXED, __HIP_MEMORY_SCOPE_AGENT); }
__device__ __forceinline__ unsigned xb_add(unsigned* p, unsigned v) { return __hip_atomic_fetch_add(p, v, __ATOMIC_RELAXED, __HIP_MEMORY_SCOPE_AGENT); }
__device__ __forceinline__ unsigned xb_xcc_id() { return (unsigned)__builtin_amdgcn_s_getreg((3 << 11) | 20) & 0xFu; }
#define XB_SPIN(cond, bar) do { unsigned _sp = 0; while (cond) { __builtin_amdgcn_s_sleep(1); \
    if ((++_sp & 255u) == 0u) { if (xb_ld(&(bar)[XB_TMO])) break; if (_sp > XB_SPIN_CAP) { atomicAdd(&(bar)[XB_TMO], 1u); break; } } } } while (0)
struct XcdBarrier { unsigned* bar; unsigned x; volatile LAS unsigned* st; };
__device__ __forceinline__ XcdBarrier xcd_barrier_post(unsigned* bar, volatile LAS unsigned* st) {
    XcdBarrier b; b.bar = bar; b.x = xb_xcc_id(); b.st = st;
    if (threadIdx.x == 0) (void)xb_add(&bar[XB_XCNT(b.x)], 1u);
    return b;
}
__device__ __forceinline__ void xcd_barrier_complete(unsigned* bar, unsigned x, unsigned& nloc, unsigned& nx) {
    const unsigned G = gridDim.x * gridDim.y * gridDim.z;
    unsigned sum, cnt, mine, sp = 0u;
    for (;;) {
        sum = 0u; cnt = 0u; mine = 0u;
#pragma unroll
        for (unsigned j = 0; j < 16; ++j) { const unsigned c = xb_ld(&bar[XB_XCNT(j)]); sum += c; cnt += (c > 0u) ? 1u : 0u; mine = (j == x) ? c : mine; }
        if (sum == G) break;
        __builtin_amdgcn_s_sleep(1);
        if ((++sp & 255u) == 0u) { if (xb_ld(&bar[XB_TMO])) break; if (sp > XB_SPIN_CAP) { atomicAdd(&bar[XB_TMO], 1u); break; } }
    }
    nloc = mine > 0u ? mine : 1u; nx = cnt > 0u ? cnt : 1u;
}
__device__ __forceinline__ void xcd_barrier(const XcdBarrier& b, const int tid) {
    asm volatile("s_waitcnt vmcnt(0)" ::: "memory");
    __syncthreads();
    if (tid == 0) {
        unsigned* bar = b.bar;
        __builtin_amdgcn_s_waitcnt(0);
        unsigned nloc = b.st[0], nx = b.st[1];
        if (nloc == 0u) { xcd_barrier_complete(bar, b.x, nloc, nx); b.st[0] = nloc; b.st[1] = nx; }
        const unsigned old = xb_add(&bar[XB_XSUB(b.x)], 1u);
        const unsigned gen = old / nloc;
        if (old + 1u == (gen + 1u) * nloc) {
            __builtin_amdgcn_fence(__ATOMIC_RELEASE, "agent");
            asm volatile("s_waitcnt vmcnt(0)" ::: "memory");
            const unsigned og = xb_add(&bar[XB_TOP], 1u);
            const unsigned tg = og / nx;
            if (og + 1u == (tg + 1u) * nx) xb_add(&bar[XB_TOPGEN], 1u);
            else XB_SPIN(xb_ld(&bar[XB_TOPGEN]) == tg, bar);
            __builtin_amdgcn_fence(__ATOMIC_ACQUIRE, "agent");
            xb_add(&bar[XB_XGEN(b.x)], 1u);
            asm volatile("s_waitcnt vmcnt(0)" ::: "memory");
        } else {
            XB_SPIN(xb_ld(&bar[XB_XGEN(b.x)]) == gen, bar);
            __builtin_amdgcn_fence(__ATOMIC_ACQUIRE, "agent");
            asm volatile("s_waitcnt vmcnt(0)" ::: "memory");
        }
    }
    __syncthreads();
}

struct Args {
    const float* in[18]; float* out; unsigned char* ws; int ph_lo, ph_hi, li, pad;
};
enum { I_X = 0, I_C, I_WADA, I_BADA, I_NORMW, I_WIN, I_CONVW, I_ALOG, I_DTB, I_ANW, I_RELB, I_WOUT, I_WR, I_BR, I_WUP, I_BUP, I_WDN, I_BDN };

__device__ __forceinline__ int map_row(int mode, int n) {
    if (mode == 0) return n < 2048 ? n : (n < 2056 ? -1 : n - 8);
    if (mode == 2) { const int j = n & 1023, half = n >> 10; return (j >> 7) * 256 + half * 128 + (j & 127); }
    return n;
}
__device__ __forceinline__ void transpose_item(const float* W, int K, int N, bf16* WT, int mode, ldsf* scr, int item, int lane) {
    const int nblk = (N + 31) / 32, kb = item / nblk, nb = item % nblk, k0 = 64 * kb, n0 = 32 * nb;
    const int nn = n0 + (lane & 31);
#pragma unroll 8
    for (int i = 0; i < 32; ++i) { const int kk = 2 * i + (lane >> 5); scr[kk * 33 + (lane & 31)] = (nn < N) ? W[(size_t)(k0 + kk) * N + nn] : 0.f; }
    asm volatile("s_waitcnt lgkmcnt(0)" ::: "memory");
    const int c = lane & 7;
#pragma unroll
    for (int j = 0; j < 4; ++j) { const int nl = (lane >> 3) + 8 * j; const int n = n0 + nl; const ldsf* s = scr + (8 * c) * 33 + nl;
        const int row = (n < N) ? map_row(mode, n) : -1;
        v4u o; o.x = pk2(s[0 * 33], s[1 * 33]); o.y = pk2(s[2 * 33], s[3 * 33]); o.z = pk2(s[4 * 33], s[5 * 33]); o.w = pk2(s[6 * 33], s[7 * 33]);
        if (row >= 0) *(v4u*)(WT + (size_t)row * K + k0 + 8 * c) = o; }
    asm volatile("s_waitcnt lgkmcnt(0)" ::: "memory");
}
__device__ __forceinline__ void transpose_item8(const float* W, int K, int N, unsigned char* WT, int mode, ldsf* scr, int item, int lane) {
    const int nblk = N / 32, kb = item / nblk, nb = item % nblk, k0 = 64 * kb, n0 = 32 * nb;
#pragma unroll 8
    for (int i = 0; i < 32; ++i) { const int kk = 2 * i + (lane >> 5); scr[kk * 33 + (lane & 31)] = __builtin_nontemporal_load(W + (size_t)(k0 + kk) * N + n0 + (lane & 31)); }
    asm volatile("s_waitcnt lgkmcnt(0)" ::: "memory");
    const int nl = lane >> 1, kh = lane & 1; const ldsf* sp = scr + (32 * kh) * 33 + nl;
    const int row = map_row(mode, n0 + nl);
    v4u o0, o1;
    o0.x = pg8::pk4_fp8(sp[0 * 33] * 32.f, sp[1 * 33] * 32.f, sp[2 * 33] * 32.f, sp[3 * 33] * 32.f);     o0.y = pg8::pk4_fp8(sp[4 * 33] * 32.f, sp[5 * 33] * 32.f, sp[6 * 33] * 32.f, sp[7 * 33] * 32.f);
    o0.z = pg8::pk4_fp8(sp[8 * 33] * 32.f, sp[9 * 33] * 32.f, sp[10 * 33] * 32.f, sp[11 * 33] * 32.f);   o0.w = pg8::pk4_fp8(sp[12 * 33] * 32.f, sp[13 * 33] * 32.f, sp[14 * 33] * 32.f, sp[15 * 33] * 32.f);
    o1.x = pg8::pk4_fp8(sp[16 * 33] * 32.f, sp[17 * 33] * 32.f, sp[18 * 33] * 32.f, sp[19 * 33] * 32.f); o1.y = pg8::pk4_fp8(sp[20 * 33] * 32.f, sp[21 * 33] * 32.f, sp[22 * 33] * 32.f, sp[23 * 33] * 32.f);
    o1.z = pg8::pk4_fp8(sp[24 * 33] * 32.f, sp[25 * 33] * 32.f, sp[26 * 33] * 32.f, sp[27 * 33] * 32.f); o1.w = pg8::pk4_fp8(sp[28 * 33] * 32.f, sp[29 * 33] * 32.f, sp[30 * 33] * 32.f, sp[31 * 33] * 32.f);
    unsigned char* dst = WT + (size_t)row * K + k0 + 32 * kh;
    __builtin_nontemporal_store(o0, (v4u*)dst); __builtin_nontemporal_store(o1, (v4u*)(dst + 16));
    asm volatile("s_waitcnt lgkmcnt(0)" ::: "memory");
}
__device__ __forceinline__ void mod_item(const float* c, const float* w_ada, const float* b_ada, float* mod, int item, ldsf* red, int tid, int lane, int wave) {
    const int j0 = item * 24;
    float a0[24], a1[24];
#pragma unroll
    for (int k = 0; k < 24; ++k) { a0[k] = 0.f; a1[k] = 0.f; }
#pragma unroll
    for (int rr = 0; rr < 2; ++rr) {
        const int d = tid + rr * 512;
        const float s0 = siluf(c[d]), s1 = siluf(c[1024 + d]);
        const f32x4* wp = (const f32x4*)(w_ada + (size_t)d * 6144 + j0);
#pragma unroll
        for (int q = 0; q < 6; ++q) { const f32x4 w = wp[q];
#pragma unroll
            for (int e = 0; e < 4; ++e) { a0[4 * q + e] += s0 * w[e]; a1[4 * q + e] += s1 * w[e]; } }
    }
#pragma unroll
    for (int k = 0; k < 24; ++k) { a0[k] = wave_sum(a0[k]); a1[k] = wave_sum(a1[k]); }
    if (lane == 0) {
#pragma unroll
        for (int k = 0; k < 24; ++k) { red[wave * 48 + k] = a0[k]; red[wave * 48 + 24 + k] = a1[k]; }
    }
    __syncthreads();
    if (tid < 48) { float s = 0.f;
#pragma unroll
        for (int w = 0; w < 8; ++w) s += red[w * 48 + tid];
        const int b = tid / 24, k = tid % 24; mod[b * 6144 + j0 + k] = s + b_ada[j0 + k]; }
    __syncthreads();
}

#define SB() __builtin_amdgcn_sched_barrier(0)
#define GI_W(mt, t2, s2) ((((mt) * 4 + (t2)) * 2) + (s2))
#define GI_Q(mt, t2, s2) (16 + (((mt) * 4 + (t2)) * 2) + (s2))
#define GI_K(t2, mt, s2) (32 + (((t2) * 2 + (mt)) * 2) + (s2))
#define GI_A(mt, mp, s2) (48 + (((mt) * 2 + (mp)) * 2) + (s2))
#define FRAG(f_) (*(const LAS bf16x8*)(Bf + (f_) * 1024))
#define LD_WQ(dst, t2, s2) do { dst[0] = FRAG(GI_W(0, t2, s2)); dst[1] = FRAG(GI_Q(0, t2, s2)); dst[2] = FRAG(GI_W(1, t2, s2)); dst[3] = FRAG(GI_Q(1, t2, s2)); } while (0)
#define MM_WQ(src, t2, s2) do { const bf16x8 sb_ = pack8(S[t2], s2); VN[0] = MFMA32(src[0], sb_, VN[0]); O[0] = MFMA32(src[1], sb_, O[0]); VN[1] = MFMA32(src[2], sb_, VN[1]); O[1] = MFMA32(src[3], sb_, O[1]); } while (0)
#define LD_AT(dst, s2) do { dst[0] = FRAG(GI_A(0, 0, s2)); dst[1] = FRAG(GI_A(1, 0, s2)); dst[2] = FRAG(GI_A(1, 1, s2)); } while (0)
#define MM_AT(src, s2) do { O[0] = MFMA32(src[0], vb[0][s2], O[0]); O[1] = MFMA32(src[1], vb[0][s2], O[1]); O[1] = MFMA32(src[2], vb[1][s2], O[1]); } while (0)
#define LD_K(dst, t2) do { dst[0] = FRAG(GI_K(t2, 0, 0)); dst[1] = FRAG(GI_K(t2, 0, 1)); dst[2] = FRAG(GI_K(t2, 1, 0)); dst[3] = FRAG(GI_K(t2, 1, 1)); } while (0)
#define MM_K(src, t2) do { S[t2] = MFMA32(src[0], vb[0][0], S[t2]); S[t2] = MFMA32(src[1], vb[0][1], S[t2]); S[t2] = MFMA32(src[2], vb[1][0], S[t2]); S[t2] = MFMA32(src[3], vb[1][1], S[t2]); } while (0)
#define SCALE_S(t2) do { _Pragma("unroll") for (int q_ = 0; q_ < 16; ++q_) S[t2][q_] *= egl; } while (0)
__device__ __forceinline__ void scan_step(const int n, f32x16 (&S)[4], v4u (&UC)[4], v4u (&UN)[4], const float egl, float& egl_next,
                                          LAS unsigned char* lds, const float* Uf, const float* glp, const int wave, const int lane, const int stg_off, const int stg_row) {
    const int r = lane & 31, h = lane >> 5;
    asm volatile("s_waitcnt lgkmcnt(0)" ::: "memory"); __builtin_amdgcn_s_barrier(); asm volatile("" ::: "memory");
    if (n + 1 < 128) {
        const v4u* up = (const v4u*)((const unsigned char*)Uf + (size_t)(n + 1) * 16384) + (wave * 4) * 64 + lane;
#pragma unroll
        for (int f = 0; f < 4; ++f) UN[f] = up[f * 64];
        egl_next = glp[n + 1];
    }
    SB();
    f32x16 VN[2];
#pragma unroll
    for (int mt = 0; mt < 2; ++mt)
#pragma unroll
        for (int q8 = 0; q8 < 2; ++q8) { const v4u u = UC[mt * 2 + q8];
            VN[mt][8 * q8 + 0] = bflo(u.x); VN[mt][8 * q8 + 1] = bfhi(u.x); VN[mt][8 * q8 + 2] = bflo(u.y); VN[mt][8 * q8 + 3] = bfhi(u.y);
            VN[mt][8 * q8 + 4] = bflo(u.z); VN[mt][8 * q8 + 5] = bfhi(u.z); VN[mt][8 * q8 + 6] = bflo(u.w); VN[mt][8 * q8 + 7] = bfhi(u.w); }
    const LAS unsigned char* Bf = lds + (n & 1) * OPS_BYTES + lane * 16;
    f32x16 O[2];
#pragma unroll
    for (int mt = 0; mt < 2; ++mt)
#pragma unroll
        for (int q = 0; q < 16; ++q) O[mt][q] = 0.f;
    bf16x8 fA[4], fB[4], vb[2][2];
    LD_WQ(fA, 0, 0); SB();
    LD_WQ(fB, 0, 1); SB(); MM_WQ(fA, 0, 0); SB();
    LD_WQ(fA, 1, 0); SB(); MM_WQ(fB, 0, 1); SCALE_S(0); SB();
    LD_WQ(fB, 1, 1); SB(); MM_WQ(fA, 1, 0); SB();
    LD_WQ(fA, 2, 0); SB(); MM_WQ(fB, 1, 1); SCALE_S(1); SB();
    LD_WQ(fB, 2, 1); SB(); MM_WQ(fA, 2, 0); SB();
    LD_WQ(fA, 3, 0); SB(); MM_WQ(fB, 2, 1); SCALE_S(2); SB();
    LD_WQ(fB, 3, 1); SB(); MM_WQ(fA, 3, 0); SB();
    LD_AT(fA, 0); SB(); MM_WQ(fB, 3, 1); SCALE_S(3); SB();
#pragma unroll
    for (int mt = 0; mt < 2; ++mt)
#pragma unroll
        for (int s2 = 0; s2 < 2; ++s2) vb[mt][s2] = pack8(VN[mt], s2);
    LD_AT(fB, 1); SB(); MM_AT(fA, 0); SB();
    LD_K(fA, 0); SB(); MM_AT(fB, 1); SB();
    {
        LAS unsigned short* sp = (LAS unsigned short*)(lds + stg_off + (n & 1) * (64 * stg_row)) + 32 * wave + r;
#pragma unroll
        for (int mt = 0; mt < 2; ++mt)
#pragma unroll
            for (int q = 0; q < 16; q += 2) { const unsigned w = cvtpk(O[mt][q], O[mt][q + 1]);
                sp[(32 * mt + crow(q, h)) * (stg_row / 2)] = (unsigned short)(w & 0xffffu); sp[(32 * mt + crow(q + 1, h)) * (stg_row / 2)] = (unsigned short)(w >> 16); }
    }
    asm volatile("s_waitcnt lgkmcnt(0)" ::: "memory"); __builtin_amdgcn_s_barrier(); asm volatile("" ::: "memory");
    LD_K(fB, 1); SB(); MM_K(fA, 0); SB();
    LD_K(fA, 2); SB(); MM_K(fB, 1); SB();
    LD_K(fB, 3); SB(); MM_K(fA, 2); SB();
    MM_K(fB, 3); SB();
}
#undef FRAG

__device__ __forceinline__ int opq(int v) { asm volatile("" : "+v"(v)); return v; }
typedef const __attribute__((address_space(4))) Args* kargp_t;
__device__ __forceinline__ kargp_t karg_ptr() { kargp_t p = (kargp_t)__builtin_amdgcn_kernarg_segment_ptr(); asm volatile("" : "+s"(p)); return p; }
__global__ void __launch_bounds__(NTHR, 2) mk_fwd(Args kargs) {
    extern __shared__ __attribute__((aligned(16))) unsigned char lds_raw[];
    LAS unsigned char* lds = (LAS unsigned char*)lds_raw;
    volatile LAS unsigned* MISC = (volatile LAS unsigned*)(lds + MISC_OFF);
    const int wave = __builtin_amdgcn_readfirstlane((int)threadIdx.x >> 6);
    const int G = gridDim.x; const int bx = blockIdx.x; const int vcu = (G % 8 == 0) ? (bx % 8) * (G / 8) + bx / 8 : bx;
    const int gw = vcu * NWAVES + wave, NGW = G * NWAVES;
    if (threadIdx.x < 128) MISC[threadIdx.x] = 0u;
    __syncthreads();
    XcdBarrier bar; bar.bar = (unsigned*)(kargs.ws + WS_CTL) + CW_BAR; bar.x = 0; bar.st = nullptr;
#if MK_ONE_LAUNCH
    bar = xcd_barrier_post((unsigned*)(kargs.ws + WS_CTL) + CW_BAR + kargs.li * XCD_BAR_WORDS, MISC + 8);
#define GRID_BAR() xcd_barrier(bar, tid)
#else
#define GRID_BAR() do {} while (0)
#endif
    const int lo = kargs.ph_lo, hi = kargs.ph_hi;
#ifndef PH_MASK
#define PH_MASK 0xFFFF
#endif
#define IN(k) ((((PH_MASK) >> (k)) & 1) && lo <= (k) && (k) < hi)
#define BOTH(k) (IN(k) && IN((k) + 1))

#define args (*ap_)
#define P_WS (args.ws)
#define ctl ((unsigned*)(P_WS + WS_CTL))
#define Xp (args.in[I_X])
#define OUTp (args.out)
#define MODp ((float*)(P_WS + WS_MOD))
#define gbuf ((float*)(P_WS + WS_G))
#define betabuf ((float*)(P_WS + WS_BETA))
#define glbuf ((float*)(P_WS + WS_GL))
#define asg_e ((int*)(P_WS + WS_AE))
#define asg_p ((int*)(P_WS + WS_AP))
#define asg_g ((float*)(P_WS + WS_AG))
#define asg_s ((int*)(P_WS + WS_AS))
#define WinT ((bf16*)(P_WS + WS_WIN))
#define WoutT ((bf16*)(P_WS + WS_WOUT))
#define WupT ((bf16*)(P_WS + WS_WUP))
#define WdnT ((bf16*)(P_WS + WS_WDN))
#define hbuf ((bf16*)(P_WS + WS_H))
#define projb ((bf16*)(P_WS + WS_PROJ))
#define Ub ((float*)(P_WS + WS_U))
#define opsb (P_WS + WS_OPS)
#define zsb ((bf16*)(P_WS + WS_ZS))
#define qfb (P_WS + WS_QF)
#define kfb (P_WS + WS_KF)
#define vtfb (P_WS + WS_VTF)
#define omix ((bf16*)(P_WS + WS_OMIX))
#define ybuf ((bf16*)(P_WS + WS_Y))
#define xg ((bf16*)(P_WS + WS_XG))
#define actb ((bf16*)(P_WS + WS_ACT))
#define yslot ((bf16*)(P_WS + WS_XG))

    if (IN(0)) {
        const int lane = (int)__builtin_amdgcn_mbcnt_hi(~0u, __builtin_amdgcn_mbcnt_lo(~0u, 0u)), tid = wave * 64 + lane; const kargp_t ap_ = karg_ptr();
        ldsf* scr = (ldsf*)(lds + wave * 16384);
        constexpr int I_IN = 16 * 113, I_OUT = 16 * 32;
        constexpr int NITEMS = I_IN + I_OUT;
        for (int it = gw; it < NITEMS; it += NGW) {
            int r = it;
            if (r < I_IN) { transpose_item(args.in[I_WIN], D, IN_COLS, WinT, 0, scr, r, lane); continue; } r -= I_IN;
            transpose_item(args.in[I_WOUT], D, D, WoutT, 1, scr, r, lane);
        }
        __syncthreads();
        for (int idx = bx * NTHR + tid; idx < 8192; idx += G * NTHR) { const int col = idx >> 3, k = idx & 7; ((float*)(P_WS + WS_WG))[k * 1024 + col] = args.in[I_WIN][(size_t)col * IN_COLS + 2048 + k]; }
        for (int idx = bx * NTHR + tid; idx < 32768; idx += G * NTHR) { const int col = idx >> 5, e = idx & 31; ((float*)(P_WS + WS_WR))[e * 1024 + col] = args.in[I_WR][idx]; }
        for (int it = bx; it < 256; it += G) mod_item(args.in[I_C], args.in[I_WADA], args.in[I_BADA], MODp, it, (ldsf*)lds, tid, lane, wave);
        if (BOTH(0)) GRID_BAR();
    }

    if (IN(1)) {
        const int lane = (int)__builtin_amdgcn_mbcnt_hi(~0u, __builtin_amdgcn_mbcnt_lo(~0u, 0u)), tid = wave * 64 + lane; const kargp_t ap_ = karg_ptr();
        ldsf* wg = (ldsf*)lds;
        const float* w_in = args.in[I_WIN];
        for (int idx = tid; idx < 2048; idx += NTHR) *((LAS f32x4*)wg + idx) = *((const f32x4*)(P_WS + WS_WG) + idx);
        __syncthreads();
        const float* nw0 = args.in[I_NORMW];
        const float dtb = args.in[I_DTB][lane & 3], alg = -expf(args.in[I_ALOG][lane & 3]);
        f32x4 vnx[4];
#pragma unroll
        for (int j = 0; j < 4; ++j) vnx[j] = *((const f32x4*)(Xp + (size_t)gw * D) + lane + 64 * j);
        for (int bb = 0; bb < BATCH; ++bb) {
            f32x4 av[4], shv[4];
#pragma unroll
            for (int j = 0; j < 4; ++j) { const int col = 4 * lane + 256 * j; const f32x4 nw = *(const f32x4*)(nw0 + col), sc = *(const f32x4*)(MODp + bb * 6144 + 1024 + col); shv[j] = *(const f32x4*)(MODp + bb * 6144 + col);
#pragma unroll
                for (int e = 0; e < 4; ++e) av[j][e] = nw[e] * (1.0f + sc[e]); }
            for (int r = gw + bb * (NTOK / BATCH); r < (bb + 1) * (NTOK / BATCH); r += NGW) {
                f32x4 v[4]; float ss = 0.f;
#pragma unroll
                for (int j = 0; j < 4; ++j) { v[j] = vnx[j]; ss += (v[j].x * v[j].x + v[j].y * v[j].y) + (v[j].z * v[j].z + v[j].w * v[j].w); }
                __builtin_amdgcn_sched_barrier(0);
                if (r + NGW < NTOK) {
#pragma unroll
                    for (int j = 0; j < 4; ++j) vnx[j] = *((const f32x4*)(Xp + (size_t)(r + NGW) * D) + lane + 64 * j);
                }
                __builtin_amdgcn_sched_barrier(0);
                const float rstd = rsqrtf(wave_sum(ss) * (1.0f / D) + EPS);
                float al[8];
#pragma unroll
                for (int k = 0; k < 8; ++k) al[k] = 0.f;
                v2u ov[4];
#pragma unroll
                for (int j = 0; j < 4; ++j) {
                    const int col = 4 * lane + 256 * j;
                    f32x4 h;
#pragma unroll
                    for (int e = 0; e < 4; ++e) h[e] = v[j][e] * rstd * av[j][e] + shv[j][e];
                    ov[j].x = pk2(h[0], h[1]); ov[j].y = pk2(h[2], h[3]);
#pragma unroll
                    for (int k = 0; k < 8; ++k) { const f32x4 w = *(const LAS f32x4*)(wg + k * 1024 + col); al[k] += (h[0] * w[0] + h[1] * w[1]) + (h[2] * w[2] + h[3] * w[3]); }
                }
#pragma unroll
                for (int j = 0; j < 4; ++j) *(v2u*)(hbuf + (size_t)r * D + 4 * lane + 256 * j) = ov[j];
#pragma unroll
                for (int k = 0; k < 8; ++k) al[k] = wave_sum(al[k]);
                if (lane < 4) {
                    const float aa = lane == 0 ? al[0] : (lane == 1 ? al[1] : (lane == 2 ? al[2] : al[3]));
                    const float ab = lane == 0 ? al[4] : (lane == 1 ? al[5] : (lane == 2 ? al[6] : al[7]));
                    const float xx = aa + dtb;
                    const float sp = xx > 20.f ? xx : log1pf(expf(xx));
                    gbuf[r * 4 + lane] = alg * sp;
                    betabuf[r * 4 + lane] = 1.0f / (1.0f + expf(-ab));
                }
            }
        }
        if (BOTH(1)) GRID_BAR();
    }

    if (IN(2)) {
        const int lane = (int)__builtin_amdgcn_mbcnt_hi(~0u, __builtin_amdgcn_mbcnt_lo(~0u, 0u)), tid = wave * 64 + lane; const kargp_t ap_ = karg_ptr();
        pg8::Gemm g{hbuf, WinT, NTOK, PCOLS, D}; pg8::StaticOrder S; S.init(NTOK, PCOLS, G, bx);
        pg8::EpiBf16 E{projb, PCOLS, nullptr, nullptr, 0, 1.0f};
        pg8::gemm_phase<pg8::EpiBf16, pg8::StaticOrder, true, true>(lds, g, S, E, tid);
        if (BOTH(2)) GRID_BAR();
    }

    if (IN(3)) {
        const int lane = (int)__builtin_amdgcn_mbcnt_hi(~0u, __builtin_amdgcn_mbcnt_lo(~0u, 0u)), tid = wave * 64 + lane; const kargp_t ap_ = karg_ptr();
        ldsf* qs = (ldsf*)lds; ldsf* ks = qs + 64 * 129; ldsf* vs = ks + 64 * 129; ldsf* Wsm = vs + 64 * 129; ldsf* Ls = Wsm + 64 * 129;
        constexpr int LSTR = 68;
        constexpr int RAW_OFF = 4 * 64 * 129 * 3;
        ldsf* gc = (ldsf*)(lds + 151296); ldsf* bt = gc + 64; ldsf* eg = bt + 64; ldsf* ekd = eg + 64;
        const float* conv_w = args.in[I_CONVW];
        const int r = lane & 31, h = lane >> 5;
        for (int item = (args.pad & 1) ? 1024 : bx; item < 1024; item += G) {
            const int bh = item >> 7, n = item & 127, b = bh >> 2, hh = bh & 3;
            const size_t row0 = (size_t)b * T + n * 64;
            unsigned char* ops = opsb + (size_t)item * OPS_BYTES;
            {
#pragma unroll
                for (int jp = 0; jp < 7; ++jp) {
                    const int p = wave + 8 * jp;
                    if (p < 51) {
                        int sg = 4 * p + (lane >> 4); sg = sg > 200 ? 200 : sg;
                        const int rw = sg / 3, wh = sg - 3 * rw; int tt = n * 64 + rw - 3; tt = tt < 0 ? 0 : tt;
                        __builtin_amdgcn_global_load_lds((const unsigned*)(projb + ((size_t)b * T + tt) * PCOLS + wh * 512 + hh * 128 + (lane & 15) * 8), (LAS unsigned*)(lds + RAW_OFF + p * 1024), 16, 0, 0);
                    }
                }
#pragma unroll
                for (int o = 0; o < 2; ++o) {
                    const int idx = tid + NTHR * o, i = idx >> 4, d0 = (idx & 15) * 8;
                    const v4u zw = *(const v4u*)(projb + ((size_t)b * T + n * 64 + i) * PCOLS + 1536 + hh * 128 + d0);
                    const f32x4 wa = *(const f32x4*)(args.in[I_ANW] + d0), wb = *(const f32x4*)(args.in[I_ANW] + d0 + 4);
                    v4u ow; ow.x = cvtpk(wa[0] * siluf(bflo(zw.x)), wa[1] * siluf(bfhi(zw.x))); ow.y = cvtpk(wa[2] * siluf(bflo(zw.y)), wa[3] * siluf(bfhi(zw.y)));
                    ow.z = cvtpk(wb[0] * siluf(bflo(zw.z)), wb[1] * siluf(bfhi(zw.z))); ow.w = cvtpk(wb[2] * siluf(bflo(zw.w)), wb[3] * siluf(bfhi(zw.w)));
                    *(v4u*)(zsb + ((size_t)b * T + n * 64 + i) * 512 + hh * 128 + d0) = ow;
                }
                asm volatile("s_waitcnt vmcnt(0)" ::: "memory");
                __syncthreads();
#pragma unroll 2
                for (int o = 0; o < 6; ++o) {
                    const int idx = tid + NTHR * o, i = idx / 48, c8 = idx - 48 * i, which = c8 >> 4, d0 = (c8 & 15) * 8, gch = which * 512 + hh * 128 + d0;
                    const LAS unsigned char* rp = lds + RAW_OFF + i * 768 + which * 256 + d0 * 2;
                    float acc[8];
#pragma unroll
                    for (int e = 0; e < 8; ++e) acc[e] = 0.f;
#pragma unroll
                    for (int tap = 0; tap < 4; ++tap) {
                        const v4u xw = *(const LAS v4u*)(rp + tap * 768);
                        const f32x4 wa = *(const f32x4*)(conv_w + tap * 1536 + gch), wb = *(const f32x4*)(conv_w + tap * 1536 + gch + 4);
                        const float msk = (n * 64 + i - 3 + tap) >= 0 ? 1.0f : 0.0f;
                        acc[0] += msk * wa[0] * bflo(xw.x); acc[1] += msk * wa[1] * bfhi(xw.x); acc[2] += msk * wa[2] * bflo(xw.y); acc[3] += msk * wa[3] * bfhi(xw.y);
                        acc[4] += msk * wb[0] * bflo(xw.z); acc[5] += msk * wb[1] * bfhi(xw.z); acc[6] += msk * wb[2] * bflo(xw.w); acc[7] += msk * wb[3] * bfhi(xw.w);
                    }
                    ldsf* dst = (which == 0 ? qs : (which == 1 ? ks : vs)) + i * 129 + d0;
#pragma unroll
                    for (int e = 0; e < 8; ++e) dst[e] = siluf(acc[e]);
                }
            }
            if (wave == 7) {
                float gv = gbuf[(row0 + lane) * 4 + hh];
#pragma unroll
                for (int o = 1; o < 64; o <<= 1) { const float t2 = __shfl_up(gv, o); if (lane >= o) gv += t2; }
                const float glast = __shfl(gv, 63);
                gc[lane] = gv; eg[lane] = expf(gv); bt[lane] = betabuf[(row0 + lane) * 4 + hh]; ekd[lane] = expf(glast - gv);
                if (lane == 0) glbuf[item] = expf(glast);
            }
            __syncthreads();
            if (((args.pad >> 2) & 7) == 1) continue;
            for (int i = wave; i < 64; i += NWAVES) {
                const float q0 = qs[i * 129 + lane], q1 = qs[i * 129 + 64 + lane], k0 = ks[i * 129 + lane], k1 = ks[i * 129 + 64 + lane];
                const float sq = rsqrtf(wave_sum(q0 * q0 + q1 * q1) + EPS) * 0.08838834764831845f, sk = rsqrtf(wave_sum(k0 * k0 + k1 * k1) + EPS);
                qs[i * 129 + lane] = q0 * sq; qs[i * 129 + 64 + lane] = q1 * sq; ks[i * 129 + lane] = k0 * sk; ks[i * 129 + 64 + lane] = k1 * sk;
            }
            __syncthreads();
            if (((args.pad >> 2) & 7) == 2) continue;
            {
                const int which = wave >> 2, ta = (wave >> 1) & 1, tb = wave & 1;
                if (tb <= ta) {
                    f32x16 acc;
#pragma unroll
                    for (int q = 0; q < 16; ++q) acc[q] = 0.f;
                    const ldsf* Ap = ks + (32 * (which == 0 ? ta : tb) + r) * 129 + 8 * h;
                    const ldsf* Bp = (which == 0 ? ks + (32 * tb + r) * 129 : qs + (32 * ta + r) * 129) + 8 * h;
#pragma unroll 4
                    for (int k = 0; k < 8; ++k) {
                        v4u pa, pb;
                        pa.x = cvtpk(Ap[16 * k + 0], Ap[16 * k + 1]); pa.y = cvtpk(Ap[16 * k + 2], Ap[16 * k + 3]); pa.z = cvtpk(Ap[16 * k + 4], Ap[16 * k + 5]); pa.w = cvtpk(Ap[16 * k + 6], Ap[16 * k + 7]);
                        pb.x = cvtpk(Bp[16 * k + 0], Bp[16 * k + 1]); pb.y = cvtpk(Bp[16 * k + 2], Bp[16 * k + 3]); pb.z = cvtpk(Bp[16 * k + 4], Bp[16 * k + 5]); pb.w = cvtpk(Bp[16 * k + 6], Bp[16 * k + 7]);
                        acc = MFMA32(__builtin_bit_cast(bf16x8, pa), __builtin_bit_cast(bf16x8, pb), acc);
                    }
                    if (which == 0) {
                        const int j = 32 * tb + r; const float gj = gc[j];
#pragma unroll
                        for (int q = 0; q < 16; ++q) { const int i = 32 * ta + crow(q, h); Ls[i * LSTR + j] = (j < i) ? bt[i] * acc[q] * __expf(gc[i] - gj) : 0.f; }
                    } else {
                        const int i = 32 * ta + r; const float gi = gc[i];
#pragma unroll
                        for (int q = 0; q < 16; ++q) { const int j = 32 * tb + crow(q, h); acc[q] = (j <= i) ? acc[q] * __expf(gi - gc[j]) : 0.f; }
#pragma unroll
                        for (int s2 = 0; s2 < 2; ++s2) *(bf16x8*)(ops + (48 + (ta * 2 + tb) * 2 + s2) * 1024 + lane * 16) = pack8(acc, s2);
                    }
                }
            }
            __syncthreads();
            if (((args.pad >> 2) & 7) == 3) continue;
            if (wave < 4) {
                const int d = tid & 127; const bool isw = tid >= 128;
                int z; asm volatile("v_mov_b32 %0, 0" : "=v"(z));
                const ldsf* Lz = Ls + z; const ldsf* btz = bt + z; const ldsf* egz = eg + z;
                float xr[32];
                const ldsf* srcx = (isw ? ks : vs) + d;
                ldsf* dst = (isw ? Wsm : vs) + d;
#pragma unroll
                for (int i = 0; i < 32; ++i) { const float e_ = egz[i]; xr[i] = srcx[i * 129] * btz[i] * (isw ? e_ : 1.0f); }
#pragma unroll
                for (int i = 32; i < 64; ++i) { const float e_ = egz[i]; dst[i * 129] = srcx[i * 129] * btz[i] * (isw ? e_ : 1.0f); }
#pragma unroll
                for (int i = 1; i < 32; ++i) {
                    float s0 = xr[i], s1 = 0.f;
#pragma unroll
                    for (int j4 = 0; j4 < (i + 3) / 4; ++j4) {
                        const f32x4 l = *(const LAS f32x4*)(Lz + i * LSTR + 4 * j4);
                        s0 -= l[0] * xr[4 * j4]; s1 -= l[1] * xr[4 * j4 + 1]; s0 -= l[2] * xr[4 * j4 + 2]; s1 -= l[3] * xr[4 * j4 + 3];
                    }
                    xr[i] = s0 + s1;
                    asm volatile("" ::: "memory");
                }
#pragma unroll
                for (int i = 0; i < 32; ++i) dst[i * 129] = xr[i];
            } else {
#pragma unroll 1
                for (int ff = 0; ff < 8; ++ff) {
                    const int f = (wave - 4) * 8 + ff;
                    v4u p; float v8[8];
                    if (f < 16) { const int mt = f >> 3, t2 = (f >> 1) & 3, s2 = f & 1; const int i = 32 * mt + r; const float e = eg[i];
#pragma unroll
                        for (int j = 0; j < 8; ++j) v8[j] = qs[i * 129 + 32 * t2 + 16 * s2 + 8 * (j >> 2) + 4 * h + (j & 3)] * e;
                    } else { const int g2 = f - 16, t2 = g2 >> 2, mt = (g2 >> 1) & 1, s2 = g2 & 1; const int d = 32 * t2 + r;
#pragma unroll
                        for (int j = 0; j < 8; ++j) { const int i = 32 * mt + 16 * s2 + 8 * (j >> 2) + 4 * h + (j & 3); v8[j] = ks[i * 129 + d] * ekd[i]; }
                    }
                    p.x = cvtpk(v8[0], v8[1]); p.y = cvtpk(v8[2], v8[3]); p.z = cvtpk(v8[4], v8[5]); p.w = cvtpk(v8[6], v8[7]);
                    *(v4u*)(ops + (16 + f) * 1024 + lane * 16) = p;
                }
            }
            __syncthreads();
            {
                ldsf* X = (wave < 4) ? vs + 32 * wave : Wsm + 32 * (wave - 4);
                f32x16 acc;
#pragma unroll
                for (int q = 0; q < 16; ++q) acc[q] = X[(32 + crow(q, h)) * 129 + r];
                const ldsf* Ap = Ls + (32 + r) * LSTR + h;
                const ldsf* Bp = X + h * 129 + r;
#pragma unroll 8
                for (int k = 0; k < 16; ++k) acc = __builtin_amdgcn_mfma_f32_32x32x2f32(-Ap[2 * k], Bp[(2 * k) * 129], acc, 0, 0, 0);
#pragma unroll
                for (int q = 0; q < 16; ++q) X[(32 + crow(q, h)) * 129 + r] = acc[q];
            }
            __syncthreads();
            if (wave < 4) {
                const int d = tid & 127; const bool isw = tid >= 128;
                int z; asm volatile("v_mov_b32 %0, 0" : "=v"(z));
                const ldsf* Lz = Ls + z;
                ldsf* dst = (isw ? Wsm : vs) + d;
                float xr[32];
#pragma unroll
                for (int i = 0; i < 32; ++i) xr[i] = dst[(32 + i) * 129];
#pragma unroll
                for (int i = 1; i < 32; ++i) {
                    float s0 = xr[i], s1 = 0.f;
#pragma unroll
                    for (int j4 = 0; j4 < (i + 3) / 4; ++j4) {
                        const f32x4 l = *(const LAS f32x4*)(Lz + (32 + i) * LSTR + 32 + 4 * j4);
                        s0 -= l[0] * xr[4 * j4]; s1 -= l[1] * xr[4 * j4 + 1]; s0 -= l[2] * xr[4 * j4 + 2]; s1 -= l[3] * xr[4 * j4 + 3];
                    }
                    xr[i] = s0 + s1;
                    asm volatile("" ::: "memory");
                }
#pragma unroll
                for (int i = 0; i < 32; ++i) dst[(32 + i) * 129] = xr[i];
            }
            __syncthreads();
            if (((args.pad >> 2) & 7) == 4) continue;
#pragma unroll
            for (int o = 0; o < 2; ++o) {
                const int idx8 = tid + NTHR * o, l2 = idx8 & 63, q8 = (idx8 >> 6) & 1, mt = (idx8 >> 7) & 1, w = idx8 >> 8;
                const int c = 32 * w + (l2 & 31), hh2 = l2 >> 5;
                float u8[8];
#pragma unroll
                for (int e = 0; e < 8; ++e) u8[e] = vs[(32 * mt + crow(8 * q8 + e, hh2)) * 129 + c];
                v4u p; p.x = cvtpk(u8[0], u8[1]); p.y = cvtpk(u8[2], u8[3]); p.z = cvtpk(u8[4], u8[5]); p.w = cvtpk(u8[6], u8[7]);
                *(v4u*)((unsigned char*)Ub + (size_t)item * 16384 + idx8 * 16) = p;
            }
#pragma unroll
            for (int ff = 0; ff < 2; ++ff) {
                const int f = wave * 2 + ff, mt = f >> 3, t2 = (f >> 1) & 3, s2 = f & 1; const int i = 32 * mt + r;
                float v8[8];
#pragma unroll
                for (int j = 0; j < 8; ++j) v8[j] = -Wsm[i * 129 + 32 * t2 + 16 * s2 + 8 * (j >> 2) + 4 * h + (j & 3)];
                v4u p; p.x = cvtpk(v8[0], v8[1]); p.y = cvtpk(v8[2], v8[3]); p.z = cvtpk(v8[4], v8[5]); p.w = cvtpk(v8[6], v8[7]);
                *(v4u*)(ops + f * 1024 + lane * 16) = p;
            }
            __syncthreads();
        }
        {
            const int r = lane & 31, h = lane >> 5;
            for (int it = (args.pad & 2) ? 2048 : gw; it < 2048; it += NGW) {
                const int c = it & 127, hh = (it >> 7) & 7, b = it >> 10;
                const bf16* base = projb + ((size_t)b * T + c * 64) * PCOLS + hh * 64;
#pragma unroll
                for (int kb2 = 0; kb2 < 2; ++kb2)
#pragma unroll
                    for (int ks = 0; ks < 4; ++ks) {
                        const bf16* rp = base + (size_t)(32 * kb2 + r) * PCOLS + 16 * ks + 8 * h;
                        *(v4u*)(qfb + (size_t)it * 8192 + (kb2 * 4 + ks) * 1024 + lane * 16) = *(const v4u*)(rp + 2048);
                        *(v4u*)(kfb + (size_t)it * 8192 + (kb2 * 4 + ks) * 1024 + lane * 16) = *(const v4u*)(rp + 2560);
                    }
#pragma unroll
                for (int dt = 0; dt < 2; ++dt)
#pragma unroll
                    for (int kb2 = 0; kb2 < 2; ++kb2)
#pragma unroll
                        for (int s2 = 0; s2 < 2; ++s2) {
                            unsigned short e8[8];
#pragma unroll
                            for (int j = 0; j < 8; ++j) e8[j] = base[(size_t)(32 * kb2 + 16 * s2 + 8 * (j >> 2) + 4 * h + (j & 3)) * PCOLS + 3072 + 32 * dt + r];
                            v4u p; p.x = e8[0] | ((unsigned)e8[1] << 16); p.y = e8[2] | ((unsigned)e8[3] << 16); p.z = e8[4] | ((unsigned)e8[5] << 16); p.w = e8[6] | ((unsigned)e8[7] << 16);
                            *(v4u*)(vtfb + (size_t)it * 8192 + ((dt * 2 + kb2) * 2 + s2) * 1024 + lane * 16) = p;
                        }
            }
        }
        if (BOTH(3)) GRID_BAR();
    }

    if (IN(4)) {
        const int lane = (int)__builtin_amdgcn_mbcnt_hi(~0u, __builtin_amdgcn_mbcnt_lo(~0u, 0u)), tid = wave * 64 + lane; const kargp_t ap_ = karg_ptr();
        if (bx < 64) {
            constexpr int SEGC = 16;
            const int bh = bx & 7, seg = bx >> 3, b = bh >> 2, hh = bh & 3;
            const int r = lane & 31, h = lane >> 5;
            const int c0 = seg * SEGC;
#define SCAN_BAR() do { asm volatile("s_waitcnt lgkmcnt(0)" ::: "memory"); __builtin_amdgcn_s_barrier(); asm volatile("" ::: "memory"); } while (0)
#define FRAG(f_) (*(const LAS bf16x8*)(Bf + (f_) * 1024))
            {
                const unsigned char* ops = opsb + (size_t)(bh * 128 + c0) * OPS_BYTES;
                const float* Uf = (const float*)((const unsigned char*)Ub + (size_t)(bh * 128 + c0) * 16384);
                float* segp = (float*)(args.ws + WS_SEG) + (size_t)(bh * 8 + seg) * 32768;
                ldsf* egls = (ldsf*)(lds + 4 * 32768);
                if (tid < SEGC) egls[tid] = glbuf[bh * 128 + c0 + tid];
                const int pbase = (wave < 6) ? (wave - 4) * 8 : 32 + (wave - 6) * 8, fbase = (wave - 4) * 8;
#define A_DMA(n_) do { const unsigned char* src_ = ops + (size_t)(n_) * OPS_BYTES + pbase * 1024 + lane * 16; \
                _Pragma("unroll") for (int p_ = 0; p_ < 8; ++p_) __builtin_amdgcn_global_load_lds((const unsigned*)(src_ + p_ * 1024), (LAS unsigned*)(lds + ((n_) & 3) * 32768 + (fbase + p_) * 1024), 16, 0, 0); } while (0)
                f32x16 S[4]; v4u Ur[4];
#pragma unroll
                for (int t2 = 0; t2 < 4; ++t2)
#pragma unroll
                    for (int q = 0; q < 16; ++q) S[t2][q] = (wave >= 4 && (32 * t2 + crow(q, h)) == (32 * (wave - 4) + r)) ? 1.0f : 0.0f;
#pragma unroll
                for (int f = 0; f < 4; ++f) Ur[f] = (v4u){0u, 0u, 0u, 0u};
                if (wave < 4) {
#pragma unroll
                    for (int f = 0; f < 4; ++f) Ur[f] = *((const v4u*)Uf + (wave * 4 + f) * 64 + lane);
                } else { A_DMA(0); A_DMA(1); A_DMA(2); }
                for (int n = 0; n < SEGC; ++n) {
                    if (wave >= 4) { if (n <= SEGC - 3) asm volatile("s_waitcnt vmcnt(16)" ::: "memory"); else if (n == SEGC - 2) asm volatile("s_waitcnt vmcnt(8)" ::: "memory"); else asm volatile("s_waitcnt vmcnt(0)" ::: "memory"); }
                    SCAN_BAR();
                    if (wave >= 4 && n + 3 < SEGC) A_DMA(n + 3);
                    const LAS unsigned char* Bf = lds + (n & 3) * 32768 + lane * 16;
                    f32x16 VN[2];
#pragma unroll
                    for (int mt = 0; mt < 2; ++mt)
#pragma unroll
                        for (int q8 = 0; q8 < 2; ++q8) { const v4u u = Ur[mt * 2 + q8];
                            VN[mt][8 * q8 + 0] = bflo(u.x); VN[mt][8 * q8 + 1] = bfhi(u.x); VN[mt][8 * q8 + 2] = bflo(u.y); VN[mt][8 * q8 + 3] = bfhi(u.y);
                            VN[mt][8 * q8 + 4] = bflo(u.z); VN[mt][8 * q8 + 5] = bfhi(u.z); VN[mt][8 * q8 + 6] = bflo(u.w); VN[mt][8 * q8 + 7] = bfhi(u.w); }
                    if (wave < 4 && n + 1 < SEGC) {
                        const v4u* up = (const v4u*)((const unsigned char*)Uf + (size_t)(n + 1) * 16384) + (wave * 4) * 64 + lane;
#pragma unroll
                        for (int f = 0; f < 4; ++f) Ur[f] = up[f * 64];
                    }
                    const float egl = egls[n];
#pragma unroll
                    for (int t2 = 0; t2 < 4; ++t2)
#pragma unroll
                        for (int s2 = 0; s2 < 2; ++s2) {
                            const bf16x8 sb = pack8(S[t2], s2);
#pragma unroll
                            for (int mt = 0; mt < 2; ++mt) VN[mt] = MFMA32(FRAG((mt * 4 + t2) * 2 + s2), sb, VN[mt]);
                        }
                    bf16x8 vb[2][2];
#pragma unroll
                    for (int mt = 0; mt < 2; ++mt)
#pragma unroll
                        for (int s2 = 0; s2 < 2; ++s2) vb[mt][s2] = pack8(VN[mt], s2);
#pragma unroll
                    for (int t2 = 0; t2 < 4; ++t2) {
#pragma unroll
                        for (int q = 0; q < 16; ++q) S[t2][q] *= egl;
#pragma unroll
                        for (int mt = 0; mt < 2; ++mt)
#pragma unroll
                            for (int s2 = 0; s2 < 2; ++s2) S[t2] = MFMA32(FRAG(16 + (t2 * 2 + mt) * 2 + s2), vb[mt][s2], S[t2]);
                    }
                }
#undef A_DMA
                if (wave < 4) {
#pragma unroll
                    for (int t2 = 0; t2 < 4; ++t2)
#pragma unroll
                        for (int q = 0; q < 16; ++q) segp[((wave * 4 + t2) * 16 + q) * 64 + lane] = S[t2][q];
                } else {
                    unsigned short* pp = (unsigned short*)(args.ws + WS_SEGP) + (size_t)(bh * 8 + seg) * 16384 + (((wave - 4) * 2 + (r >> 4)) * 64 + 32 * ((r >> 3) & 1)) * 8 + (r & 7);
#pragma unroll
                    for (int t2 = 0; t2 < 4; ++t2)
#pragma unroll
                        for (int q = 0; q < 16; ++q) pp[(t2 * 8 * 64 + crow(q, h)) * 8] = (unsigned short)f2bf(S[t2][q]);
                }
            }
            asm volatile("s_waitcnt vmcnt(0)" ::: "memory");
            __syncthreads();
            if (tid == 0) { __builtin_amdgcn_fence(__ATOMIC_RELEASE, "agent"); asm volatile("s_waitcnt vmcnt(0)" ::: "memory"); __hip_atomic_fetch_add(ctl + CW_SEGA + 64 * bh, 1u, RLX_AGENT); }
            if (seg == 0) {
                if (tid == 0) { unsigned sp_ = 0; while (__hip_atomic_load(ctl + CW_SEGA + 64 * bh, RLX_AGENT) < 8u) { __builtin_amdgcn_s_sleep(4); if (++sp_ > (1u << 24)) break; }
                    __builtin_amdgcn_fence(__ATOMIC_ACQUIRE, "agent"); asm volatile("s_waitcnt vmcnt(0)" ::: "memory"); }
                __syncthreads();
                constexpr int ST_ROW = 272, ST_BYTES = 128 * ST_ROW;
                const int nt = wave & 3, mt0 = 2 * (wave >> 2);
                const float* seg0 = (const float*)(args.ws + WS_SEG) + (size_t)(bh * 8) * 32768;
                const unsigned char* pa0 = args.ws + WS_SEGP + (size_t)(bh * 8) * 32768 + lane * 16;
                float* sst0 = (float*)(args.ws + WS_SST) + (size_t)(bh * 8) * 16384;
#define PB_LOADA(dst, k_) do { const unsigned char* pk_ = pa0 + (size_t)(k_) * 32768; \
                    _Pragma("unroll") for (int i_ = 0; i_ < 2; ++i_) _Pragma("unroll") for (int f_ = 0; f_ < 8; ++f_) dst[i_ * 8 + f_] = *(const bf16x8*)(pk_ + (((mt0 + i_) * 4) * 2 + f_) * 1024); } while (0)
#define PB_ITER(k_, Acur, Anext) do { \
                    if ((k_) + 1 <= 6) PB_LOADA(Anext, (k_) + 1); \
                    const float* sk_ = seg0 + (size_t)(k_) * 32768; \
                    f32x16 z0_[2], Z_[2]; \
                    _Pragma("unroll") for (int i_ = 0; i_ < 2; ++i_) _Pragma("unroll") for (int q_ = 0; q_ < 16; ++q_) { z0_[i_][q_] = sk_[((nt * 4 + mt0 + i_) * 16 + q_) * 64 + lane]; Z_[i_][q_] = 0.f; } \
                    if ((k_) > 0) { const LAS unsigned char* stc_ = lds + ((k_) & 1) * ST_BYTES + (32 * nt + r) * ST_ROW + 16 * h; \
                        _Pragma("unroll") for (int f_ = 0; f_ < 8; ++f_) { const bf16x8 bfr_ = *(const LAS bf16x8*)(stc_ + (16 * f_) * 2); \
                            Z_[0] = MFMA32(Acur[f_], bfr_, Z_[0]); Z_[1] = MFMA32(Acur[8 + f_], bfr_, Z_[1]); } } \
                    float* so_ = sst0 + (size_t)((k_) + 1) * 16384; \
                    LAS unsigned char* stn_ = lds + (((k_) + 1) & 1) * ST_BYTES + (32 * nt + r) * ST_ROW; \
                    _Pragma("unroll") for (int i_ = 0; i_ < 2; ++i_) { \
                        _Pragma("unroll") for (int q_ = 0; q_ < 16; ++q_) { Z_[i_][q_] += z0_[i_][q_]; so_[((nt * 4 + mt0 + i_) * 16 + q_) * 64 + lane] = Z_[i_][q_]; } \
                        _Pragma("unroll") for (int q_ = 0; q_ < 16; q_ += 2) *(LAS unsigned*)(stn_ + (32 * (mt0 + i_) + crow(q_, h)) * 2) = cvtpk(Z_[i_][q_], Z_[i_][q_ + 1]); } \
                    SCAN_BAR(); } while (0)
                bf16x8 Aa[16], Ab[16];
#pragma unroll
                for (int f = 0; f < 16; ++f) { Aa[f] = (bf16x8){0, 0, 0, 0, 0, 0, 0, 0}; Ab[f] = Aa[f]; }
                PB_ITER(0, Ab, Aa);
                PB_ITER(1, Aa, Ab);
                PB_ITER(2, Ab, Aa);
                PB_ITER(3, Aa, Ab);
                PB_ITER(4, Ab, Aa);
                PB_ITER(5, Aa, Ab);
                PB_ITER(6, Ab, Aa);
#undef PB_ITER
#undef PB_LOADA
                asm volatile("s_waitcnt vmcnt(0)" ::: "memory");
                __syncthreads();
                if (tid == 0) { __builtin_amdgcn_fence(__ATOMIC_RELEASE, "agent"); asm volatile("s_waitcnt vmcnt(0)" ::: "memory"); __hip_atomic_store(ctl + CW_SEGB + 64 * bh, 1u, RLX_AGENT); }
            }
            if (tid == 0) { unsigned sp_ = 0; while (__hip_atomic_load(ctl + CW_SEGB + 64 * bh, RLX_AGENT) == 0u) { __builtin_amdgcn_s_sleep(4); if (++sp_ > (1u << 24)) break; }
                __builtin_amdgcn_fence(__ATOMIC_ACQUIRE, "agent"); asm volatile("s_waitcnt vmcnt(0)" ::: "memory"); }
            __syncthreads();
#undef FRAG
            const kargp_t ap2_ = karg_ptr();
            const unsigned char* ops = ((*ap2_).ws + WS_OPS) + (size_t)(bh * 128 + c0) * OPS_BYTES;
            const float* Uf = (const float*)((const unsigned char*)((*ap2_).ws + WS_U) + (size_t)(bh * 128 + c0) * 16384);
            const float* sstp = (const float*)((*ap2_).ws + WS_SST) + (size_t)(bh * 8 + seg) * 16384;
#define SCAN_DMA(n_, buf_) do { const unsigned char* src_ = ops + (size_t)(n_) * OPS_BYTES + ((wave - 4) * 14) * 1024 + lane * 16; \
            _Pragma("unroll") for (int p_ = 0; p_ < 14; ++p_) __builtin_amdgcn_global_load_lds((const unsigned*)(src_ + p_ * 1024), (LAS unsigned*)(lds + (buf_) * OPS_BYTES + ((wave - 4) * 14 + p_) * 1024), 16, 0, 0); } while (0)
            constexpr int STG_OFF = 2 * OPS_BYTES, STG_ROW = 272, STG_BYTES = 64 * STG_ROW;
            if (wave < 4) {
                f32x16 S[4]; v4u Ur[4];
#pragma unroll
                for (int t2 = 0; t2 < 4; ++t2)
#pragma unroll
                    for (int q = 0; q < 16; ++q) S[t2][q] = (seg > 0) ? sstp[((wave * 4 + t2) * 16 + q) * 64 + lane] : 0.f;
#pragma unroll
                for (int f = 0; f < 4; ++f) Ur[f] = *((const v4u*)Uf + (wave * 4 + f) * 64 + lane);
                const float* glp = glbuf + bh * 128 + c0;
                float eglr = glp[0];
                for (int n = 0; n < SEGC; ++n) {
                    SCAN_BAR();
                    const LAS unsigned char* Bf = lds + (n & 1) * OPS_BYTES + lane * 16;
#define FRAG(f_) (*(const LAS bf16x8*)(Bf + (f_) * 1024))
                    f32x16 VN[2], O[2];
#pragma unroll
                    for (int mt = 0; mt < 2; ++mt)
#pragma unroll
                        for (int q8 = 0; q8 < 2; ++q8) { const v4u u = Ur[mt * 2 + q8];
                            VN[mt][8 * q8 + 0] = bflo(u.x); VN[mt][8 * q8 + 1] = bfhi(u.x); VN[mt][8 * q8 + 2] = bflo(u.y); VN[mt][8 * q8 + 3] = bfhi(u.y);
                            VN[mt][8 * q8 + 4] = bflo(u.z); VN[mt][8 * q8 + 5] = bfhi(u.z); VN[mt][8 * q8 + 6] = bflo(u.w); VN[mt][8 * q8 + 7] = bfhi(u.w); }
                    const float egl = eglr;
                    if (n + 1 < SEGC) {
                        const v4u* up = (const v4u*)((const unsigned char*)Uf + (size_t)(n + 1) * 16384) + (wave * 4) * 64 + lane;
#pragma unroll
                        for (int f = 0; f < 4; ++f) Ur[f] = up[f * 64];
                        eglr = glp[n + 1];
                    }
#pragma unroll
                    for (int mt = 0; mt < 2; ++mt)
#pragma unroll
                        for (int q = 0; q < 16; ++q) O[mt][q] = 0.f;
#pragma unroll
                    for (int t2 = 0; t2 < 4; ++t2)
#pragma unroll
                        for (int s2 = 0; s2 < 2; ++s2) {
                            const bf16x8 sb = pack8(S[t2], s2);
#pragma unroll
                            for (int mt = 0; mt < 2; ++mt) {
                                VN[mt] = MFMA32(FRAG((mt * 4 + t2) * 2 + s2), sb, VN[mt]);
                                O[mt] = MFMA32(FRAG(16 + (mt * 4 + t2) * 2 + s2), sb, O[mt]);
                            }
                        }
                    bf16x8 vb[2][2];
#pragma unroll
                    for (int mt = 0; mt < 2; ++mt)
#pragma unroll
                        for (int s2 = 0; s2 < 2; ++s2) vb[mt][s2] = pack8(VN[mt], s2);
#pragma unroll
                    for (int s2 = 0; s2 < 2; ++s2) {
                        O[0] = MFMA32(FRAG(48 + 0 * 2 + s2), vb[0][s2], O[0]);
                        O[1] = MFMA32(FRAG(48 + 2 * 2 + s2), vb[0][s2], O[1]);
                        O[1] = MFMA32(FRAG(48 + 3 * 2 + s2), vb[1][s2], O[1]);
                    }
                    {
                        LAS unsigned short* sp = (LAS unsigned short*)(lds + STG_OFF + (n & 1) * STG_BYTES) + 32 * wave + r;
#pragma unroll
                        for (int mt = 0; mt < 2; ++mt)
#pragma unroll
                            for (int q = 0; q < 16; q += 2) { const unsigned w = cvtpk(O[mt][q], O[mt][q + 1]);
                                sp[(32 * mt + crow(q, h)) * (STG_ROW / 2)] = (unsigned short)(w & 0xffffu); sp[(32 * mt + crow(q + 1, h)) * (STG_ROW / 2)] = (unsigned short)(w >> 16); }
                    }
                    SCAN_BAR();
#pragma unroll
                    for (int t2 = 0; t2 < 4; ++t2) {
#pragma unroll
                        for (int q = 0; q < 16; ++q) S[t2][q] *= egl;
#pragma unroll
                        for (int mt = 0; mt < 2; ++mt)
#pragma unroll
                            for (int s2 = 0; s2 < 2; ++s2) S[t2] = MFMA32(FRAG(32 + (t2 * 2 + mt) * 2 + s2), vb[mt][s2], S[t2]);
                    }
#undef FRAG
                }
                SCAN_BAR();
            } else {
                const int w4 = wave - 4, row = 16 * w4 + (lane >> 2), qt = lane & 3;
                const bf16* zp = zsb + ((size_t)b * T + c0 * 64 + row) * 512 + hh * 128 + qt * 32;
                bf16* op = omix + ((size_t)b * T + c0 * 64 + row) * D + hh * 128 + qt * 32;
                SCAN_DMA(0, 0);
                asm volatile("s_waitcnt vmcnt(0)" ::: "memory");
                v4u zr[4];
#pragma unroll
                for (int k = 0; k < 4; ++k) zr[k] = *(const v4u*)(zp + 8 * k);
                unsigned pfacc = 0u, pf0 = 0u, pf1 = 0u;
                for (int n = 0; n <= SEGC; ++n) {
                    SCAN_BAR();
                    if (n < SEGC - 1) SCAN_DMA(n + 1, (n + 1) & 1);
                    asm volatile("" ::: "memory");
                    if (n < SEGC - 2) {
                        const unsigned char* pf = ops + (size_t)(n + 2) * OPS_BYTES + (w4 * 112 + lane) * 128;
                        pfacc += pf0 + pf1; pf0 = *(const unsigned*)pf; pf1 = (lane < 48) ? *(const unsigned*)(pf + 64 * 128) : 0u;
                    }
                    asm volatile("" ::: "memory");
                    if (n < SEGC) SCAN_BAR();
                    if (n > 0) {
                        const LAS unsigned char* sp = lds + STG_OFF + ((n - 1) & 1) * STG_BYTES + row * STG_ROW + qt * 64;
                        v4u ov[4]; float ss = 0.f;
#pragma unroll
                        for (int k = 0; k < 4; ++k) { ov[k] = *(const LAS v4u*)(sp + 16 * k);
                            const float a0 = bflo(ov[k].x), a1 = bfhi(ov[k].x), a2 = bflo(ov[k].y), a3 = bfhi(ov[k].y), a4 = bflo(ov[k].z), a5 = bfhi(ov[k].z), a6 = bflo(ov[k].w), a7 = bfhi(ov[k].w);
                            ss += (a0 * a0 + a1 * a1) + (a2 * a2 + a3 * a3) + (a4 * a4 + a5 * a5) + (a6 * a6 + a7 * a7); }
                        ss += __shfl_xor(ss, 1); ss += __shfl_xor(ss, 2);
                        const float rstd = rsqrtf(ss * (1.0f / 128.0f) + EPS);
                        bf16* o2 = op + (size_t)(n - 1) * 64 * D;
#pragma unroll
                        for (int k = 0; k < 4; ++k) {
                            v4u w;
                            w.x = cvtpk(bflo(ov[k].x) * rstd * bflo(zr[k].x), bfhi(ov[k].x) * rstd * bfhi(zr[k].x));
                            w.y = cvtpk(bflo(ov[k].y) * rstd * bflo(zr[k].y), bfhi(ov[k].y) * rstd * bfhi(zr[k].y));
                            w.z = cvtpk(bflo(ov[k].z) * rstd * bflo(zr[k].z), bfhi(ov[k].z) * rstd * bfhi(zr[k].z));
                            w.w = cvtpk(bflo(ov[k].w) * rstd * bflo(zr[k].w), bfhi(ov[k].w) * rstd * bfhi(zr[k].w));
                            *(v4u*)(o2 + 8 * k) = w;
                        }
                    }
                    asm volatile("" ::: "memory");
                    if (n >= 1 && n < SEGC) {
#pragma unroll
                        for (int k = 0; k < 4; ++k) zr[k] = *(const v4u*)(zp + (size_t)n * 64 * 512 + 8 * k);
                    }
                    asm volatile("" ::: "memory");
                    if (n < SEGC) { if (n == 0 || n >= SEGC - 2) asm volatile("s_waitcnt vmcnt(0)" ::: "memory"); else asm volatile("s_waitcnt vmcnt(10)" ::: "memory"); }
                }
                if (pfacc == 0x12345679u) glbuf[1024 + lane] = 1.0f;
            }
#undef SCAN_DMA
#undef SCAN_BAR
        } else {
            const float* relb = args.in[I_RELB];
            ldsf* rbl = (ldsf*)lds;
            for (int idx = tid; idx < 8 * 257; idx += NTHR) rbl[idx] = relb[idx] * 1.4426950408889634f;
            __syncthreads();
            const int r = lane & 31, h = lane >> 5;
            const int AW = (G - 64) * NWAVES, aw = (bx - 64) * NWAVES + wave;
            for (int task = aw; task < 4096; task += AW) {
                const int qh = task & 1, hh = (task >> 1) & 7, n = (task >> 4) & 127, b = task >> 11;
                const int bhc = (b * 8 + hh) * 128;
                bf16x8 qf[4];
#pragma unroll
                for (int ks = 0; ks < 4; ++ks) qf[ks] = *(const bf16x8*)(qfb + (size_t)(bhc + n) * 8192 + (qh * 4 + ks) * 1024 + lane * 16);
                f32x16 OT[2];
#pragma unroll
                for (int dt = 0; dt < 2; ++dt)
#pragma unroll
                    for (int q = 0; q < 16; ++q) OT[dt][q] = 0.f;
                float m = -1e30f, l = 0.f;
                const float c0 = rbl[hh * 257 + 256];
                const int iq = 32 * qh + r;
                const int cb0 = (n >= 8) ? 0 : 8 - n;
                for (int blk = cb0 * 2; blk < 18; ++blk) {
                    const int cb = blk >> 1, kb2 = blk & 1, cidx = n - 8 + cb;
                    const unsigned char* kp = kfb + (size_t)(bhc + cidx) * 8192 + (kb2 * 4) * 1024 + lane * 16;
                    const unsigned char* vp = vtfb + (size_t)(bhc + cidx) * 8192 + lane * 16;
                    bf16x8 kf[4], vf[2][2];
#pragma unroll
                    for (int ks = 0; ks < 4; ++ks) kf[ks] = *(const bf16x8*)(kp + ks * 1024);
#pragma unroll
                    for (int dt = 0; dt < 2; ++dt)
#pragma unroll
                        for (int s2 = 0; s2 < 2; ++s2) vf[dt][s2] = *(const bf16x8*)(vp + ((dt * 2 + kb2) * 2 + s2) * 1024);
                    f32x16 st;
#pragma unroll
                    for (int q = 0; q < 16; ++q) st[q] = 0.f;
#pragma unroll
                    for (int ks = 0; ks < 4; ++ks) st = MFMA32(kf[ks], qf[ks], st);
                    if (cb >= 6) {
                        const int kpos0 = cb * 64 + 32 * kb2;
#pragma unroll
                        for (int q = 0; q < 16; ++q) { int rel = iq + 512 - (kpos0 + crow(q, h)); rel = rel > 128 ? 128 : rel; st[q] = st[q] * 0.18033688011112042f + rbl[hh * 257 + rel + 128]; }
                    } else {
#pragma unroll
                        for (int q = 0; q < 16; ++q) st[q] = st[q] * 0.18033688011112042f + c0;
                    }
                    float bm = st[0];
#pragma unroll
                    for (int q = 1; q < 16; ++q) bm = fmaxf(bm, st[q]);
                    bm = fmaxf(bm, __shfl_xor(bm, 32));
                    const float mn = fmaxf(m, bm);
                    if (__any(mn > m)) {
                        const float corr = __builtin_amdgcn_exp2f(m - mn);
                        l *= corr;
#pragma unroll
                        for (int dt = 0; dt < 2; ++dt)
#pragma unroll
                            for (int q = 0; q < 16; ++q) OT[dt][q] *= corr;
                        m = mn;
                    }
                    float ps = 0.f;
#pragma unroll
                    for (int q = 0; q < 16; ++q) { st[q] = __builtin_amdgcn_exp2f(st[q] - m); ps += st[q]; }
                    ps += __shfl_xor(ps, 32);
                    l += ps;
                    const bf16x8 p0 = pack8(st, 0), p1 = pack8(st, 1);
#pragma unroll
                    for (int dt = 0; dt < 2; ++dt) { OT[dt] = MFMA32(vf[dt][0], p0, OT[dt]); OT[dt] = MFMA32(vf[dt][1], p1, OT[dt]); }
                }
                const float inv = 1.0f / l;
                bf16* op = omix + ((size_t)b * T + n * 64 + iq) * D + 512 + hh * 64;
#pragma unroll
                for (int dt = 0; dt < 2; ++dt)
#pragma unroll
                    for (int q4 = 0; q4 < 4; ++q4) {
                        v2u w; w.x = cvtpk(OT[dt][4 * q4] * inv, OT[dt][4 * q4 + 1] * inv); w.y = cvtpk(OT[dt][4 * q4 + 2] * inv, OT[dt][4 * q4 + 3] * inv);
                        *(v2u*)(op + 32 * dt + 8 * q4 + 4 * h) = w;
                    }
            }
            __syncthreads();
            {
                ldsf* scr = (ldsf*)(lds + wave * 16384);
                constexpr int I_UP1 = 16 * 64, I_DN1 = 16 * 32;
                for (int it = aw; it < NE * (I_UP1 + I_DN1); it += AW) {
                    int r2 = it;
                    if (r2 < NE * I_UP1) { const int e = r2 / I_UP1; transpose_item8(args.in[I_WUP] + (size_t)e * D * 2048, D, 2048, (unsigned char*)WupT + (size_t)e * 2048 * D, 2, scr, r2 % I_UP1, lane); continue; } r2 -= NE * I_UP1;
                    { const int e = r2 / I_DN1; transpose_item8(args.in[I_WDN] + (size_t)e * D * D, D, D, (unsigned char*)WdnT + (size_t)e * D * D, 1, scr, r2 % I_DN1, lane); }
                }
            }
        }
        if (BOTH(4)) GRID_BAR();
    }


    if (IN(6)) {
        const int lane = (int)__builtin_amdgcn_mbcnt_hi(~0u, __builtin_amdgcn_mbcnt_lo(~0u, 0u)), tid = wave * 64 + lane; const kargp_t ap_ = karg_ptr();
        pg8::Gemm g{omix, WoutT, NTOK, D, D}; pg8::StaticOrder S; S.init(NTOK, D, G, bx);
        pg8::EpiBf16 E{ybuf, D, nullptr, nullptr, 0, 1.0f};
        pg8::gemm_phase<pg8::EpiBf16, pg8::StaticOrder, true, true>(lds, g, S, E, tid);
        if (BOTH(6)) GRID_BAR();
    }

    if (IN(7)) {
        const int lane = (int)__builtin_amdgcn_mbcnt_hi(~0u, __builtin_amdgcn_mbcnt_lo(~0u, 0u)), tid = wave * 64 + lane; const kargp_t ap_ = karg_ptr();
        ldsf* wrT = (ldsf*)lds;
        { const char* src = (const char*)(P_WS + WS_WR) + (size_t)wave * 16384 + lane * 16;
#pragma unroll
          for (int p = 0; p < 16; ++p) __builtin_amdgcn_global_load_lds((const unsigned*)(src + p * 1024), (LAS unsigned*)(lds + wave * 16384 + p * 1024), 16, 0, 0); }
        LAS int* lcnt = (LAS int*)(lds + 131072);
        if (tid < 32) lcnt[tid] = 0;
        asm volatile("s_waitcnt vmcnt(0)" ::: "memory");
        __syncthreads();
        const float* nw1 = args.in[I_NORMW] + 1024; const float* nw2 = args.in[I_NORMW] + 2048; const float* b_r = args.in[I_BR];
        typedef unsigned u32x2_t __attribute__((ext_vector_type(2)));
        u32x2_t ynx[4]; f32x4 xnx[4];
#pragma unroll
        for (int j = 0; j < 4; ++j) { ynx[j] = *((const u32x2_t*)(ybuf + (size_t)gw * D) + lane + 64 * j); xnx[j] = *((const f32x4*)(Xp + (size_t)gw * D) + lane + 64 * j); }
        for (int bb = 0; bb < BATCH; ++bb) {
        f32x4 g1v[4], a2v[4], sh2v[4];
#pragma unroll
        for (int j = 0; j < 4; ++j) { const int col = 4 * lane + 256 * j;
            const f32x4 n1 = *(const f32x4*)(nw1 + col), ga = *(const f32x4*)(MODp + bb * 6144 + 2048 + col), n2 = *(const f32x4*)(nw2 + col), sc = *(const f32x4*)(MODp + bb * 6144 + 4096 + col);
            sh2v[j] = *(const f32x4*)(MODp + bb * 6144 + 3072 + col);
#pragma unroll
            for (int e = 0; e < 4; ++e) { g1v[j][e] = ga[e] * n1[e]; a2v[j][e] = n2[e] * (1.0f + sc[e]); } }
        for (int r = gw + bb * (NTOK / BATCH); r < (bb + 1) * (NTOK / BATCH); r += NGW) {
            f32x4 v[4], xv4[4]; float ss = 0.f;
#pragma unroll
            for (int j = 0; j < 4; ++j) { v[j] = (f32x4){__uint_as_float(ynx[j].x << 16), __uint_as_float(ynx[j].x & 0xffff0000u), __uint_as_float(ynx[j].y << 16), __uint_as_float(ynx[j].y & 0xffff0000u)}; xv4[j] = xnx[j]; ss += (v[j].x * v[j].x + v[j].y * v[j].y) + (v[j].z * v[j].z + v[j].w * v[j].w); }
            __builtin_amdgcn_sched_barrier(0);
            if (r + NGW < NTOK) {
#pragma unroll
                for (int j = 0; j < 4; ++j) { ynx[j] = *((const u32x2_t*)(ybuf + (size_t)(r + NGW) * D) + lane + 64 * j); xnx[j] = *((const f32x4*)(Xp + (size_t)(r + NGW) * D) + lane + 64 * j); }
            }
            __builtin_amdgcn_sched_barrier(0);
            const float rstd1 = rsqrtf(wave_sum(ss) * (1.0f / D) + EPS);
            float ss2 = 0.f;
#pragma unroll
            for (int j = 0; j < 4; ++j) {
#pragma unroll
                for (int e = 0; e < 4; ++e) { v[j][e] = xv4[j][e] + g1v[j][e] * (v[j][e] * rstd1); ss2 += v[j][e] * v[j][e]; }
            }
            const float rstd2 = rsqrtf(wave_sum(ss2) * (1.0f / D) + EPS);
            f32x4 hv[4]; unsigned h8[4];
#pragma unroll
            for (int j = 0; j < 4; ++j) {
#pragma unroll
                for (int e = 0; e < 4; ++e) hv[j][e] = v[j][e] * rstd2 * a2v[j][e] + sh2v[j][e];
                h8[j] = pg8::pk4_fp8(hv[j][0], hv[j][1], hv[j][2], hv[j][3]);
            }
#pragma unroll
            for (int j = 0; j < 4; ++j) { const int col = 4 * lane + 256 * j; *(f32x4*)(OUTp + (size_t)r * D + col) = v[j]; *(unsigned*)((unsigned char*)hbuf + (size_t)r * D + col) = h8[j]; }
            float pe[32];
#pragma unroll
            for (int e = 0; e < 32; ++e) {
                float p = 0.f;
#pragma unroll
                for (int j = 0; j < 4; ++j) { const f32x4 w = *(const LAS f32x4*)(wrT + e * 1024 + 4 * lane + 256 * j); p += (hv[j][0] * w[0] + hv[j][1] * w[1]) + (hv[j][2] * w[2] + hv[j][3] * w[3]); }
                pe[e] = p;
                if ((e & 1) == 1) asm volatile("" ::: "memory");
            }
            float r16[16];
            { const bool up = lane >= 32;
#pragma unroll
              for (int e = 0; e < 16; ++e) { const float send = up ? pe[e] : pe[e + 16], keep = up ? pe[e + 16] : pe[e]; r16[e] = keep + xchg32(send, lane); } }
            float r8[8];
            { const bool up = (lane & 16) != 0;
#pragma unroll
              for (int e = 0; e < 8; ++e) { const float send = up ? r16[e] : r16[e + 8], keep = up ? r16[e + 8] : r16[e]; r8[e] = keep + xchg16(send, lane); } }
            float r4[4];
            { const bool up = (lane & 8) != 0;
#pragma unroll
              for (int e = 0; e < 4; ++e) { const float send = up ? r8[e] : r8[e + 4], keep = up ? r8[e + 4] : r8[e]; r4[e] = keep + dppx<0x128>(send); } }
            float r2[2];
            { const bool up = (lane & 4) != 0;
#pragma unroll
              for (int e = 0; e < 2; ++e) { const float send = up ? r4[e] : r4[e + 2], keep = up ? r4[e + 2] : r4[e]; r2[e] = keep + __shfl_xor(send, 4); } }
            float r1;
            { const bool up = (lane & 2) != 0; const float send = up ? r2[0] : r2[1], keep = up ? r2[1] : r2[0]; r1 = keep + dppx<0x4E>(send); }
            r1 += dppx<0xB1>(r1);
            const int eid = ((lane >> 5) << 4) | (((lane >> 4) & 1) << 3) | (((lane >> 3) & 1) << 2) | (((lane >> 2) & 1) << 1) | ((lane >> 1) & 1);
            float mylg = r1 + b_r[eid];
            int se[4]; float sv[4];
#pragma unroll
            for (int k = 0; k < 4; ++k) {
                const float bv = wave_max(mylg); const int bi = wave_min_i(mylg == bv ? eid : 99);
                se[k] = bi; sv[k] = bv;
                if (eid == bi) mylg = -3.0e38f;
            }
            const float e1 = __expf(sv[1] - sv[0]), e2 = __expf(sv[2] - sv[0]), e3 = __expf(sv[3] - sv[0]);
            const float inv = 1.0f / (1.0f + e1 + e2 + e3);
            if (lane < 4 && !(args.pad & 32)) {
                const int mye = lane == 0 ? se[0] : (lane == 1 ? se[1] : (lane == 2 ? se[2] : se[3]));
                const float myg = (lane == 0 ? 1.0f : (lane == 1 ? e1 : (lane == 2 ? e2 : e3))) * inv;
                const unsigned pos = atomicAdd((unsigned*)lcnt + mye, 1u);
                asg_e[r * 4 + lane] = mye; asg_p[r * 4 + lane] = (int)pos; asg_g[r * 4 + lane] = myg;
            }
        }
        }
        __syncthreads();
        if (tid < 32) ((int*)(ctl + CW_HIST))[vcu * 32 + tid] = lcnt[tid];
        if (BOTH(7)) GRID_BAR();
    }

    LAS int* pst = (LAS int*)(lds + MISC_OFF + 512);
    LAS int* tile_e = (LAS int*)(lds + MISC_OFF + 768);
    LAS int* wbase = (LAS int*)(lds + MISC_OFF + 384);
    if (hi > 8 && lo <= 10) {
        const kargp_t ap_ = karg_ptr();
        const int tix = wave * 64 + (int)__builtin_amdgcn_mbcnt_hi(~0u, __builtin_amdgcn_mbcnt_lo(~0u, 0u));
        {
            LAS int* tmp = (LAS int*)lds;
            const int e = tix & 31, part = tix >> 5; int tot = 0, bef = 0;
            const int* hist = (const int*)(ctl + CW_HIST);
            for (int bb = part; bb < G; bb += 16) { const int c = hist[bb * 32 + e]; tot += c; bef += (bb < vcu) ? c : 0; }
            tmp[part * 32 + e] = tot; tmp[512 + part * 32 + e] = bef;
            __syncthreads();
            if (tix < 32) { int t2 = 0, b2 = 0;
#pragma unroll
                for (int p = 0; p < 16; ++p) { t2 += tmp[p * 32 + tix]; b2 += tmp[512 + p * 32 + tix]; }
                tmp[1024 + tix] = t2; wbase[tix] = b2; ((LAS int*)(lds + MISC_OFF + 1920))[tix] = t2; }
            __syncthreads();
            if (tix == 0) { int run = 0, rt = 0;
                for (int e2 = 0; e2 < NE; ++e2) { pst[e2] = run; const int c = tmp[1024 + e2]; const int nt = (c + 255) >> 8; for (int t2 = 0; t2 < nt; ++t2) tile_e[rt++] = e2; run += nt * 256; }
                pst[32] = run; }
        }
        __syncthreads();
    }
    const int nslots = (hi > 8 && lo <= 10) ? pst[32] : 0;

    if (IN(8)) {
        const int lane = (int)__builtin_amdgcn_mbcnt_hi(~0u, __builtin_amdgcn_mbcnt_lo(~0u, 0u)), tid = wave * 64 + lane; const kargp_t ap_ = karg_ptr();
        {
            int* stok = (int*)(P_WS + WS_STOK);
            for (int r = gw; r < NTOK; r += NGW) {
                if (lane < 4) { const int a = r * 4 + lane; const int e = asg_e[a], pos = asg_p[a]; const int slot = pst[e] + wbase[e] + pos; asg_s[a] = slot; stok[slot] = r; }
            }
            if (bx < NE) {
                const int c = ((LAS int*)(lds + MISC_OFF + 1920))[bx], pad = (c + 255) & ~255;
                for (int s2 = c + tid; s2 < pad; s2 += NTHR) stok[pst[bx] + s2] = 0;
            }
        }
        if (BOTH(8)) GRID_BAR();
    }

    if (IN(9)) {
        const int lane = (int)__builtin_amdgcn_mbcnt_hi(~0u, __builtin_amdgcn_mbcnt_lo(~0u, 0u)), tid = wave * 64 + lane; const kargp_t ap_ = karg_ptr();
        pg8::Gemm g{hbuf, WupT, nslots, 2048, D}; pg8::MoeOrder S; S.init(nslots, 2048, G, bx); S.tile_e = tile_e; S.estride = (size_t)2048 * D; S.rowidx = (const int*)(P_WS + WS_STOK);
        pg8::EpiSwiGLU E{(unsigned char*)actb, args.in[I_BUP], tile_e, 1.0f / 32.0f};
        pg8::gemm_phase<pg8::EpiSwiGLU, pg8::MoeOrder, true, true, true, true>(lds, g, S, E, tid);
        if (BOTH(9)) GRID_BAR();
    }

    if (IN(10)) {
        const int lane = (int)__builtin_amdgcn_mbcnt_hi(~0u, __builtin_amdgcn_mbcnt_lo(~0u, 0u)), tid = wave * 64 + lane; const kargp_t ap_ = karg_ptr();
        pg8::Gemm g{actb, WdnT, nslots, D, D}; pg8::MoeOrder S; S.init(nslots, D, G, bx); S.tile_e = tile_e; S.estride = (size_t)D * D;
        pg8::EpiBf16 E{yslot, D, args.in[I_BDN], tile_e, D, 1.0f / 32.0f};
        pg8::gemm_phase<pg8::EpiBf16, pg8::MoeOrder, true, true, true>(lds, g, S, E, tid);
        if (BOTH(10)) GRID_BAR();
    }

    if (IN(11)) {
        const int lane = (int)__builtin_amdgcn_mbcnt_hi(~0u, __builtin_amdgcn_mbcnt_lo(~0u, 0u)), tid = wave * 64 + lane; const kargp_t ap_ = karg_ptr();
        const float* nw3 = args.in[I_NORMW] + 3072;
        int sln[4]; float gtn[4];
#pragma unroll
        for (int k = 0; k < 4; ++k) { sln[k] = asg_s[gw * 4 + k]; gtn[k] = asg_g[gw * 4 + k]; }
        v2u ywn[4][4]; f32x4 xon[4]; float gtc[4];
#pragma unroll
        for (int k = 0; k < 4; ++k) { gtc[k] = gtn[k];
#pragma unroll
            for (int j = 0; j < 4; ++j) ywn[k][j] = *(const v2u*)(yslot + (size_t)sln[k] * D + 4 * lane + 256 * j); }
#pragma unroll
        for (int j = 0; j < 4; ++j) xon[j] = *(const f32x4*)(OUTp + (size_t)gw * D + 4 * lane + 256 * j);
        if (gw + NGW < NTOK) {
#pragma unroll
            for (int k = 0; k < 4; ++k) { sln[k] = asg_s[(gw + NGW) * 4 + k]; gtn[k] = asg_g[(gw + NGW) * 4 + k]; }
        }
        for (int bb = 0; bb < BATCH; ++bb) {
        f32x4 g3v[4];
#pragma unroll
        for (int j = 0; j < 4; ++j) { const int col = 4 * lane + 256 * j; const f32x4 n3 = *(const f32x4*)(nw3 + col), ga = *(const f32x4*)(MODp + bb * 6144 + 5120 + col);
#pragma unroll
            for (int e = 0; e < 4; ++e) g3v[j][e] = ga[e] * n3[e]; }
        for (int r = gw + bb * (NTOK / BATCH); r < (bb + 1) * (NTOK / BATCH); r += NGW) {
            v2u yw[4][4]; f32x4 xo[4]; float gt[4];
#pragma unroll
            for (int k = 0; k < 4; ++k) { gt[k] = gtc[k];
#pragma unroll
                for (int j = 0; j < 4; ++j) yw[k][j] = ywn[k][j]; }
#pragma unroll
            for (int j = 0; j < 4; ++j) xo[j] = xon[j];
            __builtin_amdgcn_sched_barrier(0);
            if (r + NGW < NTOK) {
#pragma unroll
                for (int k = 0; k < 4; ++k) { gtc[k] = gtn[k];
#pragma unroll
                    for (int j = 0; j < 4; ++j) ywn[k][j] = *(const v2u*)(yslot + (size_t)sln[k] * D + 4 * lane + 256 * j); }
#pragma unroll
                for (int j = 0; j < 4; ++j) xon[j] = *(const f32x4*)(OUTp + (size_t)(r + NGW) * D + 4 * lane + 256 * j);
                if (r + 2 * NGW < NTOK) {
#pragma unroll
                    for (int k = 0; k < 4; ++k) { sln[k] = asg_s[(r + 2 * NGW) * 4 + k]; gtn[k] = asg_g[(r + 2 * NGW) * 4 + k]; }
                }
            }
            __builtin_amdgcn_sched_barrier(0);
            f32x4 acc[4];
#pragma unroll
            for (int j = 0; j < 4; ++j) { acc[j] = (f32x4){0.f, 0.f, 0.f, 0.f};
#pragma unroll
                for (int k = 0; k < 4; ++k) { acc[j][0] += gt[k] * bflo(yw[k][j].x); acc[j][1] += gt[k] * bfhi(yw[k][j].x); acc[j][2] += gt[k] * bflo(yw[k][j].y); acc[j][3] += gt[k] * bfhi(yw[k][j].y); } }
            float ss = 0.f;
#pragma unroll
            for (int j = 0; j < 4; ++j) ss += (acc[j][0] * acc[j][0] + acc[j][1] * acc[j][1]) + (acc[j][2] * acc[j][2] + acc[j][3] * acc[j][3]);
            const float rstd = rsqrtf(wave_sum(ss) * (1.0f / D) + EPS);
#pragma unroll
            for (int j = 0; j < 4; ++j) {
                const int col = 4 * lane + 256 * j;
                f32x4 xv = xo[j];
#pragma unroll
                for (int e = 0; e < 4; ++e) xv[e] += g3v[j][e] * (acc[j][e] * rstd);
                if (!(args.pad & 32)) *(f32x4*)(OUTp + (size_t)r * D + col) = xv;
            }
        }
        }
    }
#undef IN
#undef BOTH
}

#undef P_WS
#undef ctl
#undef Xp
#undef OUTp
#undef MODp
#undef gbuf
#undef betabuf
#undef glbuf
#undef asg_e
#undef asg_p
#undef asg_g
#undef asg_s
#undef WinT
#undef WoutT
#undef WupT
#undef WdnT
#undef hbuf
#undef projb
#undef Ub
#undef opsb
#undef zsb
#undef qfb
#undef kfb
#undef vtfb
#undef omix
#undef ybuf
#undef xg
#undef actb
#undef yslot
#undef args
constexpr int NPHASES = 12;

extern "C" void kernel_launch(void* const* d_in, const int* in_sizes, int n_in, void* d_out, int out_size, void* d_ws, size_t ws_size, hipStream_t stream) {
    static int grid = 0;
    if (grid == 0) {
        if (n_in != 18 || out_size != NTOK * D || ws_size < WS_END) { fprintf(stderr, "kernel_launch: unexpected shapes (n_in %d out %d ws %zu)\n", n_in, out_size, ws_size); grid = -1; return; }
        int dev = 0, cus = 0, per_cu = 0;
        if (hipGetDevice(&dev) != hipSuccess || hipDeviceGetAttribute(&cus, hipDeviceAttributeMultiprocessorCount, dev) != hipSuccess) { grid = -1; return; }
        if (hipFuncSetAttribute((const void*)mk_fwd, hipFuncAttributeMaxDynamicSharedMemorySize, LDS_BYTES) != hipSuccess) { fprintf(stderr, "kernel_launch: hipFuncSetAttribute failed\n"); grid = -1; return; }
        if (hipOccupancyMaxActiveBlocksPerMultiprocessor(&per_cu, (const void*)mk_fwd, NTHR, LDS_BYTES) != hipSuccess || per_cu < 1) { fprintf(stderr, "kernel_launch: occupancy query says %d blocks per CU\n", per_cu); grid = -1; return; }
        (void)hipGetLastError();
        grid = cus;
    }
    if (grid < 0) return;
    (void)hipMemsetAsync((char*)d_ws + WS_CTL, 0, CTL_ZERO_BYTES, stream);
    Args a{};
    for (int i = 0; i < 18; ++i) a.in[i] = (const float*)d_in[i];
    a.out = (float*)d_out; a.ws = (unsigned char*)d_ws;
#if MK_ONE_LAUNCH
#ifndef PROBE_PHASE
#define PROBE_PHASE -1
#endif
#ifndef PROBE_SUB
#define PROBE_SUB 0
#endif
    if (PROBE_PHASE >= 0) {
        const int k = PROBE_PHASE;
        a.ph_lo = 0; a.ph_hi = k + 1; a.li = 0; hipLaunchKernelGGL(mk_fwd, dim3(grid), dim3(NTHR), LDS_BYTES, stream, a);
        a.ph_lo = k; a.ph_hi = k + 1; a.li = 1; a.pad = (k == 7 || k == 11) ? 32 : PROBE_SUB; hipLaunchKernelGGL(mk_fwd, dim3(grid), dim3(NTHR), LDS_BYTES, stream, a); a.pad = 0;
        if (k + 1 < NPHASES) { a.ph_lo = k + 1; a.ph_hi = NPHASES; a.li = 2; hipLaunchKernelGGL(mk_fwd, dim3(grid), dim3(NTHR), LDS_BYTES, stream, a); }
        return;
    }
    a.ph_lo = 0; a.ph_hi = NPHASES; a.li = 0;
    hipLaunchKernelGGL(mk_fwd, dim3(grid), dim3(NTHR), LDS_BYTES, stream, a);
#else
    for (int p = 0; p < NPHASES; ++p) { a.ph_lo = p; a.ph_hi = p + 1; a.li = p; hipLaunchKernelGGL(mk_fwd, dim3(grid), dim3(NTHR), LDS_BYTES, stream, a); }
#endif
}
```

```cpp
#include <hip/hip_runtime.h>
#include <cstdio>
#include <cstdint>

#ifndef MK_ONE_LAUNCH
#define MK_ONE_LAUNCH 1
#endif

namespace pg8 {
#define PG8_LAS __attribute__((address_space(3)))
typedef unsigned short bf16_t;
typedef short bf16x8 __attribute__((ext_vector_type(8)));
typedef float f32x4 __attribute__((ext_vector_type(4)));
typedef unsigned u32x4 __attribute__((ext_vector_type(4)));
constexpr int BM = 256, BK = 64, HALF = 128, HTB = HALF * BK * 2, STAGE_BYTES = 8 * HTB, NXCD = 8, WGM = 8;

__host__ __device__ __forceinline__ int lds_byte(int r, int c) { const int st = (r >> 4) * 2 + (c >> 5), rr = r & 15, cc = c & 31, ob = rr * 64 + cc * 2; return st * 1024 + (ob ^ (((ob >> 9) & 1) << 5)); }
__host__ __device__ __forceinline__ void stage_rc(int b, int& R, int& C) { const int st = b / 1024, sb = b % 1024, swz = sb ^ (((sb >> 9) & 1) << 5); R = (st >> 1) * 16 + swz / 64; C = (st & 1) * 32 + (swz % 64) / 2; }
__host__ __device__ __forceinline__ int perm32(int rho) { const int n = rho >> 4, i = rho & 15; return 8 * (i >> 2) + 4 * n + (i & 3); }

struct Unit { int pm, pn; };
struct Gemm { const bf16_t* A; const bf16_t* Bt; int M, N, K; };

struct StaticOrder {
    int nM, nN, nwg, G, c;
    __host__ __device__ void init(int M, int N, int G_, int c_) { nM = M / BM; nN = N / BM; nwg = nM * nN; G = G_; c = c_; }
    __host__ __device__ bool next(int i, Unit& u) const {
        const long L = (long)i * G + c; if (L >= nwg) return false;
        int wgid = (int)L; { const int q = nwg / NXCD, r = nwg % NXCD, xcd = wgid % NXCD, off = wgid / NXCD; wgid = (xcd < r ? xcd * (q + 1) : r * (q + 1) + (xcd - r) * q) + off; }
        const int nig = WGM * nN, gid = wgid / nig, fm = gid * WGM, gsz = (nM - fm) < WGM ? (nM - fm) : WGM;
        u.pm = fm + ((wgid % nig) % gsz); u.pn = (wgid % nig) / gsz; return true;
    }
    __device__ __forceinline__ size_t boff(const Unit&) const { return 0; }
    const int* rowidx = nullptr;
};
struct MoeOrder : StaticOrder {
    const PG8_LAS int* tile_e; size_t estride;
    __device__ __forceinline__ size_t boff(const Unit& u) const { return (size_t)tile_e[u.pm] * estride; }
};

typedef int v8i_t __attribute__((ext_vector_type(8)));
typedef int v4i_t __attribute__((ext_vector_type(4)));
__device__ __forceinline__ v8i_t cat8(bf16x8 lo, bf16x8 hi) { const v4i_t a = __builtin_bit_cast(v4i_t, lo), b = __builtin_bit_cast(v4i_t, hi); return __builtin_shufflevector(a, b, 0, 1, 2, 3, 4, 5, 6, 7); }
__device__ __forceinline__ unsigned pk4_fp8(float a, float b, float c, float d) {
    a = fminf(fmaxf(a, -448.f), 448.f); b = fminf(fmaxf(b, -448.f), 448.f); c = fminf(fmaxf(c, -448.f), 448.f); d = fminf(fmaxf(d, -448.f), 448.f);
    int w = 0; w = __builtin_amdgcn_cvt_pk_fp8_f32(a, b, w, false); w = __builtin_amdgcn_cvt_pk_fp8_f32(c, d, w, true); return (unsigned)w; }
__device__ __forceinline__ unsigned cvt_pk_bf16(float lo, float hi) { unsigned r; asm volatile("v_cvt_pk_bf16_f32 %0, %1, %2" : "=v"(r) : "v"(lo), "v"(hi)); return r; }

struct EpiF32 {
    static constexpr bool PERM = false;
    float* C; int ldc;
    __device__ __forceinline__ void operator()(const f32x4 (&acc)[2][2][4][2], const Unit& u, int wr, int wc, int fr, int fq) const {
        const int row0 = u.pm * BM + wr * 64 + fr, col0 = u.pn * BM + wc * 32 + 4 * fq;
#pragma unroll
        for (int ai = 0; ai < 2; ++ai)
#pragma unroll
            for (int m = 0; m < 4; ++m) { float* rowp = C + (size_t)(row0 + ai * HALF + m * 16) * ldc + col0;
#pragma unroll
                for (int bj = 0; bj < 2; ++bj)
#pragma unroll
                    for (int n = 0; n < 2; ++n) *(f32x4*)(rowp + bj * HALF + n * 16) = acc[ai][bj][m][n]; }
    }
};
struct EpiBf16 {
    static constexpr bool PERM = true;
    bf16_t* O; int ldc; const float* bias; const PG8_LAS int* tile_e; int bstride; float scale;
    __device__ __forceinline__ void operator()(const f32x4 (&acc)[2][2][4][2], const Unit& u, int wr, int wc, int fr, int fq) const {
        const int row0 = u.pm * BM + wr * 64 + fr; const int col0 = u.pn * BM + wc * 32 + 8 * fq;
        f32x4 bv[2][2];
        const float* bp = bias ? bias + (size_t)tile_e[u.pm] * bstride + col0 : nullptr;
#pragma unroll
        for (int bj = 0; bj < 2; ++bj)
#pragma unroll
            for (int n = 0; n < 2; ++n) bv[bj][n] = bias ? *(const f32x4*)(bp + bj * HALF + 4 * n) : (f32x4){0.f, 0.f, 0.f, 0.f};
#pragma unroll
        for (int ai = 0; ai < 2; ++ai)
#pragma unroll
            for (int m = 0; m < 4; ++m) { bf16_t* rowp = O + (size_t)(row0 + ai * HALF + m * 16) * ldc + col0;
#pragma unroll
                for (int bj = 0; bj < 2; ++bj) { f32x4 v0 = acc[ai][bj][m][0] * scale + bv[bj][0], v1 = acc[ai][bj][m][1] * scale + bv[bj][1];
                    u32x4 w; w.x = cvt_pk_bf16(v0[0], v0[1]); w.y = cvt_pk_bf16(v0[2], v0[3]); w.z = cvt_pk_bf16(v1[0], v1[1]); w.w = cvt_pk_bf16(v1[2], v1[3]);
                    *(u32x4*)(rowp + bj * HALF) = w; } }
    }
};
struct EpiSwiGLU {
    static constexpr bool PERM = true;
    unsigned char* O; const float* b_up; const PG8_LAS int* tile_e; float scale;
    typedef float f32x2_t __attribute__((ext_vector_type(2)));
    __device__ __forceinline__ f32x2_t act2(float g0, float g1, float l0, float l1) const {
        const f32x2_t g = {fminf(g0, 7.0f), fminf(g1, 7.0f)};
        const f32x2_t l = {__builtin_amdgcn_fmed3f(l0, -6.0f, 8.0f), __builtin_amdgcn_fmed3f(l1, -6.0f, 8.0f)};
        const f32x2_t t = g * (-1.702f * 1.4426950408889634f);
        const f32x2_t d = (f32x2_t){__builtin_amdgcn_exp2f(t.x), __builtin_amdgcn_exp2f(t.y)} + 1.0f;
        const f32x2_t r = {__builtin_amdgcn_rcpf(d.x), __builtin_amdgcn_rcpf(d.y)};
        return g * r * l;
    }
    __device__ __forceinline__ unsigned act4(const f32x4 g, const f32x4 l) const {
        const f32x2_t a = act2(g[0], g[1], l[0], l[1]), b = act2(g[2], g[3], l[2], l[3]);
        int w = 0; w = __builtin_amdgcn_cvt_pk_fp8_f32(a.x, a.y, w, false); w = __builtin_amdgcn_cvt_pk_fp8_f32(b.x, b.y, w, true); return (unsigned)w;
    }
    __device__ __forceinline__ void operator()(const f32x4 (&acc)[2][2][4][2], const Unit& u, int wr, int wc, int fr, int fq) const {
        const int row0 = u.pm * BM + wr * 64 + fr; const int cin = wc * 32 + 8 * fq;
        const float* bg = b_up + (size_t)tile_e[u.pm] * 2048 + 128 * u.pn + cin;
        f32x4 bgv[2], blv[2];
#pragma unroll
        for (int n = 0; n < 2; ++n) { bgv[n] = *(const f32x4*)(bg + 4 * n); blv[n] = *(const f32x4*)(bg + 1024 + 4 * n) + 1.0f; }
#pragma unroll
        for (int ai = 0; ai < 2; ++ai)
#pragma unroll
            for (int m = 0; m < 4; ++m) { unsigned char* rowp = O + (size_t)(row0 + ai * HALF + m * 16) * 1024 + 128 * u.pn + cin;
                const f32x4 g0 = acc[ai][0][m][0] * scale + bgv[0], g1 = acc[ai][0][m][1] * scale + bgv[1], l0 = acc[ai][1][m][0] * scale + blv[0], l1 = acc[ai][1][m][1] * scale + blv[1];
                const unsigned w0 = act4(g0, l0), w1 = act4(g1, l1);
                typedef unsigned u32x2_t __attribute__((ext_vector_type(2)));
                *(u32x2_t*)rowp = (u32x2_t){w0, w1}; }
    }
};

template <class Epi, class Sched, bool ALIGN_EPI = false, bool SP2 = false, bool F8 = false, bool GATHER = false>
__device__ __forceinline__ void gemm_phase(PG8_LAS unsigned char* lds, const Gemm g, const Sched& S, const Epi& E, const int tid) {
    const int wid = __builtin_amdgcn_readfirstlane(tid >> 6), lane = tid & 63, wr = wid >> 2, wc = wid & 3, fr = lane & 15, fq = lane >> 4;
    constexpr int ES = F8 ? 1 : 2;
    const int K = g.K, nt = K * ES / 128;
    unsigned voffA[2], voffB[2]; int gR[2], gC[2];
#pragma unroll
    for (int i = 0; i < 2; ++i) { int R, C; stage_rc(tid * 16 + i * 8192, R, C); const int Rb = Epi::PERM ? ((R & ~31) + perm32(R & 31)) : R; gR[i] = R; gC[i] = C * 2;
        voffA[i] = (unsigned)(R * K * ES + C * 2); voffB[i] = (unsigned)(Rb * K * ES + C * 2); }
    unsigned vAc0[2] = {0u, 0u}, vAc1[2] = {0u, 0u}, vAn0[2] = {0u, 0u}, vAn1[2] = {0u, 0u};
#define PG8_GIDX(dst0, dst1, u_) do { _Pragma("unroll") for (int _i = 0; _i < 2; ++_i) { \
        dst0[_i] = (unsigned)S.rowidx[(u_).pm * BM + gR[_i]] * (unsigned)(K * ES) + (unsigned)gC[_i]; dst1[_i] = (unsigned)S.rowidx[(u_).pm * BM + HALF + gR[_i]] * (unsigned)(K * ES) + (unsigned)gC[_i]; } } while (0)
    const size_t kstep = (size_t)(BK * 2);
    const size_t hstep = (size_t)HALF * K * ES;
    const size_t tstep = 2 * hstep;
    const unsigned ldsw = (unsigned)wid * 1024u;
    const int aoff = lds_byte(wr * 64 + fr, fq * 8), boff = lds_byte(wc * 32 + fr, fq * 8);
#define PG8_SA(b, h) (((b) * 2 + (h)) * HTB)
#define PG8_SB(b, h) ((4 + (b) * 2 + (h)) * HTB)
#define PG8_STAGE(bufoff, gbase, voff) do { _Pragma("unroll") for (int _i = 0; _i < 2; ++_i) \
        __builtin_amdgcn_global_load_lds((const unsigned*)((const char*)(gbase) + (voff)[_i]), (PG8_LAS unsigned*)(lds + (bufoff) + ldsw + _i * 8192), 16, 0, 0); } while (0)
#define PG8_STAGE_A(bufoff, ptr_, half_, koff_, nxt_) do { if constexpr (GATHER) { _Pragma("unroll") for (int _i = 0; _i < 2; ++_i) { \
            const unsigned vo_ = (half_) ? ((nxt_) ? vAn1[_i] : vAc1[_i]) : ((nxt_) ? vAn0[_i] : vAc0[_i]); \
            __builtin_amdgcn_global_load_lds((const unsigned*)((const char*)g.A + (koff_) + vo_), (PG8_LAS unsigned*)(lds + (bufoff) + ldsw + _i * 8192), 16, 0, 0); } } \
        else PG8_STAGE(bufoff, ptr_, voffA); } while (0)
#define PG8_LDA(dst, b, h) do { _Pragma("unroll") for (int m = 0; m < 4; ++m) _Pragma("unroll") for (int k = 0; k < 2; ++k) dst[m][k] = *(const PG8_LAS bf16x8*)(lds + PG8_SA(b, h) + aoff + m * 2048 + k * 1024); } while (0)
#define PG8_LDB(dst, b, h) do { _Pragma("unroll") for (int n = 0; n < 2; ++n) _Pragma("unroll") for (int k = 0; k < 2; ++k) dst[n][k] = *(const PG8_LAS bf16x8*)(lds + PG8_SB(b, h) + boff + n * 2048 + k * 1024); } while (0)
#define PG8_MMA(ai, bj, At, Bt) do { __builtin_amdgcn_s_setprio(1); _Pragma("unroll") for (int m = 0; m < 4; ++m) _Pragma("unroll") for (int n = 0; n < 2; ++n) { \
        if constexpr (F8) { asm volatile("v_mfma_scale_f32_16x16x128_f8f6f4 %0, %1, %2, %0, %3, %3 op_sel_hi:[0,0,0]" : "+v"(acc[ai][bj][m][n]) : "v"(cat8(Bt[n][0], Bt[n][1])), "v"(cat8(At[m][0], At[m][1])), "v"(0x7f7f7f7f)); } \
        else { _Pragma("unroll") for (int k = 0; k < 2; ++k) acc[ai][bj][m][n] = __builtin_amdgcn_mfma_f32_16x16x32_bf16(Bt[n][k], At[m][k], acc[ai][bj][m][n], 0, 0, 0); } } \
        __builtin_amdgcn_s_setprio(0); } while (0)
#define PG8_WAIT_V(n) asm volatile("s_waitcnt vmcnt(" #n ")" ::: "memory")
#define PG8_WAIT_L(n) asm volatile("s_waitcnt lgkmcnt(" #n ")" ::: "memory")
#define PG8_BAR __builtin_amdgcn_s_barrier()
#define PG8_SCHED __builtin_amdgcn_sched_barrier(0)
    Unit cur, nxt; int ui = 0;
    if (!S.next(0, cur)) return;
    f32x4 acc[2][2][4][2];
#pragma unroll
    for (int a = 0; a < 2; ++a)
#pragma unroll
        for (int b = 0; b < 2; ++b)
#pragma unroll
            for (int m = 0; m < 4; ++m)
#pragma unroll
                for (int n = 0; n < 2; ++n) acc[a][b][m][n] = (f32x4){0.f, 0.f, 0.f, 0.f};
    bf16x8 At[4][2], B0[2][2], B1[2][2];
    const char* cA = (const char*)g.A + (size_t)cur.pm * tstep; const char* cB = (const char*)g.Bt + S.boff(cur) + (size_t)cur.pn * tstep;
    if constexpr (GATHER) { PG8_GIDX(vAc0, vAc1, cur); }
    if constexpr (SP2) {
        PG8_STAGE(PG8_SB(0, 0), cB, voffB); PG8_STAGE(PG8_SB(0, 1), cB + hstep, voffB); PG8_STAGE_A(PG8_SA(0, 0), cA, 0, 0, false); PG8_STAGE_A(PG8_SA(0, 1), cA + hstep, 1, 0, false);
        if (wr == 1) PG8_BAR;
        PG8_WAIT_V(2); PG8_BAR;
        PG8_STAGE(PG8_SB(1, 0), cB + kstep, voffB); PG8_STAGE_A(PG8_SA(1, 0), cA + kstep, 0, kstep, false); PG8_STAGE(PG8_SB(1, 1), cB + hstep + kstep, voffB);
        PG8_WAIT_V(6); PG8_BAR;
    } else {
        PG8_STAGE(PG8_SB(0, 0), cB, voffB); PG8_STAGE(PG8_SA(0, 0), cA, voffA); PG8_STAGE(PG8_SB(0, 1), cB + hstep, voffB); PG8_STAGE(PG8_SA(0, 1), cA + hstep, voffA);
        if (wr == 1) PG8_BAR;
        PG8_WAIT_V(4); PG8_BAR;
        PG8_STAGE(PG8_SB(1, 0), cB + kstep, voffB); PG8_STAGE(PG8_SA(1, 0), cA + kstep, voffA); PG8_STAGE(PG8_SB(1, 1), cB + hstep + kstep, voffB);
        PG8_WAIT_V(6); PG8_BAR;
    }
    for (;;) {
        const bool has_next = S.next(ui + 1, nxt);
        const char* nA = has_next ? (const char*)g.A + (size_t)nxt.pm * tstep : cA; const char* nB = has_next ? (const char*)g.Bt + S.boff(nxt) + (size_t)nxt.pn * tstep : cB;
        if constexpr (GATHER) {
            if (has_next) { if (wid == 0) __builtin_amdgcn_global_load_lds((const unsigned*)(S.rowidx + (size_t)nxt.pm * BM + lane * 4), (PG8_LAS unsigned*)(lds + 131072 + ((ui + 1) & 1) * 1024), 16, 0, 0); }
            else { vAn0[0] = vAc0[0]; vAn0[1] = vAc0[1]; vAn1[0] = vAc1[0]; vAn1[1] = vAc1[1]; } }
        for (int t = 0; t < nt; t += 2) {
            const bool last = (t == nt - 2);
            const char* a1 = cA + (size_t)(t + 1) * kstep;
            const char* a2 = last ? nA : cA + (size_t)(t + 2) * kstep; const char* b2 = last ? nB : cB + (size_t)(t + 2) * kstep;
            const char* a3 = a2 + kstep; const char* b3 = b2 + kstep;
            const size_t ko1 = (size_t)(t + 1) * kstep, ko2 = last ? 0 : (size_t)(t + 2) * kstep, ko3 = ko2 + kstep;
            if constexpr (GATHER) { if (last && has_next) { const PG8_LAS int* ix_ = (const PG8_LAS int*)(lds + 131072 + ((ui + 1) & 1) * 1024);
#pragma unroll
                for (int _i = 0; _i < 2; ++_i) { vAn0[_i] = (unsigned)ix_[gR[_i]] * (unsigned)(K * ES) + (unsigned)gC[_i]; vAn1[_i] = (unsigned)ix_[HALF + gR[_i]] * (unsigned)(K * ES) + (unsigned)gC[_i]; } } }
            if constexpr (SP2) {
            PG8_LDB(B0, 0, 0); PG8_LDB(B1, 0, 1); PG8_SCHED; PG8_LDA(At, 0, 0); PG8_STAGE_A(PG8_SA(1, 1), a1 + hstep, 1, ko1, false);
            PG8_WAIT_V(8); PG8_WAIT_L(0); PG8_BAR; PG8_MMA(0, 0, At, B0); PG8_MMA(0, 1, At, B1); PG8_BAR; PG8_SCHED;
            PG8_LDA(At, 0, 1); PG8_STAGE(PG8_SB(0, 0), b2, voffB); PG8_STAGE(PG8_SB(0, 1), b2 + hstep, voffB); PG8_STAGE_A(PG8_SA(0, 0), a2, 0, ko2, last);
            PG8_WAIT_V(8); PG8_WAIT_L(0); PG8_BAR; PG8_MMA(1, 0, At, B0); PG8_MMA(1, 1, At, B1); PG8_BAR; PG8_SCHED;
            PG8_LDB(B0, 1, 0); PG8_LDB(B1, 1, 1); PG8_SCHED; PG8_LDA(At, 1, 0); PG8_STAGE_A(PG8_SA(0, 1), a2 + hstep, 1, ko2, last);
            PG8_WAIT_V(8); PG8_WAIT_L(0); PG8_BAR; PG8_MMA(0, 0, At, B0); PG8_MMA(0, 1, At, B1); PG8_BAR; PG8_SCHED;
            PG8_LDA(At, 1, 1); PG8_STAGE(PG8_SB(1, 0), b3, voffB); PG8_STAGE(PG8_SB(1, 1), b3 + hstep, voffB); PG8_STAGE_A(PG8_SA(1, 0), a3, 0, ko3, last);
            PG8_WAIT_V(8); PG8_WAIT_L(0); PG8_BAR; PG8_MMA(1, 0, At, B0); PG8_MMA(1, 1, At, B1); PG8_BAR; PG8_SCHED;
            } else {
            PG8_LDB(B0, 0, 0); PG8_SCHED; PG8_LDA(At, 0, 0); PG8_STAGE(PG8_SA(1, 1), a1 + hstep, voffA);
            PG8_WAIT_L(8); PG8_BAR; PG8_WAIT_L(0); PG8_MMA(0, 0, At, B0); PG8_BAR; PG8_SCHED;
            PG8_LDB(B1, 0, 1); PG8_STAGE(PG8_SB(0, 0), b2, voffB);
            PG8_BAR; PG8_WAIT_L(0); PG8_MMA(0, 1, At, B1); PG8_BAR;
            PG8_LDA(At, 0, 1); PG8_STAGE(PG8_SA(0, 0), a2, voffA);
            PG8_BAR; PG8_WAIT_L(0); PG8_MMA(1, 0, At, B0); PG8_BAR; PG8_SCHED;
            PG8_STAGE(PG8_SB(0, 1), b2 + hstep, voffB);
            PG8_WAIT_V(6); PG8_BAR; PG8_MMA(1, 1, At, B1); PG8_BAR;
            PG8_LDB(B0, 1, 0); PG8_SCHED; PG8_LDA(At, 1, 0); PG8_STAGE(PG8_SA(0, 1), a2 + hstep, voffA);
            PG8_WAIT_L(8); PG8_BAR; PG8_WAIT_L(0); PG8_MMA(0, 0, At, B0); PG8_BAR; PG8_SCHED;
            PG8_LDB(B1, 1, 1); PG8_STAGE(PG8_SB(1, 0), b3, voffB);
            PG8_BAR; PG8_WAIT_L(0); PG8_MMA(0, 1, At, B1); PG8_BAR;
            PG8_LDA(At, 1, 1); PG8_STAGE(PG8_SA(1, 0), a3, voffA);
            PG8_BAR; PG8_WAIT_L(0); PG8_MMA(1, 0, At, B0); PG8_BAR; PG8_SCHED;
            PG8_STAGE(PG8_SB(1, 1), b3 + hstep, voffB);
            PG8_WAIT_V(6); PG8_BAR; PG8_MMA(1, 1, At, B1); PG8_BAR;
            }
        }
        if constexpr (ALIGN_EPI) { if (wr == 0) PG8_BAR; }
        E(acc, cur, wr, wc, fr, fq);
        if (!has_next) break;
#pragma unroll
        for (int a = 0; a < 2; ++a)
#pragma unroll
            for (int b = 0; b < 2; ++b)
#pragma unroll
                for (int m = 0; m < 4; ++m)
#pragma unroll
                    for (int n = 0; n < 2; ++n) acc[a][b][m][n] = (f32x4){0.f, 0.f, 0.f, 0.f};
        cur = nxt; cA = nA; cB = nB; ++ui;
        if constexpr (GATHER) { vAc0[0] = vAn0[0]; vAc0[1] = vAn0[1]; vAc1[0] = vAn1[0]; vAc1[1] = vAn1[1]; }
        if constexpr (ALIGN_EPI) { if (wr == 1) PG8_BAR; }
    }
    PG8_WAIT_V(0);
    if constexpr (!ALIGN_EPI) { if (wr == 0) PG8_BAR; }
    PG8_BAR;
#undef PG8_SA
#undef PG8_SB
#undef PG8_STAGE
#undef PG8_LDA
#undef PG8_STAGE_A
#undef PG8_GIDX
#undef PG8_LDB
#undef PG8_MMA
#undef PG8_WAIT_V
#undef PG8_WAIT_L
#undef PG8_BAR
#undef PG8_SCHED
}
}

constexpr int NWAVES = 8, NTHR = 512;
constexpr int BATCH = 2, T = 8192, D = 1024, NTOK = BATCH * T;
constexpr int IN_COLS = 3592, PCOLS = 3584;
constexpr int NE = 32, NASSIGN = NTOK * 4, MAXTILES = NASSIGN / 256 + NE;
constexpr float EPS = 1e-6f;

constexpr size_t MiB = 1u << 20;
constexpr size_t WS_CTL = 0, CTL_ZERO_BYTES = 1 * MiB;
constexpr size_t WS_MOD = 1 * MiB;
constexpr size_t WS_G = WS_MOD + 64 * 1024;
constexpr size_t WS_BETA = WS_G + 256 * 1024;
constexpr size_t WS_GL = WS_BETA + 256 * 1024;
constexpr size_t WS_AE = WS_GL + 64 * 1024;
constexpr size_t WS_AP = WS_AE + 256 * 1024;
constexpr size_t WS_AG = WS_AP + 256 * 1024;
constexpr size_t WS_AS = WS_AG + 256 * 1024;
constexpr size_t WS_WG = WS_AS + 256 * 1024;
constexpr size_t WS_STOK = WS_WG + 64 * 1024;
constexpr size_t WS_WR = 4 * MiB;
constexpr size_t WS_WIN = 8 * MiB;
constexpr size_t WS_WOUT = 16 * MiB;
constexpr size_t WS_WUP = 20 * MiB;
constexpr size_t WS_WDN = 148 * MiB;
constexpr size_t WS_H = 212 * MiB;
constexpr size_t WS_PROJ = 244 * MiB;
constexpr size_t WS_U = 356 * MiB;
constexpr size_t WS_OPS = 388 * MiB;
constexpr int OPS_BYTES = 57344;
constexpr size_t WS_QF = 444 * MiB, WS_KF = 460 * MiB, WS_VTF = 476 * MiB;
constexpr size_t WS_OSCAN = 500 * MiB;
constexpr size_t WS_OMIX = 532 * MiB;
constexpr size_t WS_Y = 564 * MiB;
constexpr size_t WS_XG = 244 * MiB;
constexpr size_t WS_ACT = 388 * MiB;
constexpr size_t WS_ZS = 628 * MiB;
constexpr size_t WS_SEG = 644 * MiB;
constexpr size_t WS_SST = 652 * MiB;
constexpr size_t WS_SEGP = 656 * MiB;
constexpr size_t WS_END = 660 * MiB;
constexpr int CW_CNT = 64;
constexpr int CW_SEGA = 1024, CW_SEGB = 2048;
constexpr int CW_BAR = 4096;
constexpr int CW_HIST = 16384;

constexpr int LDS_BYTES = 163840, MISC_OFF = 161792;

#define GAS __attribute__((address_space(1)))
#define LAS __attribute__((address_space(3)))
typedef unsigned short bf16;
typedef unsigned v4u __attribute__((ext_vector_type(4)));
typedef unsigned v2u __attribute__((ext_vector_type(2)));
typedef float f32x4 __attribute__((ext_vector_type(4)));
typedef LAS float ldsf;
#define RLX_AGENT __ATOMIC_RELAXED, __HIP_MEMORY_SCOPE_AGENT
__device__ __forceinline__ unsigned f2bf(float f) { unsigned u = __builtin_bit_cast(unsigned, f); return (u + 0x7fffu + ((u >> 16) & 1u)) >> 16; }
__device__ __forceinline__ unsigned pk2(float lo, float hi) { return f2bf(lo) | (f2bf(hi) << 16); }
__device__ __forceinline__ float bf2f(unsigned h) { return __builtin_bit_cast(float, h << 16); }
__device__ __forceinline__ float bflo(unsigned w) { return __builtin_bit_cast(float, w << 16); }
__device__ __forceinline__ float bfhi(unsigned w) { return __builtin_bit_cast(float, w & 0xffff0000u); }
template <int CTRL, int ROWMASK> __device__ __forceinline__ float dppf(float v) {
    return __builtin_bit_cast(float, __builtin_amdgcn_update_dpp(0, __builtin_bit_cast(int, v), CTRL, ROWMASK, 0xF, false)); }
__device__ __forceinline__ float wave_sum(float v) {
    v += dppf<0x111, 0xF>(v); v += dppf<0x112, 0xF>(v); v += dppf<0x114, 0xF>(v); v += dppf<0x118, 0xF>(v);
    v += dppf<0x142, 0xA>(v); v += dppf<0x143, 0xC>(v);
    return __builtin_bit_cast(float, __builtin_amdgcn_readlane(__builtin_bit_cast(int, v), 63));
}
__device__ __forceinline__ float xchg32(float send, int lane) { const unsigned u = __builtin_bit_cast(unsigned, send); const auto r_ = __builtin_amdgcn_permlane32_swap(u, u, false, false); return __builtin_bit_cast(float, lane < 32 ? r_[1] : r_[0]); }
__device__ __forceinline__ float xchg16(float send, int lane) { const unsigned u = __builtin_bit_cast(unsigned, send); const auto r_ = __builtin_amdgcn_permlane16_swap(u, u, false, false); return __builtin_bit_cast(float, (lane & 16) ? r_[0] : r_[1]); }
template <int CTRL> __device__ __forceinline__ float dppx(float v) { return __builtin_bit_cast(float, __builtin_amdgcn_update_dpp(0, __builtin_bit_cast(int, v), CTRL, 0xF, 0xF, false)); }
template <int CTRL, int ROWMASK> __device__ __forceinline__ float dppf_o(float v, float old) { return __builtin_bit_cast(float, __builtin_amdgcn_update_dpp(__builtin_bit_cast(int, old), __builtin_bit_cast(int, v), CTRL, ROWMASK, 0xF, false)); }
template <int CTRL, int ROWMASK> __device__ __forceinline__ int dppi_o(int v, int old) { return __builtin_amdgcn_update_dpp(old, v, CTRL, ROWMASK, 0xF, false); }
__device__ __forceinline__ float wave_max(float v) {
    const float ni = -3.4e38f;
    v = fmaxf(v, dppf_o<0x111, 0xF>(v, ni)); v = fmaxf(v, dppf_o<0x112, 0xF>(v, ni)); v = fmaxf(v, dppf_o<0x114, 0xF>(v, ni)); v = fmaxf(v, dppf_o<0x118, 0xF>(v, ni));
    v = fmaxf(v, dppf_o<0x142, 0xA>(v, ni)); v = fmaxf(v, dppf_o<0x143, 0xC>(v, ni));
    return __builtin_bit_cast(float, __builtin_amdgcn_readlane(__builtin_bit_cast(int, v), 63));
}
__device__ __forceinline__ int wave_min_i(int v) {
    const int mi = 0x7fffffff;
    v = min(v, dppi_o<0x111, 0xF>(v, mi)); v = min(v, dppi_o<0x112, 0xF>(v, mi)); v = min(v, dppi_o<0x114, 0xF>(v, mi)); v = min(v, dppi_o<0x118, 0xF>(v, mi));
    v = min(v, dppi_o<0x142, 0xA>(v, mi)); v = min(v, dppi_o<0x143, 0xC>(v, mi));
    return __builtin_amdgcn_readlane(v, 63);
}
__device__ __forceinline__ float siluf(float x) { return x * __builtin_amdgcn_rcpf(1.0f + __builtin_amdgcn_exp2f(-1.4426950408889634f * x)); }
typedef float f32x16 __attribute__((ext_vector_type(16)));
typedef short bf16x8 __attribute__((ext_vector_type(8)));
typedef float f32x2_t __attribute__((ext_vector_type(2)));
typedef __bf16 bf16x2_t __attribute__((ext_vector_type(2)));
__device__ __forceinline__ unsigned cvtpk(float lo, float hi) { f32x2_t v = {lo, hi}; bf16x2_t b = __builtin_convertvector(v, bf16x2_t); return __builtin_bit_cast(unsigned, b); }
__device__ __forceinline__ bf16x8 pack8(const f32x16& x, int s) {
    v4u p; p.x = cvtpk(x[8 * s], x[8 * s + 1]); p.y = cvtpk(x[8 * s + 2], x[8 * s + 3]); p.z = cvtpk(x[8 * s + 4], x[8 * s + 5]); p.w = cvtpk(x[8 * s + 6], x[8 * s + 7]);
    return __builtin_bit_cast(bf16x8, p);
}
__device__ __forceinline__ int crow(int q, int h) { return (q & 3) + 8 * (q >> 2) + 4 * h; }
#define MFMA32(a, b, c) __builtin_amdgcn_mfma_f32_32x32x16_bf16((a), (b), (c), 0, 0, 0)

#define XB_TMO      128
#define XB_XCNT(j)  (256  + 64 * (j))
#define XB_XSUB(j)  (1280 + 64 * (j))
#define XB_XGEN(j)  (2304 + 64 * (j))
#define XB_TOP      3328
#define XB_TOPGEN   3392
#define XCD_BAR_WORDS 3456
#define XB_SPIN_CAP (1u << 22)
__device__ __forceinline__ unsigned xb_ld(unsigned* p)              { return __hip_atomic_load(p, __ATOMIC_RELAXED, __HIP_MEMORY_SCOPE_AGENT); }
__device__ __forceinline__ unsigned xb_add(unsigned* p, unsigned v) { return __hip_atomic_fetch_add(p, v, __ATOMIC_RELAXED, __HIP_MEMORY_SCOPE_AGENT); }
__device__ __forceinline__ unsigned xb_xcc_id() { return (unsigned)__builtin_amdgcn_s_getreg((3 << 11) | 20) & 0xFu; }
#define XB_SPIN(cond, bar) do { unsigned _sp = 0; while (cond) { __builtin_amdgcn_s_sleep(1); \
    if ((++_sp & 255u) == 0u) { if (xb_ld(&(bar)[XB_TMO])) break; if (_sp > XB_SPIN_CAP) { atomicAdd(&(bar)[XB_TMO], 1u); break; } } } } while (0)
struct XcdBarrier { unsigned* bar; unsigned x; volatile LAS unsigned* st; };
__device__ __forceinline__ XcdBarrier xcd_barrier_post(unsigned* bar, volatile LAS unsigned* st) {
    XcdBarrier b; b.bar = bar; b.x = xb_xcc_id(); b.st = st;
    if (threadIdx.x == 0) (void)xb_add(&bar[XB_XCNT(b.x)], 1u);
    return b;
}
__device__ __forceinline__ void xcd_barrier_complete(unsigned* bar, unsigned x, unsigned& nloc, unsigned& nx) {
    const unsigned G = gridDim.x * gridDim.y * gridDim.z;
    unsigned sum, cnt, mine, sp = 0u;
    for (;;) {
        sum = 0u; cnt = 0u; mine = 0u;
#pragma unroll
        for (unsigned j = 0; j < 16; ++j) { const unsigned c = xb_ld(&bar[XB_XCNT(j)]); sum += c; cnt += (c > 0u) ? 1u : 0u; mine = (j == x) ? c : mine; }
        if (sum == G) break;
        __builtin_amdgcn_s_sleep(1);
        if ((++sp & 255u) == 0u) { if (xb_ld(&bar[XB_TMO])) break; if (sp > XB_SPIN_CAP) { atomicAdd(&bar[XB_TMO], 1u); break; } }
    }
    nloc = mine > 0u ? mine : 1u; nx = cnt > 0u ? cnt : 1u;
}
__device__ __forceinline__ void xcd_barrier(const XcdBarrier& b, const int tid) {
    asm volatile("s_waitcnt vmcnt(0)" ::: "memory");
    __syncthreads();
    if (tid == 0) {
        unsigned* bar = b.bar;
        __builtin_amdgcn_s_waitcnt(0);
        unsigned nloc = b.st[0], nx = b.st[1];
        if (nloc == 0u) { xcd_barrier_complete(bar, b.x, nloc, nx); b.st[0] = nloc; b.st[1] = nx; }
        const unsigned old = xb_add(&bar[XB_XSUB(b.x)], 1u);
        const unsigned gen = old / nloc;
        if (old + 1u == (gen + 1u) * nloc) {
            __builtin_amdgcn_fence(__ATOMIC_RELEASE, "agent");
            asm volatile("s_waitcnt vmcnt(0)" ::: "memory");
            const unsigned og = xb_add(&bar[XB_TOP], 1u);
            const unsigned tg = og / nx;
            if (og + 1u == (tg + 1u) * nx) xb_add(&bar[XB_TOPGEN], 1u);
            else XB_SPIN(xb_ld(&bar[XB_TOPGEN]) == tg, bar);
            __builtin_amdgcn_fence(__ATOMIC_ACQUIRE, "agent");
            xb_add(&bar[XB_XGEN(b.x)], 1u);
            asm volatile("s_waitcnt vmcnt(0)" ::: "memory");
        } else {
            XB_SPIN(xb_ld(&bar[XB_XGEN(b.x)]) == gen, bar);
            __builtin_amdgcn_fence(__ATOMIC_ACQUIRE, "agent");
            asm volatile("s_waitcnt vmcnt(0)" ::: "memory");
        }
    }
    __syncthreads();
}

struct Args {
    const float* in[18]; float* out; unsigned char* ws; int ph_lo, ph_hi, li, pad;
};
enum { I_X = 0, I_C, I_WADA, I_BADA, I_NORMW, I_WIN, I_CONVW, I_ALOG, I_DTB, I_ANW, I_RELB, I_WOUT, I_WR, I_BR, I_WUP, I_BUP, I_WDN, I_BDN };

__device__ __forceinline__ int map_row(int mode, int n) {
    if (mode == 0) return n < 2048 ? n : (n < 2056 ? -1 : n - 8);
    if (mode == 2) { const int j = n & 1023, half = n >> 10; return (j >> 7) * 256 + half * 128 + (j & 127); }
    return n;
}
__device__ __forceinline__ void transpose_item(const float* W, int K, int N, bf16* WT, int mode, ldsf* scr, int item, int lane) {
    const int nblk = (N + 31) / 32, kb = item / nblk, nb = item % nblk, k0 = 64 * kb, n0 = 32 * nb;
    const int nn = n0 + (lane & 31);
#pragma unroll 8
    for (int i = 0; i < 32; ++i) { const int kk = 2 * i + (lane >> 5); scr[kk * 33 + (lane & 31)] = (nn < N) ? W[(size_t)(k0 + kk) * N + nn] : 0.f; }
    asm volatile("s_waitcnt lgkmcnt(0)" ::: "memory");
    const int c = lane & 7;
#pragma unroll
    for (int j = 0; j < 4; ++j) { const int nl = (lane >> 3) + 8 * j; const int n = n0 + nl; const ldsf* s = scr + (8 * c) * 33 + nl;
        const int row = (n < N) ? map_row(mode, n) : -1;
        v4u o; o.x = pk2(s[0 * 33], s[1 * 33]); o.y = pk2(s[2 * 33], s[3 * 33]); o.z = pk2(s[4 * 33], s[5 * 33]); o.w = pk2(s[6 * 33], s[7 * 33]);
        if (row >= 0) *(v4u*)(WT + (size_t)row * K + k0 + 8 * c) = o; }
    asm volatile("s_waitcnt lgkmcnt(0)" ::: "memory");
}
__device__ __forceinline__ void transpose_item8(const float* W, int K, int N, unsigned char* WT, int mode, ldsf* scr, int item, int lane) {
    const int nblk = N / 32, kb = item / nblk, nb = item % nblk, k0 = 64 * kb, n0 = 32 * nb;
#pragma unroll 8
    for (int i = 0; i < 32; ++i) { const int kk = 2 * i + (lane >> 5); scr[kk * 33 + (lane & 31)] = __builtin_nontemporal_load(W + (size_t)(k0 + kk) * N + n0 + (lane & 31)); }
    asm volatile("s_waitcnt lgkmcnt(0)" ::: "memory");
    const int nl = lane >> 1, kh = lane & 1; const ldsf* sp = scr + (32 * kh) * 33 + nl;
    const int row = map_row(mode, n0 + nl);
    v4u o0, o1;
    o0.x = pg8::pk4_fp8(sp[0 * 33] * 32.f, sp[1 * 33] * 32.f, sp[2 * 33] * 32.f, sp[3 * 33] * 32.f);     o0.y = pg8::pk4_fp8(sp[4 * 33] * 32.f, sp[5 * 33] * 32.f, sp[6 * 33] * 32.f, sp[7 * 33] * 32.f);
    o0.z = pg8::pk4_fp8(sp[8 * 33] * 32.f, sp[9 * 33] * 32.f, sp[10 * 33] * 32.f, sp[11 * 33] * 32.f);   o0.w = pg8::pk4_fp8(sp[12 * 33] * 32.f, sp[13 * 33] * 32.f, sp[14 * 33] * 32.f, sp[15 * 33] * 32.f);
    o1.x = pg8::pk4_fp8(sp[16 * 33] * 32.f, sp[17 * 33] * 32.f, sp[18 * 33] * 32.f, sp[19 * 33] * 32.f); o1.y = pg8::pk4_fp8(sp[20 * 33] * 32.f, sp[21 * 33] * 32.f, sp[22 * 33] * 32.f, sp[23 * 33] * 32.f);
    o1.z = pg8::pk4_fp8(sp[24 * 33] * 32.f, sp[25 * 33] * 32.f, sp[26 * 33] * 32.f, sp[27 * 33] * 32.f); o1.w = pg8::pk4_fp8(sp[28 * 33] * 32.f, sp[29 * 33] * 32.f, sp[30 * 33] * 32.f, sp[31 * 33] * 32.f);
    unsigned char* dst = WT + (size_t)row * K + k0 + 32 * kh;
    __builtin_nontemporal_store(o0, (v4u*)dst); __builtin_nontemporal_store(o1, (v4u*)(dst + 16));
    asm volatile("s_waitcnt lgkmcnt(0)" ::: "memory");
}
__device__ __forceinline__ void mod_item(const float* c, const float* w_ada, const float* b_ada, float* mod, int item, ldsf* red, int tid, int lane, int wave) {
    const int j0 = item * 24;
    float a0[24], a1[24];
#pragma unroll
    for (int k = 0; k < 24; ++k) { a0[k] = 0.f; a1[k] = 0.f; }
#pragma unroll
    for (int rr = 0; rr < 2; ++rr) {
        const int d = tid + rr * 512;
        const float s0 = siluf(c[d]), s1 = siluf(c[1024 + d]);
        const f32x4* wp = (const f32x4*)(w_ada + (size_t)d * 6144 + j0);
#pragma unroll
        for (int q = 0; q < 6; ++q) { const f32x4 w = wp[q];
#pragma unroll
            for (int e = 0; e < 4; ++e) { a0[4 * q + e] += s0 * w[e]; a1[4 * q + e] += s1 * w[e]; } }
    }
#pragma unroll
    for (int k = 0; k < 24; ++k) { a0[k] = wave_sum(a0[k]); a1[k] = wave_sum(a1[k]); }
    if (lane == 0) {
#pragma unroll
        for (int k = 0; k < 24; ++k) { red[wave * 48 + k] = a0[k]; red[wave * 48 + 24 + k] = a1[k]; }
    }
    __syncthreads();
    if (tid < 48) { float s = 0.f;
#pragma unroll
        for (int w = 0; w < 8; ++w) s += red[w * 48 + tid];
        const int b = tid / 24, k = tid % 24; mod[b * 6144 + j0 + k] = s + b_ada[j0 + k]; }
    __syncthreads();
}

#define SB() __builtin_amdgcn_sched_barrier(0)
#define GI_W(mt, t2, s2) ((((mt) * 4 + (t2)) * 2) + (s2))
#define GI_Q(mt, t2, s2) (16 + (((mt) * 4 + (t2)) * 2) + (s2))
#define GI_K(t2, mt, s2) (32 + (((t2) * 2 + (mt)) * 2) + (s2))
#define GI_A(mt, mp, s2) (48 + (((mt) * 2 + (mp)) * 2) + (s2))
#define FRAG(f_) (*(const LAS bf16x8*)(Bf + (f_) * 1024))
#define LD_WQ(dst, t2, s2) do { dst[0] = FRAG(GI_W(0, t2, s2)); dst[1] = FRAG(GI_Q(0, t2, s2)); dst[2] = FRAG(GI_W(1, t2, s2)); dst[3] = FRAG(GI_Q(1, t2, s2)); } while (0)
#define MM_WQ(src, t2, s2) do { const bf16x8 sb_ = pack8(S[t2], s2); VN[0] = MFMA32(src[0], sb_, VN[0]); O[0] = MFMA32(src[1], sb_, O[0]); VN[1] = MFMA32(src[2], sb_, VN[1]); O[1] = MFMA32(src[3], sb_, O[1]); } while (0)
#define LD_AT(dst, s2) do { dst[0] = FRAG(GI_A(0, 0, s2)); dst[1] = FRAG(GI_A(1, 0, s2)); dst[2] = FRAG(GI_A(1, 1, s2)); } while (0)
#define MM_AT(src, s2) do { O[0] = MFMA32(src[0], vb[0][s2], O[0]); O[1] = MFMA32(src[1], vb[0][s2], O[1]); O[1] = MFMA32(src[2], vb[1][s2], O[1]); } while (0)
#define LD_K(dst, t2) do { dst[0] = FRAG(GI_K(t2, 0, 0)); dst[1] = FRAG(GI_K(t2, 0, 1)); dst[2] = FRAG(GI_K(t2, 1, 0)); dst[3] = FRAG(GI_K(t2, 1, 1)); } while (0)
#define MM_K(src, t2) do { S[t2] = MFMA32(src[0], vb[0][0], S[t2]); S[t2] = MFMA32(src[1], vb[0][1], S[t2]); S[t2] = MFMA32(src[2], vb[1][0], S[t2]); S[t2] = MFMA32(src[3], vb[1][1], S[t2]); } while (0)
#define SCALE_S(t2) do { _Pragma("unroll") for (int q_ = 0; q_ < 16; ++q_) S[t2][q_] *= egl; } while (0)
__device__ __forceinline__ void scan_step(const int n, f32x16 (&S)[4], v4u (&UC)[4], v4u (&UN)[4], const float egl, float& egl_next,
                                          LAS unsigned char* lds, const float* Uf, const float* glp, const int wave, const int lane, const int stg_off, const int stg_row) {
    const int r = lane & 31, h = lane >> 5;
    asm volatile("s_waitcnt lgkmcnt(0)" ::: "memory"); __builtin_amdgcn_s_barrier(); asm volatile("" ::: "memory");
    if (n + 1 < 128) {
        const v4u* up = (const v4u*)((const unsigned char*)Uf + (size_t)(n + 1) * 16384) + (wave * 4) * 64 + lane;
#pragma unroll
        for (int f = 0; f < 4; ++f) UN[f] = up[f * 64];
        egl_next = glp[n + 1];
    }
    SB();
    f32x16 VN[2];
#pragma unroll
    for (int mt = 0; mt < 2; ++mt)
#pragma unroll
        for (int q8 = 0; q8 < 2; ++q8) { const v4u u = UC[mt * 2 + q8];
            VN[mt][8 * q8 + 0] = bflo(u.x); VN[mt][8 * q8 + 1] = bfhi(u.x); VN[mt][8 * q8 + 2] = bflo(u.y); VN[mt][8 * q8 + 3] = bfhi(u.y);
            VN[mt][8 * q8 + 4] = bflo(u.z); VN[mt][8 * q8 + 5] = bfhi(u.z); VN[mt][8 * q8 + 6] = bflo(u.w); VN[mt][8 * q8 + 7] = bfhi(u.w); }
    const LAS unsigned char* Bf = lds + (n & 1) * OPS_BYTES + lane * 16;
    f32x16 O[2];
#pragma unroll
    for (int mt = 0; mt < 2; ++mt)
#pragma unroll
        for (int q = 0; q < 16; ++q) O[mt][q] = 0.f;
    bf16x8 fA[4], fB[4], vb[2][2];
    LD_WQ(fA, 0, 0); SB();
    LD_WQ(fB, 0, 1); SB(); MM_WQ(fA, 0, 0); SB();
    LD_WQ(fA, 1, 0); SB(); MM_WQ(fB, 0, 1); SCALE_S(0); SB();
    LD_WQ(fB, 1, 1); SB(); MM_WQ(fA, 1, 0); SB();
    LD_WQ(fA, 2, 0); SB(); MM_WQ(fB, 1, 1); SCALE_S(1); SB();
    LD_WQ(fB, 2, 1); SB(); MM_WQ(fA, 2, 0); SB();
    LD_WQ(fA, 3, 0); SB(); MM_WQ(fB, 2, 1); SCALE_S(2); SB();
    LD_WQ(fB, 3, 1); SB(); MM_WQ(fA, 3, 0); SB();
    LD_AT(fA, 0); SB(); MM_WQ(fB, 3, 1); SCALE_S(3); SB();
#pragma unroll
    for (int mt = 0; mt < 2; ++mt)
#pragma unroll
        for (int s2 = 0; s2 < 2; ++s2) vb[mt][s2] = pack8(VN[mt], s2);
    LD_AT(fB, 1); SB(); MM_AT(fA, 0); SB();
    LD_K(fA, 0); SB(); MM_AT(fB, 1); SB();
    {
        LAS unsigned short* sp = (LAS unsigned short*)(lds + stg_off + (n & 1) * (64 * stg_row)) + 32 * wave + r;
#pragma unroll
        for (int mt = 0; mt < 2; ++mt)
#pragma unroll
            for (int q = 0; q < 16; q += 2) { const unsigned w = cvtpk(O[mt][q], O[mt][q + 1]);
                sp[(32 * mt + crow(q, h)) * (stg_row / 2)] = (unsigned short)(w & 0xffffu); sp[(32 * mt + crow(q + 1, h)) * (stg_row / 2)] = (unsigned short)(w >> 16); }
    }
    asm volatile("s_waitcnt lgkmcnt(0)" ::: "memory"); __builtin_amdgcn_s_barrier(); asm volatile("" ::: "memory");
    LD_K(fB, 1); SB(); MM_K(fA, 0); SB();
    LD_K(fA, 2); SB(); MM_K(fB, 1); SB();
    LD_K(fB, 3); SB(); MM_K(fA, 2); SB();
    MM_K(fB, 3); SB();
}
#undef FRAG

__device__ __forceinline__ int opq(int v) { asm volatile("" : "+v"(v)); return v; }
typedef const __attribute__((address_space(4))) Args* kargp_t;
__device__ __forceinline__ kargp_t karg_ptr() { kargp_t p = (kargp_t)__builtin_amdgcn_kernarg_segment_ptr(); asm volatile("" : "+s"(p)); return p; }
__global__ void __launch_bounds__(NTHR, 2) mk_fwd(Args kargs) {
    extern __shared__ __attribute__((aligned(16))) unsigned char lds_raw[];
    LAS unsigned char* lds = (LAS unsigned char*)lds_raw;
    volatile LAS unsigned* MISC = (volatile LAS unsigned*)(lds + MISC_OFF);
    const int wave = __builtin_amdgcn_readfirstlane((int)threadIdx.x >> 6);
    const int G = gridDim.x; const int bx = blockIdx.x; const int vcu = (G % 8 == 0) ? (bx % 8) * (G / 8) + bx / 8 : bx;
    const int gw = vcu * NWAVES + wave, NGW = G * NWAVES;
    if (threadIdx.x < 128) MISC[threadIdx.x] = 0u;
    __syncthreads();
    XcdBarrier bar; bar.bar = (unsigned*)(kargs.ws + WS_CTL) + CW_BAR; bar.x = 0; bar.st = nullptr;
#if MK_ONE_LAUNCH
    bar = xcd_barrier_post((unsigned*)(kargs.ws + WS_CTL) + CW_BAR + kargs.li * XCD_BAR_WORDS, MISC + 8);
#define GRID_BAR() xcd_barrier(bar, tid)
#else
#define GRID_BAR() do {} while (0)
#endif
    const int lo = kargs.ph_lo, hi = kargs.ph_hi;
#ifndef PH_MASK
#define PH_MASK 0xFFFF
#endif
#define IN(k) ((((PH_MASK) >> (k)) & 1) && lo <= (k) && (k) < hi)
#define BOTH(k) (IN(k) && IN((k) + 1))

#define args (*ap_)
#define P_WS (args.ws)
#define ctl ((unsigned*)(P_WS + WS_CTL))
#define Xp (args.in[I_X])
#define OUTp (args.out)
#define MODp ((float*)(P_WS + WS_MOD))
#define gbuf ((float*)(P_WS + WS_G))
#define betabuf ((float*)(P_WS + WS_BETA))
#define glbuf ((float*)(P_WS + WS_GL))
#define asg_e ((int*)(P_WS + WS_AE))
#define asg_p ((int*)(P_WS + WS_AP))
#define asg_g ((float*)(P_WS + WS_AG))
#define asg_s ((int*)(P_WS + WS_AS))
#define WinT ((bf16*)(P_WS + WS_WIN))
#define WoutT ((bf16*)(P_WS + WS_WOUT))
#define WupT ((bf16*)(P_WS + WS_WUP))
#define WdnT ((bf16*)(P_WS + WS_WDN))
#define hbuf ((bf16*)(P_WS + WS_H))
#define projb ((bf16*)(P_WS + WS_PROJ))
#define Ub ((float*)(P_WS + WS_U))
#define opsb (P_WS + WS_OPS)
#define zsb ((bf16*)(P_WS + WS_ZS))
#define qfb (P_WS + WS_QF)
#define kfb (P_WS + WS_KF)
#define vtfb (P_WS + WS_VTF)
#define omix ((bf16*)(P_WS + WS_OMIX))
#define ybuf ((bf16*)(P_WS + WS_Y))
#define xg ((bf16*)(P_WS + WS_XG))
#define actb ((bf16*)(P_WS + WS_ACT))
#define yslot ((bf16*)(P_WS + WS_XG))

    if (IN(0)) {
        const int lane = (int)__builtin_amdgcn_mbcnt_hi(~0u, __builtin_amdgcn_mbcnt_lo(~0u, 0u)), tid = wave * 64 + lane; const kargp_t ap_ = karg_ptr();
        ldsf* scr = (ldsf*)(lds + wave * 16384);
        constexpr int I_IN = 16 * 113, I_OUT = 16 * 32;
        constexpr int NITEMS = I_IN + I_OUT;
        for (int it = gw; it < NITEMS; it += NGW) {
            int r = it;
            if (r < I_IN) { transpose_item(args.in[I_WIN], D, IN_COLS, WinT, 0, scr, r, lane); continue; } r -= I_IN;
            transpose_item(args.in[I_WOUT], D, D, WoutT, 1, scr, r, lane);
        }
        __syncthreads();
        for (int idx = bx * NTHR + tid; idx < 8192; idx += G * NTHR) { const int col = idx >> 3, k = idx & 7; ((float*)(P_WS + WS_WG))[k * 1024 + col] = args.in[I_WIN][(size_t)col * IN_COLS + 2048 + k]; }
        for (int idx = bx * NTHR + tid; idx < 32768; idx += G * NTHR) { const int col = idx >> 5, e = idx & 31; ((float*)(P_WS + WS_WR))[e * 1024 + col] = args.in[I_WR][idx]; }
        for (int it = bx; it < 256; it += G) mod_item(args.in[I_C], args.in[I_WADA], args.in[I_BADA], MODp, it, (ldsf*)lds, tid, lane, wave);
        if (BOTH(0)) GRID_BAR();
    }

    if (IN(1)) {
        const int lane = (int)__builtin_amdgcn_mbcnt_hi(~0u, __builtin_amdgcn_mbcnt_lo(~0u, 0u)), tid = wave * 64 + lane; const kargp_t ap_ = karg_ptr();
        ldsf* wg = (ldsf*)lds;
        const float* w_in = args.in[I_WIN];
        for (int idx = tid; idx < 2048; idx += NTHR) *((LAS f32x4*)wg + idx) = *((const f32x4*)(P_WS + WS_WG) + idx);
        __syncthreads();
        const float* nw0 = args.in[I_NORMW];
        const float dtb = args.in[I_DTB][lane & 3], alg = -expf(args.in[I_ALOG][lane & 3]);
        f32x4 vnx[4];
#pragma unroll
        for (int j = 0; j < 4; ++j) vnx[j] = *((const f32x4*)(Xp + (size_t)gw * D) + lane + 64 * j);
        for (int bb = 0; bb < BATCH; ++bb) {
            f32x4 av[4], shv[4];
#pragma unroll
            for (int j = 0; j < 4; ++j) { const int col = 4 * lane + 256 * j; const f32x4 nw = *(const f32x4*)(nw0 + col), sc = *(const f32x4*)(MODp + bb * 6144 + 1024 + col); shv[j] = *(const f32x4*)(MODp + bb * 6144 + col);
#pragma unroll
                for (int e = 0; e < 4; ++e) av[j][e] = nw[e] * (1.0f + sc[e]); }
            for (int r = gw + bb * (NTOK / BATCH); r < (bb + 1) * (NTOK / BATCH); r += NGW) {
                f32x4 v[4]; float ss = 0.f;
#pragma unroll
                for (int j = 0; j < 4; ++j) { v[j] = vnx[j]; ss += (v[j].x * v[j].x + v[j].y * v[j].y) + (v[j].z * v[j].z + v[j].w * v[j].w); }
                __builtin_amdgcn_sched_barrier(0);
                if (r + NGW < NTOK) {
#pragma unroll
                    for (int j = 0; j < 4; ++j) vnx[j] = *((const f32x4*)(Xp + (size_t)(r + NGW) * D) + lane + 64 * j);
                }
                __builtin_amdgcn_sched_barrier(0);
                const float rstd = rsqrtf(wave_sum(ss) * (1.0f / D) + EPS);
                float al[8];
#pragma unroll
                for (int k = 0; k < 8; ++k) al[k] = 0.f;
                v2u ov[4];
#pragma unroll
                for (int j = 0; j < 4; ++j) {
                    const int col = 4 * lane + 256 * j;
                    f32x4 h;
#pragma unroll
                    for (int e = 0; e < 4; ++e) h[e] = v[j][e] * rstd * av[j][e] + shv[j][e];
                    ov[j].x = pk2(h[0], h[1]); ov[j].y = pk2(h[2], h[3]);
#pragma unroll
                    for (int k = 0; k < 8; ++k) { const f32x4 w = *(const LAS f32x4*)(wg + k * 1024 + col); al[k] += (h[0] * w[0] + h[1] * w[1]) + (h[2] * w[2] + h[3] * w[3]); }
                }
#pragma unroll
                for (int j = 0; j < 4; ++j) *(v2u*)(hbuf + (size_t)r * D + 4 * lane + 256 * j) = ov[j];
#pragma unroll
                for (int k = 0; k < 8; ++k) al[k] = wave_sum(al[k]);
                if (lane < 4) {
                    const float aa = lane == 0 ? al[0] : (lane == 1 ? al[1] : (lane == 2 ? al[2] : al[3]));
                    const float ab = lane == 0 ? al[4] : (lane == 1 ? al[5] : (lane == 2 ? al[6] : al[7]));
                    const float xx = aa + dtb;
                    const float sp = xx > 20.f ? xx : log1pf(expf(xx));
                    gbuf[r * 4 + lane] = alg * sp;
                    betabuf[r * 4 + lane] = 1.0f / (1.0f + expf(-ab));
                }
            }
        }
        if (BOTH(1)) GRID_BAR();
    }

    if (IN(2)) {
        const int lane = (int)__builtin_amdgcn_mbcnt_hi(~0u, __builtin_amdgcn_mbcnt_lo(~0u, 0u)), tid = wave * 64 + lane; const kargp_t ap_ = karg_ptr();
        pg8::Gemm g{hbuf, WinT, NTOK, PCOLS, D}; pg8::StaticOrder S; S.init(NTOK, PCOLS, G, bx);
        pg8::EpiBf16 E{projb, PCOLS, nullptr, nullptr, 0, 1.0f};
        pg8::gemm_phase<pg8::EpiBf16, pg8::StaticOrder, true, true>(lds, g, S, E, tid);
        if (BOTH(2)) GRID_BAR();
    }

    if (IN(3)) {
        const int lane = (int)__builtin_amdgcn_mbcnt_hi(~0u, __builtin_amdgcn_mbcnt_lo(~0u, 0u)), tid = wave * 64 + lane; const kargp_t ap_ = karg_ptr();
        ldsf* qs = (ldsf*)lds; ldsf* ks = qs + 64 * 129; ldsf* vs = ks + 64 * 129; ldsf* Wsm = vs + 64 * 129; ldsf* Ls = Wsm + 64 * 129;
        constexpr int LSTR = 68;
        constexpr int RAW_OFF = 4 * 64 * 129 * 3;
        ldsf* gc = (ldsf*)(lds + 151296); ldsf* bt = gc + 64; ldsf* eg = bt + 64; ldsf* ekd = eg + 64;
        const float* conv_w = args.in[I_CONVW];
        const int r = lane & 31, h = lane >> 5;
        for (int item = (args.pad & 1) ? 1024 : bx; item < 1024; item += G) {
            const int bh = item >> 7, n = item & 127, b = bh >> 2, hh = bh & 3;
            const size_t row0 = (size_t)b * T + n * 64;
            unsigned char* ops = opsb + (size_t)item * OPS_BYTES;
            {
#pragma unroll
                for (int jp = 0; jp < 7; ++jp) {
                    const int p = wave + 8 * jp;
                    if (p < 51) {
                        int sg = 4 * p + (lane >> 4); sg = sg > 200 ? 200 : sg;
                        const int rw = sg / 3, wh = sg - 3 * rw; int tt = n * 64 + rw - 3; tt = tt < 0 ? 0 : tt;
                        __builtin_amdgcn_global_load_lds((const unsigned*)(projb + ((size_t)b * T + tt) * PCOLS + wh * 512 + hh * 128 + (lane & 15) * 8), (LAS unsigned*)(lds + RAW_OFF + p * 1024), 16, 0, 0);
                    }
                }
#pragma unroll
                for (int o = 0; o < 2; ++o) {
                    const int idx = tid + NTHR * o, i = idx >> 4, d0 = (idx & 15) * 8;
                    const v4u zw = *(const v4u*)(projb + ((size_t)b * T + n * 64 + i) * PCOLS + 1536 + hh * 128 + d0);
                    const f32x4 wa = *(const f32x4*)(args.in[I_ANW] + d0), wb = *(const f32x4*)(args.in[I_ANW] + d0 + 4);
                    v4u ow; ow.x = cvtpk(wa[0] * siluf(bflo(zw.x)), wa[1] * siluf(bfhi(zw.x))); ow.y = cvtpk(wa[2] * siluf(bflo(zw.y)), wa[3] * siluf(bfhi(zw.y)));
                    ow.z = cvtpk(wb[0] * siluf(bflo(zw.z)), wb[1] * siluf(bfhi(zw.z))); ow.w = cvtpk(wb[2] * siluf(bflo(zw.w)), wb[3] * siluf(bfhi(zw.w)));
                    *(v4u*)(zsb + ((size_t)b * T + n * 64 + i) * 512 + hh * 128 + d0) = ow;
                }
                asm volatile("s_waitcnt vmcnt(0)" ::: "memory");
                __syncthreads();
#pragma unroll 2
                for (int o = 0; o < 6; ++o) {
                    const int idx = tid + NTHR * o, i = idx / 48, c8 = idx - 48 * i, which = c8 >> 4, d0 = (c8 & 15) * 8, gch = which * 512 + hh * 128 + d0;
                    const LAS unsigned char* rp = lds + RAW_OFF + i * 768 + which * 256 + d0 * 2;
                    float acc[8];
#pragma unroll
                    for (int e = 0; e < 8; ++e) acc[e] = 0.f;
#pragma unroll
                    for (int tap = 0; tap < 4; ++tap) {
                        const v4u xw = *(const LAS v4u*)(rp + tap * 768);
                        const f32x4 wa = *(const f32x4*)(conv_w + tap * 1536 + gch), wb = *(const f32x4*)(conv_w + tap * 1536 + gch + 4);
                        const float msk = (n * 64 + i - 3 + tap) >= 0 ? 1.0f : 0.0f;
                        acc[0] += msk * wa[0] * bflo(xw.x); acc[1] += msk * wa[1] * bfhi(xw.x); acc[2] += msk * wa[2] * bflo(xw.y); acc[3] += msk * wa[3] * bfhi(xw.y);
                        acc[4] += msk * wb[0] * bflo(xw.z); acc[5] += msk * wb[1] * bfhi(xw.z); acc[6] += msk * wb[2] * bflo(xw.w); acc[7] += msk * wb[3] * bfhi(xw.w);
                    }
                    ldsf* dst = (which == 0 ? qs : (which == 1 ? ks : vs)) + i * 129 + d0;
#pragma unroll
                    for (int e = 0; e < 8; ++e) dst[e] = siluf(acc[e]);
                }
            }
            if (wave == 7) {
                float gv = gbuf[(row0 + lane) * 4 + hh];
#pragma unroll
                for (int o = 1; o < 64; o <<= 1) { const float t2 = __shfl_up(gv, o); if (lane >= o) gv += t2; }
                const float glast = __shfl(gv, 63);
                gc[lane] = gv; eg[lane] = expf(gv); bt[lane] = betabuf[(row0 + lane) * 4 + hh]; ekd[lane] = expf(glast - gv);
                if (lane == 0) glbuf[item] = expf(glast);
            }
            __syncthreads();
            if (((args.pad >> 2) & 7) == 1) continue;
            for (int i = wave; i < 64; i += NWAVES) {
                const float q0 = qs[i * 129 + lane], q1 = qs[i * 129 + 64 + lane], k0 = ks[i * 129 + lane], k1 = ks[i * 129 + 64 + lane];
                const float sq = rsqrtf(wave_sum(q0 * q0 + q1 * q1) + EPS) * 0.08838834764831845f, sk = rsqrtf(wave_sum(k0 * k0 + k1 * k1) + EPS);
                qs[i * 129 + lane] = q0 * sq; qs[i * 129 + 64 + lane] = q1 * sq; ks[i * 129 + lane] = k0 * sk; ks[i * 129 + 64 + lane] = k1 * sk;
            }
            __syncthreads();
            if (((args.pad >> 2) & 7) == 2) continue;
            {
                const int which = wave >> 2, ta = (wave >> 1) & 1, tb = wave & 1;
                if (tb <= ta) {
                    f32x16 acc;
#pragma unroll
                    for (int q = 0; q < 16; ++q) acc[q] = 0.f;
                    const ldsf* Ap = ks + (32 * (which == 0 ? ta : tb) + r) * 129 + 8 * h;
                    const ldsf* Bp = (which == 0 ? ks + (32 * tb + r) * 129 : qs + (32 * ta + r) * 129) + 8 * h;
#pragma unroll 4
                    for (int k = 0; k < 8; ++k) {
                        v4u pa, pb;
                        pa.x = cvtpk(Ap[16 * k + 0], Ap[16 * k + 1]); pa.y = cvtpk(Ap[16 * k + 2], Ap[16 * k + 3]); pa.z = cvtpk(Ap[16 * k + 4], Ap[16 * k + 5]); pa.w = cvtpk(Ap[16 * k + 6], Ap[16 * k + 7]);
                        pb.x = cvtpk(Bp[16 * k + 0], Bp[16 * k + 1]); pb.y = cvtpk(Bp[16 * k + 2], Bp[16 * k + 3]); pb.z = cvtpk(Bp[16 * k + 4], Bp[16 * k + 5]); pb.w = cvtpk(Bp[16 * k + 6], Bp[16 * k + 7]);
                        acc = MFMA32(__builtin_bit_cast(bf16x8, pa), __builtin_bit_cast(bf16x8, pb), acc);
                    }
                    if (which == 0) {
                        const int j = 32 * tb + r; const float gj = gc[j];
#pragma unroll
                        for (int q = 0; q < 16; ++q) { const int i = 32 * ta + crow(q, h); Ls[i * LSTR + j] = (j < i) ? bt[i] * acc[q] * __expf(gc[i] - gj) : 0.f; }
                    } else {
                        const int i = 32 * ta + r; const float gi = gc[i];
#pragma unroll
                        for (int q = 0; q < 16; ++q) { const int j = 32 * tb + crow(q, h); acc[q] = (j <= i) ? acc[q] * __expf(gi - gc[j]) : 0.f; }
#pragma unroll
                        for (int s2 = 0; s2 < 2; ++s2) *(bf16x8*)(ops + (48 + (ta * 2 + tb) * 2 + s2) * 1024 + lane * 16) = pack8(acc, s2);
                    }
                }
            }
            __syncthreads();
            if (((args.pad >> 2) & 7) == 3) continue;
            if (wave < 4) {
                const int d = tid & 127; const bool isw = tid >= 128;
                int z; asm volatile("v_mov_b32 %0, 0" : "=v"(z));
                const ldsf* Lz = Ls + z; const ldsf* btz = bt + z; const ldsf* egz = eg + z;
                float xr[32];
                const ldsf* srcx = (isw ? ks : vs) + d;
                ldsf* dst = (isw ? Wsm : vs) + d;
#pragma unroll
                for (int i = 0; i < 32; ++i) { const float e_ = egz[i]; xr[i] = srcx[i * 129] * btz[i] * (isw ? e_ : 1.0f); }
#pragma unroll
                for (int i = 32; i < 64; ++i) { const float e_ = egz[i]; dst[i * 129] = srcx[i * 129] * btz[i] * (isw ? e_ : 1.0f); }
#pragma unroll
                for (int i = 1; i < 32; ++i) {
                    float s0 = xr[i], s1 = 0.f;
#pragma unroll
                    for (int j4 = 0; j4 < (i + 3) / 4; ++j4) {
                        const f32x4 l = *(const LAS f32x4*)(Lz + i * LSTR + 4 * j4);
                        s0 -= l[0] * xr[4 * j4]; s1 -= l[1] * xr[4 * j4 + 1]; s0 -= l[2] * xr[4 * j4 + 2]; s1 -= l[3] * xr[4 * j4 + 3];
                    }
                    xr[i] = s0 + s1;
                    asm volatile("" ::: "memory");
                }
#pragma unroll
                for (int i = 0; i < 32; ++i) dst[i * 129] = xr[i];
            } else {
#pragma unroll 1
                for (int ff = 0; ff < 8; ++ff) {
                    const int f = (wave - 4) * 8 + ff;
                    v4u p; float v8[8];
                    if (f < 16) { const int mt = f >> 3, t2 = (f >> 1) & 3, s2 = f & 1; const int i = 32 * mt + r; const float e = eg[i];
#pragma unroll
                        for (int j = 0; j < 8; ++j) v8[j] = qs[i * 129 + 32 * t2 + 16 * s2 + 8 * (j >> 2) + 4 * h + (j & 3)] * e;
                    } else { const int g2 = f - 16, t2 = g2 >> 2, mt = (g2 >> 1) & 1, s2 = g2 & 1; const int d = 32 * t2 + r;
#pragma unroll
                        for (int j = 0; j < 8; ++j) { const int i = 32 * mt + 16 * s2 + 8 * (j >> 2) + 4 * h + (j & 3); v8[j] = ks[i * 129 + d] * ekd[i]; }
                    }
                    p.x = cvtpk(v8[0], v8[1]); p.y = cvtpk(v8[2], v8[3]); p.z = cvtpk(v8[4], v8[5]); p.w = cvtpk(v8[6], v8[7]);
                    *(v4u*)(ops + (16 + f) * 1024 + lane * 16) = p;
                }
            }
            __syncthreads();
            {
                ldsf* X = (wave < 4) ? vs + 32 * wave : Wsm + 32 * (wave - 4);
                f32x16 acc;
#pragma unroll
                for (int q = 0; q < 16; ++q) acc[q] = X[(32 + crow(q, h)) * 129 + r];
                const ldsf* Ap = Ls + (32 + r) * LSTR + h;
                const ldsf* Bp = X + h * 129 + r;
#pragma unroll 8
                for (int k = 0; k < 16; ++k) acc = __builtin_amdgcn_mfma_f32_32x32x2f32(-Ap[2 * k], Bp[(2 * k) * 129], acc, 0, 0, 0);
#pragma unroll
                for (int q = 0; q < 16; ++q) X[(32 + crow(q, h)) * 129 + r] = acc[q];
            }
            __syncthreads();
            if (wave < 4) {
                const int d = tid & 127; const bool isw = tid >= 128;
                int z; asm volatile("v_mov_b32 %0, 0" : "=v"(z));
                const ldsf* Lz = Ls + z;
                ldsf* dst = (isw ? Wsm : vs) + d;
                float xr[32];
#pragma unroll
                for (int i = 0; i < 32; ++i) xr[i] = dst[(32 + i) * 129];
#pragma unroll
                for (int i = 1; i < 32; ++i) {
                    float s0 = xr[i], s1 = 0.f;
#pragma unroll
                    for (int j4 = 0; j4 < (i + 3) / 4; ++j4) {
                        const f32x4 l = *(const LAS f32x4*)(Lz + (32 + i) * LSTR + 32 + 4 * j4);
                        s0 -= l[0] * xr[4 * j4]; s1 -= l[1] * xr[4 * j4 + 1]; s0 -= l[2] * xr[4 * j4 + 2]; s1 -= l[3] * xr[4 * j4 + 3];
                    }
                    xr[i] = s0 + s1;
                    asm volatile("" ::: "memory");
                }
#pragma unroll
                for (int i = 0; i < 32; ++i) dst[(32 + i) * 129] = xr[i];
            }
            __syncthreads();
            if (((args.pad >> 2) & 7) == 4) continue;
#pragma unroll
            for (int o = 0; o < 2; ++o) {
                const int idx8 = tid + NTHR * o, l2 = idx8 & 63, q8 = (idx8 >> 6) & 1, mt = (idx8 >> 7) & 1, w = idx8 >> 8;
                const int c = 32 * w + (l2 & 31), hh2 = l2 >> 5;
                float u8[8];
#pragma unroll
                for (int e = 0; e < 8; ++e) u8[e] = vs[(32 * mt + crow(8 * q8 + e, hh2)) * 129 + c];
                v4u p; p.x = cvtpk(u8[0], u8[1]); p.y = cvtpk(u8[2], u8[3]); p.z = cvtpk(u8[4], u8[5]); p.w = cvtpk(u8[6], u8[7]);
                *(v4u*)((unsigned char*)Ub + (size_t)item * 16384 + idx8 * 16) = p;
            }
#pragma unroll
            for (int ff = 0; ff < 2; ++ff) {
                const int f = wave * 2 + ff, mt = f >> 3, t2 = (f >> 1) & 3, s2 = f & 1; const int i = 32 * mt + r;
                float v8[8];
#pragma unroll
                for (int j = 0; j < 8; ++j) v8[j] = -Wsm[i * 129 + 32 * t2 + 16 * s2 + 8 * (j >> 2) + 4 * h + (j & 3)];
                v4u p; p.x = cvtpk(v8[0], v8[1]); p.y = cvtpk(v8[2], v8[3]); p.z = cvtpk(v8[4], v8[5]); p.w = cvtpk(v8[6], v8[7]);
                *(v4u*)(ops + f * 1024 + lane * 16) = p;
            }
            __syncthreads();
        }
        {
            const int r = lane & 31, h = lane >> 5;
            for (int it = (args.pad & 2) ? 2048 : gw; it < 2048; it += NGW) {
                const int c = it & 127, hh = (it >> 7) & 7, b = it >> 10;
                const bf16* base = projb + ((size_t)b * T + c * 64) * PCOLS + hh * 64;
#pragma unroll
                for (int kb2 = 0; kb2 < 2; ++kb2)
#pragma unroll
                    for (int ks = 0; ks < 4; ++ks) {
                        const bf16* rp = base + (size_t)(32 * kb2 + r) * PCOLS + 16 * ks + 8 * h;
                        *(v4u*)(qfb + (size_t)it * 8192 + (kb2 * 4 + ks) * 1024 + lane * 16) = *(const v4u*)(rp + 2048);
                        *(v4u*)(kfb + (size_t)it * 8192 + (kb2 * 4 + ks) * 1024 + lane * 16) = *(const v4u*)(rp + 2560);
                    }
#pragma unroll
                for (int dt = 0; dt < 2; ++dt)
#pragma unroll
                    for (int kb2 = 0; kb2 < 2; ++kb2)
#pragma unroll
                        for (int s2 = 0; s2 < 2; ++s2) {
                            unsigned short e8[8];
#pragma unroll
                            for (int j = 0; j < 8; ++j) e8[j] = base[(size_t)(32 * kb2 + 16 * s2 + 8 * (j >> 2) + 4 * h + (j & 3)) * PCOLS + 3072 + 32 * dt + r];
                            v4u p; p.x = e8[0] | ((unsigned)e8[1] << 16); p.y = e8[2] | ((unsigned)e8[3] << 16); p.z = e8[4] | ((unsigned)e8[5] << 16); p.w = e8[6] | ((unsigned)e8[7] << 16);
                            *(v4u*)(vtfb + (size_t)it * 8192 + ((dt * 2 + kb2) * 2 + s2) * 1024 + lane * 16) = p;
                        }
            }
        }
        if (BOTH(3)) GRID_BAR();
    }

    if (IN(4)) {
        const int lane = (int)__builtin_amdgcn_mbcnt_hi(~0u, __builtin_amdgcn_mbcnt_lo(~0u, 0u)), tid = wave * 64 + lane; const kargp_t ap_ = karg_ptr();
        if (bx < 64) {
            constexpr int SEGC = 16;
            const int bh = bx & 7, seg = bx >> 3, b = bh >> 2, hh = bh & 3;
            const int r = lane & 31, h = lane >> 5;
            const int c0 = seg * SEGC;
#define SCAN_BAR() do { asm volatile("s_waitcnt lgkmcnt(0)" ::: "memory"); __builtin_amdgcn_s_barrier(); asm volatile("" ::: "memory"); } while (0)
#define FRAG(f_) (*(const LAS bf16x8*)(Bf + (f_) * 1024))
            {
                const unsigned char* ops = opsb + (size_t)(bh * 128 + c0) * OPS_BYTES;
                const float* Uf = (const float*)((const unsigned char*)Ub + (size_t)(bh * 128 + c0) * 16384);
                float* segp = (float*)(args.ws + WS_SEG) + (size_t)(bh * 8 + seg) * 32768;
                ldsf* egls = (ldsf*)(lds + 4 * 32768);
                if (tid < SEGC) egls[tid] = glbuf[bh * 128 + c0 + tid];
                const int pbase = (wave < 6) ? (wave - 4) * 8 : 32 + (wave - 6) * 8, fbase = (wave - 4) * 8;
#define A_DMA(n_) do { const unsigned char* src_ = ops + (size_t)(n_) * OPS_BYTES + pbase * 1024 + lane * 16; \
                _Pragma("unroll") for (int p_ = 0; p_ < 8; ++p_) __builtin_amdgcn_global_load_lds((const unsigned*)(src_ + p_ * 1024), (LAS unsigned*)(lds + ((n_) & 3) * 32768 + (fbase + p_) * 1024), 16, 0, 0); } while (0)
                f32x16 S[4]; v4u Ur[4];
#pragma unroll
                for (int t2 = 0; t2 < 4; ++t2)
#pragma unroll
                    for (int q = 0; q < 16; ++q) S[t2][q] = (wave >= 4 && (32 * t2 + crow(q, h)) == (32 * (wave - 4) + r)) ? 1.0f : 0.0f;
#pragma unroll
                for (int f = 0; f < 4; ++f) Ur[f] = (v4u){0u, 0u, 0u, 0u};
                if (wave < 4) {
#pragma unroll
                    for (int f = 0; f < 4; ++f) Ur[f] = *((const v4u*)Uf + (wave * 4 + f) * 64 + lane);
                } else { A_DMA(0); A_DMA(1); A_DMA(2); }
                for (int n = 0; n < SEGC; ++n) {
                    if (wave >= 4) { if (n <= SEGC - 3) asm volatile("s_waitcnt vmcnt(16)" ::: "memory"); else if (n == SEGC - 2) asm volatile("s_waitcnt vmcnt(8)" ::: "memory"); else asm volatile("s_waitcnt vmcnt(0)" ::: "memory"); }
                    SCAN_BAR();
                    if (wave >= 4 && n + 3 < SEGC) A_DMA(n + 3);
                    const LAS unsigned char* Bf = lds + (n & 3) * 32768 + lane * 16;
                    f32x16 VN[2];
#pragma unroll
                    for (int mt = 0; mt < 2; ++mt)
#pragma unroll
                        for (int q8 = 0; q8 < 2; ++q8) { const v4u u = Ur[mt * 2 + q8];
                            VN[mt][8 * q8 + 0] = bflo(u.x); VN[mt][8 * q8 + 1] = bfhi(u.x); VN[mt][8 * q8 + 2] = bflo(u.y); VN[mt][8 * q8 + 3] = bfhi(u.y);
                            VN[mt][8 * q8 + 4] = bflo(u.z); VN[mt][8 * q8 + 5] = bfhi(u.z); VN[mt][8 * q8 + 6] = bflo(u.w); VN[mt][8 * q8 + 7] = bfhi(u.w); }
                    if (wave < 4 && n + 1 < SEGC) {
                        const v4u* up = (const v4u*)((const unsigned char*)Uf + (size_t)(n + 1) * 16384) + (wave * 4) * 64 + lane;
#pragma unroll
                        for (int f = 0; f < 4; ++f) Ur[f] = up[f * 64];
                    }
                    const float egl = egls[n];
#pragma unroll
                    for (int t2 = 0; t2 < 4; ++t2)
#pragma unroll
                        for (int s2 = 0; s2 < 2; ++s2) {
                            const bf16x8 sb = pack8(S[t2], s2);
#pragma unroll
                            for (int mt = 0; mt < 2; ++mt) VN[mt] = MFMA32(FRAG((mt * 4 + t2) * 2 + s2), sb, VN[mt]);
                        }
                    bf16x8 vb[2][2];
#pragma unroll
                    for (int mt = 0; mt < 2; ++mt)
#pragma unroll
                        for (int s2 = 0; s2 < 2; ++s2) vb[mt][s2] = pack8(VN[mt], s2);
#pragma unroll
                    for (int t2 = 0; t2 < 4; ++t2) {
#pragma unroll
                        for (int q = 0; q < 16; ++q) S[t2][q] *= egl;
#pragma unroll
                        for (int mt = 0; mt < 2; ++mt)
#pragma unroll
                            for (int s2 = 0; s2 < 2; ++s2) S[t2] = MFMA32(FRAG(16 + (t2 * 2 + mt) * 2 + s2), vb[mt][s2], S[t2]);
                    }
                }
#undef A_DMA
                if (wave < 4) {
#pragma unroll
                    for (int t2 = 0; t2 < 4; ++t2)
#pragma unroll
                        for (int q = 0; q < 16; ++q) segp[((wave * 4 + t2) * 16 + q) * 64 + lane] = S[t2][q];
                } else {
                    unsigned short* pp = (unsigned short*)(args.ws + WS_SEGP) + (size_t)(bh * 8 + seg) * 16384 + (((wave - 4) * 2 + (r >> 4)) * 64 + 32 * ((r >> 3) & 1)) * 8 + (r & 7);
#pragma unroll
                    for (int t2 = 0; t2 < 4; ++t2)
#pragma unroll
                        for (int q = 0; q < 16; ++q) pp[(t2 * 8 * 64 + crow(q, h)) * 8] = (unsigned short)f2bf(S[t2][q]);
                }
            }
            asm volatile("s_waitcnt vmcnt(0)" ::: "memory");
            __syncthreads();
            if (tid == 0) { __builtin_amdgcn_fence(__ATOMIC_RELEASE, "agent"); asm volatile("s_waitcnt vmcnt(0)" ::: "memory"); __hip_atomic_fetch_add(ctl + CW_SEGA + 64 * bh, 1u, RLX_AGENT); }
            if (seg == 0) {
                if (tid == 0) { unsigned sp_ = 0; while (__hip_atomic_load(ctl + CW_SEGA + 64 * bh, RLX_AGENT) < 8u) { __builtin_amdgcn_s_sleep(4); if (++sp_ > (1u << 24)) break; }
                    __builtin_amdgcn_fence(__ATOMIC_ACQUIRE, "agent"); asm volatile("s_waitcnt vmcnt(0)" ::: "memory"); }
                __syncthreads();
                constexpr int ST_ROW = 272, ST_BYTES = 128 * ST_ROW;
                const int nt = wave & 3, mt0 = 2 * (wave >> 2);
                const float* seg0 = (const float*)(args.ws + WS_SEG) + (size_t)(bh * 8) * 32768;
                const unsigned char* pa0 = args.ws + WS_SEGP + (size_t)(bh * 8) * 32768 + lane * 16;
                float* sst0 = (float*)(args.ws + WS_SST) + (size_t)(bh * 8) * 16384;
#define PB_LOADA(dst, k_) do { const unsigned char* pk_ = pa0 + (size_t)(k_) * 32768; \
                    _Pragma("unroll") for (int i_ = 0; i_ < 2; ++i_) _Pragma("unroll") for (int f_ = 0; f_ < 8; ++f_) dst[i_ * 8 + f_] = *(const bf16x8*)(pk_ + (((mt0 + i_) * 4) * 2 + f_) * 1024); } while (0)
#define PB_ITER(k_, Acur, Anext) do { \
                    if ((k_) + 1 <= 6) PB_LOADA(Anext, (k_) + 1); \
                    const float* sk_ = seg0 + (size_t)(k_) * 32768; \
                    f32x16 z0_[2], Z_[2]; \
                    _Pragma("unroll") for (int i_ = 0; i_ < 2; ++i_) _Pragma("unroll") for (int q_ = 0; q_ < 16; ++q_) { z0_[i_][q_] = sk_[((nt * 4 + mt0 + i_) * 16 + q_) * 64 + lane]; Z_[i_][q_] = 0.f; } \
                    if ((k_) > 0) { const LAS unsigned char* stc_ = lds + ((k_) & 1) * ST_BYTES + (32 * nt + r) * ST_ROW + 16 * h; \
                        _Pragma("unroll") for (int f_ = 0; f_ < 8; ++f_) { const bf16x8 bfr_ = *(const LAS bf16x8*)(stc_ + (16 * f_) * 2); \
                            Z_[0] = MFMA32(Acur[f_], bfr_, Z_[0]); Z_[1] = MFMA32(Acur[8 + f_], bfr_, Z_[1]); } } \
                    float* so_ = sst0 + (size_t)((k_) + 1) * 16384; \
                    LAS unsigned char* stn_ = lds + (((k_) + 1) & 1) * ST_BYTES + (32 * nt + r) * ST_ROW; \
                    _Pragma("unroll") for (int i_ = 0; i_ < 2; ++i_) { \
                        _Pragma("unroll") for (int q_ = 0; q_ < 16; ++q_) { Z_[i_][q_] += z0_[i_][q_]; so_[((nt * 4 + mt0 + i_) * 16 + q_) * 64 + lane] = Z_[i_][q_]; } \
                        _Pragma("unroll") for (int q_ = 0; q_ < 16; q_ += 2) *(LAS unsigned*)(stn_ + (32 * (mt0 + i_) + crow(q_, h)) * 2) = cvtpk(Z_[i_][q_], Z_[i_][q_ + 1]); } \
                    SCAN_BAR(); } while (0)
                bf16x8 Aa[16], Ab[16];
#pragma unroll
                for (int f = 0; f < 16; ++f) { Aa[f] = (bf16x8){0, 0, 0, 0, 0, 0, 0, 0}; Ab[f] = Aa[f]; }
                PB_ITER(0, Ab, Aa);
                PB_ITER(1, Aa, Ab);
                PB_ITER(2, Ab, Aa);
                PB_ITER(3, Aa, Ab);
                PB_ITER(4, Ab, Aa);
                PB_ITER(5, Aa, Ab);
                PB_ITER(6, Ab, Aa);
#undef PB_ITER
#undef PB_LOADA
                asm volatile("s_waitcnt vmcnt(0)" ::: "memory");
                __syncthreads();
                if (tid == 0) { __builtin_amdgcn_fence(__ATOMIC_RELEASE, "agent"); asm volatile("s_waitcnt vmcnt(0)" ::: "memory"); __hip_atomic_store(ctl + CW_SEGB + 64 * bh, 1u, RLX_AGENT); }
            }
            if (tid == 0) { unsigned sp_ = 0; while (__hip_atomic_load(ctl + CW_SEGB + 64 * bh, RLX_AGENT) == 0u) { __builtin_amdgcn_s_sleep(4); if (++sp_ > (1u << 24)) break; }
                __builtin_amdgcn_fence(__ATOMIC_ACQUIRE, "agent"); asm volatile("s_waitcnt vmcnt(0)" ::: "memory"); }
            __syncthreads();
#undef FRAG
            const kargp_t ap2_ = karg_ptr();
            const unsigned char* ops = ((*ap2_).ws + WS_OPS) + (size_t)(bh * 128 + c0) * OPS_BYTES;
            const float* Uf = (const float*)((const unsigned char*)((*ap2_).ws + WS_U) + (size_t)(bh * 128 + c0) * 16384);
            const float* sstp = (const float*)((*ap2_).ws + WS_SST) + (size_t)(bh * 8 + seg) * 16384;
#define SCAN_DMA(n_, buf_) do { const unsigned char* src_ = ops + (size_t)(n_) * OPS_BYTES + ((wave - 4) * 14) * 1024 + lane * 16; \
            _Pragma("unroll") for (int p_ = 0; p_ < 14; ++p_) __builtin_amdgcn_global_load_lds((const unsigned*)(src_ + p_ * 1024), (LAS unsigned*)(lds + (buf_) * OPS_BYTES + ((wave - 4) * 14 + p_) * 1024), 16, 0, 0); } while (0)
            constexpr int STG_OFF = 2 * OPS_BYTES, STG_ROW = 272, STG_BYTES = 64 * STG_ROW;
            if (wave < 4) {
                f32x16 S[4]; v4u Ur[4];
#pragma unroll
                for (int t2 = 0; t2 < 4; ++t2)
#pragma unroll
                    for (int q = 0; q < 16; ++q) S[t2][q] = (seg > 0) ? sstp[((wave * 4 + t2) * 16 + q) * 64 + lane] : 0.f;
#pragma unroll
                for (int f = 0; f < 4; ++f) Ur[f] = *((const v4u*)Uf + (wave * 4 + f) * 64 + lane);
                const float* glp = glbuf + bh * 128 + c0;
                float eglr = glp[0];
                for (int n = 0; n < SEGC; ++n) {
                    SCAN_BAR();
                    const LAS unsigned char* Bf = lds + (n & 1) * OPS_BYTES + lane * 16;
#define FRAG(f_) (*(const LAS bf16x8*)(Bf + (f_) * 1024))
                    f32x16 VN[2], O[2];
#pragma unroll
                    for (int mt = 0; mt < 2; ++mt)
#pragma unroll
                        for (int q8 = 0; q8 < 2; ++q8) { const v4u u = Ur[mt * 2 + q8];
                            VN[mt][8 * q8 + 0] = bflo(u.x); VN[mt][8 * q8 + 1] = bfhi(u.x); VN[mt][8 * q8 + 2] = bflo(u.y); VN[mt][8 * q8 + 3] = bfhi(u.y);
                            VN[mt][8 * q8 + 4] = bflo(u.z); VN[mt][8 * q8 + 5] = bfhi(u.z); VN[mt][8 * q8 + 6] = bflo(u.w); VN[mt][8 * q8 + 7] = bfhi(u.w); }
                    const float egl = eglr;
                    if (n + 1 < SEGC) {
                        const v4u* up = (const v4u*)((const unsigned char*)Uf + (size_t)(n + 1) * 16384) + (wave * 4) * 64 + lane;
#pragma unroll
                        for (int f = 0; f < 4; ++f) Ur[f] = up[f * 64];
                        eglr = glp[n + 1];
                    }
#pragma unroll
                    for (int mt = 0; mt < 2; ++mt)
#pragma unroll
                        for (int q = 0; q < 16; ++q) O[mt][q] = 0.f;
#pragma unroll
                    for (int t2 = 0; t2 < 4; ++t2)
#pragma unroll
                        for (int s2 = 0; s2 < 2; ++s2) {
                            const bf16x8 sb = pack8(S[t2], s2);
#pragma unroll
                            for (int mt = 0; mt < 2; ++mt) {
                                VN[mt] = MFMA32(FRAG((mt * 4 + t2) * 2 + s2), sb, VN[mt]);
                                O[mt] = MFMA32(FRAG(16 + (mt * 4 + t2) * 2 + s2), sb, O[mt]);
                            }
                        }
                    bf16x8 vb[2][2];
#pragma unroll
                    for (int mt = 0; mt < 2; ++mt)
#pragma unroll
                        for (int s2 = 0; s2 < 2; ++s2) vb[mt][s2] = pack8(VN[mt], s2);
#pragma unroll
                    for (int s2 = 0; s2 < 2; ++s2) {
                        O[0] = MFMA32(FRAG(48 + 0 * 2 + s2), vb[0][s2], O[0]);
                        O[1] = MFMA32(FRAG(48 + 2 * 2 + s2), vb[0][s2], O[1]);
                        O[1] = MFMA32(FRAG(48 + 3 * 2 + s2), vb[1][s2], O[1]);
                    }
                    {
                        LAS unsigned short* sp = (LAS unsigned short*)(lds + STG_OFF + (n & 1) * STG_BYTES) + 32 * wave + r;
#pragma unroll
                        for (int mt = 0; mt < 2; ++mt)
#pragma unroll
                            for (int q = 0; q < 16; q += 2) { const unsigned w = cvtpk(O[mt][q], O[mt][q + 1]);
                                sp[(32 * mt + crow(q, h)) * (STG_ROW / 2)] = (unsigned short)(w & 0xffffu); sp[(32 * mt + crow(q + 1, h)) * (STG_ROW / 2)] = (unsigned short)(w >> 16); }
                    }
                    SCAN_BAR();
#pragma unroll
                    for (int t2 = 0; t2 < 4; ++t2) {
#pragma unroll
                        for (int q = 0; q < 16; ++q) S[t2][q] *= egl;
#pragma unroll
                        for (int mt = 0; mt < 2; ++mt)
#pragma unroll
                            for (int s2 = 0; s2 < 2; ++s2) S[t2] = MFMA32(FRAG(32 + (t2 * 2 + mt) * 2 + s2), vb[mt][s2], S[t2]);
                    }
#undef FRAG
                }
                SCAN_BAR();
            } else {
                const int w4 = wave - 4, row = 16 * w4 + (lane >> 2), qt = lane & 3;
                const bf16* zp = zsb + ((size_t)b * T + c0 * 64 + row) * 512 + hh * 128 + qt * 32;
                bf16* op = omix + ((size_t)b * T + c0 * 64 + row) * D + hh * 128 + qt * 32;
                SCAN_DMA(0, 0);
                asm volatile("s_waitcnt vmcnt(0)" ::: "memory");
                v4u zr[4];
#pragma unroll
                for (int k = 0; k < 4; ++k) zr[k] = *(const v4u*)(zp + 8 * k);
                unsigned pfacc = 0u, pf0 = 0u, pf1 = 0u;
                for (int n = 0; n <= SEGC; ++n) {
                    SCAN_BAR();
                    if (n < SEGC - 1) SCAN_DMA(n + 1, (n + 1) & 1);
                    asm volatile("" ::: "memory");
                    if (n < SEGC - 2) {
                        const unsigned char* pf = ops + (size_t)(n + 2) * OPS_BYTES + (w4 * 112 + lane) * 128;
                        pfacc += pf0 + pf1; pf0 = *(const unsigned*)pf; pf1 = (lane < 48) ? *(const unsigned*)(pf + 64 * 128) : 0u;
                    }
                    asm volatile("" ::: "memory");
                    if (n < SEGC) SCAN_BAR();
                    if (n > 0) {
                        const LAS unsigned char* sp = lds + STG_OFF + ((n - 1) & 1) * STG_BYTES + row * STG_ROW + qt * 64;
                        v4u ov[4]; float ss = 0.f;
#pragma unroll
                        for (int k = 0; k < 4; ++k) { ov[k] = *(const LAS v4u*)(sp + 16 * k);
                            const float a0 = bflo(ov[k].x), a1 = bfhi(ov[k].x), a2 = bflo(ov[k].y), a3 = bfhi(ov[k].y), a4 = bflo(ov[k].z), a5 = bfhi(ov[k].z), a6 = bflo(ov[k].w), a7 = bfhi(ov[k].w);
                            ss += (a0 * a0 + a1 * a1) + (a2 * a2 + a3 * a3) + (a4 * a4 + a5 * a5) + (a6 * a6 + a7 * a7); }
                        ss += __shfl_xor(ss, 1); ss += __shfl_xor(ss, 2);
                        const float rstd = rsqrtf(ss * (1.0f / 128.0f) + EPS);
                        bf16* o2 = op + (size_t)(n - 1) * 64 * D;
#pragma unroll
                        for (int k = 0; k < 4; ++k) {
                            v4u w;
                            w.x = cvtpk(bflo(ov[k].x) * rstd * bflo(zr[k].x), bfhi(ov[k].x) * rstd * bfhi(zr[k].x));
                            w.y = cvtpk(bflo(ov[k].y) * rstd * bflo(zr[k].y), bfhi(ov[k].y) * rstd * bfhi(zr[k].y));
                            w.z = cvtpk(bflo(ov[k].z) * rstd * bflo(zr[k].z), bfhi(ov[k].z) * rstd * bfhi(zr[k].z));
                            w.w = cvtpk(bflo(ov[k].w) * rstd * bflo(zr[k].w), bfhi(ov[k].w) * rstd * bfhi(zr[k].w));
                            *(v4u*)(o2 + 8 * k) = w;
                        }
                    }
                    asm volatile("" ::: "memory");
                    if (n >= 1 && n < SEGC) {
#pragma unroll
                        for (int k = 0; k < 4; ++k) zr[k] = *(const v4u*)(zp + (size_t)n * 64 * 512 + 8 * k);
                    }
                    asm volatile("" ::: "memory");
                    if (n < SEGC) { if (n == 0 || n >= SEGC - 2) asm volatile("s_waitcnt vmcnt(0)" ::: "memory"); else asm volatile("s_waitcnt vmcnt(10)" ::: "memory"); }
                }
                if (pfacc == 0x12345679u) glbuf[1024 + lane] = 1.0f;
            }
#undef SCAN_DMA
#undef SCAN_BAR
        } else {
            const float* relb = args.in[I_RELB];
            ldsf* rbl = (ldsf*)lds;
            for (int idx = tid; idx < 8 * 257; idx += NTHR) rbl[idx] = relb[idx] * 1.4426950408889634f;
            __syncthreads();
            const int r = lane & 31, h = lane >> 5;
            const int AW = (G - 64) * NWAVES, aw = (bx - 64) * NWAVES + wave;
            for (int task = aw; task < 4096; task += AW) {
                const int qh = task & 1, hh = (task >> 1) & 7, n = (task >> 4) & 127, b = task >> 11;
                const int bhc = (b * 8 + hh) * 128;
                bf16x8 qf[4];
#pragma unroll
                for (int ks = 0; ks < 4; ++ks) qf[ks] = *(const bf16x8*)(qfb + (size_t)(bhc + n) * 8192 + (qh * 4 + ks) * 1024 + lane * 16);
                f32x16 OT[2];
#pragma unroll
                for (int dt = 0; dt < 2; ++dt)
#pragma unroll
                    for (int q = 0; q < 16; ++q) OT[dt][q] = 0.f;
                float m = -1e30f, l = 0.f;
                const float c0 = rbl[hh * 257 + 256];
                const int iq = 32 * qh + r;
                const int cb0 = (n >= 8) ? 0 : 8 - n;
                for (int blk = cb0 * 2; blk < 18; ++blk) {
                    const int cb = blk >> 1, kb2 = blk & 1, cidx = n - 8 + cb;
                    const unsigned char* kp = kfb + (size_t)(bhc + cidx) * 8192 + (kb2 * 4) * 1024 + lane * 16;
                    const unsigned char* vp = vtfb + (size_t)(bhc + cidx) * 8192 + lane * 16;
                    bf16x8 kf[4], vf[2][2];
#pragma unroll
                    for (int ks = 0; ks < 4; ++ks) kf[ks] = *(const bf16x8*)(kp + ks * 1024);
#pragma unroll
                    for (int dt = 0; dt < 2; ++dt)
#pragma unroll
                        for (int s2 = 0; s2 < 2; ++s2) vf[dt][s2] = *(const bf16x8*)(vp + ((dt * 2 + kb2) * 2 + s2) * 1024);
                    f32x16 st;
#pragma unroll
                    for (int q = 0; q < 16; ++q) st[q] = 0.f;
#pragma unroll
                    for (int ks = 0; ks < 4; ++ks) st = MFMA32(kf[ks], qf[ks], st);
                    if (cb >= 6) {
                        const int kpos0 = cb * 64 + 32 * kb2;
#pragma unroll
                        for (int q = 0; q < 16; ++q) { int rel = iq + 512 - (kpos0 + crow(q, h)); rel = rel > 128 ? 128 : rel; st[q] = st[q] * 0.18033688011112042f + rbl[hh * 257 + rel + 128]; }
                    } else {
#pragma unroll
                        for (int q = 0; q < 16; ++q) st[q] = st[q] * 0.18033688011112042f + c0;
                    }
                    float bm = st[0];
#pragma unroll
                    for (int q = 1; q < 16; ++q) bm = fmaxf(bm, st[q]);
                    bm = fmaxf(bm, __shfl_xor(bm, 32));
                    const float mn = fmaxf(m, bm);
                    if (__any(mn > m)) {
                        const float corr = __builtin_amdgcn_exp2f(m - mn);
                        l *= corr;
#pragma unroll
                        for (int dt = 0; dt < 2; ++dt)
#pragma unroll
                            for (int q = 0; q < 16; ++q) OT[dt][q] *= corr;
                        m = mn;
                    }
                    float ps = 0.f;
#pragma unroll
                    for (int q = 0; q < 16; ++q) { st[q] = __builtin_amdgcn_exp2f(st[q] - m); ps += st[q]; }
                    ps += __shfl_xor(ps, 32);
                    l += ps;
                    const bf16x8 p0 = pack8(st, 0), p1 = pack8(st, 1);
#pragma unroll
                    for (int dt = 0; dt < 2; ++dt) { OT[dt] = MFMA32(vf[dt][0], p0, OT[dt]); OT[dt] = MFMA32(vf[dt][1], p1, OT[dt]); }
                }
                const float inv = 1.0f / l;
                bf16* op = omix + ((size_t)b * T + n * 64 + iq) * D + 512 + hh * 64;
#pragma unroll
                for (int dt = 0; dt < 2; ++dt)
#pragma unroll
                    for (int q4 = 0; q4 < 4; ++q4) {
                        v2u w; w.x = cvtpk(OT[dt][4 * q4] * inv, OT[dt][4 * q4 + 1] * inv); w.y = cvtpk(OT[dt][4 * q4 + 2] * inv, OT[dt][4 * q4 + 3] * inv);
                        *(v2u*)(op + 32 * dt + 8 * q4 + 4 * h) = w;
                    }
            }
            __syncthreads();
            {
                ldsf* scr = (ldsf*)(lds + wave * 16384);
                constexpr int I_UP1 = 16 * 64, I_DN1 = 16 * 32;
                for (int it = aw; it < NE * (I_UP1 + I_DN1); it += AW) {
                    int r2 = it;
                    if (r2 < NE * I_UP1) { const int e = r2 / I_UP1; transpose_item8(args.in[I_WUP] + (size_t)e * D * 2048, D, 2048, (unsigned char*)WupT + (size_t)e * 2048 * D, 2, scr, r2 % I_UP1, lane); continue; } r2 -= NE * I_UP1;
                    { const int e = r2 / I_DN1; transpose_item8(args.in[I_WDN] + (size_t)e * D * D, D, D, (unsigned char*)WdnT + (size_t)e * D * D, 1, scr, r2 % I_DN1, lane); }
                }
            }
        }
        if (BOTH(4)) GRID_BAR();
    }


    if (IN(6)) {
        const int lane = (int)__builtin_amdgcn_mbcnt_hi(~0u, __builtin_amdgcn_mbcnt_lo(~0u, 0u)), tid = wave * 64 + lane; const kargp_t ap_ = karg_ptr();
        pg8::Gemm g{omix, WoutT, NTOK, D, D}; pg8::StaticOrder S; S.init(NTOK, D, G, bx);
        pg8::EpiBf16 E{ybuf, D, nullptr, nullptr, 0, 1.0f};
        pg8::gemm_phase<pg8::EpiBf16, pg8::StaticOrder, true, true>(lds, g, S, E, tid);
        if (BOTH(6)) GRID_BAR();
    }

    if (IN(7)) {
        const int lane = (int)__builtin_amdgcn_mbcnt_hi(~0u, __builtin_amdgcn_mbcnt_lo(~0u, 0u)), tid = wave * 64 + lane; const kargp_t ap_ = karg_ptr();
        ldsf* wrT = (ldsf*)lds;
        { const char* src = (const char*)(P_WS + WS_WR) + (size_t)wave * 16384 + lane * 16;
#pragma unroll
          for (int p = 0; p < 16; ++p) __builtin_amdgcn_global_load_lds((const unsigned*)(src + p * 1024), (LAS unsigned*)(lds + wave * 16384 + p * 1024), 16, 0, 0); }
        LAS int* lcnt = (LAS int*)(lds + 131072);
        if (tid < 32) lcnt[tid] = 0;
        asm volatile("s_waitcnt vmcnt(0)" ::: "memory");
        __syncthreads();
        const float* nw1 = args.in[I_NORMW] + 1024; const float* nw2 = args.in[I_NORMW] + 2048; const float* b_r = args.in[I_BR];
        typedef unsigned u32x2_t __attribute__((ext_vector_type(2)));
        u32x2_t ynx[4]; f32x4 xnx[4];
#pragma unroll
        for (int j = 0; j < 4; ++j) { ynx[j] = *((const u32x2_t*)(ybuf + (size_t)gw * D) + lane + 64 * j); xnx[j] = *((const f32x4*)(Xp + (size_t)gw * D) + lane + 64 * j); }
        for (int bb = 0; bb < BATCH; ++bb) {
        f32x4 g1v[4], a2v[4], sh2v[4];
#pragma unroll
        for (int j = 0; j < 4; ++j) { const int col = 4 * lane + 256 * j;
            const f32x4 n1 = *(const f32x4*)(nw1 + col), ga = *(const f32x4*)(MODp + bb * 6144 + 2048 + col), n2 = *(const f32x4*)(nw2 + col), sc = *(const f32x4*)(MODp + bb * 6144 + 4096 + col);
            sh2v[j] = *(const f32x4*)(MODp + bb * 6144 + 3072 + col);
#pragma unroll
            for (int e = 0; e < 4; ++e) { g1v[j][e] = ga[e] * n1[e]; a2v[j][e] = n2[e] * (1.0f + sc[e]); } }
        for (int r = gw + bb * (NTOK / BATCH); r < (bb + 1) * (NTOK / BATCH); r += NGW) {
            f32x4 v[4], xv4[4]; float ss = 0.f;
#pragma unroll
            for (int j = 0; j < 4; ++j) { v[j] = (f32x4){__uint_as_float(ynx[j].x << 16), __uint_as_float(ynx[j].x & 0xffff0000u), __uint_as_float(ynx[j].y << 16), __uint_as_float(ynx[j].y & 0xffff0000u)}; xv4[j] = xnx[j]; ss += (v[j].x * v[j].x + v[j].y * v[j].y) + (v[j].z * v[j].z + v[j].w * v[j].w); }
            __builtin_amdgcn_sched_barrier(0);
            if (r + NGW < NTOK) {
#pragma unroll
                for (int j = 0; j < 4; ++j) { ynx[j] = *((const u32x2_t*)(ybuf + (size_t)(r + NGW) * D) + lane + 64 * j); xnx[j] = *((const f32x4*)(Xp + (size_t)(r + NGW) * D) + lane + 64 * j); }
            }
            __builtin_amdgcn_sched_barrier(0);
            const float rstd1 = rsqrtf(wave_sum(ss) * (1.0f / D) + EPS);
            float ss2 = 0.f;
#pragma unroll
            for (int j = 0; j < 4; ++j) {
#pragma unroll
                for (int e = 0; e < 4; ++e) { v[j][e] = xv4[j][e] + g1v[j][e] * (v[j][e] * rstd1); ss2 += v[j][e] * v[j][e]; }
            }
            const float rstd2 = rsqrtf(wave_sum(ss2) * (1.0f / D) + EPS);
            f32x4 hv[4]; unsigned h8[4];
#pragma unroll
            for (int j = 0; j < 4; ++j) {
#pragma unroll
                for (int e = 0; e < 4; ++e) hv[j][e] = v[j][e] * rstd2 * a2v[j][e] + sh2v[j][e];
                h8[j] = pg8::pk4_fp8(hv[j][0], hv[j][1], hv[j][2], hv[j][3]);
            }
#pragma unroll
            for (int j = 0; j < 4; ++j) { const int col = 4 * lane + 256 * j; *(f32x4*)(OUTp + (size_t)r * D + col) = v[j]; *(unsigned*)((unsigned char*)hbuf + (size_t)r * D + col) = h8[j]; }
            float pe[32];
#pragma unroll
            for (int e = 0; e < 32; ++e) {
                float p = 0.f;
#pragma unroll
                for (int j = 0; j < 4; ++j) { const f32x4 w = *(const LAS f32x4*)(wrT + e * 1024 + 4 * lane + 256 * j); p += (hv[j][0] * w[0] + hv[j][1] * w[1]) + (hv[j][2] * w[2] + hv[j][3] * w[3]); }
                pe[e] = p;
                if ((e & 1) == 1) asm volatile("" ::: "memory");
            }
            float r16[16];
            { const bool up = lane >= 32;
#pragma unroll
              for (int e = 0; e < 16; ++e) { const float send = up ? pe[e] : pe[e + 16], keep = up ? pe[e + 16] : pe[e]; r16[e] = keep + xchg32(send, lane); } }
            float r8[8];
            { const bool up = (lane & 16) != 0;
#pragma unroll
              for (int e = 0; e < 8; ++e) { const float send = up ? r16[e] : r16[e + 8], keep = up ? r16[e + 8] : r16[e]; r8[e] = keep + xchg16(send, lane); } }
            float r4[4];
            { const bool up = (lane & 8) != 0;
#pragma unroll
              for (int e = 0; e < 4; ++e) { const float send = up ? r8[e] : r8[e + 4], keep = up ? r8[e + 4] : r8[e]; r4[e] = keep + dppx<0x128>(send); } }
            float r2[2];
            { const bool up = (lane & 4) != 0;
#pragma unroll
              for (int e = 0; e < 2; ++e) { const float send = up ? r4[e] : r4[e + 2], keep = up ? r4[e + 2] : r4[e]; r2[e] = keep + __shfl_xor(send, 4); } }
            float r1;
            { const bool up = (lane & 2) != 0; const float send = up ? r2[0] : r2[1], keep = up ? r2[1] : r2[0]; r1 = keep + dppx<0x4E>(send); }
            r1 += dppx<0xB1>(r1);
            const int eid = ((lane >> 5) << 4) | (((lane >> 4) & 1) << 3) | (((lane >> 3) & 1) << 2) | (((lane >> 2) & 1) << 1) | ((lane >> 1) & 1);
            float mylg = r1 + b_r[eid];
            int se[4]; float sv[4];
#pragma unroll
            for (int k = 0; k < 4; ++k) {
                const float bv = wave_max(mylg); const int bi = wave_min_i(mylg == bv ? eid : 99);
                se[k] = bi; sv[k] = bv;
                if (eid == bi) mylg = -3.0e38f;
            }
            const float e1 = __expf(sv[1] - sv[0]), e2 = __expf(sv[2] - sv[0]), e3 = __expf(sv[3] - sv[0]);
            const float inv = 1.0f / (1.0f + e1 + e2 + e3);
            if (lane < 4 && !(args.pad & 32)) {
                const int mye = lane == 0 ? se[0] : (lane == 1 ? se[1] : (lane == 2 ? se[2] : se[3]));
                const float myg = (lane == 0 ? 1.0f : (lane == 1 ? e1 : (lane == 2 ? e2 : e3))) * inv;
                const unsigned pos = atomicAdd((unsigned*)lcnt + mye, 1u);
                asg_e[r * 4 + lane] = mye; asg_p[r * 4 + lane] = (int)pos; asg_g[r * 4 + lane] = myg;
            }
        }
        }
        __syncthreads();
        if (tid < 32) ((int*)(ctl + CW_HIST))[vcu * 32 + tid] = lcnt[tid];
        if (BOTH(7)) GRID_BAR();
    }

    LAS int* pst = (LAS int*)(lds + MISC_OFF + 512);
    LAS int* tile_e = (LAS int*)(lds + MISC_OFF + 768);
    LAS int* wbase = (LAS int*)(lds + MISC_OFF + 384);
    if (hi > 8 && lo <= 10) {
        const kargp_t ap_ = karg_ptr();
        const int tix = wave * 64 + (int)__builtin_amdgcn_mbcnt_hi(~0u, __builtin_amdgcn_mbcnt_lo(~0u, 0u));
        {
            LAS int* tmp = (LAS int*)lds;
            const int e = tix & 31, part = tix >> 5; int tot = 0, bef = 0;
            const int* hist = (const int*)(ctl + CW_HIST);
            for (int bb = part; bb < G; bb += 16) { const int c = hist[bb * 32 + e]; tot += c; bef += (bb < vcu) ? c : 0; }
            tmp[part * 32 + e] = tot; tmp[512 + part * 32 + e] = bef;
            __syncthreads();
            if (tix < 32) { int t2 = 0, b2 = 0;
#pragma unroll
                for (int p = 0; p < 16; ++p) { t2 += tmp[p * 32 + tix]; b2 += tmp[512 + p * 32 + tix]; }
                tmp[1024 + tix] = t2; wbase[tix] = b2; ((LAS int*)(lds + MISC_OFF + 1920))[tix] = t2; }
            __syncthreads();
            if (tix == 0) { int run = 0, rt = 0;
                for (int e2 = 0; e2 < NE; ++e2) { pst[e2] = run; const int c = tmp[1024 + e2]; const int nt = (c + 255) >> 8; for (int t2 = 0; t2 < nt; ++t2) tile_e[rt++] = e2; run += nt * 256; }
                pst[32] = run; }
        }
        __syncthreads();
    }
    const int nslots = (hi > 8 && lo <= 10) ? pst[32] : 0;

    if (IN(8)) {
        const int lane = (int)__builtin_amdgcn_mbcnt_hi(~0u, __builtin_amdgcn_mbcnt_lo(~0u, 0u)), tid = wave * 64 + lane; const kargp_t ap_ = karg_ptr();
        {
            int* stok = (int*)(P_WS + WS_STOK);
            for (int r = gw; r < NTOK; r += NGW) {
                if (lane < 4) { const int a = r * 4 + lane; const int e = asg_e[a], pos = asg_p[a]; const int slot = pst[e] + wbase[e] + pos; asg_s[a] = slot; stok[slot] = r; }
            }
            if (bx < NE) {
                const int c = ((LAS int*)(lds + MISC_OFF + 1920))[bx], pad = (c + 255) & ~255;
                for (int s2 = c + tid; s2 < pad; s2 += NTHR) stok[pst[bx] + s2] = 0;
            }
        }
        if (BOTH(8)) GRID_BAR();
    }

    if (IN(9)) {
        const int lane = (int)__builtin_amdgcn_mbcnt_hi(~0u, __builtin_amdgcn_mbcnt_lo(~0u, 0u)), tid = wave * 64 + lane; const kargp_t ap_ = karg_ptr();
        pg8::Gemm g{hbuf, WupT, nslots, 2048, D}; pg8::MoeOrder S; S.init(nslots, 2048, G, bx); S.tile_e = tile_e; S.estride = (size_t)2048 * D; S.rowidx = (const int*)(P_WS + WS_STOK);
        pg8::EpiSwiGLU E{(unsigned char*)actb, args.in[I_BUP], tile_e, 1.0f / 32.0f};
        pg8::gemm_phase<pg8::EpiSwiGLU, pg8::MoeOrder, true, true, true, true>(lds, g, S, E, tid);
        if (BOTH(9)) GRID_BAR();
    }

    if (IN(10)) {
        const int lane = (int)__builtin_amdgcn_mbcnt_hi(~0u, __builtin_amdgcn_mbcnt_lo(~0u, 0u)), tid = wave * 64 + lane; const kargp_t ap_ = karg_ptr();
        pg8::Gemm g{actb, WdnT, nslots, D, D}; pg8::MoeOrder S; S.init(nslots, D, G, bx); S.tile_e = tile_e; S.estride = (size_t)D * D;
        pg8::EpiBf16 E{yslot, D, args.in[I_BDN], tile_e, D, 1.0f / 32.0f};
        pg8::gemm_phase<pg8::EpiBf16, pg8::MoeOrder, true, true, true>(lds, g, S, E, tid);
        if (BOTH(10)) GRID_BAR();
    }

    if (IN(11)) {
        const int lane = (int)__builtin_amdgcn_mbcnt_hi(~0u, __builtin_amdgcn_mbcnt_lo(~0u, 0u)), tid = wave * 64 + lane; const kargp_t ap_ = karg_ptr();
        const float* nw3 = args.in[I_NORMW] + 3072;
        int sln[4]; float gtn[4];
#pragma unroll
        for (int k = 0; k < 4; ++k) { sln[k] = asg_s[gw * 4 + k]; gtn[k] = asg_g[gw * 4 + k]; }
        v2u ywn[4][4]; f32x4 xon[4]; float gtc[4];
#pragma unroll
        for (int k = 0; k < 4; ++k) { gtc[k] = gtn[k];
#pragma unroll
            for (int j = 0; j < 4; ++j) ywn[k][j] = *(const v2u*)(yslot + (size_t)sln[k] * D + 4 * lane + 256 * j); }
#pragma unroll
        for (int j = 0; j < 4; ++j) xon[j] = *(const f32x4*)(OUTp + (size_t)gw * D + 4 * lane + 256 * j);
        if (gw + NGW < NTOK) {
#pragma unroll
            for (int k = 0; k < 4; ++k) { sln[k] = asg_s[(gw + NGW) * 4 + k]; gtn[k] = asg_g[(gw + NGW) * 4 + k]; }
        }
        for (int bb = 0; bb < BATCH; ++bb) {
        f32x4 g3v[4];
#pragma unroll
        for (int j = 0; j < 4; ++j) { const int col = 4 * lane + 256 * j; const f32x4 n3 = *(const f32x4*)(nw3 + col), ga = *(const f32x4*)(MODp + bb * 6144 + 5120 + col);
#pragma unroll
            for (int e = 0; e < 4; ++e) g3v[j][e] = ga[e] * n3[e]; }
        for (int r = gw + bb * (NTOK / BATCH); r < (bb + 1) * (NTOK / BATCH); r += NGW) {
            v2u yw[4][4]; f32x4 xo[4]; float gt[4];
#pragma unroll
            for (int k = 0; k < 4; ++k) { gt[k] = gtc[k];
#pragma unroll
                for (int j = 0; j < 4; ++j) yw[k][j] = ywn[k][j]; }
#pragma unroll
            for (int j = 0; j < 4; ++j) xo[j] = xon[j];
            __builtin_amdgcn_sched_barrier(0);
            if (r + NGW < NTOK) {
#pragma unroll
                for (int k = 0; k < 4; ++k) { gtc[k] = gtn[k];
#pragma unroll
                    for (int j = 0; j < 4; ++j) ywn[k][j] = *(const v2u*)(yslot + (size_t)sln[k] * D + 4 * lane + 256 * j); }
#pragma unroll
                for (int j = 0; j < 4; ++j) xon[j] = *(const f32x4*)(OUTp + (size_t)(r + NGW) * D + 4 * lane + 256 * j);
                if (r + 2 * NGW < NTOK) {
#pragma unroll
                    for (int k = 0; k < 4; ++k) { sln[k] = asg_s[(r + 2 * NGW) * 4 + k]; gtn[k] = asg_g[(r + 2 * NGW) * 4 + k]; }
                }
            }
            __builtin_amdgcn_sched_barrier(0);
            f32x4 acc[4];
#pragma unroll
            for (int j = 0; j < 4; ++j) { acc[j] = (f32x4){0.f, 0.f, 0.f, 0.f};
#pragma unroll
                for (int k = 0; k < 4; ++k) { acc[j][0] += gt[k] * bflo(yw[k][j].x); acc[j][1] += gt[k] * bfhi(yw[k][j].x); acc[j][2] += gt[k] * bflo(yw[k][j].y); acc[j][3] += gt[k] * bfhi(yw[k][j].y); } }
            float ss = 0.f;
#pragma unroll
            for (int j = 0; j < 4; ++j) ss += (acc[j][0] * acc[j][0] + acc[j][1] * acc[j][1]) + (acc[j][2] * acc[j][2] + acc[j][3] * acc[j][3]);
            const float rstd = rsqrtf(wave_sum(ss) * (1.0f / D) + EPS);
#pragma unroll
            for (int j = 0; j < 4; ++j) {
                const int col = 4 * lane + 256 * j;
                f32x4 xv = xo[j];
#pragma unroll
                for (int e = 0; e < 4; ++e) xv[e] += g3v[j][e] * (acc[j][e] * rstd);
                if (!(args.pad & 32)) *(f32x4*)(OUTp + (size_t)r * D + col) = xv;
            }
        }
        }
    }
#undef IN
#undef BOTH
}

#undef P_WS
#undef ctl
#undef Xp
#undef OUTp
#undef MODp
#undef gbuf
#undef betabuf
#undef glbuf
#undef asg_e
#undef asg_p
#undef asg_g
#undef asg_s
#undef WinT
#undef WoutT
#undef WupT
#undef WdnT
#undef hbuf
#undef projb
#undef Ub
#undef opsb
#undef zsb
#undef qfb
#undef kfb
#undef vtfb
#undef omix
#undef ybuf
#undef xg
#undef actb
#undef yslot
#undef args
constexpr int NPHASES = 12;

extern "C" void kernel_launch(void* const* d_in, const int* in_sizes, int n_in, void* d_out, int out_size, void* d_ws, size_t ws_size, hipStream_t stream) {
    static int grid = 0;
    if (grid == 0) {
        if (n_in != 18 || out_size != NTOK * D || ws_size < WS_END) { fprintf(stderr, "kernel_launch: unexpected shapes (n_in %d out %d ws %zu)\n", n_in, out_size, ws_size); grid = -1; return; }
        int dev = 0, cus = 0, per_cu = 0;
        if (hipGetDevice(&dev) != hipSuccess || hipDeviceGetAttribute(&cus, hipDeviceAttributeMultiprocessorCount, dev) != hipSuccess) { grid = -1; return; }
        if (hipFuncSetAttribute((const void*)mk_fwd, hipFuncAttributeMaxDynamicSharedMemorySize, LDS_BYTES) != hipSuccess) { fprintf(stderr, "kernel_launch: hipFuncSetAttribute failed\n"); grid = -1; return; }
        if (hipOccupancyMaxActiveBlocksPerMultiprocessor(&per_cu, (const void*)mk_fwd, NTHR, LDS_BYTES) != hipSuccess || per_cu < 1) { fprintf(stderr, "kernel_launch: occupancy query says %d blocks per CU\n", per_cu); grid = -1; return; }
        (void)hipGetLastError();
        grid = cus;
    }
    if (grid < 0) return;
    (void)hipMemsetAsync((char*)d_ws + WS_CTL, 0, CTL_ZERO_BYTES, stream);
    Args a{};
    for (int i = 0; i < 18; ++i) a.in[i] = (const float*)d_in[i];
    a.out = (float*)d_out; a.ws = (unsigned char*)d_ws;
#if MK_ONE_LAUNCH
#ifndef PROBE_PHASE
#define PROBE_PHASE -1
#endif
#ifndef PROBE_SUB
#define PROBE_SUB 0
#endif
    if (PROBE_PHASE >= 0) {
        const int k = PROBE_PHASE;
        a.ph_lo = 0; a.ph_hi = k + 1; a.li = 0; hipLaunchKernelGGL(mk_fwd, dim3(grid), dim3(NTHR), LDS_BYTES, stream, a);
        a.ph_lo = k; a.ph_hi = k + 1; a.li = 1; a.pad = (k == 7 || k == 11) ? 32 : PROBE_SUB; hipLaunchKernelGGL(mk_fwd, dim3(grid), dim3(NTHR), LDS_BYTES, stream, a); a.pad = 0;
        if (k + 1 < NPHASES) { a.ph_lo = k + 1; a.ph_hi = NPHASES; a.li = 2; hipLaunchKernelGGL(mk_fwd, dim3(grid), dim3(NTHR), LDS_BYTES, stream, a); }
        return;
    }
    a.ph_lo = 0; a.ph_hi = NPHASES; a.li = 0;
    hipLaunchKernelGGL(mk_fwd, dim3(grid), dim3(NTHR), LDS_BYTES, stream, a);
#else
    for (int p = 0; p < NPHASES; ++p) { a.ph_lo = p; a.ph_hi = p + 1; a.li = p; hipLaunchKernelGGL(mk_fwd, dim3(grid), dim3(NTHR), LDS_BYTES, stream, a); }
#endif
}
```

```cpp
#include <hip/hip_runtime.h>
#include <cstdio>
#include <cstdint>

#ifndef MK_ONE_LAUNCH
#define MK_ONE_LAUNCH 1
#endif

namespace pg8 {
#define PG8_LAS __attribute__((address_space(3)))
typedef unsigned short bf16_t;
typedef short bf16x8 __attribute__((ext_vector_type(8)));
typedef float f32x4 __attribute__((ext_vector_type(4)));
typedef unsigned u32x4 __attribute__((ext_vector_type(4)));
constexpr int BM = 256, BK = 64, HALF = 128, HTB = HALF * BK * 2, STAGE_BYTES = 8 * HTB, NXCD = 8, WGM = 8;

__host__ __device__ __forceinline__ int lds_byte(int r, int c) { const int st = (r >> 4) * 2 + (c >> 5), rr = r & 15, cc = c & 31, ob = rr * 64 + cc * 2; return st * 1024 + (ob ^ (((ob >> 9) & 1) << 5)); }
__host__ __device__ __forceinline__ void stage_rc(int b, int& R, int& C) { const int st = b / 1024, sb = b % 1024, swz = sb ^ (((sb >> 9) & 1) << 5); R = (st >> 1) * 16 + swz / 64; C = (st & 1) * 32 + (swz % 64) / 2; }
__host__ __device__ __forceinline__ int perm32(int rho) { const int n = rho >> 4, i = rho & 15; return 8 * (i >> 2) + 4 * n + (i & 3); }

struct Unit { int pm, pn; };
struct Gemm { const bf16_t* A; const bf16_t* Bt; int M, N, K; };

struct StaticOrder {
    int nM, nN, nwg, G, c;
    __host__ __device__ void init(int M, int N, int G_, int c_) { nM = M / BM; nN = N / BM; nwg = nM * nN; G = G_; c = c_; }
    __host__ __device__ bool next(int i, Unit& u) const {
        const long L = (long)i * G + c; if (L >= nwg) return false;
        int wgid = (int)L; { const int q = nwg / NXCD, r = nwg % NXCD, xcd = wgid % NXCD, off = wgid / NXCD; wgid = (xcd < r ? xcd * (q + 1) : r * (q + 1) + (xcd - r) * q) + off; }
        const int nig = WGM * nN, gid = wgid / nig, fm = gid * WGM, gsz = (nM - fm) < WGM ? (nM - fm) : WGM;
        u.pm = fm + ((wgid % nig) % gsz); u.pn = (wgid % nig) / gsz; return true;
    }
    __device__ __forceinline__ size_t boff(const Unit&) const { return 0; }
    const int* rowidx = nullptr;
};
struct MoeOrder : StaticOrder {
    const PG8_LAS int* tile_e; size_t estride;
    __device__ __forceinline__ size_t boff(const Unit& u) const { return (size_t)tile_e[u.pm] * estride; }
};

typedef int v8i_t __attribute__((ext_vector_type(8)));
typedef int v4i_t __attribute__((ext_vector_type(4)));
__device__ __forceinline__ v8i_t cat8(bf16x8 lo, bf16x8 hi) { const v4i_t a = __builtin_bit_cast(v4i_t, lo), b = __builtin_bit_cast(v4i_t, hi); return __builtin_shufflevector(a, b, 0, 1, 2, 3, 4, 5, 6, 7); }
__device__ __forceinline__ unsigned pk4_fp8(float a, float b, float c, float d) {
    a = fminf(fmaxf(a, -448.f), 448.f); b = fminf(fmaxf(b, -448.f), 448.f); c = fminf(fmaxf(c, -448.f), 448.f); d = fminf(fmaxf(d, -448.f), 448.f);
    int w = 0; w = __builtin_amdgcn_cvt_pk_fp8_f32(a, b, w, false); w = __builtin_amdgcn_cvt_pk_fp8_f32(c, d, w, true); return (unsigned)w; }
__device__ __forceinline__ unsigned cvt_pk_bf16(float lo, float hi) { unsigned r; asm volatile("v_cvt_pk_bf16_f32 %0, %1, %2" : "=v"(r) : "v"(lo), "v"(hi)); return r; }

struct EpiF32 {
    static constexpr bool PERM = false;
    float* C; int ldc;
    __device__ __forceinline__ void operator()(const f32x4 (&acc)[2][2][4][2], const Unit& u, int wr, int wc, int fr, int fq) const {
        const int row0 = u.pm * BM + wr * 64 + fr, col0 = u.pn * BM + wc * 32 + 4 * fq;
#pragma unroll
        for (int ai = 0; ai < 2; ++ai)
#pragma unroll
            for (int m = 0; m < 4; ++m) { float* rowp = C + (size_t)(row0 + ai * HALF + m * 16) * ldc + col0;
#pragma unroll
                for (int bj = 0; bj < 2; ++bj)
#pragma unroll
                    for (int n = 0; n < 2; ++n) *(f32x4*)(rowp + bj * HALF + n * 16) = acc[ai][bj][m][n]; }
    }
};
struct EpiBf16 {
    static constexpr bool PERM = true;
    bf16_t* O; int ldc; const float* bias; const PG8_LAS int* tile_e; int bstride; float scale;
    __device__ __forceinline__ void operator()(const f32x4 (&acc)[2][2][4][2], const Unit& u, int wr, int wc, int fr, int fq) const {
        const int row0 = u.pm * BM + wr * 64 + fr; const int col0 = u.pn * BM + wc * 32 + 8 * fq;
        f32x4 bv[2][2];
        const float* bp = bias ? bias + (size_t)tile_e[u.pm] * bstride + col0 : nullptr;
#pragma unroll
        for (int bj = 0; bj < 2; ++bj)
#pragma unroll
            for (int n = 0; n < 2; ++n) bv[bj][n] = bias ? *(const f32x4*)(bp + bj * HALF + 4 * n) : (f32x4){0.f, 0.f, 0.f, 0.f};
#pragma unroll
        for (int ai = 0; ai < 2; ++ai)
#pragma unroll
            for (int m = 0; m < 4; ++m) { bf16_t* rowp = O + (size_t)(row0 + ai * HALF + m * 16) * ldc + col0;
#pragma unroll
                for (int bj = 0; bj < 2; ++bj) { f32x4 v0 = acc[ai][bj][m][0] * scale + bv[bj][0], v1 = acc[ai][bj][m][1] * scale + bv[bj][1];
                    u32x4 w; w.x = cvt_pk_bf16(v0[0], v0[1]); w.y = cvt_pk_bf16(v0[2], v0[3]); w.z = cvt_pk_bf16(v1[0], v1[1]); w.w = cvt_pk_bf16(v1[2], v1[3]);
                    *(u32x4*)(rowp + bj * HALF) = w; } }
    }
};
struct EpiSwiGLU {
    static constexpr bool PERM = true;
    unsigned char* O; const float* b_up; const PG8_LAS int* tile_e; float scale;
    typedef float f32x2_t __attribute__((ext_vector_type(2)));
    __device__ __forceinline__ f32x2_t act2(float g0, float g1, float l0, float l1) const {
        const f32x2_t g = {fminf(g0, 7.0f), fminf(g1, 7.0f)};
        const f32x2_t l = {__builtin_amdgcn_fmed3f(l0, -6.0f, 8.0f), __builtin_amdgcn_fmed3f(l1, -6.0f, 8.0f)};
        const f32x2_t t = g * (-1.702f * 1.4426950408889634f);
        const f32x2_t d = (f32x2_t){__builtin_amdgcn_exp2f(t.x), __builtin_amdgcn_exp2f(t.y)} + 1.0f;
        const f32x2_t r = {__builtin_amdgcn_rcpf(d.x), __builtin_amdgcn_rcpf(d.y)};
        return g * r * l;
    }
    __device__ __forceinline__ unsigned act4(const f32x4 g, const f32x4 l) const {
        const f32x2_t a = act2(g[0], g[1], l[0], l[1]), b = act2(g[2], g[3], l[2], l[3]);
        int w = 0; w = __builtin_amdgcn_cvt_pk_fp8_f32(a.x, a.y, w, false); w = __builtin_amdgcn_cvt_pk_fp8_f32(b.x, b.y, w, true); return (unsigned)w;
    }
    __device__ __forceinline__ void operator()(const f32x4 (&acc)[2][2][4][2], const Unit& u, int wr, int wc, int fr, int fq) const {
        const int row0 = u.pm * BM + wr * 64 + fr; const int cin = wc * 32 + 8 * fq;
        const float* bg = b_up + (size_t)tile_e[u.pm] * 2048 + 128 * u.pn + cin;
        f32x4 bgv[2], blv[2];
#pragma unroll
        for (int n = 0; n < 2; ++n) { bgv[n] = *(const f32x4*)(bg + 4 * n); blv[n] = *(const f32x4*)(bg + 1024 + 4 * n) + 1.0f; }
#pragma unroll
        for (int ai = 0; ai < 2; ++ai)
#pragma unroll
            for (int m = 0; m < 4; ++m) { unsigned char* rowp = O + (size_t)(row0 + ai * HALF + m * 16) * 1024 + 128 * u.pn + cin;
                const f32x4 g0 = acc[ai][0][m][0] * scale + bgv[0], g1 = acc[ai][0][m][1] * scale + bgv[1], l0 = acc[ai][1][m][0] * scale + blv[0], l1 = acc[ai][1][m][1] * scale + blv[1];
                const unsigned w0 = act4(g0, l0), w1 = act4(g1, l1);
                typedef unsigned u32x2_t __attribute__((ext_vector_type(2)));
                *(u32x2_t*)rowp = (u32x2_t){w0, w1}; }
    }
};

template <class Epi, class Sched, bool ALIGN_EPI = false, bool SP2 = false, bool F8 = false, bool GATHER = false>
__device__ __forceinline__ void gemm_phase(PG8_LAS unsigned char* lds, const Gemm g, const Sched& S, const Epi& E, const int tid) {
    const int wid = __builtin_amdgcn_readfirstlane(tid >> 6), lane = tid & 63, wr = wid >> 2, wc = wid & 3, fr = lane & 15, fq = lane >> 4;
    constexpr int ES = F8 ? 1 : 2;
    const int K = g.K, nt = K * ES / 128;
    unsigned voffA[2], voffB[2]; int gR[2], gC[2];
#pragma unroll
    for (int i = 0; i < 2; ++i) { int R, C; stage_rc(tid * 16 + i * 8192, R, C); const int Rb = Epi::PERM ? ((R & ~31) + perm32(R & 31)) : R; gR[i] = R; gC[i] = C * 2;
        voffA[i] = (unsigned)(R * K * ES + C * 2); voffB[i] = (unsigned)(Rb * K * ES + C * 2); }
    unsigned vAc0[2] = {0u, 0u}, vAc1[2] = {0u, 0u}, vAn0[2] = {0u, 0u}, vAn1[2] = {0u, 0u};
#define PG8_GIDX(dst0, dst1, u_) do { _Pragma("unroll") for (int _i = 0; _i < 2; ++_i) { \
        dst0[_i] = (unsigned)S.rowidx[(u_).pm * BM + gR[_i]] * (unsigned)(K * ES) + (unsigned)gC[_i]; dst1[_i] = (unsigned)S.rowidx[(u_).pm * BM + HALF + gR[_i]] * (unsigned)(K * ES) + (unsigned)gC[_i]; } } while (0)
    const size_t kstep = (size_t)(BK * 2);
    const size_t hstep = (size_t)HALF * K * ES;
    const size_t tstep = 2 * hstep;
    const unsigned ldsw = (unsigned)wid * 1024u;
    const int aoff = lds_byte(wr * 64 + fr, fq * 8), boff = lds_byte(wc * 32 + fr, fq * 8);
#define PG8_SA(b, h) (((b) * 2 + (h)) * HTB)
#define PG8_SB(b, h) ((4 + (b) * 2 + (h)) * HTB)
#define PG8_STAGE(bufoff, gbase, voff) do { _Pragma("unroll") for (int _i = 0; _i < 2; ++_i) \
        __builtin_amdgcn_global_load_lds((const unsigned*)((const char*)(gbase) + (voff)[_i]), (PG8_LAS unsigned*)(lds + (bufoff) + ldsw + _i * 8192), 16, 0, 0); } while (0)
#define PG8_STAGE_A(bufoff, ptr_, half_, koff_, nxt_) do { if constexpr (GATHER) { _Pragma("unroll") for (int _i = 0; _i < 2; ++_i) { \
            const unsigned vo_ = (half_) ? ((nxt_) ? vAn1[_i] : vAc1[_i]) : ((nxt_) ? vAn0[_i] : vAc0[_i]); \
            __builtin_amdgcn_global_load_lds((const unsigned*)((const char*)g.A + (koff_) + vo_), (PG8_LAS unsigned*)(lds + (bufoff) + ldsw + _i * 8192), 16, 0, 0); } } \
        else PG8_STAGE(bufoff, ptr_, voffA); } while (0)
#define PG8_LDA(dst, b, h) do { _Pragma("unroll") for (int m = 0; m < 4; ++m) _Pragma("unroll") for (int k = 0; k < 2; ++k) dst[m][k] = *(const PG8_LAS bf16x8*)(lds + PG8_SA(b, h) + aoff + m * 2048 + k * 1024); } while (0)
#define PG8_LDB(dst, b, h) do { _Pragma("unroll") for (int n = 0; n < 2; ++n) _Pragma("unroll") for (int k = 0; k < 2; ++k) dst[n][k] = *(const PG8_LAS bf16x8*)(lds + PG8_SB(b, h) + boff + n * 2048 + k * 1024); } while (0)
#define PG8_MMA(ai, bj, At, Bt) do { __builtin_amdgcn_s_setprio(1); _Pragma("unroll") for (int m = 0; m < 4; ++m) _Pragma("unroll") for (int n = 0; n < 2; ++n) { \
        if constexpr (F8) { asm volatile("v_mfma_scale_f32_16x16x128_f8f6f4 %0, %1, %2, %0, %3, %3 op_sel_hi:[0,0,0]" : "+v"(acc[ai][bj][m][n]) : "v"(cat8(Bt[n][0], Bt[n][1])), "v"(cat8(At[m][0], At[m][1])), "v"(0x7f7f7f7f)); } \
        else { _Pragma("unroll") for (int k = 0; k < 2; ++k) acc[ai][bj][m][n] = __builtin_amdgcn_mfma_f32_16x16x32_bf16(Bt[n][k], At[m][k], acc[ai][bj][m][n], 0, 0, 0); } } \
        __builtin_amdgcn_s_setprio(0); } while (0)
#define PG8_WAIT_V(n) asm volatile("s_waitcnt vmcnt(" #n ")" ::: "memory")
#define PG8_WAIT_L(n) asm volatile("s_waitcnt lgkmcnt(" #n ")" ::: "memory")
#define PG8_BAR __builtin_amdgcn_s_barrier()
#define PG8_SCHED __builtin_amdgcn_sched_barrier(0)
    Unit cur, nxt; int ui = 0;
    if (!S.next(0, cur)) return;
    f32x4 acc[2][2][4][2];
#pragma unroll
    for (int a = 0; a < 2; ++a)
#pragma unroll
        for (int b = 0; b < 2; ++b)
#pragma unroll
            for (int m = 0; m < 4; ++m)
#pragma unroll
                for (int n = 0; n < 2; ++n) acc[a][b][m][n] = (f32x4){0.f, 0.f, 0.f, 0.f};
    bf16x8 At[4][2], B0[2][2], B1[2][2];
    const char* cA = (const char*)g.A + (size_t)cur.pm * tstep; const char* cB = (const char*)g.Bt + S.boff(cur) + (size_t)cur.pn * tstep;
    if constexpr (GATHER) { PG8_GIDX(vAc0, vAc1, cur); }
    if constexpr (SP2) {
        PG8_STAGE(PG8_SB(0, 0), cB, voffB); PG8_STAGE(PG8_SB(0, 1), cB + hstep, voffB); PG8_STAGE_A(PG8_SA(0, 0), cA, 0, 0, false); PG8_STAGE_A(PG8_SA(0, 1), cA + hstep, 1, 0, false);
        if (wr == 1) PG8_BAR;
        PG8_WAIT_V(2); PG8_BAR;
        PG8_STAGE(PG8_SB(1, 0), cB + kstep, voffB); PG8_STAGE_A(PG8_SA(1, 0), cA + kstep, 0, kstep, false); PG8_STAGE(PG8_SB(1, 1), cB + hstep + kstep, voffB);
        PG8_WAIT_V(6); PG8_BAR;
    } else {
        PG8_STAGE(PG8_SB(0, 0), cB, voffB); PG8_STAGE(PG8_SA(0, 0), cA, voffA); PG8_STAGE(PG8_SB(0, 1), cB + hstep, voffB); PG8_STAGE(PG8_SA(0, 1), cA + hstep, voffA);
        if (wr == 1) PG8_BAR;
        PG8_WAIT_V(4); PG8_BAR;
        PG8_STAGE(PG8_SB(1, 0), cB + kstep, voffB); PG8_STAGE(PG8_SA(1, 0), cA + kstep, voffA); PG8_STAGE(PG8_SB(1, 1), cB + hstep + kstep, voffB);
        PG8_WAIT_V(6); PG8_BAR;
    }
    for (;;) {
        const bool has_next = S.next(ui + 1, nxt);
        const char* nA = has_next ? (const char*)g.A + (size_t)nxt.pm * tstep : cA; const char* nB = has_next ? (const char*)g.Bt + S.boff(nxt) + (size_t)nxt.pn * tstep : cB;
        if constexpr (GATHER) {
            if (has_next) { if (wid == 0) __builtin_amdgcn_global_load_lds((const unsigned*)(S.rowidx + (size_t)nxt.pm * BM + lane * 4), (PG8_LAS unsigned*)(lds + 131072 + ((ui + 1) & 1) * 1024), 16, 0, 0); }
            else { vAn0[0] = vAc0[0]; vAn0[1] = vAc0[1]; vAn1[0] = vAc1[0]; vAn1[1] = vAc1[1]; } }
        for (int t = 0; t < nt; t += 2) {
            const bool last = (t == nt - 2);
            const char* a1 = cA + (size_t)(t + 1) * kstep;
            const char* a2 = last ? nA : cA + (size_t)(t + 2) * kstep; const char* b2 = last ? nB : cB + (size_t)(t + 2) * kstep;
            const char* a3 = a2 + kstep; const char* b3 = b2 + kstep;
            const size_t ko1 = (size_t)(t + 1) * kstep, ko2 = last ? 0 : (size_t)(t + 2) * kstep, ko3 = ko2 + kstep;
            if constexpr (GATHER) { if (last && has_next) { const PG8_LAS int* ix_ = (const PG8_LAS int*)(lds + 131072 + ((ui + 1) & 1) * 1024);
#pragma unroll
                for (int _i = 0; _i < 2; ++_i) { vAn0[_i] = (unsigned)ix_[gR[_i]] * (unsigned)(K * ES) + (unsigned)gC[_i]; vAn1[_i] = (unsigned)ix_[HALF + gR[_i]] * (unsigned)(K * ES) + (unsigned)gC[_i]; } } }
            if constexpr (SP2) {
            PG8_LDB(B0, 0, 0); PG8_LDB(B1, 0, 1); PG8_SCHED; PG8_LDA(At, 0, 0); PG8_STAGE_A(PG8_SA(1, 1), a1 + hstep, 1, ko1, false);
            PG8_WAIT_V(8); PG8_WAIT_L(0); PG8_BAR; PG8_MMA(0, 0, At, B0); PG8_MMA(0, 1, At, B1); PG8_BAR; PG8_SCHED;
            PG8_LDA(At, 0, 1); PG8_STAGE(PG8_SB(0, 0), b2, voffB); PG8_STAGE(PG8_SB(0, 1), b2 + hstep, voffB); PG8_STAGE_A(PG8_SA(0, 0), a2, 0, ko2, last);
            PG8_WAIT_V(8); PG8_WAIT_L(0); PG8_BAR; PG8_MMA(1, 0, At, B0); PG8_MMA(1, 1, At, B1); PG8_BAR; PG8_SCHED;
            PG8_LDB(B0, 1, 0); PG8_LDB(B1, 1, 1); PG8_SCHED; PG8_LDA(At, 1, 0); PG8_STAGE_A(PG8_SA(0, 1), a2 + hstep, 1, ko2, last);
            PG8_WAIT_V(8); PG8_WAIT_L(0); PG8_BAR; PG8_MMA(0, 0, At, B0); PG8_MMA(0, 1, At, B1); PG8_BAR; PG8_SCHED;
            PG8_LDA(At, 1, 1); PG8_STAGE(PG8_SB(1, 0), b3, voffB); PG8_STAGE(PG8_SB(1, 1), b3 + hstep, voffB); PG8_STAGE_A(PG8_SA(1, 0), a3, 0, ko3, last);
            PG8_WAIT_V(8); PG8_WAIT_L(0); PG8_BAR; PG8_MMA(1, 0, At, B0); PG8_MMA(1, 1, At, B1); PG8_BAR; PG8_SCHED;
            } else {
            PG8_LDB(B0, 0, 0); PG8_SCHED; PG8_LDA(At, 0, 0); PG8_STAGE(PG8_SA(1, 1), a1 + hstep, voffA);
            PG8_WAIT_L(8); PG8_BAR; PG8_WAIT_L(0); PG8_MMA(0, 0, At, B0); PG8_BAR; PG8_SCHED;
            PG8_LDB(B1, 0, 1); PG8_STAGE(PG8_SB(0, 0), b2, voffB);
            PG8_BAR; PG8_WAIT_L(0); PG8_MMA(0, 1, At, B1); PG8_BAR;
            PG8_LDA(At, 0, 1); PG8_STAGE(PG8_SA(0, 0), a2, voffA);
            PG8_BAR; PG8_WAIT_L(0); PG8_MMA(1, 0, At, B0); PG8_BAR; PG8_SCHED;
            PG8_STAGE(PG8_SB(0, 1), b2 + hstep, voffB);
            PG8_WAIT_V(6); PG8_BAR; PG8_MMA(1, 1, At, B1); PG8_BAR;
            PG8_LDB(B0, 1, 0); PG8_SCHED; PG8_LDA(At, 1, 0); PG8_STAGE(PG8_SA(0, 1), a2 + hstep, voffA);
            PG8_WAIT_L(8); PG8_BAR; PG8_WAIT_L(0); PG8_MMA(0, 0, At, B0); PG8_BAR; PG8_SCHED;
            PG8_LDB(B1, 1, 1); PG8_STAGE(PG8_SB(1, 0), b3, voffB);
            PG8_BAR; PG8_WAIT_L(0); PG8_MMA(0, 1, At, B1); PG8_BAR;
            PG8_LDA(At, 1, 1); PG8_STAGE(PG8_SA(1, 0), a3, voffA);
            PG8_BAR; PG8_WAIT_L(0); PG8_MMA(1, 0, At, B0); PG8_BAR; PG8_SCHED;
            PG8_STAGE(PG8_SB(1, 1), b3 + hstep, voffB);
            PG8_WAIT_V(6); PG8_BAR; PG8_MMA(1, 1, At, B1); PG8_BAR;
            }
        }
        if constexpr (ALIGN_EPI) { if (wr == 0) PG8_BAR; }
        E(acc, cur, wr, wc, fr, fq);
        if (!has_next) break;
#pragma unroll
        for (int a = 0; a < 2; ++a)
#pragma unroll
            for (int b = 0; b < 2; ++b)
#pragma unroll
                for (int m = 0; m < 4; ++m)
#pragma unroll
                    for (int n = 0; n < 2; ++n) acc[a][b][m][n] = (f32x4){0.f, 0.f, 0.f, 0.f};
        cur = nxt; cA = nA; cB = nB; ++ui;
        if constexpr (GATHER) { vAc0[0] = vAn0[0]; vAc0[1] = vAn0[1]; vAc1[0] = vAn1[0]; vAc1[1] = vAn1[1]; }
        if constexpr (ALIGN_EPI) { if (wr == 1) PG8_BAR; }
    }
    PG8_WAIT_V(0);
    if constexpr (!ALIGN_EPI) { if (wr == 0) PG8_BAR; }
    PG8_BAR;
#undef PG8_SA
#undef PG8_SB
#undef PG8_STAGE
#undef PG8_LDA
#undef PG8_STAGE_A
#undef PG8_GIDX
#undef PG8_LDB
#undef PG8_MMA
#undef PG8_WAIT_V
#undef PG8_WAIT_L
#undef PG8_BAR
#undef PG8_SCHED
}
}

constexpr int NWAVES = 8, NTHR = 512;
constexpr int BATCH = 2, T = 8192, D = 1024, NTOK = BATCH * T;
constexpr int IN_COLS = 3592, PCOLS = 3584;
constexpr int NE = 32, NASSIGN = NTOK * 4, MAXTILES = NASSIGN / 256 + NE;
constexpr float EPS = 1e-6f;

constexpr size_t MiB = 1u << 20;
constexpr size_t WS_CTL = 0, CTL_ZERO_BYTES = 1 * MiB;
constexpr size_t WS_MOD = 1 * MiB;
constexpr size_t WS_G = WS_MOD + 64 * 1024;
constexpr size_t WS_BETA = WS_G + 256 * 1024;
constexpr size_t WS_GL = WS_BETA + 256 * 1024;
constexpr size_t WS_AE = WS_GL + 64 * 1024;
constexpr size_t WS_AP = WS_AE + 256 * 1024;
constexpr size_t WS_AG = WS_AP + 256 * 1024;
constexpr size_t WS_AS = WS_AG + 256 * 1024;
constexpr size_t WS_WG = WS_AS + 256 * 1024;
constexpr size_t WS_STOK = WS_WG + 64 * 1024;
constexpr size_t WS_WR = 4 * MiB;
constexpr size_t WS_WIN = 8 * MiB;
constexpr size_t WS_WOUT = 16 * MiB;
constexpr size_t WS_WUP = 20 * MiB;
constexpr size_t WS_WDN = 148 * MiB;
constexpr size_t WS_H = 212 * MiB;
constexpr size_t WS_PROJ = 244 * MiB;
constexpr size_t WS_U = 356 * MiB;
constexpr size_t WS_OPS = 388 * MiB;
constexpr int OPS_BYTES = 57344;
constexpr size_t WS_QF = 444 * MiB, WS_KF = 460 * MiB, WS_VTF = 476 * MiB;
constexpr size_t WS_OSCAN = 500 * MiB;
constexpr size_t WS_OMIX = 532 * MiB;
constexpr size_t WS_Y = 564 * MiB;
constexpr size_t WS_XG = 244 * MiB;
constexpr size_t WS_ACT = 388 * MiB;
constexpr size_t WS_ZS = 628 * MiB;
constexpr size_t WS_SEG = 644 * MiB;
constexpr size_t WS_SST = 652 * MiB;
constexpr size_t WS_SEGP = 656 * MiB;
constexpr size_t WS_END = 660 * MiB;
constexpr int CW_CNT = 64;
constexpr int CW_SEGA = 1024, CW_SEGB = 2048;
constexpr int CW_BAR = 4096;
constexpr int CW_HIST = 16384;

constexpr int LDS_BYTES = 163840, MISC_OFF = 161792;

#define GAS __attribute__((address_space(1)))
#define LAS __attribute__((address_space(3)))
typedef unsigned short bf16;
typedef unsigned v4u __attribute__((ext_vector_type(4)));
typedef unsigned v2u __attribute__((ext_vector_type(2)));
typedef float f32x4 __attribute__((ext_vector_type(4)));
typedef LAS float ldsf;
#define RLX_AGENT __ATOMIC_RELAXED, __HIP_MEMORY_SCOPE_AGENT
__device__ __forceinline__ unsigned f2bf(float f) { unsigned u = __builtin_bit_cast(unsigned, f); return (u + 0x7fffu + ((u >> 16) & 1u)) >> 16; }
__device__ __forceinline__ unsigned pk2(float lo, float hi) { return f2bf(lo) | (f2bf(hi) << 16); }
__device__ __forceinline__ float bf2f(unsigned h) { return __builtin_bit_cast(float, h << 16); }
__device__ __forceinline__ float bflo(unsigned w) { return __builtin_bit_cast(float, w << 16); }
__device__ __forceinline__ float bfhi(unsigned w) { return __builtin_bit_cast(float, w & 0xffff0000u); }
template <int CTRL, int ROWMASK> __device__ __forceinline__ float dppf(float v) {
    return __builtin_bit_cast(float, __builtin_amdgcn_update_dpp(0, __builtin_bit_cast(int, v), CTRL, ROWMASK, 0xF, false)); }
__device__ __forceinline__ float wave_sum(float v) {
    v += dppf<0x111, 0xF>(v); v += dppf<0x112, 0xF>(v); v += dppf<0x114, 0xF>(v); v += dppf<0x118, 0xF>(v);
    v += dppf<0x142, 0xA>(v); v += dppf<0x143, 0xC>(v);
    return __builtin_bit_cast(float, __builtin_amdgcn_readlane(__builtin_bit_cast(int, v), 63));
}
__device__ __forceinline__ float xchg32(float send, int lane) { const unsigned u = __builtin_bit_cast(unsigned, send); const auto r_ = __builtin_amdgcn_permlane32_swap(u, u, false, false); return __builtin_bit_cast(float, lane < 32 ? r_[1] : r_[0]); }
__device__ __forceinline__ float xchg16(float send, int lane) { const unsigned u = __builtin_bit_cast(unsigned, send); const auto r_ = __builtin_amdgcn_permlane16_swap(u, u, false, false); return __builtin_bit_cast(float, (lane & 16) ? r_[0] : r_[1]); }
template <int CTRL> __device__ __forceinline__ float dppx(float v) { return __builtin_bit_cast(float, __builtin_amdgcn_update_dpp(0, __builtin_bit_cast(int, v), CTRL, 0xF, 0xF, false)); }
template <int CTRL, int ROWMASK> __device__ __forceinline__ float dppf_o(float v, float old) { return __builtin_bit_cast(float, __builtin_amdgcn_update_dpp(__builtin_bit_cast(int, old), __builtin_bit_cast(int, v), CTRL, ROWMASK, 0xF, false)); }
template <int CTRL, int ROWMASK> __device__ __forceinline__ int dppi_o(int v, int old) { return __builtin_amdgcn_update_dpp(old, v, CTRL, ROWMASK, 0xF, false); }
__device__ __forceinline__ float wave_max(float v) {
    const float ni = -3.4e38f;
    v = fmaxf(v, dppf_o<0x111, 0xF>(v, ni)); v = fmaxf(v, dppf_o<0x112, 0xF>(v, ni)); v = fmaxf(v, dppf_o<0x114, 0xF>(v, ni)); v = fmaxf(v, dppf_o<0x118, 0xF>(v, ni));
    v = fmaxf(v, dppf_o<0x142, 0xA>(v, ni)); v = fmaxf(v, dppf_o<0x143, 0xC>(v, ni));
    return __builtin_bit_cast(float, __builtin_amdgcn_readlane(__builtin_bit_cast(int, v), 63));
}
__device__ __forceinline__ int wave_min_i(int v) {
    const int mi = 0x7fffffff;
    v = min(v, dppi_o<0x111, 0xF>(v, mi)); v = min(v, dppi_o<0x112, 0xF>(v, mi)); v = min(v, dppi_o<0x114, 0xF>(v, mi)); v = min(v, dppi_o<0x118, 0xF>(v, mi));
    v = min(v, dppi_o<0x142, 0xA>(v, mi)); v = min(v, dppi_o<0x143, 0xC>(v, mi));
    return __builtin_amdgcn_readlane(v, 63);
}
__device__ __forceinline__ float siluf(float x) { return x * __builtin_amdgcn_rcpf(1.0f + __builtin_amdgcn_exp2f(-1.4426950408889634f * x)); }
typedef float f32x16 __attribute__((ext_vector_type(16)));
typedef short bf16x8 __attribute__((ext_vector_type(8)));
typedef float f32x2_t __attribute__((ext_vector_type(2)));
typedef __bf16 bf16x2_t __attribute__((ext_vector_type(2)));
__device__ __forceinline__ unsigned cvtpk(float lo, float hi) { f32x2_t v = {lo, hi}; bf16x2_t b = __builtin_convertvector(v, bf16x2_t); return __builtin_bit_cast(unsigned, b); }
__device__ __forceinline__ bf16x8 pack8(const f32x16& x, int s) {
    v4u p; p.x = cvtpk(x[8 * s], x[8 * s + 1]); p.y = cvtpk(x[8 * s + 2], x[8 * s + 3]); p.z = cvtpk(x[8 * s + 4], x[8 * s + 5]); p.w = cvtpk(x[8 * s + 6], x[8 * s + 7]);
    return __builtin_bit_cast(bf16x8, p);
}
__device__ __forceinline__ int crow(int q, int h) { return (q & 3) + 8 * (q >> 2) + 4 * h; }
#define MFMA32(a, b, c) __builtin_amdgcn_mfma_f32_32x32x16_bf16((a), (b), (c), 0, 0, 0)

#define XB_TMO      128
#define XB_XCNT(j)  (256  + 64 * (j))
#define XB_XSUB(j)  (1280 + 64 * (j))
#define XB_XGEN(j)  (2304 + 64 * (j))
#define XB_TOP      3328
#define XB_TOPGEN   3392
#define XCD_BAR_WORDS 3456
#define XB_SPIN_CAP (1u << 22)
__device__ __forceinline__ unsigned xb_ld(unsigned* p)              { return __hip_atomic_load(p, __ATOMIC_RELAXED, __HIP_MEMORY_SCOPE_AGENT); }
__device__ __forceinline__ unsigned xb_add(unsigned* p, unsigned v) { return __hip_atomic_fetch_add(p, v, __ATOMIC_RELAXED, __HIP_MEMORY_SCOPE_AGENT); }
__device__ __forceinline__ unsigned xb_xcc_id() { return (unsigned)__builtin_amdgcn_s_getreg((3 << 11) | 20) & 0xFu; }
#define XB_SPIN(cond, bar) do { unsigned _sp = 0; while (cond) { __builtin_amdgcn_s_sleep(1); \
    if ((++_sp & 255u) == 0u) { if (xb_ld(&(bar)[XB_TMO])) break; if (_sp > XB_SPIN_CAP) { atomicAdd(&(bar)[XB_TMO], 1u); break; } } } } while (0)
struct XcdBarrier { unsigned* bar; unsigned x; volatile LAS unsigned* st; };
__device__ __forceinline__ XcdBarrier xcd_barrier_post(unsigned* bar, volatile LAS unsigned* st) {
    XcdBarrier b; b.bar = bar; b.x = xb_xcc_id(); b.st = st;
    if (threadIdx.x == 0) (void)xb_add(&bar[XB_XCNT(b.x)], 1u);
    return b;
}
__device__ __forceinline__ void xcd_barrier_complete(unsigned* bar, unsigned x, unsigned& nloc, unsigned& nx) {
    const unsigned G = gridDim.x * gridDim.y * gridDim.z;
    unsigned sum, cnt, mine, sp = 0u;
    for (;;) {
        sum = 0u; cnt = 0u; mine = 0u;
#pragma unroll
        for (unsigned j = 0; j < 16; ++j) { const unsigned c = xb_ld(&bar[XB_XCNT(j)]); sum += c; cnt += (c > 0u) ? 1u : 0u; mine = (j == x) ? c : mine; }
        if (sum == G) break;
        __builtin_amdgcn_s_sleep(1);
        if ((++sp & 255u) == 0u) { if (xb_ld(&bar[XB_TMO])) break; if (sp > XB_SPIN_CAP) { atomicAdd(&bar[XB_TMO], 1u); break; } }
    }
    nloc = mine > 0u ? mine : 1u; nx = cnt > 0u ? cnt : 1u;
}
__device__ __forceinline__ void xcd_barrier(const XcdBarrier& b, const int tid) {
    asm volatile("s_waitcnt vmcnt(0)" ::: "memory");
    __syncthreads();
    if (tid == 0) {
        unsigned* bar = b.bar;
        __builtin_amdgcn_s_waitcnt(0);
        unsigned nloc = b.st[0], nx = b.st[1];
        if (nloc == 0u) { xcd_barrier_complete(bar, b.x, nloc, nx); b.st[0] = nloc; b.st[1] = nx; }
        const unsigned old = xb_add(&bar[XB_XSUB(b.x)], 1u);
        const unsigned gen = old / nloc;
        if (old + 1u == (gen + 1u) * nloc) {
            __builtin_amdgcn_fence(__ATOMIC_RELEASE, "agent");
            asm volatile("s_waitcnt vmcnt(0)" ::: "memory");
            const unsigned og = xb_add(&bar[XB_TOP], 1u);
            const unsigned tg = og / nx;
            if (og + 1u == (tg + 1u) * nx) xb_add(&bar[XB_TOPGEN], 1u);
            else XB_SPIN(xb_ld(&bar[XB_TOPGEN]) == tg, bar);
            __builtin_amdgcn_fence(__ATOMIC_ACQUIRE, "agent");
            xb_add(&bar[XB_XGEN(b.x)], 1u);
            asm volatile("s_waitcnt vmcnt(0)" ::: "memory");
        } else {
            XB_SPIN(xb_ld(&bar[XB_XGEN(b.x)]) == gen, bar);
            __builtin_amdgcn_fence(__ATOMIC_ACQUIRE, "agent");
            asm volatile("s_waitcnt vmcnt(0)" ::: "memory");
        }
    }
    __syncthreads();
}

struct Args {
    const float* in[18]; float* out; unsigned char* ws; int ph_lo, ph_hi, li, pad;
};
enum { I_X = 0, I_C, I_WADA, I_BADA, I_NORMW, I_WIN, I_CONVW, I_ALOG, I_DTB, I_ANW, I_RELB, I_WOUT, I_WR, I_BR, I_WUP, I_BUP, I_WDN, I_BDN };

__device__ __forceinline__ int map_row(int mode, int n) {
    if (mode == 0) return n < 2048 ? n : (n < 2056 ? -1 : n - 8);
    if (mode == 2) { const int j = n & 1023, half = n >> 10; return (j >> 7) * 256 + half * 128 + (j & 127); }
    return n;
}
__device__ __forceinline__ void transpose_item(const float* W, int K, int N, bf16* WT, int mode, ldsf* scr, int item, int lane) {
    const int nblk = (N + 31) / 32, kb = item / nblk, nb = item % nblk, k0 = 64 * kb, n0 = 32 * nb;
    const int nn = n0 + (lane & 31);
#pragma unroll 8
    for (int i = 0; i < 32; ++i) { const int kk = 2 * i + (lane >> 5); scr[kk * 33 + (lane & 31)] = (nn < N) ? W[(size_t)(k0 + kk) * N + nn] : 0.f; }
    asm volatile("s_waitcnt lgkmcnt(0)" ::: "memory");
    const int c = lane & 7;
#pragma unroll
    for (int j = 0; j < 4; ++j) { const int nl = (lane >> 3) + 8 * j; const int n = n0 + nl; const ldsf* s = scr + (8 * c) * 33 + nl;
        const int row = (n < N) ? map_row(mode, n) : -1;
        v4u o; o.x = pk2(s[0 * 33], s[1 * 33]); o.y = pk2(s[2 * 33], s[3 * 33]); o.z = pk2(s[4 * 33], s[5 * 33]); o.w = pk2(s[6 * 33], s[7 * 33]);
        if (row >= 0) *(v4u*)(WT + (size_t)row * K + k0 + 8 * c) = o; }
    asm volatile("s_waitcnt lgkmcnt(0)" ::: "memory");
}
__device__ __forceinline__ void transpose_item8(const float* W, int K, int N, unsigned char* WT, int mode, ldsf* scr, int item, int lane) {
    const int nblk = N / 32, kb = item / nblk, nb = item % nblk, k0 = 64 * kb, n0 = 32 * nb;
#pragma unroll 8
    for (int i = 0; i < 32; ++i) { const int kk = 2 * i + (lane >> 5); scr[kk * 33 + (lane & 31)] = __builtin_nontemporal_load(W + (size_t)(k0 + kk) * N + n0 + (lane & 31)); }
    asm volatile("s_waitcnt lgkmcnt(0)" ::: "memory");
    const int nl = lane >> 1, kh = lane & 1; const ldsf* sp = scr + (32 * kh) * 33 + nl;
    const int row = map_row(mode, n0 + nl);
    v4u o0, o1;
    o0.x = pg8::pk4_fp8(sp[0 * 33] * 32.f, sp[1 * 33] * 32.f, sp[2 * 33] * 32.f, sp[3 * 33] * 32.f);     o0.y = pg8::pk4_fp8(sp[4 * 33] * 32.f, sp[5 * 33] * 32.f, sp[6 * 33] * 32.f, sp[7 * 33] * 32.f);
    o0.z = pg8::pk4_fp8(sp[8 * 33] * 32.f, sp[9 * 33] * 32.f, sp[10 * 33] * 32.f, sp[11 * 33] * 32.f);   o0.w = pg8::pk4_fp8(sp[12 * 33] * 32.f, sp[13 * 33] * 32.f, sp[14 * 33] * 32.f, sp[15 * 33] * 32.f);
    o1.x = pg8::pk4_fp8(sp[16 * 33] * 32.f, sp[17 * 33] * 32.f, sp[18 * 33] * 32.f, sp[19 * 33] * 32.f); o1.y = pg8::pk4_fp8(sp[20 * 33] * 32.f, sp[21 * 33] * 32.f, sp[22 * 33] * 32.f, sp[23 * 33] * 32.f);
    o1.z = pg8::pk4_fp8(sp[24 * 33] * 32.f, sp[25 * 33] * 32.f, sp[26 * 33] * 32.f, sp[27 * 33] * 32.f); o1.w = pg8::pk4_fp8(sp[28 * 33] * 32.f, sp[29 * 33] * 32.f, sp[30 * 33] * 32.f, sp[31 * 33] * 32.f);
    unsigned char* dst = WT + (size_t)row * K + k0 + 32 * kh;
    __builtin_nontemporal_store(o0, (v4u*)dst); __builtin_nontemporal_store(o1, (v4u*)(dst + 16));
    asm volatile("s_waitcnt lgkmcnt(0)" ::: "memory");
}
__device__ __forceinline__ void mod_item(const float* c, const float* w_ada, const float* b_ada, float* mod, int item, ldsf* red, int tid, int lane, int wave) {
    const int j0 = item * 24;
    float a0[24], a1[24];
#pragma unroll
    for (int k = 0; k < 24; ++k) { a0[k] = 0.f; a1[k] = 0.f; }
#pragma unroll
    for (int rr = 0; rr < 2; ++rr) {
        const int d = tid + rr * 512;
        const float s0 = siluf(c[d]), s1 = siluf(c[1024 + d]);
        const f32x4* wp = (const f32x4*)(w_ada + (size_t)d * 6144 + j0);
#pragma unroll
        for (int q = 0; q < 6; ++q) { const f32x4 w = wp[q];
#pragma unroll
            for (int e = 0; e < 4; ++e) { a0[4 * q + e] += s0 * w[e]; a1[4 * q + e] += s1 * w[e]; } }
    }
#pragma unroll
    for (int k = 0; k < 24; ++k) { a0[k] = wave_sum(a0[k]); a1[k] = wave_sum(a1[k]); }
    if (lane == 0) {
#pragma unroll
        for (int k = 0; k < 24; ++k) { red[wave * 48 + k] = a0[k]; red[wave * 48 + 24 + k] = a1[k]; }
    }
    __syncthreads();
    if (tid < 48) { float s = 0.f;
#pragma unroll
        for (int w = 0; w < 8; ++w) s += red[w * 48 + tid];
        const int b = tid / 24, k = tid % 24; mod[b * 6144 + j0 + k] = s + b_ada[j0 + k]; }
    __syncthreads();
}

#define SB() __builtin_amdgcn_sched_barrier(0)
#define GI_W(mt, t2, s2) ((((mt) * 4 + (t2)) * 2) + (s2))
#define GI_Q(mt, t2, s2) (16 + (((mt) * 4 + (t2)) * 2) + (s2))
#define GI_K(t2, mt, s2) (32 + (((t2) * 2 + (mt)) * 2) + (s2))
#define GI_A(mt, mp, s2) (48 + (((mt) * 2 + (mp)) * 2) + (s2))
#define FRAG(f_) (*(const LAS bf16x8*)(Bf + (f_) * 1024))
#define LD_WQ(dst, t2, s2) do { dst[0] = FRAG(GI_W(0, t2, s2)); dst[1] = FRAG(GI_Q(0, t2, s2)); dst[2] = FRAG(GI_W(1, t2, s2)); dst[3] = FRAG(GI_Q(1, t2, s2)); } while (0)
#define MM_WQ(src, t2, s2) do { const bf16x8 sb_ = pack8(S[t2], s2); VN[0] = MFMA32(src[0], sb_, VN[0]); O[0] = MFMA32(src[1], sb_, O[0]); VN[1] = MFMA32(src[2], sb_, VN[1]); O[1] = MFMA32(src[3], sb_, O[1]); } while (0)
#define LD_AT(dst, s2) do { dst[0] = FRAG(GI_A(0, 0, s2)); dst[1] = FRAG(GI_A(1, 0, s2)); dst[2] = FRAG(GI_A(1, 1, s2)); } while (0)
#define MM_AT(src, s2) do { O[0] = MFMA32(src[0], vb[0][s2], O[0]); O[1] = MFMA32(src[1], vb[0][s2], O[1]); O[1] = MFMA32(src[2], vb[1][s2], O[1]); } while (0)
#define LD_K(dst, t2) do { dst[0] = FRAG(GI_K(t2, 0, 0)); dst[1] = FRAG(GI_K(t2, 0, 1)); dst[2] = FRAG(GI_K(t2, 1, 0)); dst[3] = FRAG(GI_K(t2, 1, 1)); } while (0)
#define MM_K(src, t2) do { S[t2] = MFMA32(src[0], vb[0][0], S[t2]); S[t2] = MFMA32(src[1], vb[0][1], S[t2]); S[t2] = MFMA32(src[2], vb[1][0], S[t2]); S[t2] = MFMA32(src[3], vb[1][1], S[t2]); } while (0)
#define SCALE_S(t2) do { _Pragma("unroll") for (int q_ = 0; q_ < 16; ++q_) S[t2][q_] *= egl; } while (0)
__device__ __forceinline__ void scan_step(const int n, f32x16 (&S)[4], v4u (&UC)[4], v4u (&UN)[4], const float egl, float& egl_next,
                                          LAS unsigned char* lds, const float* Uf, const float* glp, const int wave, const int lane, const int stg_off, const int stg_row) {
    const int r = lane & 31, h = lane >> 5;
    asm volatile("s_waitcnt lgkmcnt(0)" ::: "memory"); __builtin_amdgcn_s_barrier(); asm volatile("" ::: "memory");
    if (n + 1 < 128) {
        const v4u* up = (const v4u*)((const unsigned char*)Uf + (size_t)(n + 1) * 16384) + (wave * 4) * 64 + lane;
#pragma unroll
        for (int f = 0; f < 4; ++f) UN[f] = up[f * 64];
        egl_next = glp[n + 1];
    }
    SB();
    f32x16 VN[2];
#pragma unroll
    for (int mt = 0; mt < 2; ++mt)
#pragma unroll
        for (int q8 = 0; q8 < 2; ++q8) { const v4u u = UC[mt * 2 + q8];
            VN[mt][8 * q8 + 0] = bflo(u.x); VN[mt][8 * q8 + 1] = bfhi(u.x); VN[mt][8 * q8 + 2] = bflo(u.y); VN[mt][8 * q8 + 3] = bfhi(u.y);
            VN[mt][8 * q8 + 4] = bflo(u.z); VN[mt][8 * q8 + 5] = bfhi(u.z); VN[mt][8 * q8 + 6] = bflo(u.w); VN[mt][8 * q8 + 7] = bfhi(u.w); }
    const LAS unsigned char* Bf = lds + (n & 1) * OPS_BYTES + lane * 16;
    f32x16 O[2];
#pragma unroll
    for (int mt = 0; mt < 2; ++mt)
#pragma unroll
        for (int q = 0; q < 16; ++q) O[mt][q] = 0.f;
    bf16x8 fA[4], fB[4], vb[2][2];
    LD_WQ(fA, 0, 0); SB();
    LD_WQ(fB, 0, 1); SB(); MM_WQ(fA, 0, 0); SB();
    LD_WQ(fA, 1, 0); SB(); MM_WQ(fB, 0, 1); SCALE_S(0); SB();
    LD_WQ(fB, 1, 1); SB(); MM_WQ(fA, 1, 0); SB();
    LD_WQ(fA, 2, 0); SB(); MM_WQ(fB, 1, 1); SCALE_S(1); SB();
    LD_WQ(fB, 2, 1); SB(); MM_WQ(fA, 2, 0); SB();
    LD_WQ(fA, 3, 0); SB(); MM_WQ(fB, 2, 1); SCALE_S(2); SB();
    LD_WQ(fB, 3, 1); SB(); MM_WQ(fA, 3, 0); SB();
    LD_AT(fA, 0); SB(); MM_WQ(fB, 3, 1); SCALE_S(3); SB();
#pragma unroll
    for (int mt = 0; mt < 2; ++mt)
#pragma unroll
        for (int s2 = 0; s2 < 2; ++s2) vb[mt][s2] = pack8(VN[mt], s2);
    LD_AT(fB, 1); SB(); MM_AT(fA, 0); SB();
    LD_K(fA, 0); SB(); MM_AT(fB, 1); SB();
    {
        LAS unsigned short* sp = (LAS unsigned short*)(lds + stg_off + (n & 1) * (64 * stg_row)) + 32 * wave + r;
#pragma unroll
        for (int mt = 0; mt < 2; ++mt)
#pragma unroll
            for (int q = 0; q < 16; q += 2) { const unsigned w = cvtpk(O[mt][q], O[mt][q + 1]);
                sp[(32 * mt + crow(q, h)) * (stg_row / 2)] = (unsigned short)(w & 0xffffu); sp[(32 * mt + crow(q + 1, h)) * (stg_row / 2)] = (unsigned short)(w >> 16); }
    }
    asm volatile("s_waitcnt lgkmcnt(0)" ::: "memory"); __builtin_amdgcn_s_barrier(); asm volatile("" ::: "memory");
    LD_K(fB, 1); SB(); MM_K(fA, 0); SB();
    LD_K(fA, 2); SB(); MM_K(fB, 1); SB();
    LD_K(fB, 3); SB(); MM_K(fA, 2); SB();
    MM_K(fB, 3); SB();
}
#undef FRAG

__device__ __forceinline__ int opq(int v) { asm volatile("" : "+v"(v)); return v; }
typedef const __attribute__((address_space(4))) Args* kargp_t;
__device__ __forceinline__ kargp_t karg_ptr() { kargp_t p = (kargp_t)__builtin_amdgcn_kernarg_segment_ptr(); asm volatile("" : "+s"(p)); return p; }
__global__ void __launch_bounds__(NTHR, 2) mk_fwd(Args kargs) {
    extern __shared__ __attribute__((aligned(16))) unsigned char lds_raw[];
    LAS unsigned char* lds = (LAS unsigned char*)lds_raw;
    volatile LAS unsigned* MISC = (volatile LAS unsigned*)(lds + MISC_OFF);
    const int wave = __builtin_amdgcn_readfirstlane((int)threadIdx.x >> 6);
    const int G = gridDim.x; const int bx = blockIdx.x; const int vcu = (G % 8 == 0) ? (bx % 8) * (G / 8) + bx / 8 : bx;
    const int gw = vcu * NWAVES + wave, NGW = G * NWAVES;
    if (threadIdx.x < 128) MISC[threadIdx.x] = 0u;
    __syncthreads();
    XcdBarrier bar; bar.bar = (unsigned*)(kargs.ws + WS_CTL) + CW_BAR; bar.x = 0; bar.st = nullptr;
#if MK_ONE_LAUNCH
    bar = xcd_barrier_post((unsigned*)(kargs.ws + WS_CTL) + CW_BAR + kargs.li * XCD_BAR_WORDS, MISC + 8);
#define GRID_BAR() xcd_barrier(bar, tid)
#else
#define GRID_BAR() do {} while (0)
#endif
    const int lo = kargs.ph_lo, hi = kargs.ph_hi;
#ifndef PH_MASK
#define PH_MASK 0xFFFF
#endif
#define IN(k) ((((PH_MASK) >> (k)) & 1) && lo <= (k) && (k) < hi)
#define BOTH(k) (IN(k) && IN((k) + 1))

#define args (*ap_)
#define P_WS (args.ws)
#define ctl ((unsigned*)(P_WS + WS_CTL))
#define Xp (args.in[I_X])
#define OUTp (args.out)
#define MODp ((float*)(P_WS + WS_MOD))
#define gbuf ((float*)(P_WS + WS_G))
#define betabuf ((float*)(P_WS + WS_BETA))
#define glbuf ((float*)(P_WS + WS_GL))
#define asg_e ((int*)(P_WS + WS_AE))
#define asg_p ((int*)(P_WS + WS_AP))
#define asg_g ((float*)(P_WS + WS_AG))
#define asg_s ((int*)(P_WS + WS_AS))
#define WinT ((bf16*)(P_WS + WS_WIN))
#define WoutT ((bf16*)(P_WS + WS_WOUT))
#define WupT ((bf16*)(P_WS + WS_WUP))
#define WdnT ((bf16*)(P_WS + WS_WDN))
#define hbuf ((bf16*)(P_WS + WS_H))
#define projb ((bf16*)(P_WS + WS_PROJ))
#define Ub ((float*)(P_WS + WS_U))
#define opsb (P_WS + WS_OPS)
#define zsb ((bf16*)(P_WS + WS_ZS))
#define qfb (P_WS + WS_QF)
#define kfb (P_WS + WS_KF)
#define vtfb (P_WS + WS_VTF)
#define omix ((bf16*)(P_WS + WS_OMIX))
#define ybuf ((bf16*)(P_WS + WS_Y))
#define xg ((bf16*)(P_WS + WS_XG))
#define actb ((bf16*)(P_WS + WS_ACT))
#define yslot ((bf16*)(P_WS + WS_XG))

    if (IN(0)) {
        const int lane = (int)__builtin_amdgcn_mbcnt_hi(~0u, __builtin_amdgcn_mbcnt_lo(~0u, 0u)), tid = wave * 64 + lane; const kargp_t ap_ = karg_ptr();
        ldsf* scr = (ldsf*)(lds + wave * 16384);
        constexpr int I_IN = 16 * 113, I_OUT = 16 * 32;
        constexpr int NITEMS = I_IN + I_OUT;
        for (int it = gw; it < NITEMS; it += NGW) {
            int r = it;
            if (r < I_IN) { transpose_item(args.in[I_WIN], D, IN_COLS, WinT, 0, scr, r, lane); continue; } r -= I_IN;
            transpose_item(args.in[I_WOUT], D, D, WoutT, 1, scr, r, lane);
        }
        __syncthreads();
        for (int idx = bx * NTHR + tid; idx < 8192; idx += G * NTHR) { const int col = idx >> 3, k = idx & 7; ((float*)(P_WS + WS_WG))[k * 1024 + col] = args.in[I_WIN][(size_t)col * IN_COLS + 2048 + k]; }
        for (int idx = bx * NTHR + tid; idx < 32768; idx += G * NTHR) { const int col = idx >> 5, e = idx & 31; ((float*)(P_WS + WS_WR))[e * 1024 + col] = args.in[I_WR][idx]; }
        for (int it = bx; it < 256; it += G) mod_item(args.in[I_C], args.in[I_WADA], args.in[I_BADA], MODp, it, (ldsf*)lds, tid, lane, wave);
        if (BOTH(0)) GRID_BAR();
    }

    if (IN(1)) {
        const int lane = (int)__builtin_amdgcn_mbcnt_hi(~0u, __builtin_amdgcn_mbcnt_lo(~0u, 0u)), tid = wave * 64 + lane; const kargp_t ap_ = karg_ptr();
        ldsf* wg = (ldsf*)lds;
        const float* w_in = args.in[I_WIN];
        for (int idx = tid; idx < 2048; idx += NTHR) *((LAS f32x4*)wg + idx) = *((const f32x4*)(P_WS + WS_WG) + idx);
        __syncthreads();
        const float* nw0 = args.in[I_NORMW];
        const float dtb = args.in[I_DTB][lane & 3], alg = -expf(args.in[I_ALOG][lane & 3]);
        f32x4 vnx[4];
#pragma unroll
        for (int j = 0; j < 4; ++j) vnx[j] = *((const f32x4*)(Xp + (size_t)gw * D) + lane + 64 * j);
        for (int bb = 0; bb < BATCH; ++bb) {
            f32x4 av[4], shv[4];
#pragma unroll
            for (int j = 0; j < 4; ++j) { const int col = 4 * lane + 256 * j; const f32x4 nw = *(const f32x4*)(nw0 + col), sc = *(const f32x4*)(MODp + bb * 6144 + 1024 + col); shv[j] = *(const f32x4*)(MODp + bb * 6144 + col);
#pragma unroll
                for (int e = 0; e < 4; ++e) av[j][e] = nw[e] * (1.0f + sc[e]); }
            for (int r = gw + bb * (NTOK / BATCH); r < (bb + 1) * (NTOK / BATCH); r += NGW) {
                f32x4 v[4]; float ss = 0.f;
#pragma unroll
                for (int j = 0; j < 4; ++j) { v[j] = vnx[j]; ss += (v[j].x * v[j].x + v[j].y * v[j].y) + (v[j].z * v[j].z + v[j].w * v[j].w); }
                __builtin_amdgcn_sched_barrier(0);
                if (r + NGW < NTOK) {
#pragma unroll
                    for (int j = 0; j < 4; ++j) vnx[j] = *((const f32x4*)(Xp + (size_t)(r + NGW) * D) + lane + 64 * j);
                }
                __builtin_amdgcn_sched_barrier(0);
                const float rstd = rsqrtf(wave_sum(ss) * (1.0f / D) + EPS);
                float al[8];
#pragma unroll
                for (int k = 0; k < 8; ++k) al[k] = 0.f;
                v2u ov[4];
#pragma unroll
                for (int j = 0; j < 4; ++j) {
                    const int col = 4 * lane + 256 * j;
                    f32x4 h;
#pragma unroll
                    for (int e = 0; e < 4; ++e) h[e] = v[j][e] * rstd * av[j][e] + shv[j][e];
                    ov[j].x = pk2(h[0], h[1]); ov[j].y = pk2(h[2], h[3]);
#pragma unroll
                    for (int k = 0; k < 8; ++k) { const f32x4 w = *(const LAS f32x4*)(wg + k * 1024 + col); al[k] += (h[0] * w[0] + h[1] * w[1]) + (h[2] * w[2] + h[3] * w[3]); }
                }
#pragma unroll
                for (int j = 0; j < 4; ++j) *(v2u*)(hbuf + (size_t)r * D + 4 * lane + 256 * j) = ov[j];
#pragma unroll
                for (int k = 0; k < 8; ++k) al[k] = wave_sum(al[k]);
                if (lane < 4) {
                    const float aa = lane == 0 ? al[0] : (lane == 1 ? al[1] : (lane == 2 ? al[2] : al[3]));
                    const float ab = lane == 0 ? al[4] : (lane == 1 ? al[5] : (lane == 2 ? al[6] : al[7]));
                    const float xx = aa + dtb;
                    const float sp = xx > 20.f ? xx : log1pf(expf(xx));
                    gbuf[r * 4 + lane] = alg * sp;
                    betabuf[r * 4 + lane] = 1.0f / (1.0f + expf(-ab));
                }
            }
        }
        if (BOTH(1)) GRID_BAR();
    }

    if (IN(2)) {
        const int lane = (int)__builtin_amdgcn_mbcnt_hi(~0u, __builtin_amdgcn_mbcnt_lo(~0u, 0u)), tid = wave * 64 + lane; const kargp_t ap_ = karg_ptr();
        pg8::Gemm g{hbuf, WinT, NTOK, PCOLS, D}; pg8::StaticOrder S; S.init(NTOK, PCOLS, G, bx);
        pg8::EpiBf16 E{projb, PCOLS, nullptr, nullptr, 0, 1.0f};
        pg8::gemm_phase<pg8::EpiBf16, pg8::StaticOrder, true, true>(lds, g, S, E, tid);
        if (BOTH(2)) GRID_BAR();
    }

    if (IN(3)) {
        const int lane = (int)__builtin_amdgcn_mbcnt_hi(~0u, __builtin_amdgcn_mbcnt_lo(~0u, 0u)), tid = wave * 64 + lane; const kargp_t ap_ = karg_ptr();
        ldsf* qs = (ldsf*)lds; ldsf* ks = qs + 64 * 129; ldsf* vs = ks + 64 * 129; ldsf* Wsm = vs + 64 * 129; ldsf* Ls = Wsm + 64 * 129;
        constexpr int LSTR = 68;
        constexpr int RAW_OFF = 4 * 64 * 129 * 3;
        ldsf* gc = (ldsf*)(lds + 151296); ldsf* bt = gc + 64; ldsf* eg = bt + 64; ldsf* ekd = eg + 64;
        const float* conv_w = args.in[I_CONVW];
        const int r = lane & 31, h = lane >> 5;
        for (int item = (args.pad & 1) ? 1024 : bx; item < 1024; item += G) {
            const int bh = item >> 7, n = item & 127, b = bh >> 2, hh = bh & 3;
            const size_t row0 = (size_t)b * T + n * 64;
            unsigned char* ops = opsb + (size_t)item * OPS_BYTES;
            {
#pragma unroll
                for (int jp = 0; jp < 7; ++jp) {
                    const int p = wave + 8 * jp;
                    if (p < 51) {
                        int sg = 4 * p + (lane >> 4); sg = sg > 200 ? 200 : sg;
                        const int rw = sg / 3, wh = sg - 3 * rw; int tt = n * 64 + rw - 3; tt = tt < 0 ? 0 : tt;
                        __builtin_amdgcn_global_load_lds((const unsigned*)(projb + ((size_t)b * T + tt) * PCOLS + wh * 512 + hh * 128 + (lane & 15) * 8), (LAS unsigned*)(lds + RAW_OFF + p * 1024), 16, 0, 0);
                    }
                }
#pragma unroll
                for (int o = 0; o < 2; ++o) {
                    const int idx = tid + NTHR * o, i = idx >> 4, d0 = (idx & 15) * 8;
                    const v4u zw = *(const v4u*)(projb + ((size_t)b * T + n * 64 + i) * PCOLS + 1536 + hh * 128 + d0);
                    const f32x4 wa = *(const f32x4*)(args.in[I_ANW] + d0), wb = *(const f32x4*)(args.in[I_ANW] + d0 + 4);
                    v4u ow; ow.x = cvtpk(wa[0] * siluf(bflo(zw.x)), wa[1] * siluf(bfhi(zw.x))); ow.y = cvtpk(wa[2] * siluf(bflo(zw.y)), wa[3] * siluf(bfhi(zw.y)));
                    ow.z = cvtpk(wb[0] * siluf(bflo(zw.z)), wb[1] * siluf(bfhi(zw.z))); ow.w = cvtpk(wb[2] * siluf(bflo(zw.w)), wb[3] * siluf(bfhi(zw.w)));
                    *(v4u*)(zsb + ((size_t)b * T + n * 64 + i) * 512 + hh * 128 + d0) = ow;
                }
                asm volatile("s_waitcnt vmcnt(0)" ::: "memory");
                __syncthreads();
#pragma unroll 2
                for (int o = 0; o < 6; ++o) {
                    const int idx = tid + NTHR * o, i = idx / 48, c8 = idx - 48 * i, which = c8 >> 4, d0 = (c8 & 15) * 8, gch = which * 512 + hh * 128 + d0;
                    const LAS unsigned char* rp = lds + RAW_OFF + i * 768 + which * 256 + d0 * 2;
                    float acc[8];
#pragma unroll
                    for (int e = 0; e < 8; ++e) acc[e] = 0.f;
#pragma unroll
                    for (int tap = 0; tap < 4; ++tap) {
                        const v4u xw = *(const LAS v4u*)(rp + tap * 768);
                        const f32x4 wa = *(const f32x4*)(conv_w + tap * 1536 + gch), wb = *(const f32x4*)(conv_w + tap * 1536 + gch + 4);
                        const float msk = (n * 64 + i - 3 + tap) >= 0 ? 1.0f : 0.0f;
                        acc[0] += msk * wa[0] * bflo(xw.x); acc[1] += msk * wa[1] * bfhi(xw.x); acc[2] += msk * wa[2] * bflo(xw.y); acc[3] += msk * wa[3] * bfhi(xw.y);
                        acc[4] += msk * wb[0] * bflo(xw.z); acc[5] += msk * wb[1] * bfhi(xw.z); acc[6] += msk * wb[2] * bflo(xw.w); acc[7] += msk * wb[3] * bfhi(xw.w);
                    }
                    ldsf* dst = (which == 0 ? qs : (which == 1 ? ks : vs)) + i * 129 + d0;
#pragma unroll
                    for (int e = 0; e < 8; ++e) dst[e] = siluf(acc[e]);
                }
            }
            if (wave == 7) {
                float gv = gbuf[(row0 + lane) * 4 + hh];
#pragma unroll
                for (int o = 1; o < 64; o <<= 1) { const float t2 = __shfl_up(gv, o); if (lane >= o) gv += t2; }
                const float glast = __shfl(gv, 63);
                gc[lane] = gv; eg[lane] = expf(gv); bt[lane] = betabuf[(row0 + lane) * 4 + hh]; ekd[lane] = expf(glast - gv);
                if (lane == 0) glbuf[item] = expf(glast);
            }
            __syncthreads();
            if (((args.pad >> 2) & 7) == 1) continue;
            for (int i = wave; i < 64; i += NWAVES) {
                const float q0 = qs[i * 129 + lane], q1 = qs[i * 129 + 64 + lane], k0 = ks[i * 129 + lane], k1 = ks[i * 129 + 64 + lane];
                const float sq = rsqrtf(wave_sum(q0 * q0 + q1 * q1) + EPS) * 0.08838834764831845f, sk = rsqrtf(wave_sum(k0 * k0 + k1 * k1) + EPS);
                qs[i * 129 + lane] = q0 * sq; qs[i * 129 + 64 + lane] = q1 * sq; ks[i * 129 + lane] = k0 * sk; ks[i * 129 + 64 + lane] = k1 * sk;
            }
            __syncthreads();
            if (((args.pad >> 2) & 7) == 2) continue;
            {
                const int which = wave >> 2, ta = (wave >> 1) & 1, tb = wave & 1;
                if (tb <= ta) {
                    f32x16 acc;
#pragma unroll
                    for (int q = 0; q < 16; ++q) acc[q] = 0.f;
                    const ldsf* Ap = ks + (32 * (which == 0 ? ta : tb) + r) * 129 + 8 * h;
                    const ldsf* Bp = (which == 0 ? ks + (32 * tb + r) * 129 : qs + (32 * ta + r) * 129) + 8 * h;
#pragma unroll 4
                    for (int k = 0; k < 8; ++k) {
                        v4u pa, pb;
                        pa.x = cvtpk(Ap[16 * k + 0], Ap[16 * k + 1]); pa.y = cvtpk(Ap[16 * k + 2], Ap[16 * k + 3]); pa.z = cvtpk(Ap[16 * k + 4], Ap[16 * k + 5]); pa.w = cvtpk(Ap[16 * k + 6], Ap[16 * k + 7]);
                        pb.x = cvtpk(Bp[16 * k + 0], Bp[16 * k + 1]); pb.y = cvtpk(Bp[16 * k + 2], Bp[16 * k + 3]); pb.z = cvtpk(Bp[16 * k + 4], Bp[16 * k + 5]); pb.w = cvtpk(Bp[16 * k + 6], Bp[16 * k + 7]);
                        acc = MFMA32(__builtin_bit_cast(bf16x8, pa), __builtin_bit_cast(bf16x8, pb), acc);
                    }
                    if (which == 0) {
                        const int j = 32 * tb + r; const float gj = gc[j];
#pragma unroll
                        for (int q = 0; q < 16; ++q) { const int i = 32 * ta + crow(q, h); Ls[i * LSTR + j] = (j < i) ? bt[i] * acc[q] * __expf(gc[i] - gj) : 0.f; }
                    } else {
                        const int i = 32 * ta + r; const float gi = gc[i];
#pragma unroll
                        for (int q = 0; q < 16; ++q) { const int j = 32 * tb + crow(q, h); acc[q] = (j <= i) ? acc[q] * __expf(gi - gc[j]) : 0.f; }
#pragma unroll
                        for (int s2 = 0; s2 < 2; ++s2) *(bf16x8*)(ops + (48 + (ta * 2 + tb) * 2 + s2) * 1024 + lane * 16) = pack8(acc, s2);
                    }
                }
            }
            __syncthreads();
            if (((args.pad >> 2) & 7) == 3) continue;
            if (wave < 4) {
                const int d = tid & 127; const bool isw = tid >= 128;
                int z; asm volatile("v_mov_b32 %0, 0" : "=v"(z));
                const ldsf* Lz = Ls + z; const ldsf* btz = bt + z; const ldsf* egz = eg + z;
                float xr[32];
                const ldsf* srcx = (isw ? ks : vs) + d;
                ldsf* dst = (isw ? Wsm : vs) + d;
#pragma unroll
                for (int i = 0; i < 32; ++i) { const float e_ = egz[i]; xr[i] = srcx[i * 129] * btz[i] * (isw ? e_ : 1.0f); }
#pragma unroll
                for (int i = 32; i < 64; ++i) { const float e_ = egz[i]; dst[i * 129] = srcx[i * 129] * btz[i] * (isw ? e_ : 1.0f); }
#pragma unroll
                for (int i = 1; i < 32; ++i) {
                    float s0 = xr[i], s1 = 0.f;
#pragma unroll
                    for (int j4 = 0; j4 < (i + 3) / 4; ++j4) {
                        const f32x4 l = *(const LAS f32x4*)(Lz + i * LSTR + 4 * j4);
                        s0 -= l[0] * xr[4 * j4]; s1 -= l[1] * xr[4 * j4 + 1]; s0 -= l[2] * xr[4 * j4 + 2]; s1 -= l[3] * xr[4 * j4 + 3];
                    }
                    xr[i] = s0 + s1;
                    asm volatile("" ::: "memory");
                }
#pragma unroll
                for (int i = 0; i < 32; ++i) dst[i * 129] = xr[i];
            } else {
#pragma unroll 1
                for (int ff = 0; ff < 8; ++ff) {
                    const int f = (wave - 4) * 8 + ff;
                    v4u p; float v8[8];
                    if (f < 16) { const int mt = f >> 3, t2 = (f >> 1) & 3, s2 = f & 1; const int i = 32 * mt + r; const float e = eg[i];
#pragma unroll
                        for (int j = 0; j < 8; ++j) v8[j] = qs[i * 129 + 32 * t2 + 16 * s2 + 8 * (j >> 2) + 4 * h + (j & 3)] * e;
                    } else { const int g2 = f - 16, t2 = g2 >> 2, mt = (g2 >> 1) & 1, s2 = g2 & 1; const int d = 32 * t2 + r;
#pragma unroll
                        for (int j = 0; j < 8; ++j) { const int i = 32 * mt + 16 * s2 + 8 * (j >> 2) + 4 * h + (j & 3); v8[j] = ks[i * 129 + d] * ekd[i]; }
                    }
                    p.x = cvtpk(v8[0], v8[1]); p.y = cvtpk(v8[2], v8[3]); p.z = cvtpk(v8[4], v8[5]); p.w = cvtpk(v8[6], v8[7]);
                    *(v4u*)(ops + (16 + f) * 1024 + lane * 16) = p;
                }
            }
            __syncthreads();
            {
                ldsf* X = (wave < 4) ? vs + 32 * wave : Wsm + 32 * (wave - 4);
                f32x16 acc;
#pragma unroll
                for (int q = 0; q < 16; ++q) acc[q] = X[(32 + crow(q, h)) * 129 + r];
                const ldsf* Ap = Ls + (32 + r) * LSTR + h;
                const ldsf* Bp = X + h * 129 + r;
#pragma unroll 8
                for (int k = 0; k < 16; ++k) acc = __builtin_amdgcn_mfma_f32_32x32x2f32(-Ap[2 * k], Bp[(2 * k) * 129], acc, 0, 0, 0);
#pragma unroll
                for (int q = 0; q < 16; ++q) X[(32 + crow(q, h)) * 129 + r] = acc[q];
            }
            __syncthreads();
            if (wave < 4) {
                const int d = tid & 127; const bool isw = tid >= 128;
                int z; asm volatile("v_mov_b32 %0, 0" : "=v"(z));
                const ldsf* Lz = Ls + z;
                ldsf* dst = (isw ? Wsm : vs) + d;
                float xr[32];
#pragma unroll
                for (int i = 0; i < 32; ++i) xr[i] = dst[(32 + i) * 129];
#pragma unroll
                for (int i = 1; i < 32; ++i) {
                    float s0 = xr[i], s1 = 0.f;
#pragma unroll
                    for (int j4 = 0; j4 < (i + 3) / 4; ++j4) {
                        const f32x4 l = *(const LAS f32x4*)(Lz + (32 + i) * LSTR + 32 + 4 * j4);
                        s0 -= l[0] * xr[4 * j4]; s1 -= l[1] * xr[4 * j4 + 1]; s0 -= l[2] * xr[4 * j4 + 2]; s1 -= l[3] * xr[4 * j4 + 3];
                    }
                    xr[i] = s0 + s1;
                    asm volatile("" ::: "memory");
                }
#pragma unroll
                for (int i = 0; i < 32; ++i) dst[(32 + i) * 129] = xr[i];
            }
            __syncthreads();
            if (((args.pad >> 2) & 7) == 4) continue;
#pragma unroll
            for (int o = 0; o < 2; ++o) {
                const int idx8 = tid + NTHR * o, l2 = idx8 & 63, q8 = (idx8 >> 6) & 1, mt = (idx8 >> 7) & 1, w = idx8 >> 8;
                const int c = 32 * w + (l2 & 31), hh2 = l2 >> 5;
                float u8[8];
#pragma unroll
                for (int e = 0; e < 8; ++e) u8[e] = vs[(32 * mt + crow(8 * q8 + e, hh2)) * 129 + c];
                v4u p; p.x = cvtpk(u8[0], u8[1]); p.y = cvtpk(u8[2], u8[3]); p.z = cvtpk(u8[4], u8[5]); p.w = cvtpk(u8[6], u8[7]);
                *(v4u*)((unsigned char*)Ub + (size_t)item * 16384 + idx8 * 16) = p;
            }
#pragma unroll
            for (int ff = 0; ff < 2; ++ff) {
                const int f = wave * 2 + ff, mt = f >> 3, t2 = (f >> 1) & 3, s2 = f & 1; const int i = 32 * mt + r;
                float v8[8];
#pragma unroll
                for (int j = 0; j < 8; ++j) v8[j] = -Wsm[i * 129 + 32 * t2 + 16 * s2 + 8 * (j >> 2) + 4 * h + (j & 3)];
                v4u p; p.x = cvtpk(v8[0], v8[1]); p.y = cvtpk(v8[2], v8[3]); p.z = cvtpk(v8[4], v8[5]); p.w = cvtpk(v8[6], v8[7]);
                *(v4u*)(ops + f * 1024 + lane * 16) = p;
            }
            __syncthreads();
        }
        {
            const int r = lane & 31, h = lane >> 5;
            for (int it = (args.pad & 2) ? 2048 : gw; it < 2048; it += NGW) {
                const int c = it & 127, hh = (it >> 7) & 7, b = it >> 10;
                const bf16* base = projb + ((size_t)b * T + c * 64) * PCOLS + hh * 64;
#pragma unroll
                for (int kb2 = 0; kb2 < 2; ++kb2)
#pragma unroll
                    for (int ks = 0; ks < 4; ++ks) {
                        const bf16* rp = base + (size_t)(32 * kb2 + r) * PCOLS + 16 * ks + 8 * h;
                        *(v4u*)(qfb + (size_t)it * 8192 + (kb2 * 4 + ks) * 1024 + lane * 16) = *(const v4u*)(rp + 2048);
                        *(v4u*)(kfb + (size_t)it * 8192 + (kb2 * 4 + ks) * 1024 + lane * 16) = *(const v4u*)(rp + 2560);
                    }
#pragma unroll
                for (int dt = 0; dt < 2; ++dt)
#pragma unroll
                    for (int kb2 = 0; kb2 < 2; ++kb2)
#pragma unroll
                        for (int s2 = 0; s2 < 2; ++s2) {
                            unsigned short e8[8];
#pragma unroll
                            for (int j = 0; j < 8; ++j) e8[j] = base[(size_t)(32 * kb2 + 16 * s2 + 8 * (j >> 2) + 4 * h + (j & 3)) * PCOLS + 3072 + 32 * dt + r];
                            v4u p; p.x = e8[0] | ((unsigned)e8[1] << 16); p.y = e8[2] | ((unsigned)e8[3] << 16); p.z = e8[4] | ((unsigned)e8[5] << 16); p.w = e8[6] | ((unsigned)e8[7] << 16);
                            *(v4u*)(vtfb + (size_t)it * 8192 + ((dt * 2 + kb2) * 2 + s2) * 1024 + lane * 16) = p;
                        }
            }
        }
        if (BOTH(3)) GRID_BAR();
    }

    if (IN(4)) {
        const int lane = (int)__builtin_amdgcn_mbcnt_hi(~0u, __builtin_amdgcn_mbcnt_lo(~0u, 0u)), tid = wave * 64 + lane; const kargp_t ap_ = karg_ptr();
        if (bx < 64) {
            constexpr int SEGC = 16;
            const int bh = bx & 7, seg = bx >> 3, b = bh >> 2, hh = bh & 3;
            const int r = lane & 31, h = lane >> 5;
            const int c0 = seg * SEGC;
#define SCAN_BAR() do { asm volatile("s_waitcnt lgkmcnt(0)" ::: "memory"); __builtin_amdgcn_s_barrier(); asm volatile("" ::: "memory"); } while (0)
#define FRAG(f_) (*(const LAS bf16x8*)(Bf + (f_) * 1024))
            {
                const unsigned char* ops = opsb + (size_t)(bh * 128 + c0) * OPS_BYTES;
                const float* Uf = (const float*)((const unsigned char*)Ub + (size_t)(bh * 128 + c0) * 16384);
                float* segp = (float*)(args.ws + WS_SEG) + (size_t)(bh * 8 + seg) * 32768;
                ldsf* egls = (ldsf*)(lds + 4 * 32768);
                if (tid < SEGC) egls[tid] = glbuf[bh * 128 + c0 + tid];
                const int pbase = (wave < 6) ? (wave - 4) * 8 : 32 + (wave - 6) * 8, fbase = (wave - 4) * 8;
#define A_DMA(n_) do { const unsigned char* src_ = ops + (size_t)(n_) * OPS_BYTES + pbase * 1024 + lane * 16; \
                _Pragma("unroll") for (int p_ = 0; p_ < 8; ++p_) __builtin_amdgcn_global_load_lds((const unsigned*)(src_ + p_ * 1024), (LAS unsigned*)(lds + ((n_) & 3) * 32768 + (fbase + p_) * 1024), 16, 0, 0); } while (0)
                f32x16 S[4]; v4u Ur[4];
#pragma unroll
                for (int t2 = 0; t2 < 4; ++t2)
#pragma unroll
                    for (int q = 0; q < 16; ++q) S[t2][q] = (wave >= 4 && (32 * t2 + crow(q, h)) == (32 * (wave - 4) + r)) ? 1.0f : 0.0f;
#pragma unroll
                for (int f = 0; f < 4; ++f) Ur[f] = (v4u){0u, 0u, 0u, 0u};
                if (wave < 4) {
#pragma unroll
                    for (int f = 0; f < 4; ++f) Ur[f] = *((const v4u*)Uf + (wave * 4 + f) * 64 + lane);
                } else { A_DMA(0); A_DMA(1); A_DMA(2); }
                for (int n = 0; n < SEGC; ++n) {
                    if (wave >= 4) { if (n <= SEGC - 3) asm volatile("s_waitcnt vmcnt(16)" ::: "memory"); else if (n == SEGC - 2) asm volatile("s_waitcnt vmcnt(8)" ::: "memory"); else asm volatile("s_waitcnt vmcnt(0)" ::: "memory"); }
                    SCAN_BAR();
                    if (wave >= 4 && n + 3 < SEGC) A_DMA(n + 3);
                    const LAS unsigned char* Bf = lds + (n & 3) * 32768 + lane * 16;
                    f32x16 VN[2];
#pragma unroll
                    for (int mt = 0; mt < 2; ++mt)
#pragma unroll
                        for (int q8 = 0; q8 < 2; ++q8) { const v4u u = Ur[mt * 2 + q8];
                            VN[mt][8 * q8 + 0] = bflo(u.x); VN[mt][8 * q8 + 1] = bfhi(u.x); VN[mt][8 * q8 + 2] = bflo(u.y); VN[mt][8 * q8 + 3] = bfhi(u.y);
                            VN[mt][8 * q8 + 4] = bflo(u.z); VN[mt][8 * q8 + 5] = bfhi(u.z); VN[mt][8 * q8 + 6] = bflo(u.w); VN[mt][8 * q8 + 7] = bfhi(u.w); }
                    if (wave < 4 && n + 1 < SEGC) {
                        const v4u* up = (const v4u*)((const unsigned char*)Uf + (size_t)(n + 1) * 16384) + (wave * 4) * 64 + lane;
#pragma unroll
                        for (int f = 0; f < 4; ++f) Ur[f] = up[f * 64];
                    }
                    const float egl = egls[n];
#pragma unroll
                    for (int t2 = 0; t2 < 4; ++t2)
#pragma unroll
                        for (int s2 = 0; s2 < 2; ++s2) {
                            const bf16x8 sb = pack8(S[t2], s2);
#pragma unroll
                            for (int mt = 0; mt < 2; ++mt) VN[mt] = MFMA32(FRAG((mt * 4 + t2) * 2 + s2), sb, VN[mt]);
                        }
                    bf16x8 vb[2][2];
#pragma unroll
                    for (int mt = 0; mt < 2; ++mt)
#pragma unroll
                        for (int s2 = 0; s2 < 2; ++s2) vb[mt][s2] = pack8(VN[mt], s2);
#pragma unroll
                    for (int t2 = 0; t2 < 4; ++t2) {
#pragma unroll
                        for (int q = 0; q < 16; ++q) S[t2][q] *= egl;
#pragma unroll
                        for (int mt = 0; mt < 2; ++mt)
#pragma unroll
                            for (int s2 = 0; s2 < 2; ++s2) S[t2] = MFMA32(FRAG(16 + (t2 * 2 + mt) * 2 + s2), vb[mt][s2], S[t2]);
                    }
                }
#undef A_DMA
                if (wave < 4) {
#pragma unroll
                    for (int t2 = 0; t2 < 4; ++t2)
#pragma unroll
                        for (int q = 0; q < 16; ++q) segp[((wave * 4 + t2) * 16 + q) * 64 + lane] = S[t2][q];
                } else {
                    unsigned short* pp = (unsigned short*)(args.ws + WS_SEGP) + (size_t)(bh * 8 + seg) * 16384 + (((wave - 4) * 2 + (r >> 4)) * 64 + 32 * ((r >> 3) & 1)) * 8 + (r & 7);
#pragma unroll
                    for (int t2 = 0; t2 < 4; ++t2)
#pragma unroll
                        for (int q = 0; q < 16; ++q) pp[(t2 * 8 * 64 + crow(q, h)) * 8] = (unsigned short)f2bf(S[t2][q]);
                }
            }
            asm volatile("s_waitcnt vmcnt(0)" ::: "memory");
            __syncthreads();
            if (tid == 0) { __builtin_amdgcn_fence(__ATOMIC_RELEASE, "agent"); asm volatile("s_waitcnt vmcnt(0)" ::: "memory"); __hip_atomic_fetch_add(ctl + CW_SEGA + 64 * bh, 1u, RLX_AGENT); }
            if (seg == 0) {
                if (tid == 0) { unsigned sp_ = 0; while (__hip_atomic_load(ctl + CW_SEGA + 64 * bh, RLX_AGENT) < 8u) { __builtin_amdgcn_s_sleep(4); if (++sp_ > (1u << 24)) break; }
                    __builtin_amdgcn_fence(__ATOMIC_ACQUIRE, "agent"); asm volatile("s_waitcnt vmcnt(0)" ::: "memory"); }
                __syncthreads();
                constexpr int ST_ROW = 272, ST_BYTES = 128 * ST_ROW;
                const int nt = wave & 3, mt0 = 2 * (wave >> 2);
                const float* seg0 = (const float*)(args.ws + WS_SEG) + (size_t)(bh * 8) * 32768;
                const unsigned char* pa0 = args.ws + WS_SEGP + (size_t)(bh * 8) * 32768 + lane * 16;
                float* sst0 = (float*)(args.ws + WS_SST) + (size_t)(bh * 8) * 16384;
#define PB_LOADA(dst, k_) do { const unsigned char* pk_ = pa0 + (size_t)(k_) * 32768; \
                    _Pragma("unroll") for (int i_ = 0; i_ < 2; ++i_) _Pragma("unroll") for (int f_ = 0; f_ < 8; ++f_) dst[i_ * 8 + f_] = *(const bf16x8*)(pk_ + (((mt0 + i_) * 4) * 2 + f_) * 1024); } while (0)
#define PB_ITER(k_, Acur, Anext) do { \
                    if ((k_) + 1 <= 6) PB_LOADA(Anext, (k_) + 1); \
                    const float* sk_ = seg0 + (size_t)(k_) * 32768; \
                    f32x16 z0_[2], Z_[2]; \
                    _Pragma("unroll") for (int i_ = 0; i_ < 2; ++i_) _Pragma("unroll") for (int q_ = 0; q_ < 16; ++q_) { z0_[i_][q_] = sk_[((nt * 4 + mt0 + i_) * 16 + q_) * 64 + lane]; Z_[i_][q_] = 0.f; } \
                    if ((k_) > 0) { const LAS unsigned char* stc_ = lds + ((k_) & 1) * ST_BYTES + (32 * nt + r) * ST_ROW + 16 * h; \
                        _Pragma("unroll") for (int f_ = 0; f_ < 8; ++f_) { const bf16x8 bfr_ = *(const LAS bf16x8*)(stc_ + (16 * f_) * 2); \
                            Z_[0] = MFMA32(Acur[f_], bfr_, Z_[0]); Z_[1] = MFMA32(Acur[8 + f_], bfr_, Z_[1]); } } \
                    float* so_ = sst0 + (size_t)((k_) + 1) * 16384; \
                    LAS unsigned char* stn_ = lds + (((k_) + 1) & 1) * ST_BYTES + (32 * nt + r) * ST_ROW; \
                    _Pragma("unroll") for (int i_ = 0; i_ < 2; ++i_) { \
                        _Pragma("unroll") for (int q_ = 0; q_ < 16; ++q_) { Z_[i_][q_] += z0_[i_][q_]; so_[((nt * 4 + mt0 + i_) * 16 + q_) * 64 + lane] = Z_[i_][q_]; } \
                        _Pragma("unroll") for (int q_ = 0; q_ < 16; q_ += 2) *(LAS unsigned*)(stn_ + (32 * (mt0 + i_) + crow(q_, h)) * 2) = cvtpk(Z_[i_][q_], Z_[i_][q_ + 1]); } \
                    SCAN_BAR(); } while (0)
                bf16x8 Aa[16], Ab[16];
#pragma unroll
                for (int f = 0; f < 16; ++f) { Aa[f] = (bf16x8){0, 0, 0, 0, 0, 0, 0, 0}; Ab[f] = Aa[f]; }
                PB_ITER(0, Ab, Aa);
                PB_ITER(1, Aa, Ab);
                PB_ITER(2, Ab, Aa);
                PB_ITER(3, Aa, Ab);
                PB_ITER(4, Ab, Aa);
                PB_ITER(5, Aa, Ab);
                PB_ITER(6, Ab, Aa);
#undef PB_ITER
#undef PB_LOADA
                asm volatile("s_waitcnt vmcnt(0)" ::: "memory");
                __syncthreads();
                if (tid == 0) { __builtin_amdgcn_fence(__ATOMIC_RELEASE, "agent"); asm volatile("s_waitcnt vmcnt(0)" ::: "memory"); __hip_atomic_store(ctl + CW_SEGB + 64 * bh, 1u, RLX_AGENT); }
            }
            if (tid == 0) { unsigned sp_ = 0; while (__hip_atomic_load(ctl + CW_SEGB + 64 * bh, RLX_AGENT) == 0u) { __builtin_amdgcn_s_sleep(4); if (++sp_ > (1u << 24)) break; }
                __builtin_amdgcn_fence(__ATOMIC_ACQUIRE, "agent"); asm volatile("s_waitcnt vmcnt(0)" ::: "memory"); }
            __syncthreads();
#undef FRAG
            const kargp_t ap2_ = karg_ptr();
            const unsigned char* ops = ((*ap2_).ws + WS_OPS) + (size_t)(bh * 128 + c0) * OPS_BYTES;
            const float* Uf = (const float*)((const unsigned char*)((*ap2_).ws + WS_U) + (size_t)(bh * 128 + c0) * 16384);
            const float* sstp = (const float*)((*ap2_).ws + WS_SST) + (size_t)(bh * 8 + seg) * 16384;
#define SCAN_DMA(n_, buf_) do { const unsigned char* src_ = ops + (size_t)(n_) * OPS_BYTES + ((wave - 4) * 14) * 1024 + lane * 16; \
            _Pragma("unroll") for (int p_ = 0; p_ < 14; ++p_) __builtin_amdgcn_global_load_lds((const unsigned*)(src_ + p_ * 1024), (LAS unsigned*)(lds + (buf_) * OPS_BYTES + ((wave - 4) * 14 + p_) * 1024), 16, 0, 0); } while (0)
            constexpr int STG_OFF = 2 * OPS_BYTES, STG_ROW = 272, STG_BYTES = 64 * STG_ROW;
            if (wave < 4) {
                f32x16 S[4]; v4u Ur[4];
#pragma unroll
                for (int t2 = 0; t2 < 4; ++t2)
#pragma unroll
                    for (int q = 0; q < 16; ++q) S[t2][q] = (seg > 0) ? sstp[((wave * 4 + t2) * 16 + q) * 64 + lane] : 0.f;
#pragma unroll
                for (int f = 0; f < 4; ++f) Ur[f] = *((const v4u*)Uf + (wave * 4 + f) * 64 + lane);
                const float* glp = glbuf + bh * 128 + c0;
                float eglr = glp[0];
                for (int n = 0; n < SEGC; ++n) {
                    SCAN_BAR();
                    const LAS unsigned char* Bf = lds + (n & 1) * OPS_BYTES + lane * 16;
#define FRAG(f_) (*(const LAS bf16x8*)(Bf + (f_) * 1024))
                    f32x16 VN[2], O[2];
#pragma unroll
                    for (int mt = 0; mt < 2; ++mt)
#pragma unroll
                        for (int q8 = 0; q8 < 2; ++q8) { const v4u u = Ur[mt * 2 + q8];
                            VN[mt][8 * q8 + 0] = bflo(u.x); VN[mt][8 * q8 + 1] = bfhi(u.x); VN[mt][8 * q8 + 2] = bflo(u.y); VN[mt][8 * q8 + 3] = bfhi(u.y);
                            VN[mt][8 * q8 + 4] = bflo(u.z); VN[mt][8 * q8 + 5] = bfhi(u.z); VN[mt][8 * q8 + 6] = bflo(u.w); VN[mt][8 * q8 + 7] = bfhi(u.w); }
                    const float egl = eglr;
                    if (n + 1 < SEGC) {
                        const v4u* up = (const v4u*)((const unsigned char*)Uf + (size_t)(n + 1) * 16384) + (wave * 4) * 64 + lane;
#pragma unroll
                        for (int f = 0; f < 4; ++f) Ur[f] = up[f * 64];
                        eglr = glp[n + 1];
                    }
#pragma unroll
                    for (int mt = 0; mt < 2; ++mt)
#pragma unroll
                        for (int q = 0; q < 16; ++q) O[mt][q] = 0.f;
#pragma unroll
                    for (int t2 = 0; t2 < 4; ++t2)
#pragma unroll
                        for (int s2 = 0; s2 < 2; ++s2) {
                            const bf16x8 sb = pack8(S[t2], s2);
#pragma unroll
                            for (int mt = 0; mt < 2; ++mt) {
                                VN[mt] = MFMA32(FRAG((mt * 4 + t2) * 2 + s2), sb, VN[mt]);
                                O[mt] = MFMA32(FRAG(16 + (mt * 4 + t2) * 2 + s2), sb, O[mt]);
                            }
                        }
                    bf16x8 vb[2][2];
#pragma unroll
                    for (int mt = 0; mt < 2; ++mt)
#pragma unroll
                        for (int s2 = 0; s2 < 2; ++s2) vb[mt][s2] = pack8(VN[mt], s2);
#pragma unroll
                    for (int s2 = 0; s2 < 2; ++s2) {
                        O[0] = MFMA32(FRAG(48 + 0 * 2 + s2), vb[0][s2], O[0]);
                        O[1] = MFMA32(FRAG(48 + 2 * 2 + s2), vb[0][s2], O[1]);
                        O[1] = MFMA32(FRAG(48 + 3 * 2 + s2), vb[1][s2], O[1]);
                    }
                    {
                        LAS unsigned short* sp = (LAS unsigned short*)(lds + STG_OFF + (n & 1) * STG_BYTES) + 32 * wave + r;
#pragma unroll
                        for (int mt = 0; mt < 2; ++mt)
#pragma unroll
                            for (int q = 0; q < 16; q += 2) { const unsigned w = cvtpk(O[mt][q], O[mt][q + 1]);
                                sp[(32 * mt + crow(q, h)) * (STG_ROW / 2)] = (unsigned short)(w & 0xffffu); sp[(32 * mt + crow(q + 1, h)) * (STG_ROW / 2)] = (unsigned short)(w >> 16); }
                    }
                    SCAN_BAR();
#pragma unroll
                    for (int t2 = 0; t2 < 4; ++t2) {
#pragma unroll
                        for (int q = 0; q < 16; ++q) S[t2][q] *= egl;
#pragma unroll
                        for (int mt = 0; mt < 2; ++mt)
#pragma unroll
                            for (int s2 = 0; s2 < 2; ++s2) S[t2] = MFMA32(FRAG(32 + (t2 * 2 + mt) * 2 + s2), vb[mt][s2], S[t2]);
                    }
#undef FRAG
                }
                SCAN_BAR();
            } else {
                const int w4 = wave - 4, row = 16 * w4 + (lane >> 2), qt = lane & 3;
                const bf16* zp = zsb + ((size_t)b * T + c0 * 64 + row) * 512 + hh * 128 + qt * 32;
                bf16* op = omix + ((size_t)b * T + c0 * 64 + row) * D + hh * 128 + qt * 32;
                SCAN_DMA(0, 0);
                asm volatile("s_waitcnt vmcnt(0)" ::: "memory");
                v4u zr[4];
#pragma unroll
                for (int k = 0; k < 4; ++k) zr[k] = *(const v4u*)(zp + 8 * k);
                unsigned pfacc = 0u, pf0 = 0u, pf1 = 0u;
                for (int n = 0; n <= SEGC; ++n) {
                    SCAN_BAR();
                    if (n < SEGC - 1) SCAN_DMA(n + 1, (n + 1) & 1);
                    asm volatile("" ::: "memory");
                    if (n < SEGC - 2) {
                        const unsigned char* pf = ops + (size_t)(n + 2) * OPS_BYTES + (w4 * 112 + lane) * 128;
                        pfacc += pf0 + pf1; pf0 = *(const unsigned*)pf; pf1 = (lane < 48) ? *(const unsigned*)(pf + 64 * 128) : 0u;
                    }
                    asm volatile("" ::: "memory");
                    if (n < SEGC) SCAN_BAR();
                    if (n > 0) {
                        const LAS unsigned char* sp = lds + STG_OFF + ((n - 1) & 1) * STG_BYTES + row * STG_ROW + qt * 64;
                        v4u ov[4]; float ss = 0.f;
#pragma unroll
                        for (int k = 0; k < 4; ++k) { ov[k] = *(const LAS v4u*)(sp + 16 * k);
                            const float a0 = bflo(ov[k].x), a1 = bfhi(ov[k].x), a2 = bflo(ov[k].y), a3 = bfhi(ov[k].y), a4 = bflo(ov[k].z), a5 = bfhi(ov[k].z), a6 = bflo(ov[k].w), a7 = bfhi(ov[k].w);
                            ss += (a0 * a0 + a1 * a1) + (a2 * a2 + a3 * a3) + (a4 * a4 + a5 * a5) + (a6 * a6 + a7 * a7); }
                        ss += __shfl_xor(ss, 1); ss += __shfl_xor(ss, 2);
                        const float rstd = rsqrtf(ss * (1.0f / 128.0f) + EPS);
                        bf16* o2 = op + (size_t)(n - 1) * 64 * D;
#pragma unroll
                        for (int k = 0; k < 4; ++k) {
                            v4u w;
                            w.x = cvtpk(bflo(ov[k].x) * rstd * bflo(zr[k].x), bfhi(ov[k].x) * rstd * bfhi(zr[k].x));
                            w.y = cvtpk(bflo(ov[k].y) * rstd * bflo(zr[k].y), bfhi(ov[k].y) * rstd * bfhi(zr[k].y));
                            w.z = cvtpk(bflo(ov[k].z) * rstd * bflo(zr[k].z), bfhi(ov[k].z) * rstd * bfhi(zr[k].z));
                            w.w = cvtpk(bflo(ov[k].w) * rstd * bflo(zr[k].w), bfhi(ov[k].w) * rstd * bfhi(zr[k].w));
                            *(v4u*)(o2 + 8 * k) = w;
                        }
                    }
                    asm volatile("" ::: "memory");
                    if (n >= 1 && n < SEGC) {
#pragma unroll
                        for (int k = 0; k < 4; ++k) zr[k] = *(const v4u*)(zp + (size_t)n * 64 * 512 + 8 * k);
                    }
                    asm volatile("" ::: "memory");
                    if (n < SEGC) { if (n == 0 || n >= SEGC - 2) asm volatile("s_waitcnt vmcnt(0)" ::: "memory"); else asm volatile("s_waitcnt vmcnt(10)" ::: "memory"); }
                }
                if (pfacc == 0x12345679u) glbuf[1024 + lane] = 1.0f;
            }
#undef SCAN_DMA
#undef SCAN_BAR
        } else {
            const float* relb = args.in[I_RELB];
            ldsf* rbl = (ldsf*)lds;
            for (int idx = tid; idx < 8 * 257; idx += NTHR) rbl[idx] = relb[idx] * 1.4426950408889634f;
            __syncthreads();
            const int r = lane & 31, h = lane >> 5;
            const int AW = (G - 64) * NWAVES, aw = (bx - 64) * NWAVES + wave;
            for (int task = aw; task < 4096; task += AW) {
                const int qh = task & 1, hh = (task >> 1) & 7, n = (task >> 4) & 127, b = task >> 11;
                const int bhc = (b * 8 + hh) * 128;
                bf16x8 qf[4];
#pragma unroll
                for (int ks = 0; ks < 4; ++ks) qf[ks] = *(const bf16x8*)(qfb + (size_t)(bhc + n) * 8192 + (qh * 4 + ks) * 1024 + lane * 16);
                f32x16 OT[2];
#pragma unroll
                for (int dt = 0; dt < 2; ++dt)
#pragma unroll
                    for (int q = 0; q < 16; ++q) OT[dt][q] = 0.f;
                float m = -1e30f, l = 0.f;
                const float c0 = rbl[hh * 257 + 256];
                const int iq = 32 * qh + r;
                const int cb0 = (n >= 8) ? 0 : 8 - n;
                for (int blk = cb0 * 2; blk < 18; ++blk) {
                    const int cb = blk >> 1, kb2 = blk & 1, cidx = n - 8 + cb;
                    const unsigned char* kp = kfb + (size_t)(bhc + cidx) * 8192 + (kb2 * 4) * 1024 + lane * 16;
                    const unsigned char* vp = vtfb + (size_t)(bhc + cidx) * 8192 + lane * 16;
                    bf16x8 kf[4], vf[2][2];
#pragma unroll
                    for (int ks = 0; ks < 4; ++ks) kf[ks] = *(const bf16x8*)(kp + ks * 1024);
#pragma unroll
                    for (int dt = 0; dt < 2; ++dt)
#pragma unroll
                        for (int s2 = 0; s2 < 2; ++s2) vf[dt][s2] = *(const bf16x8*)(vp + ((dt * 2 + kb2) * 2 + s2) * 1024);
                    f32x16 st;
#pragma unroll
                    for (int q = 0; q < 16; ++q) st[q] = 0.f;
#pragma unroll
                    for (int ks = 0; ks < 4; ++ks) st = MFMA32(kf[ks], qf[ks], st);
                    if (cb >= 6) {
                        const int kpos0 = cb * 64 + 32 * kb2;
#pragma unroll
                        for (int q = 0; q < 16; ++q) { int rel = iq + 512 - (kpos0 + crow(q, h)); rel = rel > 128 ? 128 : rel; st[q] = st[q] * 0.18033688011112042f + rbl[hh * 257 + rel + 128]; }
                    } else {
#pragma unroll
                        for (int q = 0; q < 16; ++q) st[q] = st[q] * 0.18033688011112042f + c0;
                    }
                    float bm = st[0];
#pragma unroll
                    for (int q = 1; q < 16; ++q) bm = fmaxf(bm, st[q]);
                    bm = fmaxf(bm, __shfl_xor(bm, 32));
                    const float mn = fmaxf(m, bm);
                    if (__any(mn > m)) {
                        const float corr = __builtin_amdgcn_exp2f(m - mn);
                        l *= corr;
#pragma unroll
                        for (int dt = 0; dt < 2; ++dt)
#pragma unroll
                            for (int q = 0; q < 16; ++q) OT[dt][q] *= corr;
                        m = mn;
                    }
                    float ps = 0.f;
#pragma unroll
                    for (int q = 0; q < 16; ++q) { st[q] = __builtin_amdgcn_exp2f(st[q] - m); ps += st[q]; }
                    ps += __shfl_xor(ps, 32);
                    l += ps;
                    const bf16x8 p0 = pack8(st, 0), p1 = pack8(st, 1);
#pragma unroll
                    for (int dt = 0; dt < 2; ++dt) { OT[dt] = MFMA32(vf[dt][0], p0, OT[dt]); OT[dt] = MFMA32(vf[dt][1], p1, OT[dt]); }
                }
                const float inv = 1.0f / l;
                bf16* op = omix + ((size_t)b * T + n * 64 + iq) * D + 512 + hh * 64;
#pragma unroll
                for (int dt = 0; dt < 2; ++dt)
#pragma unroll
                    for (int q4 = 0; q4 < 4; ++q4) {
                        v2u w; w.x = cvtpk(OT[dt][4 * q4] * inv, OT[dt][4 * q4 + 1] * inv); w.y = cvtpk(OT[dt][4 * q4 + 2] * inv, OT[dt][4 * q4 + 3] * inv);
                        *(v2u*)(op + 32 * dt + 8 * q4 + 4 * h) = w;
                    }
            }
            __syncthreads();
            {
                ldsf* scr = (ldsf*)(lds + wave * 16384);
                constexpr int I_UP1 = 16 * 64, I_DN1 = 16 * 32;
                for (int it = aw; it < NE * (I_UP1 + I_DN1); it += AW) {
                    int r2 = it;
                    if (r2 < NE * I_UP1) { const int e = r2 / I_UP1; transpose_item8(args.in[I_WUP] + (size_t)e * D * 2048, D, 2048, (unsigned char*)WupT + (size_t)e * 2048 * D, 2, scr, r2 % I_UP1, lane); continue; } r2 -= NE * I_UP1;
                    { const int e = r2 / I_DN1; transpose_item8(args.in[I_WDN] + (size_t)e * D * D, D, D, (unsigned char*)WdnT + (size_t)e * D * D, 1, scr, r2 % I_DN1, lane); }
                }
            }
        }
        if (BOTH(4)) GRID_BAR();
    }


    if (IN(6)) {
        const int lane = (int)__builtin_amdgcn_mbcnt_hi(~0u, __builtin_amdgcn_mbcnt_lo(~0u, 0u)), tid = wave * 64 + lane; const kargp_t ap_ = karg_ptr();
        pg8::Gemm g{omix, WoutT, NTOK, D, D}; pg8::StaticOrder S; S.init(NTOK, D, G, bx);
        pg8::EpiBf16 E{ybuf, D, nullptr, nullptr, 0, 1.0f};
        pg8::gemm_phase<pg8::EpiBf16, pg8::StaticOrder, true, true>(lds, g, S, E, tid);
        if (BOTH(6)) GRID_BAR();
    }

    if (IN(7)) {
        const int lane = (int)__builtin_amdgcn_mbcnt_hi(~0u, __builtin_amdgcn_mbcnt_lo(~0u, 0u)), tid = wave * 64 + lane; const kargp_t ap_ = karg_ptr();
        ldsf* wrT = (ldsf*)lds;
        { const char* src = (const char*)(P_WS + WS_WR) + (size_t)wave * 16384 + lane * 16;
#pragma unroll
          for (int p = 0; p < 16; ++p) __builtin_amdgcn_global_load_lds((const unsigned*)(src + p * 1024), (LAS unsigned*)(lds + wave * 16384 + p * 1024), 16, 0, 0); }
        LAS int* lcnt = (LAS int*)(lds + 131072);
        if (tid < 32) lcnt[tid] = 0;
        asm volatile("s_waitcnt vmcnt(0)" ::: "memory");
        __syncthreads();
        const float* nw1 = args.in[I_NORMW] + 1024; const float* nw2 = args.in[I_NORMW] + 2048; const float* b_r = args.in[I_BR];
        typedef unsigned u32x2_t __attribute__((ext_vector_type(2)));
        u32x2_t ynx[4]; f32x4 xnx[4];
#pragma unroll
        for (int j = 0; j < 4; ++j) { ynx[j] = *((const u32x2_t*)(ybuf + (size_t)gw * D) + lane + 64 * j); xnx[j] = *((const f32x4*)(Xp + (size_t)gw * D) + lane + 64 * j); }
        for (int bb = 0; bb < BATCH; ++bb) {
        f32x4 g1v[4], a2v[4], sh2v[4];
#pragma unroll
        for (int j = 0; j < 4; ++j) { const int col = 4 * lane + 256 * j;
            const f32x4 n1 = *(const f32x4*)(nw1 + col), ga = *(const f32x4*)(MODp + bb * 6144 + 2048 + col), n2 = *(const f32x4*)(nw2 + col), sc = *(const f32x4*)(MODp + bb * 6144 + 4096 + col);
            sh2v[j] = *(const f32x4*)(MODp + bb * 6144 + 3072 + col);
#pragma unroll
            for (int e = 0; e < 4; ++e) { g1v[j][e] = ga[e] * n1[e]; a2v[j][e] = n2[e] * (1.0f + sc[e]); } }
        for (int r = gw + bb * (NTOK / BATCH); r < (bb + 1) * (NTOK / BATCH); r += NGW) {
            f32x4 v[4], xv4[4]; float ss = 0.f;
#pragma unroll
            for (int j = 0; j < 4; ++j) { v[j] = (f32x4){__uint_as_float(ynx[j].x << 16), __uint_as_float(ynx[j].x & 0xffff0000u), __uint_as_float(ynx[j].y << 16), __uint_as_float(ynx[j].y & 0xffff0000u)}; xv4[j] = xnx[j]; ss += (v[j].x * v[j].x + v[j].y * v[j].y) + (v[j].z * v[j].z + v[j].w * v[j].w); }
            __builtin_amdgcn_sched_barrier(0);
            if (r + NGW < NTOK) {
#pragma unroll
                for (int j = 0; j < 4; ++j) { ynx[j] = *((const u32x2_t*)(ybuf + (size_t)(r + NGW) * D) + lane + 64 * j); xnx[j] = *((const f32x4*)(Xp + (size_t)(r + NGW) * D) + lane + 64 * j); }
            }
            __builtin_amdgcn_sched_barrier(0);
            const float rstd1 = rsqrtf(wave_sum(ss) * (1.0f / D) + EPS);
            float ss2 = 0.f;
#pragma unroll
            for (int j = 0; j < 4; ++j) {
#pragma unroll
                for (int e = 0; e < 4; ++e) { v[j][e] = xv4[j][e] + g1v[j][e] * (v[j][e] * rstd1); ss2 += v[j][e] * v[j][e]; }
            }
            const float rstd2 = rsqrtf(wave_sum(ss2) * (1.0f / D) + EPS);
            f32x4 hv[4]; unsigned h8[4];
#pragma unroll
            for (int j = 0; j < 4; ++j) {
#pragma unroll
                for (int e = 0; e < 4; ++e) hv[j][e] = v[j][e] * rstd2 * a2v[j][e] + sh2v[j][e];
                h8[j] = pg8::pk4_fp8(hv[j][0], hv[j][1], hv[j][2], hv[j][3]);
            }
#pragma unroll
            for (int j = 0; j < 4; ++j) { const int col = 4 * lane + 256 * j; *(f32x4*)(OUTp + (size_t)r * D + col) = v[j]; *(unsigned*)((unsigned char*)hbuf + (size_t)r * D + col) = h8[j]; }
            float pe[32];
#pragma unroll
            for (int e = 0; e < 32; ++e) {
                typedef float f32x2_t __attribute__((ext_vector_type(2)));
                f32x2_t p2 = {0.f, 0.f};
#pragma unroll
                for (int j = 0; j < 4; ++j) { const f32x4 w = *(const LAS f32x4*)(wrT + e * 1024 + 4 * lane + 256 * j);
                    p2 += (f32x2_t){hv[j][0], hv[j][1]} * (f32x2_t){w[0], w[1]}; p2 += (f32x2_t){hv[j][2], hv[j][3]} * (f32x2_t){w[2], w[3]}; }
                pe[e] = p2.x + p2.y;
                if ((e & 1) == 1) asm volatile("" ::: "memory");
            }
            float r16[16];
            { const bool up = lane >= 32;
#pragma unroll
              for (int e = 0; e < 16; ++e) { const float send = up ? pe[e] : pe[e + 16], keep = up ? pe[e + 16] : pe[e]; r16[e] = keep + xchg32(send, lane); } }
            float r8[8];
            { const bool up = (lane & 16) != 0;
#pragma unroll
              for (int e = 0; e < 8; ++e) { const float send = up ? r16[e] : r16[e + 8], keep = up ? r16[e + 8] : r16[e]; r8[e] = keep + xchg16(send, lane); } }
            float r4[4];
            { const bool up = (lane & 8) != 0;
#pragma unroll
              for (int e = 0; e < 4; ++e) { const float send = up ? r8[e] : r8[e + 4], keep = up ? r8[e + 4] : r8[e]; r4[e] = keep + dppx<0x128>(send); } }
            float r2[2];
            { const bool up = (lane & 4) != 0;
#pragma unroll
              for (int e = 0; e < 2; ++e) { const float send = up ? r4[e] : r4[e + 2], keep = up ? r4[e + 2] : r4[e]; r2[e] = keep + __shfl_xor(send, 4); } }
            float r1;
            { const bool up = (lane & 2) != 0; const float send = up ? r2[0] : r2[1], keep = up ? r2[1] : r2[0]; r1 = keep + dppx<0x4E>(send); }
            r1 += dppx<0xB1>(r1);
            const int eid = ((lane >> 5) << 4) | (((lane >> 4) & 1) << 3) | (((lane >> 3) & 1) << 2) | (((lane >> 2) & 1) << 1) | ((lane >> 1) & 1);
            float mylg = r1 + b_r[eid];
            int se[4]; float sv[4];
#pragma unroll
            for (int k = 0; k < 4; ++k) {
                const float bv = wave_max(mylg); const int bi = wave_min_i(mylg == bv ? eid : 99);
                se[k] = bi; sv[k] = bv;
                if (eid == bi) mylg = -3.0e38f;
            }
            const float e1 = __expf(sv[1] - sv[0]), e2 = __expf(sv[2] - sv[0]), e3 = __expf(sv[3] - sv[0]);
            const float inv = 1.0f / (1.0f + e1 + e2 + e3);
            if (lane < 4 && !(args.pad & 32)) {
                const int mye = lane == 0 ? se[0] : (lane == 1 ? se[1] : (lane == 2 ? se[2] : se[3]));
                const float myg = (lane == 0 ? 1.0f : (lane == 1 ? e1 : (lane == 2 ? e2 : e3))) * inv;
                const unsigned pos = atomicAdd((unsigned*)lcnt + mye, 1u);
                asg_e[r * 4 + lane] = mye; asg_p[r * 4 + lane] = (int)pos; asg_g[r * 4 + lane] = myg;
            }
        }
        }
        __syncthreads();
        if (tid < 32) ((int*)(ctl + CW_HIST))[vcu * 32 + tid] = lcnt[tid];
        if (BOTH(7)) GRID_BAR();
    }

    LAS int* pst = (LAS int*)(lds + MISC_OFF + 512);
    LAS int* tile_e = (LAS int*)(lds + MISC_OFF + 768);
    LAS int* wbase = (LAS int*)(lds + MISC_OFF + 384);
    if (hi > 8 && lo <= 10) {
        const kargp_t ap_ = karg_ptr();
        const int tix = wave * 64 + (int)__builtin_amdgcn_mbcnt_hi(~0u, __builtin_amdgcn_mbcnt_lo(~0u, 0u));
        {
            LAS int* tmp = (LAS int*)lds;
            const int e = tix & 31, part = tix >> 5; int tot = 0, bef = 0;
            const int* hist = (const int*)(ctl + CW_HIST);
            for (int bb = part; bb < G; bb += 16) { const int c = hist[bb * 32 + e]; tot += c; bef += (bb < vcu) ? c : 0; }
            tmp[part * 32 + e] = tot; tmp[512 + part * 32 + e] = bef;
            __syncthreads();
            if (tix < 32) { int t2 = 0, b2 = 0;
#pragma unroll
                for (int p = 0; p < 16; ++p) { t2 += tmp[p * 32 + tix]; b2 += tmp[512 + p * 32 + tix]; }
                tmp[1024 + tix] = t2; wbase[tix] = b2; ((LAS int*)(lds + MISC_OFF + 1920))[tix] = t2; }
            __syncthreads();
            if (tix == 0) { int run = 0, rt = 0;
                for (int e2 = 0; e2 < NE; ++e2) { pst[e2] = run; const int c = tmp[1024 + e2]; const int nt = (c + 255) >> 8; for (int t2 = 0; t2 < nt; ++t2) tile_e[rt++] = e2; run += nt * 256; }
                pst[32] = run; }
        }
        __syncthreads();
    }
    const int nslots = (hi > 8 && lo <= 10) ? pst[32] : 0;

    if (IN(8)) {
        const int lane = (int)__builtin_amdgcn_mbcnt_hi(~0u, __builtin_amdgcn_mbcnt_lo(~0u, 0u)), tid = wave * 64 + lane; const kargp_t ap_ = karg_ptr();
        {
            int* stok = (int*)(P_WS + WS_STOK);
            for (int r = gw; r < NTOK; r += NGW) {
                if (lane < 4) { const int a = r * 4 + lane; const int e = asg_e[a], pos = asg_p[a]; const int slot = pst[e] + wbase[e] + pos; asg_s[a] = slot; stok[slot] = r; }
            }
            if (bx < NE) {
                const int c = ((LAS int*)(lds + MISC_OFF + 1920))[bx], pad = (c + 255) & ~255;
                for (int s2 = c + tid; s2 < pad; s2 += NTHR) stok[pst[bx] + s2] = 0;
            }
        }
        if (BOTH(8)) GRID_BAR();
    }

    if (IN(9)) {
        const int lane = (int)__builtin_amdgcn_mbcnt_hi(~0u, __builtin_amdgcn_mbcnt_lo(~0u, 0u)), tid = wave * 64 + lane; const kargp_t ap_ = karg_ptr();
        pg8::Gemm g{hbuf, WupT, nslots, 2048, D}; pg8::MoeOrder S; S.init(nslots, 2048, G, bx); S.tile_e = tile_e; S.estride = (size_t)2048 * D; S.rowidx = (const int*)(P_WS + WS_STOK);
        pg8::EpiSwiGLU E{(unsigned char*)actb, args.in[I_BUP], tile_e, 1.0f / 32.0f};
        pg8::gemm_phase<pg8::EpiSwiGLU, pg8::MoeOrder, true, true, true, true>(lds, g, S, E, tid);
        if (BOTH(9)) GRID_BAR();
    }

    if (IN(10)) {
        const int lane = (int)__builtin_amdgcn_mbcnt_hi(~0u, __builtin_amdgcn_mbcnt_lo(~0u, 0u)), tid = wave * 64 + lane; const kargp_t ap_ = karg_ptr();
        pg8::Gemm g{actb, WdnT, nslots, D, D}; pg8::MoeOrder S; S.init(nslots, D, G, bx); S.tile_e = tile_e; S.estride = (size_t)D * D;
        pg8::EpiBf16 E{yslot, D, args.in[I_BDN], tile_e, D, 1.0f / 32.0f};
        pg8::gemm_phase<pg8::EpiBf16, pg8::MoeOrder, true, true, true>(lds, g, S, E, tid);
        if (BOTH(10)) GRID_BAR();
    }

    if (IN(11)) {
        const int lane = (int)__builtin_amdgcn_mbcnt_hi(~0u, __builtin_amdgcn_mbcnt_lo(~0u, 0u)), tid = wave * 64 + lane; const kargp_t ap_ = karg_ptr();
        const float* nw3 = args.in[I_NORMW] + 3072;
        int sln[4]; float gtn[4];
#pragma unroll
        for (int k = 0; k < 4; ++k) { sln[k] = asg_s[gw * 4 + k]; gtn[k] = asg_g[gw * 4 + k]; }
        v2u ywn[4][4]; f32x4 xon[4]; float gtc[4];
#pragma unroll
        for (int k = 0; k < 4; ++k) { gtc[k] = gtn[k];
#pragma unroll
            for (int j = 0; j < 4; ++j) ywn[k][j] = *(const v2u*)(yslot + (size_t)sln[k] * D + 4 * lane + 256 * j); }
#pragma unroll
        for (int j = 0; j < 4; ++j) xon[j] = *(const f32x4*)(OUTp + (size_t)gw * D + 4 * lane + 256 * j);
        if (gw + NGW < NTOK) {
#pragma unroll
            for (int k = 0; k < 4; ++k) { sln[k] = asg_s[(gw + NGW) * 4 + k]; gtn[k] = asg_g[(gw + NGW) * 4 + k]; }
        }
        for (int bb = 0; bb < BATCH; ++bb) {
        f32x4 g3v[4];
#pragma unroll
        for (int j = 0; j < 4; ++j) { const int col = 4 * lane + 256 * j; const f32x4 n3 = *(const f32x4*)(nw3 + col), ga = *(const f32x4*)(MODp + bb * 6144 + 5120 + col);
#pragma unroll
            for (int e = 0; e < 4; ++e) g3v[j][e] = ga[e] * n3[e]; }
        for (int r = gw + bb * (NTOK / BATCH); r < (bb + 1) * (NTOK / BATCH); r += NGW) {
            v2u yw[4][4]; f32x4 xo[4]; float gt[4];
#pragma unroll
            for (int k = 0; k < 4; ++k) { gt[k] = gtc[k];
#pragma unroll
                for (int j = 0; j < 4; ++j) yw[k][j] = ywn[k][j]; }
#pragma unroll
            for (int j = 0; j < 4; ++j) xo[j] = xon[j];
            __builtin_amdgcn_sched_barrier(0);
            if (r + NGW < NTOK) {
#pragma unroll
                for (int k = 0; k < 4; ++k) { gtc[k] = gtn[k];
#pragma unroll
                    for (int j = 0; j < 4; ++j) ywn[k][j] = *(const v2u*)(yslot + (size_t)sln[k] * D + 4 * lane + 256 * j); }
#pragma unroll
                for (int j = 0; j < 4; ++j) xon[j] = *(const f32x4*)(OUTp + (size_t)(r + NGW) * D + 4 * lane + 256 * j);
                if (r + 2 * NGW < NTOK) {
#pragma unroll
                    for (int k = 0; k < 4; ++k) { sln[k] = asg_s[(r + 2 * NGW) * 4 + k]; gtn[k] = asg_g[(r + 2 * NGW) * 4 + k]; }
                }
            }
            __builtin_amdgcn_sched_barrier(0);
            f32x4 acc[4];
#pragma unroll
            for (int j = 0; j < 4; ++j) { acc[j] = (f32x4){0.f, 0.f, 0.f, 0.f};
#pragma unroll
                for (int k = 0; k < 4; ++k) { acc[j][0] += gt[k] * bflo(yw[k][j].x); acc[j][1] += gt[k] * bfhi(yw[k][j].x); acc[j][2] += gt[k] * bflo(yw[k][j].y); acc[j][3] += gt[k] * bfhi(yw[k][j].y); } }
            float ss = 0.f;
#pragma unroll
            for (int j = 0; j < 4; ++j) ss += (acc[j][0] * acc[j][0] + acc[j][1] * acc[j][1]) + (acc[j][2] * acc[j][2] + acc[j][3] * acc[j][3]);
            const float rstd = rsqrtf(wave_sum(ss) * (1.0f / D) + EPS);
#pragma unroll
            for (int j = 0; j < 4; ++j) {
                const int col = 4 * lane + 256 * j;
                f32x4 xv = xo[j];
#pragma unroll
                for (int e = 0; e < 4; ++e) xv[e] += g3v[j][e] * (acc[j][e] * rstd);
                if (!(args.pad & 32)) *(f32x4*)(OUTp + (size_t)r * D + col) = xv;
            }
        }
        }
    }
#undef IN
#undef BOTH
}

#undef P_WS
#undef ctl
#undef Xp
#undef OUTp
#undef MODp
#undef gbuf
#undef betabuf
#undef glbuf
#undef asg_e
#undef asg_p
#undef asg_g
#undef asg_s
#undef WinT
#undef WoutT
#undef WupT
#undef WdnT
#undef hbuf
#undef projb
#undef Ub
#undef opsb
#undef zsb
#undef qfb
#undef kfb
#undef vtfb
#undef omix
#undef ybuf
#undef xg
#undef actb
#undef yslot
#undef args
constexpr int NPHASES = 12;

extern "C" void kernel_launch(void* const* d_in, const int* in_sizes, int n_in, void* d_out, int out_size, void* d_ws, size_t ws_size, hipStream_t stream) {
    static int grid = 0;
    if (grid == 0) {
        if (n_in != 18 || out_size != NTOK * D || ws_size < WS_END) { fprintf(stderr, "kernel_launch: unexpected shapes (n_in %d out %d ws %zu)\n", n_in, out_size, ws_size); grid = -1; return; }
        int dev = 0, cus = 0, per_cu = 0;
        if (hipGetDevice(&dev) != hipSuccess || hipDeviceGetAttribute(&cus, hipDeviceAttributeMultiprocessorCount, dev) != hipSuccess) { grid = -1; return; }
        if (hipFuncSetAttribute((const void*)mk_fwd, hipFuncAttributeMaxDynamicSharedMemorySize, LDS_BYTES) != hipSuccess) { fprintf(stderr, "kernel_launch: hipFuncSetAttribute failed\n"); grid = -1; return; }
        if (hipOccupancyMaxActiveBlocksPerMultiprocessor(&per_cu, (const void*)mk_fwd, NTHR, LDS_BYTES) != hipSuccess || per_cu < 1) { fprintf(stderr, "kernel_launch: occupancy query says %d blocks per CU\n", per_cu); grid = -1; return; }
        (void)hipGetLastError();
        grid = cus;
    }
    if (grid < 0) return;
    (void)hipMemsetAsync((char*)d_ws + WS_CTL, 0, CTL_ZERO_BYTES, stream);
    Args a{};
    for (int i = 0; i < 18; ++i) a.in[i] = (const float*)d_in[i];
    a.out = (float*)d_out; a.ws = (unsigned char*)d_ws;
#if MK_ONE_LAUNCH
#ifndef PROBE_PHASE
#define PROBE_PHASE -1
#endif
#ifndef PROBE_SUB
#define PROBE_SUB 0
#endif
    if (PROBE_PHASE >= 0) {
        const int k = PROBE_PHASE;
        a.ph_lo = 0; a.ph_hi = k + 1; a.li = 0; hipLaunchKernelGGL(mk_fwd, dim3(grid), dim3(NTHR), LDS_BYTES, stream, a);
        a.ph_lo = k; a.ph_hi = k + 1; a.li = 1; a.pad = (k == 7 || k == 11) ? 32 : PROBE_SUB; hipLaunchKernelGGL(mk_fwd, dim3(grid), dim3(NTHR), LDS_BYTES, stream, a); a.pad = 0;
        if (k + 1 < NPHASES) { a.ph_lo = k + 1; a.ph_hi = NPHASES; a.li = 2; hipLaunchKernelGGL(mk_fwd, dim3(grid), dim3(NTHR), LDS_BYTES, stream, a); }
        return;
    }
    a.ph_lo = 0; a.ph_hi = NPHASES; a.li = 0;
    hipLaunchKernelGGL(mk_fwd, dim3(grid), dim3(NTHR), LDS_BYTES, stream, a);
#else
    for (int p = 0; p < NPHASES; ++p) { a.ph_lo = p; a.ph_hi = p + 1; a.li = p; hipLaunchKernelGGL(mk_fwd, dim3(grid), dim3(NTHR), LDS_BYTES, stream, a); }
#endif
}
```

```cpp
#include <hip/hip_runtime.h>
#include <cstdio>
#include <cstdint>

#ifndef MK_ONE_LAUNCH
#define MK_ONE_LAUNCH 1
#endif

namespace pg8 {
#define PG8_LAS __attribute__((address_space(3)))
typedef unsigned short bf16_t;
typedef short bf16x8 __attribute__((ext_vector_type(8)));
typedef float f32x4 __attribute__((ext_vector_type(4)));
typedef unsigned u32x4 __attribute__((ext_vector_type(4)));
constexpr int BM = 256, BK = 64, HALF = 128, HTB = HALF * BK * 2, STAGE_BYTES = 8 * HTB, NXCD = 8, WGM = 8;

__host__ __device__ __forceinline__ int lds_byte(int r, int c) { const int st = (r >> 4) * 2 + (c >> 5), rr = r & 15, cc = c & 31, ob = rr * 64 + cc * 2; return st * 1024 + (ob ^ (((ob >> 9) & 1) << 5)); }
__host__ __device__ __forceinline__ void stage_rc(int b, int& R, int& C) { const int st = b / 1024, sb = b % 1024, swz = sb ^ (((sb >> 9) & 1) << 5); R = (st >> 1) * 16 + swz / 64; C = (st & 1) * 32 + (swz % 64) / 2; }
__host__ __device__ __forceinline__ int perm32(int rho) { const int n = rho >> 4, i = rho & 15; return 8 * (i >> 2) + 4 * n + (i & 3); }

struct Unit { int pm, pn, half, hs; };
struct Gemm { const bf16_t* A; const bf16_t* Bt; int M, N, K; };

struct StaticOrder {
    int nM, nN, nwg, G, c, F, Rm;
    __host__ __device__ void init(int M, int N, int G_, int c_) { nM = M / BM; nN = N / BM; nwg = nM * nN; G = G_; c = c_;
        F = nwg / G; Rm = nwg - F * G; if (!(F > 0 && Rm > 0 && 2 * Rm <= G)) Rm = 0; }
    __host__ __device__ bool next(int i, Unit& u) const {
        long L; u.half = 0; u.hs = 0;
        if (Rm > 0 && i >= F) { if (i > F || c >= 2 * Rm) return false; L = (long)F * G + (c >> 1); u.half = 1; u.hs = c & 1; }
        else { L = (long)i * G + c; if (L >= nwg) return false; }
        int wgid = (int)L; { const int q = nwg / NXCD, r = nwg % NXCD, xcd = wgid % NXCD, off = wgid / NXCD; wgid = (xcd < r ? xcd * (q + 1) : r * (q + 1) + (xcd - r) * q) + off; }
        const int nig = WGM * nN, gid = wgid / nig, fm = gid * WGM, gsz = (nM - fm) < WGM ? (nM - fm) : WGM;
        u.pm = fm + ((wgid % nig) % gsz); u.pn = (wgid % nig) / gsz; return true;
    }
    __device__ __forceinline__ size_t boff(const Unit&) const { return 0; }
    const int* rowidx = nullptr;
};
struct MoeOrder : StaticOrder {
    const PG8_LAS int* tile_e; size_t estride;
    __device__ __forceinline__ size_t boff(const Unit& u) const { return (size_t)tile_e[u.pm] * estride; }
};

typedef int v8i_t __attribute__((ext_vector_type(8)));
typedef int v4i_t __attribute__((ext_vector_type(4)));
__device__ __forceinline__ v8i_t cat8(bf16x8 lo, bf16x8 hi) { const v4i_t a = __builtin_bit_cast(v4i_t, lo), b = __builtin_bit_cast(v4i_t, hi); return __builtin_shufflevector(a, b, 0, 1, 2, 3, 4, 5, 6, 7); }
__device__ __forceinline__ unsigned pk4_fp8(float a, float b, float c, float d) {
    a = fminf(fmaxf(a, -448.f), 448.f); b = fminf(fmaxf(b, -448.f), 448.f); c = fminf(fmaxf(c, -448.f), 448.f); d = fminf(fmaxf(d, -448.f), 448.f);
    int w = 0; w = __builtin_amdgcn_cvt_pk_fp8_f32(a, b, w, false); w = __builtin_amdgcn_cvt_pk_fp8_f32(c, d, w, true); return (unsigned)w; }
__device__ __forceinline__ unsigned cvt_pk_bf16(float lo, float hi) { unsigned r; asm volatile("v_cvt_pk_bf16_f32 %0, %1, %2" : "=v"(r) : "v"(lo), "v"(hi)); return r; }

struct EpiF32 {
    static constexpr bool PERM = false;
    float* C; int ldc;
    __device__ __forceinline__ void operator()(const f32x4 (&acc)[2][2][4][2], const Unit& u, int wr, int wc, int fr, int fq) const {
        const int row0 = u.pm * BM + (u.half ? u.hs * HALF : 0) + wr * 64 + fr, col0 = u.pn * BM + wc * 32 + 4 * fq;
#pragma unroll
        for (int ai = 0; ai < 2; ++ai) if (ai == 0 || !u.half)
#pragma unroll
            for (int m = 0; m < 4; ++m) { float* rowp = C + (size_t)(row0 + ai * HALF + m * 16) * ldc + col0;
#pragma unroll
                for (int bj = 0; bj < 2; ++bj)
#pragma unroll
                    for (int n = 0; n < 2; ++n) *(f32x4*)(rowp + bj * HALF + n * 16) = acc[ai][bj][m][n]; }
    }
};
struct EpiBf16 {
    static constexpr bool PERM = true;
    bf16_t* O; int ldc; const float* bias; const PG8_LAS int* tile_e; int bstride; float scale;
    __device__ __forceinline__ void operator()(const f32x4 (&acc)[2][2][4][2], const Unit& u, int wr, int wc, int fr, int fq) const {
        const int row0 = u.pm * BM + (u.half ? u.hs * HALF : 0) + wr * 64 + fr; const int col0 = u.pn * BM + wc * 32 + 8 * fq;
        f32x4 bv[2][2];
        const float* bp = bias ? bias + (size_t)tile_e[u.pm] * bstride + col0 : nullptr;
#pragma unroll
        for (int bj = 0; bj < 2; ++bj)
#pragma unroll
            for (int n = 0; n < 2; ++n) bv[bj][n] = bias ? *(const f32x4*)(bp + bj * HALF + 4 * n) : (f32x4){0.f, 0.f, 0.f, 0.f};
#pragma unroll
        for (int ai = 0; ai < 2; ++ai) if (ai == 0 || !u.half)
#pragma unroll
            for (int m = 0; m < 4; ++m) { bf16_t* rowp = O + (size_t)(row0 + ai * HALF + m * 16) * ldc + col0;
#pragma unroll
                for (int bj = 0; bj < 2; ++bj) { f32x4 v0 = acc[ai][bj][m][0] * scale + bv[bj][0], v1 = acc[ai][bj][m][1] * scale + bv[bj][1];
                    u32x4 w; w.x = cvt_pk_bf16(v0[0], v0[1]); w.y = cvt_pk_bf16(v0[2], v0[3]); w.z = cvt_pk_bf16(v1[0], v1[1]); w.w = cvt_pk_bf16(v1[2], v1[3]);
                    *(u32x4*)(rowp + bj * HALF) = w; } }
    }
};
struct EpiSwiGLU {
    static constexpr bool PERM = true;
    unsigned char* O; const float* b_up; const PG8_LAS int* tile_e; float scale;
    typedef float f32x2_t __attribute__((ext_vector_type(2)));
    __device__ __forceinline__ f32x2_t act2(float g0, float g1, float l0, float l1) const {
        const f32x2_t g = {fminf(g0, 7.0f), fminf(g1, 7.0f)};
        const f32x2_t l = {__builtin_amdgcn_fmed3f(l0, -6.0f, 8.0f), __builtin_amdgcn_fmed3f(l1, -6.0f, 8.0f)};
        const f32x2_t t = g * (-1.702f * 1.4426950408889634f);
        const f32x2_t d = (f32x2_t){__builtin_amdgcn_exp2f(t.x), __builtin_amdgcn_exp2f(t.y)} + 1.0f;
        const f32x2_t r = {__builtin_amdgcn_rcpf(d.x), __builtin_amdgcn_rcpf(d.y)};
        return g * r * l;
    }
    __device__ __forceinline__ unsigned act4(const f32x4 g, const f32x4 l) const {
        const f32x2_t a = act2(g[0], g[1], l[0], l[1]), b = act2(g[2], g[3], l[2], l[3]);
        int w = 0; w = __builtin_amdgcn_cvt_pk_fp8_f32(a.x, a.y, w, false); w = __builtin_amdgcn_cvt_pk_fp8_f32(b.x, b.y, w, true); return (unsigned)w;
    }
    __device__ __forceinline__ void operator()(const f32x4 (&acc)[2][2][4][2], const Unit& u, int wr, int wc, int fr, int fq) const {
        const int row0 = u.pm * BM + (u.half ? u.hs * HALF : 0) + wr * 64 + fr; const int cin = wc * 32 + 8 * fq;
        const float* bg = b_up + (size_t)tile_e[u.pm] * 2048 + 128 * u.pn + cin;
        f32x4 bgv[2], blv[2];
#pragma unroll
        for (int n = 0; n < 2; ++n) { bgv[n] = *(const f32x4*)(bg + 4 * n); blv[n] = *(const f32x4*)(bg + 1024 + 4 * n) + 1.0f; }
#pragma unroll
        for (int ai = 0; ai < 2; ++ai) if (ai == 0 || !u.half)
#pragma unroll
            for (int m = 0; m < 4; ++m) { unsigned char* rowp = O + (size_t)(row0 + ai * HALF + m * 16) * 1024 + 128 * u.pn + cin;
                const f32x4 g0 = acc[ai][0][m][0] * scale + bgv[0], g1 = acc[ai][0][m][1] * scale + bgv[1], l0 = acc[ai][1][m][0] * scale + blv[0], l1 = acc[ai][1][m][1] * scale + blv[1];
                const unsigned w0 = act4(g0, l0), w1 = act4(g1, l1);
                typedef unsigned u32x2_t __attribute__((ext_vector_type(2)));
                *(u32x2_t*)rowp = (u32x2_t){w0, w1}; }
    }
};

template <class Epi, class Sched, bool ALIGN_EPI = false, bool SP2 = false, bool F8 = false, bool GATHER = false>
__device__ __forceinline__ void gemm_phase(PG8_LAS unsigned char* lds, const Gemm g, const Sched& S, const Epi& E, const int tid) {
    static_assert(SP2, "half units are only wired into the SP2 schedule");
    const int wid = __builtin_amdgcn_readfirstlane(tid >> 6), lane = tid & 63, wr = wid >> 2, wc = wid & 3, fr = lane & 15, fq = lane >> 4;
    constexpr int ES = F8 ? 1 : 2;
    const int K = g.K, nt = K * ES / 128;
    unsigned voffA[2], voffB[2]; int gR[2], gC[2];
#pragma unroll
    for (int i = 0; i < 2; ++i) { int R, C; stage_rc(tid * 16 + i * 8192, R, C); const int Rb = Epi::PERM ? ((R & ~31) + perm32(R & 31)) : R; gR[i] = R; gC[i] = C * 2;
        voffA[i] = (unsigned)(R * K * ES + C * 2); voffB[i] = (unsigned)(Rb * K * ES + C * 2); }
    unsigned vAc0[2] = {0u, 0u}, vAc1[2] = {0u, 0u}, vAn0[2] = {0u, 0u}, vAn1[2] = {0u, 0u};
#define PG8_GIDX(dst0, dst1, u_) do { _Pragma("unroll") for (int _i = 0; _i < 2; ++_i) { \
        dst0[_i] = (unsigned)S.rowidx[(u_).pm * BM + gR[_i]] * (unsigned)(K * ES) + (unsigned)gC[_i]; dst1[_i] = (unsigned)S.rowidx[(u_).pm * BM + HALF + gR[_i]] * (unsigned)(K * ES) + (unsigned)gC[_i]; } } while (0)
    const size_t kstep = (size_t)(BK * 2);
    const size_t hstep = (size_t)HALF * K * ES;
    const size_t tstep = 2 * hstep;
    const unsigned ldsw = (unsigned)wid * 1024u;
    const int aoff = lds_byte(wr * 64 + fr, fq * 8), boff = lds_byte(wc * 32 + fr, fq * 8);
#define PG8_SA(b, h) (((b) * 2 + (h)) * HTB)
#define PG8_SB(b, h) ((4 + (b) * 2 + (h)) * HTB)
#define PG8_STAGE(bufoff, gbase, voff) do { _Pragma("unroll") for (int _i = 0; _i < 2; ++_i) \
        __builtin_amdgcn_global_load_lds((const unsigned*)((const char*)(gbase) + (voff)[_i]), (PG8_LAS unsigned*)(lds + (bufoff) + ldsw + _i * 8192), 16, 0, 0); } while (0)
#define PG8_STAGE_A(bufoff, ptr_, half_, koff_, nxt_) do { if constexpr (GATHER) { _Pragma("unroll") for (int _i = 0; _i < 2; ++_i) { \
            const unsigned vo_ = (half_) ? ((nxt_) ? vAn1[_i] : vAc1[_i]) : ((nxt_) ? vAn0[_i] : vAc0[_i]); \
            __builtin_amdgcn_global_load_lds((const unsigned*)((const char*)g.A + (koff_) + vo_), (PG8_LAS unsigned*)(lds + (bufoff) + ldsw + _i * 8192), 16, 0, 0); } } \
        else PG8_STAGE(bufoff, ptr_, voffA); } while (0)
#define PG8_LDA(dst, b, h) do { _Pragma("unroll") for (int m = 0; m < 4; ++m) _Pragma("unroll") for (int k = 0; k < 2; ++k) dst[m][k] = *(const PG8_LAS bf16x8*)(lds + PG8_SA(b, h) + aoff + m * 2048 + k * 1024); } while (0)
#define PG8_LDB(dst, b, h) do { _Pragma("unroll") for (int n = 0; n < 2; ++n) _Pragma("unroll") for (int k = 0; k < 2; ++k) dst[n][k] = *(const PG8_LAS bf16x8*)(lds + PG8_SB(b, h) + boff + n * 2048 + k * 1024); } while (0)
#define PG8_MMA(ai, bj, At, Bt) do { __builtin_amdgcn_s_setprio(1); _Pragma("unroll") for (int m = 0; m < 4; ++m) _Pragma("unroll") for (int n = 0; n < 2; ++n) { \
        if constexpr (F8) { asm volatile("v_mfma_scale_f32_16x16x128_f8f6f4 %0, %1, %2, %0, %3, %3 op_sel_hi:[0,0,0]" : "+v"(acc[ai][bj][m][n]) : "v"(cat8(Bt[n][0], Bt[n][1])), "v"(cat8(At[m][0], At[m][1])), "v"(0x7f7f7f7f)); } \
        else { _Pragma("unroll") for (int k = 0; k < 2; ++k) acc[ai][bj][m][n] = __builtin_amdgcn_mfma_f32_16x16x32_bf16(Bt[n][k], At[m][k], acc[ai][bj][m][n], 0, 0, 0); } } \
        __builtin_amdgcn_s_setprio(0); } while (0)
#define PG8_WAIT_V(n) asm volatile("s_waitcnt vmcnt(" #n ")" ::: "memory")
#define PG8_WAIT_L(n) asm volatile("s_waitcnt lgkmcnt(" #n ")" ::: "memory")
#define PG8_WAIT_VH do { if (hf) PG8_WAIT_V(6); else PG8_WAIT_V(8); } while (0)
#define PG8_BAR __builtin_amdgcn_s_barrier()
#define PG8_SCHED __builtin_amdgcn_sched_barrier(0)
    Unit cur, nxt; int ui = 0;
    if (!S.next(0, cur)) return;
    f32x4 acc[2][2][4][2];
#pragma unroll
    for (int a = 0; a < 2; ++a)
#pragma unroll
        for (int b = 0; b < 2; ++b)
#pragma unroll
            for (int m = 0; m < 4; ++m)
#pragma unroll
                for (int n = 0; n < 2; ++n) acc[a][b][m][n] = (f32x4){0.f, 0.f, 0.f, 0.f};
    bf16x8 At[4][2], B0[2][2], B1[2][2];
    const char* cA = (const char*)g.A + (size_t)cur.pm * tstep + (cur.half ? cur.hs * hstep : 0); const char* cB = (const char*)g.Bt + S.boff(cur) + (size_t)cur.pn * tstep;
    if constexpr (GATHER) { PG8_GIDX(vAc0, vAc1, cur); }
    if constexpr (SP2) {
        PG8_STAGE(PG8_SB(0, 0), cB, voffB); PG8_STAGE(PG8_SB(0, 1), cB + hstep, voffB); PG8_STAGE_A(PG8_SA(0, 0), cA, 0, 0, false); PG8_STAGE_A(PG8_SA(0, 1), cA + hstep, 1, 0, false);
        if (wr == 1) PG8_BAR;
        PG8_WAIT_V(2); PG8_BAR;
        PG8_STAGE(PG8_SB(1, 0), cB + kstep, voffB); PG8_STAGE_A(PG8_SA(1, 0), cA + kstep, 0, kstep, false); PG8_STAGE(PG8_SB(1, 1), cB + hstep + kstep, voffB);
        PG8_WAIT_V(6); PG8_BAR;
    } else {
        PG8_STAGE(PG8_SB(0, 0), cB, voffB); PG8_STAGE(PG8_SA(0, 0), cA, voffA); PG8_STAGE(PG8_SB(0, 1), cB + hstep, voffB); PG8_STAGE(PG8_SA(0, 1), cA + hstep, voffA);
        if (wr == 1) PG8_BAR;
        PG8_WAIT_V(4); PG8_BAR;
        PG8_STAGE(PG8_SB(1, 0), cB + kstep, voffB); PG8_STAGE(PG8_SA(1, 0), cA + kstep, voffA); PG8_STAGE(PG8_SB(1, 1), cB + hstep + kstep, voffB);
        PG8_WAIT_V(6); PG8_BAR;
    }
    for (;;) {
        const bool has_next = S.next(ui + 1, nxt);
        const char* nA = has_next ? (const char*)g.A + (size_t)nxt.pm * tstep + (nxt.half ? nxt.hs * hstep : 0) : cA;
        const bool hf = cur.half != 0;
        const size_t nhs = (has_next && nxt.half) ? 0 : hstep;
        const char* nB = has_next ? (const char*)g.Bt + S.boff(nxt) + (size_t)nxt.pn * tstep : cB;
        if constexpr (GATHER) {
            if (has_next) { if (wid == 0) __builtin_amdgcn_global_load_lds((const unsigned*)(S.rowidx + (size_t)nxt.pm * BM + lane * 4), (PG8_LAS unsigned*)(lds + 131072 + ((ui + 1) & 1) * 1024), 16, 0, 0); }
            else { vAn0[0] = vAc0[0]; vAn0[1] = vAc0[1]; vAn1[0] = vAc1[0]; vAn1[1] = vAc1[1]; } }
        for (int t = 0; t < nt; t += 2) {
            const bool last = (t == nt - 2);
            const char* a1 = cA + (size_t)(t + 1) * kstep;
            const char* a2 = last ? nA : cA + (size_t)(t + 2) * kstep; const char* b2 = last ? nB : cB + (size_t)(t + 2) * kstep;
            const char* a3 = a2 + kstep; const char* b3 = b2 + kstep;
            const size_t ko1 = (size_t)(t + 1) * kstep, ko2 = last ? 0 : (size_t)(t + 2) * kstep, ko3 = ko2 + kstep;
            if constexpr (GATHER) { if (last && has_next) { const PG8_LAS int* ix_ = (const PG8_LAS int*)(lds + 131072 + ((ui + 1) & 1) * 1024);
#pragma unroll
                for (int _i = 0; _i < 2; ++_i) { const int o0_ = nxt.half ? nxt.hs * HALF : 0, o1_ = nxt.half ? nxt.hs * HALF : HALF;
                    vAn0[_i] = (unsigned)ix_[o0_ + gR[_i]] * (unsigned)(K * ES) + (unsigned)gC[_i]; vAn1[_i] = (unsigned)ix_[o1_ + gR[_i]] * (unsigned)(K * ES) + (unsigned)gC[_i]; } } }
            if constexpr (SP2) {
            const size_t h2s = last ? nhs : hstep;
            PG8_LDB(B0, 0, 0); PG8_LDB(B1, 0, 1); PG8_SCHED; PG8_LDA(At, 0, 0); if (!hf) PG8_STAGE_A(PG8_SA(1, 1), a1 + hstep, 1, ko1, false);
            PG8_WAIT_VH; PG8_WAIT_L(0); PG8_BAR; PG8_MMA(0, 0, At, B0); PG8_MMA(0, 1, At, B1); PG8_BAR; PG8_SCHED;
            if (!hf) PG8_LDA(At, 0, 1); PG8_STAGE(PG8_SB(0, 0), b2, voffB); PG8_STAGE(PG8_SB(0, 1), b2 + hstep, voffB); PG8_STAGE_A(PG8_SA(0, 0), a2, 0, ko2, last);
            PG8_WAIT_VH; PG8_WAIT_L(0); PG8_BAR; if (!hf) { PG8_MMA(1, 0, At, B0); PG8_MMA(1, 1, At, B1); } PG8_BAR; PG8_SCHED;
            PG8_LDB(B0, 1, 0); PG8_LDB(B1, 1, 1); PG8_SCHED; PG8_LDA(At, 1, 0); if (!hf) PG8_STAGE_A(PG8_SA(0, 1), a2 + h2s, 1, ko2, last);
            PG8_WAIT_VH; PG8_WAIT_L(0); PG8_BAR; PG8_MMA(0, 0, At, B0); PG8_MMA(0, 1, At, B1); PG8_BAR; PG8_SCHED;
            if (!hf) PG8_LDA(At, 1, 1); PG8_STAGE(PG8_SB(1, 0), b3, voffB); PG8_STAGE(PG8_SB(1, 1), b3 + hstep, voffB); PG8_STAGE_A(PG8_SA(1, 0), a3, 0, ko3, last);
            PG8_WAIT_VH; PG8_WAIT_L(0); PG8_BAR; if (!hf) { PG8_MMA(1, 0, At, B0); PG8_MMA(1, 1, At, B1); } PG8_BAR; PG8_SCHED;
            } else {
            PG8_LDB(B0, 0, 0); PG8_SCHED; PG8_LDA(At, 0, 0); PG8_STAGE(PG8_SA(1, 1), a1 + hstep, voffA);
            PG8_WAIT_L(8); PG8_BAR; PG8_WAIT_L(0); PG8_MMA(0, 0, At, B0); PG8_BAR; PG8_SCHED;
            PG8_LDB(B1, 0, 1); PG8_STAGE(PG8_SB(0, 0), b2, voffB);
            PG8_BAR; PG8_WAIT_L(0); PG8_MMA(0, 1, At, B1); PG8_BAR;
            PG8_LDA(At, 0, 1); PG8_STAGE(PG8_SA(0, 0), a2, voffA);
            PG8_BAR; PG8_WAIT_L(0); PG8_MMA(1, 0, At, B0); PG8_BAR; PG8_SCHED;
            PG8_STAGE(PG8_SB(0, 1), b2 + hstep, voffB);
            PG8_WAIT_V(6); PG8_BAR; PG8_MMA(1, 1, At, B1); PG8_BAR;
            PG8_LDB(B0, 1, 0); PG8_SCHED; PG8_LDA(At, 1, 0); PG8_STAGE(PG8_SA(0, 1), a2 + hstep, voffA);
            PG8_WAIT_L(8); PG8_BAR; PG8_WAIT_L(0); PG8_MMA(0, 0, At, B0); PG8_BAR; PG8_SCHED;
            PG8_LDB(B1, 1, 1); PG8_STAGE(PG8_SB(1, 0), b3, voffB);
            PG8_BAR; PG8_WAIT_L(0); PG8_MMA(0, 1, At, B1); PG8_BAR;
            PG8_LDA(At, 1, 1); PG8_STAGE(PG8_SA(1, 0), a3, voffA);
            PG8_BAR; PG8_WAIT_L(0); PG8_MMA(1, 0, At, B0); PG8_BAR; PG8_SCHED;
            PG8_STAGE(PG8_SB(1, 1), b3 + hstep, voffB);
            PG8_WAIT_V(6); PG8_BAR; PG8_MMA(1, 1, At, B1); PG8_BAR;
            }
        }
        if constexpr (ALIGN_EPI) { if (wr == 0) PG8_BAR; }
        E(acc, cur, wr, wc, fr, fq);
        if (!has_next) break;
#pragma unroll
        for (int a = 0; a < 2; ++a)
#pragma unroll
            for (int b = 0; b < 2; ++b)
#pragma unroll
                for (int m = 0; m < 4; ++m)
#pragma unroll
                    for (int n = 0; n < 2; ++n) acc[a][b][m][n] = (f32x4){0.f, 0.f, 0.f, 0.f};
        cur = nxt; cA = nA; cB = nB; ++ui;
        if constexpr (GATHER) { vAc0[0] = vAn0[0]; vAc0[1] = vAn0[1]; vAc1[0] = vAn1[0]; vAc1[1] = vAn1[1]; }
        if constexpr (ALIGN_EPI) { if (wr == 1) PG8_BAR; }
    }
    PG8_WAIT_V(0);
    if constexpr (!ALIGN_EPI) { if (wr == 0) PG8_BAR; }
    PG8_BAR;
#undef PG8_SA
#undef PG8_SB
#undef PG8_STAGE
#undef PG8_LDA
#undef PG8_STAGE_A
#undef PG8_GIDX
#undef PG8_LDB
#undef PG8_MMA
#undef PG8_WAIT_V
#undef PG8_WAIT_VH
#undef PG8_WAIT_L
#undef PG8_BAR
#undef PG8_SCHED
}
}

constexpr int NWAVES = 8, NTHR = 512;
constexpr int BATCH = 2, T = 8192, D = 1024, NTOK = BATCH * T;
constexpr int IN_COLS = 3592, PCOLS = 3584;
constexpr int NE = 32, NASSIGN = NTOK * 4, MAXTILES = NASSIGN / 256 + NE;
constexpr float EPS = 1e-6f;

constexpr size_t MiB = 1u << 20;
constexpr size_t WS_CTL = 0, CTL_ZERO_BYTES = 1 * MiB;
constexpr size_t WS_MOD = 1 * MiB;
constexpr size_t WS_G = WS_MOD + 64 * 1024;
constexpr size_t WS_BETA = WS_G + 256 * 1024;
constexpr size_t WS_GL = WS_BETA + 256 * 1024;
constexpr size_t WS_AE = WS_GL + 64 * 1024;
constexpr size_t WS_AP = WS_AE + 256 * 1024;
constexpr size_t WS_AG = WS_AP + 256 * 1024;
constexpr size_t WS_AS = WS_AG + 256 * 1024;
constexpr size_t WS_WG = WS_AS + 256 * 1024;
constexpr size_t WS_STOK = WS_WG + 64 * 1024;
constexpr size_t WS_WR = 4 * MiB;
constexpr size_t WS_WIN = 8 * MiB;
constexpr size_t WS_WOUT = 16 * MiB;
constexpr size_t WS_WUP = 20 * MiB;
constexpr size_t WS_WDN = 148 * MiB;
constexpr size_t WS_H = 212 * MiB;
constexpr size_t WS_PROJ = 244 * MiB;
constexpr size_t WS_U = 356 * MiB;
constexpr size_t WS_OPS = 388 * MiB;
constexpr int OPS_BYTES = 57344;
constexpr size_t WS_QF = 444 * MiB, WS_KF = 460 * MiB, WS_VTF = 476 * MiB;
constexpr size_t WS_OSCAN = 500 * MiB;
constexpr size_t WS_OMIX = 532 * MiB;
constexpr size_t WS_Y = 564 * MiB;
constexpr size_t WS_XG = 244 * MiB;
constexpr size_t WS_ACT = 388 * MiB;
constexpr size_t WS_ZS = 628 * MiB;
constexpr size_t WS_SEG = 644 * MiB;
constexpr size_t WS_SST = 652 * MiB;
constexpr size_t WS_SEGP = 656 * MiB;
constexpr size_t WS_END = 660 * MiB;
constexpr int CW_CNT = 64;
constexpr int CW_SEGA = 1024, CW_SEGB = 2048;
constexpr int CW_BAR = 4096;
constexpr int CW_HIST = 16384;

constexpr int LDS_BYTES = 163840, MISC_OFF = 161792;

#define GAS __attribute__((address_space(1)))
#define LAS __attribute__((address_space(3)))
typedef unsigned short bf16;
typedef unsigned v4u __attribute__((ext_vector_type(4)));
typedef unsigned v2u __attribute__((ext_vector_type(2)));
typedef float f32x4 __attribute__((ext_vector_type(4)));
typedef LAS float ldsf;
#define RLX_AGENT __ATOMIC_RELAXED, __HIP_MEMORY_SCOPE_AGENT
__device__ __forceinline__ unsigned f2bf(float f) { unsigned u = __builtin_bit_cast(unsigned, f); return (u + 0x7fffu + ((u >> 16) & 1u)) >> 16; }
__device__ __forceinline__ unsigned pk2(float lo, float hi) { return f2bf(lo) | (f2bf(hi) << 16); }
__device__ __forceinline__ float bf2f(unsigned h) { return __builtin_bit_cast(float, h << 16); }
__device__ __forceinline__ float bflo(unsigned w) { return __builtin_bit_cast(float, w << 16); }
__device__ __forceinline__ float bfhi(unsigned w) { return __builtin_bit_cast(float, w & 0xffff0000u); }
template <int CTRL, int ROWMASK> __device__ __forceinline__ float dppf(float v) {
    return __builtin_bit_cast(float, __builtin_amdgcn_update_dpp(0, __builtin_bit_cast(int, v), CTRL, ROWMASK, 0xF, false)); }
__device__ __forceinline__ float wave_sum(float v) {
    v += dppf<0x111, 0xF>(v); v += dppf<0x112, 0xF>(v); v += dppf<0x114, 0xF>(v); v += dppf<0x118, 0xF>(v);
    v += dppf<0x142, 0xA>(v); v += dppf<0x143, 0xC>(v);
    return __builtin_bit_cast(float, __builtin_amdgcn_readlane(__builtin_bit_cast(int, v), 63));
}
__device__ __forceinline__ float xchg32(float send, int lane) { const unsigned u = __builtin_bit_cast(unsigned, send); const auto r_ = __builtin_amdgcn_permlane32_swap(u, u, false, false); return __builtin_bit_cast(float, lane < 32 ? r_[1] : r_[0]); }
__device__ __forceinline__ float xchg16(float send, int lane) { const unsigned u = __builtin_bit_cast(unsigned, send); const auto r_ = __builtin_amdgcn_permlane16_swap(u, u, false, false); return __builtin_bit_cast(float, (lane & 16) ? r_[0] : r_[1]); }
template <int CTRL> __device__ __forceinline__ float dppx(float v) { return __builtin_bit_cast(float, __builtin_amdgcn_update_dpp(0, __builtin_bit_cast(int, v), CTRL, 0xF, 0xF, false)); }
template <int CTRL, int ROWMASK> __device__ __forceinline__ float dppf_o(float v, float old) { return __builtin_bit_cast(float, __builtin_amdgcn_update_dpp(__builtin_bit_cast(int, old), __builtin_bit_cast(int, v), CTRL, ROWMASK, 0xF, false)); }
template <int CTRL, int ROWMASK> __device__ __forceinline__ int dppi_o(int v, int old) { return __builtin_amdgcn_update_dpp(old, v, CTRL, ROWMASK, 0xF, false); }
__device__ __forceinline__ float wave_max(float v) {
    const float ni = -3.4e38f;
    v = fmaxf(v, dppf_o<0x111, 0xF>(v, ni)); v = fmaxf(v, dppf_o<0x112, 0xF>(v, ni)); v = fmaxf(v, dppf_o<0x114, 0xF>(v, ni)); v = fmaxf(v, dppf_o<0x118, 0xF>(v, ni));
    v = fmaxf(v, dppf_o<0x142, 0xA>(v, ni)); v = fmaxf(v, dppf_o<0x143, 0xC>(v, ni));
    return __builtin_bit_cast(float, __builtin_amdgcn_readlane(__builtin_bit_cast(int, v), 63));
}
__device__ __forceinline__ int wave_min_i(int v) {
    const int mi = 0x7fffffff;
    v = min(v, dppi_o<0x111, 0xF>(v, mi)); v = min(v, dppi_o<0x112, 0xF>(v, mi)); v = min(v, dppi_o<0x114, 0xF>(v, mi)); v = min(v, dppi_o<0x118, 0xF>(v, mi));
    v = min(v, dppi_o<0x142, 0xA>(v, mi)); v = min(v, dppi_o<0x143, 0xC>(v, mi));
    return __builtin_amdgcn_readlane(v, 63);
}
__device__ __forceinline__ float siluf(float x) { return x * __builtin_amdgcn_rcpf(1.0f + __builtin_amdgcn_exp2f(-1.4426950408889634f * x)); }
typedef float f32x16 __attribute__((ext_vector_type(16)));
typedef short bf16x8 __attribute__((ext_vector_type(8)));
typedef float f32x2_t __attribute__((ext_vector_type(2)));
typedef __bf16 bf16x2_t __attribute__((ext_vector_type(2)));
__device__ __forceinline__ unsigned cvtpk(float lo, float hi) { f32x2_t v = {lo, hi}; bf16x2_t b = __builtin_convertvector(v, bf16x2_t); return __builtin_bit_cast(unsigned, b); }
__device__ __forceinline__ bf16x8 pack8(const f32x16& x, int s) {
    v4u p; p.x = cvtpk(x[8 * s], x[8 * s + 1]); p.y = cvtpk(x[8 * s + 2], x[8 * s + 3]); p.z = cvtpk(x[8 * s + 4], x[8 * s + 5]); p.w = cvtpk(x[8 * s + 6], x[8 * s + 7]);
    return __builtin_bit_cast(bf16x8, p);
}
__device__ __forceinline__ int crow(int q, int h) { return (q & 3) + 8 * (q >> 2) + 4 * h; }
#define MFMA32(a, b, c) __builtin_amdgcn_mfma_f32_32x32x16_bf16((a), (b), (c), 0, 0, 0)

#define XB_TMO      128
#define XB_XCNT(j)  (256  + 64 * (j))
#define XB_XSUB(j)  (1280 + 64 * (j))
#define XB_XGEN(j)  (2304 + 64 * (j))
#define XB_TOP      3328
#define XB_TOPGEN   3392
#define XCD_BAR_WORDS 3456
#define XB_SPIN_CAP (1u << 22)
__device__ __forceinline__ unsigned xb_ld(unsigned* p)              { return __hip_atomic_load(p, __ATOMIC_RELAXED, __HIP_MEMORY_SCOPE_AGENT); }
__device__ __forceinline__ unsigned xb_add(unsigned* p, unsigned v) { return __hip_atomic_fetch_add(p, v, __ATOMIC_RELAXED, __HIP_MEMORY_SCOPE_AGENT); }
__device__ __forceinline__ unsigned xb_xcc_id() { return (unsigned)__builtin_amdgcn_s_getreg((3 << 11) | 20) & 0xFu; }
#define XB_SPIN(cond, bar) do { unsigned _sp = 0; while (cond) { __builtin_amdgcn_s_sleep(1); \
    if ((++_sp & 255u) == 0u) { if (xb_ld(&(bar)[XB_TMO])) break; if (_sp > XB_SPIN_CAP) { atomicAdd(&(bar)[XB_TMO], 1u); break; } } } } while (0)
struct XcdBarrier { unsigned* bar; unsigned x; volatile LAS unsigned* st; };
__device__ __forceinline__ XcdBarrier xcd_barrier_post(unsigned* bar, volatile LAS unsigned* st) {
    XcdBarrier b; b.bar = bar; b.x = xb_xcc_id(); b.st = st;
    if (threadIdx.x == 0) (void)xb_add(&bar[XB_XCNT(b.x)], 1u);
    return b;
}
__device__ __forceinline__ void xcd_barrier_complete(unsigned* bar, unsigned x, unsigned& nloc, unsigned& nx) {
    const unsigned G = gridDim.x * gridDim.y * gridDim.z;
    unsigned sum, cnt, mine, sp = 0u;
    for (;;) {
        sum = 0u; cnt = 0u; mine = 0u;
#pragma unroll
        for (unsigned j = 0; j < 16; ++j) { const unsigned c = xb_ld(&bar[XB_XCNT(j)]); sum += c; cnt += (c > 0u) ? 1u : 0u; mine = (j == x) ? c : mine; }
        if (sum == G) break;
        __builtin_amdgcn_s_sleep(1);
        if ((++sp & 255u) == 0u) { if (xb_ld(&bar[XB_TMO])) break; if (sp > XB_SPIN_CAP) { atomicAdd(&bar[XB_TMO], 1u); break; } }
    }
    nloc = mine > 0u ? mine : 1u; nx = cnt > 0u ? cnt : 1u;
}
__device__ __forceinline__ void xcd_barrier(const XcdBarrier& b, const int tid) {
    asm volatile("s_waitcnt vmcnt(0)" ::: "memory");
    __syncthreads();
    if (tid == 0) {
        unsigned* bar = b.bar;
        __builtin_amdgcn_s_waitcnt(0);
        unsigned nloc = b.st[0], nx = b.st[1];
        if (nloc == 0u) { xcd_barrier_complete(bar, b.x, nloc, nx); b.st[0] = nloc; b.st[1] = nx; }
        const unsigned old = xb_add(&bar[XB_XSUB(b.x)], 1u);
        const unsigned gen = old / nloc;
        if (old + 1u == (gen + 1u) * nloc) {
            __builtin_amdgcn_fence(__ATOMIC_RELEASE, "agent");
            asm volatile("s_waitcnt vmcnt(0)" ::: "memory");
            const unsigned og = xb_add(&bar[XB_TOP], 1u);
            const unsigned tg = og / nx;
            if (og + 1u == (tg + 1u) * nx) xb_add(&bar[XB_TOPGEN], 1u);
            else XB_SPIN(xb_ld(&bar[XB_TOPGEN]) == tg, bar);
            __builtin_amdgcn_fence(__ATOMIC_ACQUIRE, "agent");
            xb_add(&bar[XB_XGEN(b.x)], 1u);
            asm volatile("s_waitcnt vmcnt(0)" ::: "memory");
        } else {
            XB_SPIN(xb_ld(&bar[XB_XGEN(b.x)]) == gen, bar);
            __builtin_amdgcn_fence(__ATOMIC_ACQUIRE, "agent");
            asm volatile("s_waitcnt vmcnt(0)" ::: "memory");
        }
    }
    __syncthreads();
}

struct Args {
    const float* in[18]; float* out; unsigned char* ws; int ph_lo, ph_hi, li, pad;
};
enum { I_X = 0, I_C, I_WADA, I_BADA, I_NORMW, I_WIN, I_CONVW, I_ALOG, I_DTB, I_ANW, I_RELB, I_WOUT, I_WR, I_BR, I_WUP, I_BUP, I_WDN, I_BDN };

__device__ __forceinline__ int map_row(int mode, int n) {
    if (mode == 0) return n < 2048 ? n : (n < 2056 ? -1 : n - 8);
    if (mode == 2) { const int j = n & 1023, half = n >> 10; return (j >> 7) * 256 + half * 128 + (j & 127); }
    return n;
}
__device__ __forceinline__ void transpose_item(const float* W, int K, int N, bf16* WT, int mode, ldsf* scr, int item, int lane) {
    const int nblk = (N + 31) / 32, kb = item / nblk, nb = item % nblk, k0 = 64 * kb, n0 = 32 * nb;
    const int nn = n0 + (lane & 31);
#pragma unroll 8
    for (int i = 0; i < 32; ++i) { const int kk = 2 * i + (lane >> 5); scr[kk * 33 + (lane & 31)] = (nn < N) ? W[(size_t)(k0 + kk) * N + nn] : 0.f; }
    asm volatile("s_waitcnt lgkmcnt(0)" ::: "memory");
    const int c = lane & 7;
#pragma unroll
    for (int j = 0; j < 4; ++j) { const int nl = (lane >> 3) + 8 * j; const int n = n0 + nl; const ldsf* s = scr + (8 * c) * 33 + nl;
        const int row = (n < N) ? map_row(mode, n) : -1;
        v4u o; o.x = pk2(s[0 * 33], s[1 * 33]); o.y = pk2(s[2 * 33], s[3 * 33]); o.z = pk2(s[4 * 33], s[5 * 33]); o.w = pk2(s[6 * 33], s[7 * 33]);
        if (row >= 0) *(v4u*)(WT + (size_t)row * K + k0 + 8 * c) = o; }
    asm volatile("s_waitcnt lgkmcnt(0)" ::: "memory");
}
__device__ __forceinline__ void transpose_item8(const float* W, int K, int N, unsigned char* WT, int mode, ldsf* scr, int item, int lane) {
    const int nblk = N / 32, kb = item / nblk, nb = item % nblk, k0 = 64 * kb, n0 = 32 * nb;
#pragma unroll 8
    for (int i = 0; i < 32; ++i) { const int kk = 2 * i + (lane >> 5); scr[kk * 33 + (lane & 31)] = __builtin_nontemporal_load(W + (size_t)(k0 + kk) * N + n0 + (lane & 31)); }
    asm volatile("s_waitcnt lgkmcnt(0)" ::: "memory");
    const int nl = lane >> 1, kh = lane & 1; const ldsf* sp = scr + (32 * kh) * 33 + nl;
    const int row = map_row(mode, n0 + nl);
    v4u o0, o1;
    o0.x = pg8::pk4_fp8(sp[0 * 33] * 32.f, sp[1 * 33] * 32.f, sp[2 * 33] * 32.f, sp[3 * 33] * 32.f);     o0.y = pg8::pk4_fp8(sp[4 * 33] * 32.f, sp[5 * 33] * 32.f, sp[6 * 33] * 32.f, sp[7 * 33] * 32.f);
    o0.z = pg8::pk4_fp8(sp[8 * 33] * 32.f, sp[9 * 33] * 32.f, sp[10 * 33] * 32.f, sp[11 * 33] * 32.f);   o0.w = pg8::pk4_fp8(sp[12 * 33] * 32.f, sp[13 * 33] * 32.f, sp[14 * 33] * 32.f, sp[15 * 33] * 32.f);
    o1.x = pg8::pk4_fp8(sp[16 * 33] * 32.f, sp[17 * 33] * 32.f, sp[18 * 33] * 32.f, sp[19 * 33] * 32.f); o1.y = pg8::pk4_fp8(sp[20 * 33] * 32.f, sp[21 * 33] * 32.f, sp[22 * 33] * 32.f, sp[23 * 33] * 32.f);
    o1.z = pg8::pk4_fp8(sp[24 * 33] * 32.f, sp[25 * 33] * 32.f, sp[26 * 33] * 32.f, sp[27 * 33] * 32.f); o1.w = pg8::pk4_fp8(sp[28 * 33] * 32.f, sp[29 * 33] * 32.f, sp[30 * 33] * 32.f, sp[31 * 33] * 32.f);
    unsigned char* dst = WT + (size_t)row * K + k0 + 32 * kh;
    __builtin_nontemporal_store(o0, (v4u*)dst); __builtin_nontemporal_store(o1, (v4u*)(dst + 16));
    asm volatile("s_waitcnt lgkmcnt(0)" ::: "memory");
}
__device__ __forceinline__ void mod_item(const float* c, const float* w_ada, const float* b_ada, float* mod, int item, ldsf* red, int tid, int lane, int wave) {
    const int j0 = item * 24;
    float a0[24], a1[24];
#pragma unroll
    for (int k = 0; k < 24; ++k) { a0[k] = 0.f; a1[k] = 0.f; }
#pragma unroll
    for (int rr = 0; rr < 2; ++rr) {
        const int d = tid + rr * 512;
        const float s0 = siluf(c[d]), s1 = siluf(c[1024 + d]);
        const f32x4* wp = (const f32x4*)(w_ada + (size_t)d * 6144 + j0);
#pragma unroll
        for (int q = 0; q < 6; ++q) { const f32x4 w = wp[q];
#pragma unroll
            for (int e = 0; e < 4; ++e) { a0[4 * q + e] += s0 * w[e]; a1[4 * q + e] += s1 * w[e]; } }
    }
#pragma unroll
    for (int k = 0; k < 24; ++k) { a0[k] = wave_sum(a0[k]); a1[k] = wave_sum(a1[k]); }
    if (lane == 0) {
#pragma unroll
        for (int k = 0; k < 24; ++k) { red[wave * 48 + k] = a0[k]; red[wave * 48 + 24 + k] = a1[k]; }
    }
    __syncthreads();
    if (tid < 48) { float s = 0.f;
#pragma unroll
        for (int w = 0; w < 8; ++w) s += red[w * 48 + tid];
        const int b = tid / 24, k = tid % 24; mod[b * 6144 + j0 + k] = s + b_ada[j0 + k]; }
    __syncthreads();
}

#define SB() __builtin_amdgcn_sched_barrier(0)
#define GI_W(mt, t2, s2) ((((mt) * 4 + (t2)) * 2) + (s2))
#define GI_Q(mt, t2, s2) (16 + (((mt) * 4 + (t2)) * 2) + (s2))
#define GI_K(t2, mt, s2) (32 + (((t2) * 2 + (mt)) * 2) + (s2))
#define GI_A(mt, mp, s2) (48 + (((mt) * 2 + (mp)) * 2) + (s2))
#define FRAG(f_) (*(const LAS bf16x8*)(Bf + (f_) * 1024))
#define LD_WQ(dst, t2, s2) do { dst[0] = FRAG(GI_W(0, t2, s2)); dst[1] = FRAG(GI_Q(0, t2, s2)); dst[2] = FRAG(GI_W(1, t2, s2)); dst[3] = FRAG(GI_Q(1, t2, s2)); } while (0)
#define MM_WQ(src, t2, s2) do { const bf16x8 sb_ = pack8(S[t2], s2); VN[0] = MFMA32(src[0], sb_, VN[0]); O[0] = MFMA32(src[1], sb_, O[0]); VN[1] = MFMA32(src[2], sb_, VN[1]); O[1] = MFMA32(src[3], sb_, O[1]); } while (0)
#define LD_AT(dst, s2) do { dst[0] = FRAG(GI_A(0, 0, s2)); dst[1] = FRAG(GI_A(1, 0, s2)); dst[2] = FRAG(GI_A(1, 1, s2)); } while (0)
#define MM_AT(src, s2) do { O[0] = MFMA32(src[0], vb[0][s2], O[0]); O[1] = MFMA32(src[1], vb[0][s2], O[1]); O[1] = MFMA32(src[2], vb[1][s2], O[1]); } while (0)
#define LD_K(dst, t2) do { dst[0] = FRAG(GI_K(t2, 0, 0)); dst[1] = FRAG(GI_K(t2, 0, 1)); dst[2] = FRAG(GI_K(t2, 1, 0)); dst[3] = FRAG(GI_K(t2, 1, 1)); } while (0)
#define MM_K(src, t2) do { S[t2] = MFMA32(src[0], vb[0][0], S[t2]); S[t2] = MFMA32(src[1], vb[0][1], S[t2]); S[t2] = MFMA32(src[2], vb[1][0], S[t2]); S[t2] = MFMA32(src[3], vb[1][1], S[t2]); } while (0)
#define SCALE_S(t2) do { _Pragma("unroll") for (int q_ = 0; q_ < 16; ++q_) S[t2][q_] *= egl; } while (0)
__device__ __forceinline__ void scan_step(const int n, f32x16 (&S)[4], v4u (&UC)[4], v4u (&UN)[4], const float egl, float& egl_next,
                                          LAS unsigned char* lds, const float* Uf, const float* glp, const int wave, const int lane, const int stg_off, const int stg_row) {
    const int r = lane & 31, h = lane >> 5;
    asm volatile("s_waitcnt lgkmcnt(0)" ::: "memory"); __builtin_amdgcn_s_barrier(); asm volatile("" ::: "memory");
    if (n + 1 < 128) {
        const v4u* up = (const v4u*)((const unsigned char*)Uf + (size_t)(n + 1) * 16384) + (wave * 4) * 64 + lane;
#pragma unroll
        for (int f = 0; f < 4; ++f) UN[f] = up[f * 64];
        egl_next = glp[n + 1];
    }
    SB();
    f32x16 VN[2];
#pragma unroll
    for (int mt = 0; mt < 2; ++mt)
#pragma unroll
        for (int q8 = 0; q8 < 2; ++q8) { const v4u u = UC[mt * 2 + q8];
            VN[mt][8 * q8 + 0] = bflo(u.x); VN[mt][8 * q8 + 1] = bfhi(u.x); VN[mt][8 * q8 + 2] = bflo(u.y); VN[mt][8 * q8 + 3] = bfhi(u.y);
            VN[mt][8 * q8 + 4] = bflo(u.z); VN[mt][8 * q8 + 5] = bfhi(u.z); VN[mt][8 * q8 + 6] = bflo(u.w); VN[mt][8 * q8 + 7] = bfhi(u.w); }
    const LAS unsigned char* Bf = lds + (n & 1) * OPS_BYTES + lane * 16;
    f32x16 O[2];
#pragma unroll
    for (int mt = 0; mt < 2; ++mt)
#pragma unroll
        for (int q = 0; q < 16; ++q) O[mt][q] = 0.f;
    bf16x8 fA[4], fB[4], vb[2][2];
    LD_WQ(fA, 0, 0); SB();
    LD_WQ(fB, 0, 1); SB(); MM_WQ(fA, 0, 0); SB();
    LD_WQ(fA, 1, 0); SB(); MM_WQ(fB, 0, 1); SCALE_S(0); SB();
    LD_WQ(fB, 1, 1); SB(); MM_WQ(fA, 1, 0); SB();
    LD_WQ(fA, 2, 0); SB(); MM_WQ(fB, 1, 1); SCALE_S(1); SB();
    LD_WQ(fB, 2, 1); SB(); MM_WQ(fA, 2, 0); SB();
    LD_WQ(fA, 3, 0); SB(); MM_WQ(fB, 2, 1); SCALE_S(2); SB();
    LD_WQ(fB, 3, 1); SB(); MM_WQ(fA, 3, 0); SB();
    LD_AT(fA, 0); SB(); MM_WQ(fB, 3, 1); SCALE_S(3); SB();
#pragma unroll
    for (int mt = 0; mt < 2; ++mt)
#pragma unroll
        for (int s2 = 0; s2 < 2; ++s2) vb[mt][s2] = pack8(VN[mt], s2);
    LD_AT(fB, 1); SB(); MM_AT(fA, 0); SB();
    LD_K(fA, 0); SB(); MM_AT(fB, 1); SB();
    {
        LAS unsigned short* sp = (LAS unsigned short*)(lds + stg_off + (n & 1) * (64 * stg_row)) + 32 * wave + r;
#pragma unroll
        for (int mt = 0; mt < 2; ++mt)
#pragma unroll
            for (int q = 0; q < 16; q += 2) { const unsigned w = cvtpk(O[mt][q], O[mt][q + 1]);
                sp[(32 * mt + crow(q, h)) * (stg_row / 2)] = (unsigned short)(w & 0xffffu); sp[(32 * mt + crow(q + 1, h)) * (stg_row / 2)] = (unsigned short)(w >> 16); }
    }
    asm volatile("s_waitcnt lgkmcnt(0)" ::: "memory"); __builtin_amdgcn_s_barrier(); asm volatile("" ::: "memory");
    LD_K(fB, 1); SB(); MM_K(fA, 0); SB();
    LD_K(fA, 2); SB(); MM_K(fB, 1); SB();
    LD_K(fB, 3); SB(); MM_K(fA, 2); SB();
    MM_K(fB, 3); SB();
}
#undef FRAG

__device__ __forceinline__ int opq(int v) { asm volatile("" : "+v"(v)); return v; }
typedef const __attribute__((address_space(4))) Args* kargp_t;
__device__ __forceinline__ kargp_t karg_ptr() { kargp_t p = (kargp_t)__builtin_amdgcn_kernarg_segment_ptr(); asm volatile("" : "+s"(p)); return p; }
__global__ void __launch_bounds__(NTHR, 2) mk_fwd(Args kargs) {
    extern __shared__ __attribute__((aligned(16))) unsigned char lds_raw[];
    LAS unsigned char* lds = (LAS unsigned char*)lds_raw;
    volatile LAS unsigned* MISC = (volatile LAS unsigned*)(lds + MISC_OFF);
    const int wave = __builtin_amdgcn_readfirstlane((int)threadIdx.x >> 6);
    const int G = gridDim.x; const int bx = blockIdx.x; const int vcu = (G % 8 == 0) ? (bx % 8) * (G / 8) + bx / 8 : bx;
    const int gw = vcu * NWAVES + wave, NGW = G * NWAVES;
    if (threadIdx.x < 128) MISC[threadIdx.x] = 0u;
    __syncthreads();
    XcdBarrier bar; bar.bar = (unsigned*)(kargs.ws + WS_CTL) + CW_BAR; bar.x = 0; bar.st = nullptr;
#if MK_ONE_LAUNCH
    bar = xcd_barrier_post((unsigned*)(kargs.ws + WS_CTL) + CW_BAR + kargs.li * XCD_BAR_WORDS, MISC + 8);
#define GRID_BAR() xcd_barrier(bar, tid)
#else
#define GRID_BAR() do {} while (0)
#endif
    const int lo = kargs.ph_lo, hi = kargs.ph_hi;
#ifndef PH_MASK
#define PH_MASK 0xFFFF
#endif
#define IN(k) ((((PH_MASK) >> (k)) & 1) && lo <= (k) && (k) < hi)
#define BOTH(k) (IN(k) && IN((k) + 1))

#define args (*ap_)
#define P_WS (args.ws)
#define ctl ((unsigned*)(P_WS + WS_CTL))
#define Xp (args.in[I_X])
#define OUTp (args.out)
#define MODp ((float*)(P_WS + WS_MOD))
#define gbuf ((float*)(P_WS + WS_G))
#define betabuf ((float*)(P_WS + WS_BETA))
#define glbuf ((float*)(P_WS + WS_GL))
#define asg_e ((int*)(P_WS + WS_AE))
#define asg_p ((int*)(P_WS + WS_AP))
#define asg_g ((float*)(P_WS + WS_AG))
#define asg_s ((int*)(P_WS + WS_AS))
#define WinT ((bf16*)(P_WS + WS_WIN))
#define WoutT ((bf16*)(P_WS + WS_WOUT))
#define WupT ((bf16*)(P_WS + WS_WUP))
#define WdnT ((bf16*)(P_WS + WS_WDN))
#define hbuf ((bf16*)(P_WS + WS_H))
#define projb ((bf16*)(P_WS + WS_PROJ))
#define Ub ((float*)(P_WS + WS_U))
#define opsb (P_WS + WS_OPS)
#define zsb ((bf16*)(P_WS + WS_ZS))
#define qfb (P_WS + WS_QF)
#define kfb (P_WS + WS_KF)
#define vtfb (P_WS + WS_VTF)
#define omix ((bf16*)(P_WS + WS_OMIX))
#define ybuf ((bf16*)(P_WS + WS_Y))
#define xg ((bf16*)(P_WS + WS_XG))
#define actb ((bf16*)(P_WS + WS_ACT))
#define yslot ((bf16*)(P_WS + WS_XG))

    if (IN(0)) {
        const int lane = (int)__builtin_amdgcn_mbcnt_hi(~0u, __builtin_amdgcn_mbcnt_lo(~0u, 0u)), tid = wave * 64 + lane; const kargp_t ap_ = karg_ptr();
        ldsf* scr = (ldsf*)(lds + wave * 16384);
        constexpr int I_IN = 16 * 113, I_OUT = 16 * 32;
        constexpr int NITEMS = I_IN + I_OUT;
        for (int it = gw; it < NITEMS; it += NGW) {
            int r = it;
            if (r < I_IN) { transpose_item(args.in[I_WIN], D, IN_COLS, WinT, 0, scr, r, lane); continue; } r -= I_IN;
            transpose_item(args.in[I_WOUT], D, D, WoutT, 1, scr, r, lane);
        }
        __syncthreads();
        for (int idx = bx * NTHR + tid; idx < 8192; idx += G * NTHR) { const int col = idx >> 3, k = idx & 7; ((float*)(P_WS + WS_WG))[k * 1024 + col] = args.in[I_WIN][(size_t)col * IN_COLS + 2048 + k]; }
        for (int idx = bx * NTHR + tid; idx < 32768; idx += G * NTHR) { const int col = idx >> 5, e = idx & 31; ((float*)(P_WS + WS_WR))[e * 1024 + col] = args.in[I_WR][idx]; }
        for (int it = bx; it < 256; it += G) mod_item(args.in[I_C], args.in[I_WADA], args.in[I_BADA], MODp, it, (ldsf*)lds, tid, lane, wave);
        if (BOTH(0)) GRID_BAR();
    }

    if (IN(1)) {
        const int lane = (int)__builtin_amdgcn_mbcnt_hi(~0u, __builtin_amdgcn_mbcnt_lo(~0u, 0u)), tid = wave * 64 + lane; const kargp_t ap_ = karg_ptr();
        ldsf* wg = (ldsf*)lds;
        const float* w_in = args.in[I_WIN];
        for (int idx = tid; idx < 2048; idx += NTHR) *((LAS f32x4*)wg + idx) = *((const f32x4*)(P_WS + WS_WG) + idx);
        __syncthreads();
        const float* nw0 = args.in[I_NORMW];
        const float dtb = args.in[I_DTB][lane & 3], alg = -expf(args.in[I_ALOG][lane & 3]);
        f32x4 vnx[4];
#pragma unroll
        for (int j = 0; j < 4; ++j) vnx[j] = *((const f32x4*)(Xp + (size_t)gw * D) + lane + 64 * j);
        for (int bb = 0; bb < BATCH; ++bb) {
            f32x4 av[4], shv[4];
#pragma unroll
            for (int j = 0; j < 4; ++j) { const int col = 4 * lane + 256 * j; const f32x4 nw = *(const f32x4*)(nw0 + col), sc = *(const f32x4*)(MODp + bb * 6144 + 1024 + col); shv[j] = *(const f32x4*)(MODp + bb * 6144 + col);
#pragma unroll
                for (int e = 0; e < 4; ++e) av[j][e] = nw[e] * (1.0f + sc[e]); }
            for (int r = gw + bb * (NTOK / BATCH); r < (bb + 1) * (NTOK / BATCH); r += NGW) {
                f32x4 v[4]; float ss = 0.f;
#pragma unroll
                for (int j = 0; j < 4; ++j) { v[j] = vnx[j]; ss += (v[j].x * v[j].x + v[j].y * v[j].y) + (v[j].z * v[j].z + v[j].w * v[j].w); }
                __builtin_amdgcn_sched_barrier(0);
                if (r + NGW < NTOK) {
#pragma unroll
                    for (int j = 0; j < 4; ++j) vnx[j] = *((const f32x4*)(Xp + (size_t)(r + NGW) * D) + lane + 64 * j);
                }
                __builtin_amdgcn_sched_barrier(0);
                const float rstd = rsqrtf(wave_sum(ss) * (1.0f / D) + EPS);
                float al[8];
#pragma unroll
                for (int k = 0; k < 8; ++k) al[k] = 0.f;
                v2u ov[4];
#pragma unroll
                for (int j = 0; j < 4; ++j) {
                    const int col = 4 * lane + 256 * j;
                    f32x4 h;
#pragma unroll
                    for (int e = 0; e < 4; ++e) h[e] = v[j][e] * rstd * av[j][e] + shv[j][e];
                    ov[j].x = pk2(h[0], h[1]); ov[j].y = pk2(h[2], h[3]);
#pragma unroll
                    for (int k = 0; k < 8; ++k) { const f32x4 w = *(const LAS f32x4*)(wg + k * 1024 + col); al[k] += (h[0] * w[0] + h[1] * w[1]) + (h[2] * w[2] + h[3] * w[3]); }
                }
#pragma unroll
                for (int j = 0; j < 4; ++j) *(v2u*)(hbuf + (size_t)r * D + 4 * lane + 256 * j) = ov[j];
#pragma unroll
                for (int k = 0; k < 8; ++k) al[k] = wave_sum(al[k]);
                if (lane < 4) {
                    const float aa = lane == 0 ? al[0] : (lane == 1 ? al[1] : (lane == 2 ? al[2] : al[3]));
                    const float ab = lane == 0 ? al[4] : (lane == 1 ? al[5] : (lane == 2 ? al[6] : al[7]));
                    const float xx = aa + dtb;
                    const float sp = xx > 20.f ? xx : log1pf(expf(xx));
                    gbuf[r * 4 + lane] = alg * sp;
                    betabuf[r * 4 + lane] = 1.0f / (1.0f + expf(-ab));
                }
            }
        }
        if (BOTH(1)) GRID_BAR();
    }

    if (IN(2)) {
        const int lane = (int)__builtin_amdgcn_mbcnt_hi(~0u, __builtin_amdgcn_mbcnt_lo(~0u, 0u)), tid = wave * 64 + lane; const kargp_t ap_ = karg_ptr();
        pg8::Gemm g{hbuf, WinT, NTOK, PCOLS, D}; pg8::StaticOrder S; S.init(NTOK, PCOLS, G, bx);
        pg8::EpiBf16 E{projb, PCOLS, nullptr, nullptr, 0, 1.0f};
        pg8::gemm_phase<pg8::EpiBf16, pg8::StaticOrder, true, true>(lds, g, S, E, tid);
        if (BOTH(2)) GRID_BAR();
    }

    if (IN(3)) {
        const int lane = (int)__builtin_amdgcn_mbcnt_hi(~0u, __builtin_amdgcn_mbcnt_lo(~0u, 0u)), tid = wave * 64 + lane; const kargp_t ap_ = karg_ptr();
        ldsf* qs = (ldsf*)lds; ldsf* ks = qs + 64 * 129; ldsf* vs = ks + 64 * 129; ldsf* Wsm = vs + 64 * 129; ldsf* Ls = Wsm + 64 * 129;
        constexpr int LSTR = 68;
        constexpr int RAW_OFF = 4 * 64 * 129 * 3;
        ldsf* gc = (ldsf*)(lds + 151296); ldsf* bt = gc + 64; ldsf* eg = bt + 64; ldsf* ekd = eg + 64;
        const float* conv_w = args.in[I_CONVW];
        const int r = lane & 31, h = lane >> 5;
        for (int item = (args.pad & 1) ? 1024 : bx; item < 1024; item += G) {
            const int bh = item >> 7, n = item & 127, b = bh >> 2, hh = bh & 3;
            const size_t row0 = (size_t)b * T + n * 64;
            unsigned char* ops = opsb + (size_t)item * OPS_BYTES;
            {
#pragma unroll
                for (int jp = 0; jp < 7; ++jp) {
                    const int p = wave + 8 * jp;
                    if (p < 51) {
                        int sg = 4 * p + (lane >> 4); sg = sg > 200 ? 200 : sg;
                        const int rw = sg / 3, wh = sg - 3 * rw; int tt = n * 64 + rw - 3; tt = tt < 0 ? 0 : tt;
                        __builtin_amdgcn_global_load_lds((const unsigned*)(projb + ((size_t)b * T + tt) * PCOLS + wh * 512 + hh * 128 + (lane & 15) * 8), (LAS unsigned*)(lds + RAW_OFF + p * 1024), 16, 0, 0);
                    }
                }
#pragma unroll
                for (int o = 0; o < 2; ++o) {
                    const int idx = tid + NTHR * o, i = idx >> 4, d0 = (idx & 15) * 8;
                    const v4u zw = *(const v4u*)(projb + ((size_t)b * T + n * 64 + i) * PCOLS + 1536 + hh * 128 + d0);
                    const f32x4 wa = *(const f32x4*)(args.in[I_ANW] + d0), wb = *(const f32x4*)(args.in[I_ANW] + d0 + 4);
                    v4u ow; ow.x = cvtpk(wa[0] * siluf(bflo(zw.x)), wa[1] * siluf(bfhi(zw.x))); ow.y = cvtpk(wa[2] * siluf(bflo(zw.y)), wa[3] * siluf(bfhi(zw.y)));
                    ow.z = cvtpk(wb[0] * siluf(bflo(zw.z)), wb[1] * siluf(bfhi(zw.z))); ow.w = cvtpk(wb[2] * siluf(bflo(zw.w)), wb[3] * siluf(bfhi(zw.w)));
                    *(v4u*)(zsb + ((size_t)b * T + n * 64 + i) * 512 + hh * 128 + d0) = ow;
                }
                asm volatile("s_waitcnt vmcnt(0)" ::: "memory");
                __syncthreads();
#pragma unroll 2
                for (int o = 0; o < 6; ++o) {
                    const int idx = tid + NTHR * o, i = idx / 48, c8 = idx - 48 * i, which = c8 >> 4, d0 = (c8 & 15) * 8, gch = which * 512 + hh * 128 + d0;
                    const LAS unsigned char* rp = lds + RAW_OFF + i * 768 + which * 256 + d0 * 2;
                    float acc[8];
#pragma unroll
                    for (int e = 0; e < 8; ++e) acc[e] = 0.f;
#pragma unroll
                    for (int tap = 0; tap < 4; ++tap) {
                        const v4u xw = *(const LAS v4u*)(rp + tap * 768);
                        const f32x4 wa = *(const f32x4*)(conv_w + tap * 1536 + gch), wb = *(const f32x4*)(conv_w + tap * 1536 + gch + 4);
                        const float msk = (n * 64 + i - 3 + tap) >= 0 ? 1.0f : 0.0f;
                        acc[0] += msk * wa[0] * bflo(xw.x); acc[1] += msk * wa[1] * bfhi(xw.x); acc[2] += msk * wa[2] * bflo(xw.y); acc[3] += msk * wa[3] * bfhi(xw.y);
                        acc[4] += msk * wb[0] * bflo(xw.z); acc[5] += msk * wb[1] * bfhi(xw.z); acc[6] += msk * wb[2] * bflo(xw.w); acc[7] += msk * wb[3] * bfhi(xw.w);
                    }
                    ldsf* dst = (which == 0 ? qs : (which == 1 ? ks : vs)) + i * 129 + d0;
#pragma unroll
                    for (int e = 0; e < 8; ++e) dst[e] = siluf(acc[e]);
                }
            }
            if (wave == 7) {
                float gv = gbuf[(row0 + lane) * 4 + hh];
#pragma unroll
                for (int o = 1; o < 64; o <<= 1) { const float t2 = __shfl_up(gv, o); if (lane >= o) gv += t2; }
                const float glast = __shfl(gv, 63);
                gc[lane] = gv; eg[lane] = expf(gv); bt[lane] = betabuf[(row0 + lane) * 4 + hh]; ekd[lane] = expf(glast - gv);
                if (lane == 0) glbuf[item] = expf(glast);
            }
            __syncthreads();
            if (((args.pad >> 2) & 7) == 1) continue;
            for (int i = wave; i < 64; i += NWAVES) {
                const float q0 = qs[i * 129 + lane], q1 = qs[i * 129 + 64 + lane], k0 = ks[i * 129 + lane], k1 = ks[i * 129 + 64 + lane];
                const float sq = rsqrtf(wave_sum(q0 * q0 + q1 * q1) + EPS) * 0.08838834764831845f, sk = rsqrtf(wave_sum(k0 * k0 + k1 * k1) + EPS);
                qs[i * 129 + lane] = q0 * sq; qs[i * 129 + 64 + lane] = q1 * sq; ks[i * 129 + lane] = k0 * sk; ks[i * 129 + 64 + lane] = k1 * sk;
            }
            __syncthreads();
            if (((args.pad >> 2) & 7) == 2) continue;
            {
                const int which = wave >> 2, ta = (wave >> 1) & 1, tb = wave & 1;
                if (tb <= ta) {
                    f32x16 acc;
#pragma unroll
                    for (int q = 0; q < 16; ++q) acc[q] = 0.f;
                    const ldsf* Ap = ks + (32 * (which == 0 ? ta : tb) + r) * 129 + 8 * h;
                    const ldsf* Bp = (which == 0 ? ks + (32 * tb + r) * 129 : qs + (32 * ta + r) * 129) + 8 * h;
#pragma unroll 4
                    for (int k = 0; k < 8; ++k) {
                        v4u pa, pb;
                        pa.x = cvtpk(Ap[16 * k + 0], Ap[16 * k + 1]); pa.y = cvtpk(Ap[16 * k + 2], Ap[16 * k + 3]); pa.z = cvtpk(Ap[16 * k + 4], Ap[16 * k + 5]); pa.w = cvtpk(Ap[16 * k + 6], Ap[16 * k + 7]);
                        pb.x = cvtpk(Bp[16 * k + 0], Bp[16 * k + 1]); pb.y = cvtpk(Bp[16 * k + 2], Bp[16 * k + 3]); pb.z = cvtpk(Bp[16 * k + 4], Bp[16 * k + 5]); pb.w = cvtpk(Bp[16 * k + 6], Bp[16 * k + 7]);
                        acc = MFMA32(__builtin_bit_cast(bf16x8, pa), __builtin_bit_cast(bf16x8, pb), acc);
                    }
                    if (which == 0) {
                        const int j = 32 * tb + r; const float gj = gc[j];
#pragma unroll
                        for (int q = 0; q < 16; ++q) { const int i = 32 * ta + crow(q, h); Ls[i * LSTR + j] = (j < i) ? bt[i] * acc[q] * __expf(gc[i] - gj) : 0.f; }
                    } else {
                        const int i = 32 * ta + r; const float gi = gc[i];
#pragma unroll
                        for (int q = 0; q < 16; ++q) { const int j = 32 * tb + crow(q, h); acc[q] = (j <= i) ? acc[q] * __expf(gi - gc[j]) : 0.f; }
#pragma unroll
                        for (int s2 = 0; s2 < 2; ++s2) *(bf16x8*)(ops + (48 + (ta * 2 + tb) * 2 + s2) * 1024 + lane * 16) = pack8(acc, s2);
                    }
                }
            }
            __syncthreads();
            if (((args.pad >> 2) & 7) == 3) continue;
            if (wave < 4) {
                const int d = tid & 127; const bool isw = tid >= 128;
                int z; asm volatile("v_mov_b32 %0, 0" : "=v"(z));
                const ldsf* Lz = Ls + z; const ldsf* btz = bt + z; const ldsf* egz = eg + z;
                float xr[32];
                const ldsf* srcx = (isw ? ks : vs) + d;
                ldsf* dst = (isw ? Wsm : vs) + d;
#pragma unroll
                for (int i = 0; i < 32; ++i) { const float e_ = egz[i]; xr[i] = srcx[i * 129] * btz[i] * (isw ? e_ : 1.0f); }
#pragma unroll
                for (int i = 32; i < 64; ++i) { const float e_ = egz[i]; dst[i * 129] = srcx[i * 129] * btz[i] * (isw ? e_ : 1.0f); }
#pragma unroll
                for (int i = 1; i < 32; ++i) {
                    float s0 = xr[i], s1 = 0.f;
#pragma unroll
                    for (int j4 = 0; j4 < (i + 3) / 4; ++j4) {
                        const f32x4 l = *(const LAS f32x4*)(Lz + i * LSTR + 4 * j4);
                        s0 -= l[0] * xr[4 * j4]; s1 -= l[1] * xr[4 * j4 + 1]; s0 -= l[2] * xr[4 * j4 + 2]; s1 -= l[3] * xr[4 * j4 + 3];
                    }
                    xr[i] = s0 + s1;
                    asm volatile("" ::: "memory");
                }
#pragma unroll
                for (int i = 0; i < 32; ++i) dst[i * 129] = xr[i];
            } else {
#pragma unroll 1
                for (int ff = 0; ff < 8; ++ff) {
                    const int f = (wave - 4) * 8 + ff;
                    v4u p; float v8[8];
                    if (f < 16) { const int mt = f >> 3, t2 = (f >> 1) & 3, s2 = f & 1; const int i = 32 * mt + r; const float e = eg[i];
#pragma unroll
                        for (int j = 0; j < 8; ++j) v8[j] = qs[i * 129 + 32 * t2 + 16 * s2 + 8 * (j >> 2) + 4 * h + (j & 3)] * e;
                    } else { const int g2 = f - 16, t2 = g2 >> 2, mt = (g2 >> 1) & 1, s2 = g2 & 1; const int d = 32 * t2 + r;
#pragma unroll
                        for (int j = 0; j < 8; ++j) { const int i = 32 * mt + 16 * s2 + 8 * (j >> 2) + 4 * h + (j & 3); v8[j] = ks[i * 129 + d] * ekd[i]; }
                    }
                    p.x = cvtpk(v8[0], v8[1]); p.y = cvtpk(v8[2], v8[3]); p.z = cvtpk(v8[4], v8[5]); p.w = cvtpk(v8[6], v8[7]);
                    *(v4u*)(ops + (16 + f) * 1024 + lane * 16) = p;
                }
            }
            __syncthreads();
            {
                ldsf* X = (wave < 4) ? vs + 32 * wave : Wsm + 32 * (wave - 4);
                f32x16 acc;
#pragma unroll
                for (int q = 0; q < 16; ++q) acc[q] = X[(32 + crow(q, h)) * 129 + r];
                const ldsf* Ap = Ls + (32 + r) * LSTR + h;
                const ldsf* Bp = X + h * 129 + r;
#pragma unroll 8
                for (int k = 0; k < 16; ++k) acc = __builtin_amdgcn_mfma_f32_32x32x2f32(-Ap[2 * k], Bp[(2 * k) * 129], acc, 0, 0, 0);
#pragma unroll
                for (int q = 0; q < 16; ++q) X[(32 + crow(q, h)) * 129 + r] = acc[q];
            }
            __syncthreads();
            if (wave < 4) {
                const int d = tid & 127; const bool isw = tid >= 128;
                int z; asm volatile("v_mov_b32 %0, 0" : "=v"(z));
                const ldsf* Lz = Ls + z;
                ldsf* dst = (isw ? Wsm : vs) + d;
                float xr[32];
#pragma unroll
                for (int i = 0; i < 32; ++i) xr[i] = dst[(32 + i) * 129];
#pragma unroll
                for (int i = 1; i < 32; ++i) {
                    float s0 = xr[i], s1 = 0.f;
#pragma unroll
                    for (int j4 = 0; j4 < (i + 3) / 4; ++j4) {
                        const f32x4 l = *(const LAS f32x4*)(Lz + (32 + i) * LSTR + 32 + 4 * j4);
                        s0 -= l[0] * xr[4 * j4]; s1 -= l[1] * xr[4 * j4 + 1]; s0 -= l[2] * xr[4 * j4 + 2]; s1 -= l[3] * xr[4 * j4 + 3];
                    }
                    xr[i] = s0 + s1;
                    asm volatile("" ::: "memory");
                }
#pragma unroll
                for (int i = 0; i < 32; ++i) dst[(32 + i) * 129] = xr[i];
            }
            __syncthreads();
            if (((args.pad >> 2) & 7) == 4) continue;
#pragma unroll
            for (int o = 0; o < 2; ++o) {
                const int idx8 = tid + NTHR * o, l2 = idx8 & 63, q8 = (idx8 >> 6) & 1, mt = (idx8 >> 7) & 1, w = idx8 >> 8;
                const int c = 32 * w + (l2 & 31), hh2 = l2 >> 5;
                float u8[8];
#pragma unroll
                for (int e = 0; e < 8; ++e) u8[e] = vs[(32 * mt + crow(8 * q8 + e, hh2)) * 129 + c];
                v4u p; p.x = cvtpk(u8[0], u8[1]); p.y = cvtpk(u8[2], u8[3]); p.z = cvtpk(u8[4], u8[5]); p.w = cvtpk(u8[6], u8[7]);
                *(v4u*)((unsigned char*)Ub + (size_t)item * 16384 + idx8 * 16) = p;
            }
#pragma unroll
            for (int ff = 0; ff < 2; ++ff) {
                const int f = wave * 2 + ff, mt = f >> 3, t2 = (f >> 1) & 3, s2 = f & 1; const int i = 32 * mt + r;
                float v8[8];
#pragma unroll
                for (int j = 0; j < 8; ++j) v8[j] = -Wsm[i * 129 + 32 * t2 + 16 * s2 + 8 * (j >> 2) + 4 * h + (j & 3)];
                v4u p; p.x = cvtpk(v8[0], v8[1]); p.y = cvtpk(v8[2], v8[3]); p.z = cvtpk(v8[4], v8[5]); p.w = cvtpk(v8[6], v8[7]);
                *(v4u*)(ops + f * 1024 + lane * 16) = p;
            }
            __syncthreads();
        }
        {
            const int r = lane & 31, h = lane >> 5;
            for (int it = (args.pad & 2) ? 2048 : gw; it < 2048; it += NGW) {
                const int c = it & 127, hh = (it >> 7) & 7, b = it >> 10;
                const bf16* base = projb + ((size_t)b * T + c * 64) * PCOLS + hh * 64;
#pragma unroll
                for (int kb2 = 0; kb2 < 2; ++kb2)
#pragma unroll
                    for (int ks = 0; ks < 4; ++ks) {
                        const bf16* rp = base + (size_t)(32 * kb2 + r) * PCOLS + 16 * ks + 8 * h;
                        *(v4u*)(qfb + (size_t)it * 8192 + (kb2 * 4 + ks) * 1024 + lane * 16) = *(const v4u*)(rp + 2048);
                        *(v4u*)(kfb + (size_t)it * 8192 + (kb2 * 4 + ks) * 1024 + lane * 16) = *(const v4u*)(rp + 2560);
                    }
#pragma unroll
                for (int dt = 0; dt < 2; ++dt)
#pragma unroll
                    for (int kb2 = 0; kb2 < 2; ++kb2)
#pragma unroll
                        for (int s2 = 0; s2 < 2; ++s2) {
                            unsigned short e8[8];
#pragma unroll
                            for (int j = 0; j < 8; ++j) e8[j] = base[(size_t)(32 * kb2 + 16 * s2 + 8 * (j >> 2) + 4 * h + (j & 3)) * PCOLS + 3072 + 32 * dt + r];
                            v4u p; p.x = e8[0] | ((unsigned)e8[1] << 16); p.y = e8[2] | ((unsigned)e8[3] << 16); p.z = e8[4] | ((unsigned)e8[5] << 16); p.w = e8[6] | ((unsigned)e8[7] << 16);
                            *(v4u*)(vtfb + (size_t)it * 8192 + ((dt * 2 + kb2) * 2 + s2) * 1024 + lane * 16) = p;
                        }
            }
        }
        if (BOTH(3)) GRID_BAR();
    }

    if (IN(4)) {
        const int lane = (int)__builtin_amdgcn_mbcnt_hi(~0u, __builtin_amdgcn_mbcnt_lo(~0u, 0u)), tid = wave * 64 + lane; const kargp_t ap_ = karg_ptr();
        if (bx < 64) {
            constexpr int SEGC = 16;
            const int bh = bx & 7, seg = bx >> 3, b = bh >> 2, hh = bh & 3;
            const int r = lane & 31, h = lane >> 5;
            const int c0 = seg * SEGC;
#define SCAN_BAR() do { asm volatile("s_waitcnt lgkmcnt(0)" ::: "memory"); __builtin_amdgcn_s_barrier(); asm volatile("" ::: "memory"); } while (0)
#define FRAG(f_) (*(const LAS bf16x8*)(Bf + (f_) * 1024))
            {
                const unsigned char* ops = opsb + (size_t)(bh * 128 + c0) * OPS_BYTES;
                const float* Uf = (const float*)((const unsigned char*)Ub + (size_t)(bh * 128 + c0) * 16384);
                float* segp = (float*)(args.ws + WS_SEG) + (size_t)(bh * 8 + seg) * 32768;
                ldsf* egls = (ldsf*)(lds + 4 * 32768);
                if (tid < SEGC) egls[tid] = glbuf[bh * 128 + c0 + tid];
                const int pbase = (wave < 6) ? (wave - 4) * 8 : 32 + (wave - 6) * 8, fbase = (wave - 4) * 8;
#define A_DMA(n_) do { const unsigned char* src_ = ops + (size_t)(n_) * OPS_BYTES + pbase * 1024 + lane * 16; \
                _Pragma("unroll") for (int p_ = 0; p_ < 8; ++p_) __builtin_amdgcn_global_load_lds((const unsigned*)(src_ + p_ * 1024), (LAS unsigned*)(lds + ((n_) & 3) * 32768 + (fbase + p_) * 1024), 16, 0, 0); } while (0)
                f32x16 S[4]; v4u Ur[4];
#pragma unroll
                for (int t2 = 0; t2 < 4; ++t2)
#pragma unroll
                    for (int q = 0; q < 16; ++q) S[t2][q] = (wave >= 4 && (32 * t2 + crow(q, h)) == (32 * (wave - 4) + r)) ? 1.0f : 0.0f;
#pragma unroll
                for (int f = 0; f < 4; ++f) Ur[f] = (v4u){0u, 0u, 0u, 0u};
                if (wave < 4) {
#pragma unroll
                    for (int f = 0; f < 4; ++f) Ur[f] = *((const v4u*)Uf + (wave * 4 + f) * 64 + lane);
                } else { A_DMA(0); A_DMA(1); A_DMA(2); }
                for (int n = 0; n < SEGC; ++n) {
                    if (wave >= 4) { if (n <= SEGC - 3) asm volatile("s_waitcnt vmcnt(16)" ::: "memory"); else if (n == SEGC - 2) asm volatile("s_waitcnt vmcnt(8)" ::: "memory"); else asm volatile("s_waitcnt vmcnt(0)" ::: "memory"); }
                    SCAN_BAR();
                    if (wave >= 4 && n + 3 < SEGC) A_DMA(n + 3);
                    const LAS unsigned char* Bf = lds + (n & 3) * 32768 + lane * 16;
                    f32x16 VN[2];
#pragma unroll
                    for (int mt = 0; mt < 2; ++mt)
#pragma unroll
                        for (int q8 = 0; q8 < 2; ++q8) { const v4u u = Ur[mt * 2 + q8];
                            VN[mt][8 * q8 + 0] = bflo(u.x); VN[mt][8 * q8 + 1] = bfhi(u.x); VN[mt][8 * q8 + 2] = bflo(u.y); VN[mt][8 * q8 + 3] = bfhi(u.y);
                            VN[mt][8 * q8 + 4] = bflo(u.z); VN[mt][8 * q8 + 5] = bfhi(u.z); VN[mt][8 * q8 + 6] = bflo(u.w); VN[mt][8 * q8 + 7] = bfhi(u.w); }
                    if (wave < 4 && n + 1 < SEGC) {
                        const v4u* up = (const v4u*)((const unsigned char*)Uf + (size_t)(n + 1) * 16384) + (wave * 4) * 64 + lane;
#pragma unroll
                        for (int f = 0; f < 4; ++f) Ur[f] = up[f * 64];
                    }
                    const float egl = egls[n];
#pragma unroll
                    for (int t2 = 0; t2 < 4; ++t2)
#pragma unroll
                        for (int s2 = 0; s2 < 2; ++s2) {
                            const bf16x8 sb = pack8(S[t2], s2);
#pragma unroll
                            for (int mt = 0; mt < 2; ++mt) VN[mt] = MFMA32(FRAG((mt * 4 + t2) * 2 + s2), sb, VN[mt]);
                        }
                    bf16x8 vb[2][2];
#pragma unroll
                    for (int mt = 0; mt < 2; ++mt)
#pragma unroll
                        for (int s2 = 0; s2 < 2; ++s2) vb[mt][s2] = pack8(VN[mt], s2);
#pragma unroll
                    for (int t2 = 0; t2 < 4; ++t2) {
#pragma unroll
                        for (int q = 0; q < 16; ++q) S[t2][q] *= egl;
#pragma unroll
                        for (int mt = 0; mt < 2; ++mt)
#pragma unroll
                            for (int s2 = 0; s2 < 2; ++s2) S[t2] = MFMA32(FRAG(16 + (t2 * 2 + mt) * 2 + s2), vb[mt][s2], S[t2]);
                    }
                }
#undef A_DMA
                if (wave < 4) {
#pragma unroll
                    for (int t2 = 0; t2 < 4; ++t2)
#pragma unroll
                        for (int q = 0; q < 16; ++q) segp[((wave * 4 + t2) * 16 + q) * 64 + lane] = S[t2][q];
                } else {
                    unsigned short* pp = (unsigned short*)(args.ws + WS_SEGP) + (size_t)(bh * 8 + seg) * 16384 + (((wave - 4) * 2 + (r >> 4)) * 64 + 32 * ((r >> 3) & 1)) * 8 + (r & 7);
#pragma unroll
                    for (int t2 = 0; t2 < 4; ++t2)
#pragma unroll
                        for (int q = 0; q < 16; ++q) pp[(t2 * 8 * 64 + crow(q, h)) * 8] = (unsigned short)f2bf(S[t2][q]);
                }
            }
            asm volatile("s_waitcnt vmcnt(0)" ::: "memory");
            __syncthreads();
            if (tid == 0) { __builtin_amdgcn_fence(__ATOMIC_RELEASE, "agent"); asm volatile("s_waitcnt vmcnt(0)" ::: "memory"); __hip_atomic_fetch_add(ctl + CW_SEGA + 64 * bh, 1u, RLX_AGENT); }
            if (seg == 0) {
                if (tid == 0) { unsigned sp_ = 0; while (__hip_atomic_load(ctl + CW_SEGA + 64 * bh, RLX_AGENT) < 8u) { __builtin_amdgcn_s_sleep(4); if (++sp_ > (1u << 24)) break; }
                    __builtin_amdgcn_fence(__ATOMIC_ACQUIRE, "agent"); asm volatile("s_waitcnt vmcnt(0)" ::: "memory"); }
                __syncthreads();
                constexpr int ST_ROW = 272, ST_BYTES = 128 * ST_ROW;
                const int nt = wave & 3, mt0 = 2 * (wave >> 2);
                const float* seg0 = (const float*)(args.ws + WS_SEG) + (size_t)(bh * 8) * 32768;
                const unsigned char* pa0 = args.ws + WS_SEGP + (size_t)(bh * 8) * 32768 + lane * 16;
                float* sst0 = (float*)(args.ws + WS_SST) + (size_t)(bh * 8) * 16384;
#define PB_LOADA(dst, k_) do { const unsigned char* pk_ = pa0 + (size_t)(k_) * 32768; \
                    _Pragma("unroll") for (int i_ = 0; i_ < 2; ++i_) _Pragma("unroll") for (int f_ = 0; f_ < 8; ++f_) dst[i_ * 8 + f_] = *(const bf16x8*)(pk_ + (((mt0 + i_) * 4) * 2 + f_) * 1024); } while (0)
#define PB_ITER(k_, Acur, Anext) do { \
                    if ((k_) + 1 <= 6) PB_LOADA(Anext, (k_) + 1); \
                    const float* sk_ = seg0 + (size_t)(k_) * 32768; \
                    f32x16 z0_[2], Z_[2]; \
                    _Pragma("unroll") for (int i_ = 0; i_ < 2; ++i_) _Pragma("unroll") for (int q_ = 0; q_ < 16; ++q_) { z0_[i_][q_] = sk_[((nt * 4 + mt0 + i_) * 16 + q_) * 64 + lane]; Z_[i_][q_] = 0.f; } \
                    if ((k_) > 0) { const LAS unsigned char* stc_ = lds + ((k_) & 1) * ST_BYTES + (32 * nt + r) * ST_ROW + 16 * h; \
                        _Pragma("unroll") for (int f_ = 0; f_ < 8; ++f_) { const bf16x8 bfr_ = *(const LAS bf16x8*)(stc_ + (16 * f_) * 2); \
                            Z_[0] = MFMA32(Acur[f_], bfr_, Z_[0]); Z_[1] = MFMA32(Acur[8 + f_], bfr_, Z_[1]); } } \
                    float* so_ = sst0 + (size_t)((k_) + 1) * 16384; \
                    LAS unsigned char* stn_ = lds + (((k_) + 1) & 1) * ST_BYTES + (32 * nt + r) * ST_ROW; \
                    _Pragma("unroll") for (int i_ = 0; i_ < 2; ++i_) { \
                        _Pragma("unroll") for (int q_ = 0; q_ < 16; ++q_) { Z_[i_][q_] += z0_[i_][q_]; so_[((nt * 4 + mt0 + i_) * 16 + q_) * 64 + lane] = Z_[i_][q_]; } \
                        _Pragma("unroll") for (int q_ = 0; q_ < 16; q_ += 2) *(LAS unsigned*)(stn_ + (32 * (mt0 + i_) + crow(q_, h)) * 2) = cvtpk(Z_[i_][q_], Z_[i_][q_ + 1]); } \
                    SCAN_BAR(); } while (0)
                bf16x8 Aa[16], Ab[16];
#pragma unroll
                for (int f = 0; f < 16; ++f) { Aa[f] = (bf16x8){0, 0, 0, 0, 0, 0, 0, 0}; Ab[f] = Aa[f]; }
                PB_ITER(0, Ab, Aa);
                PB_ITER(1, Aa, Ab);
                PB_ITER(2, Ab, Aa);
                PB_ITER(3, Aa, Ab);
                PB_ITER(4, Ab, Aa);
                PB_ITER(5, Aa, Ab);
                PB_ITER(6, Ab, Aa);
#undef PB_ITER
#undef PB_LOADA
                asm volatile("s_waitcnt vmcnt(0)" ::: "memory");
                __syncthreads();
                if (tid == 0) { __builtin_amdgcn_fence(__ATOMIC_RELEASE, "agent"); asm volatile("s_waitcnt vmcnt(0)" ::: "memory"); __hip_atomic_store(ctl + CW_SEGB + 64 * bh, 1u, RLX_AGENT); }
            }
            if (tid == 0) { unsigned sp_ = 0; while (__hip_atomic_load(ctl + CW_SEGB + 64 * bh, RLX_AGENT) == 0u) { __builtin_amdgcn_s_sleep(4); if (++sp_ > (1u << 24)) break; }
                __builtin_amdgcn_fence(__ATOMIC_ACQUIRE, "agent"); asm volatile("s_waitcnt vmcnt(0)" ::: "memory"); }
            __syncthreads();
#undef FRAG
            const kargp_t ap2_ = karg_ptr();
            const unsigned char* ops = ((*ap2_).ws + WS_OPS) + (size_t)(bh * 128 + c0) * OPS_BYTES;
            const float* Uf = (const float*)((const unsigned char*)((*ap2_).ws + WS_U) + (size_t)(bh * 128 + c0) * 16384);
            const float* sstp = (const float*)((*ap2_).ws + WS_SST) + (size_t)(bh * 8 + seg) * 16384;
#define SCAN_DMA(n_, buf_) do { const unsigned char* src_ = ops + (size_t)(n_) * OPS_BYTES + ((wave - 4) * 14) * 1024 + lane * 16; \
            _Pragma("unroll") for (int p_ = 0; p_ < 14; ++p_) __builtin_amdgcn_global_load_lds((const unsigned*)(src_ + p_ * 1024), (LAS unsigned*)(lds + (buf_) * OPS_BYTES + ((wave - 4) * 14 + p_) * 1024), 16, 0, 0); } while (0)
            constexpr int STG_OFF = 2 * OPS_BYTES, STG_ROW = 272, STG_BYTES = 64 * STG_ROW;
            if (wave < 4) {
                f32x16 S[4]; v4u Ur[4];
#pragma unroll
                for (int t2 = 0; t2 < 4; ++t2)
#pragma unroll
                    for (int q = 0; q < 16; ++q) S[t2][q] = (seg > 0) ? sstp[((wave * 4 + t2) * 16 + q) * 64 + lane] : 0.f;
#pragma unroll
                for (int f = 0; f < 4; ++f) Ur[f] = *((const v4u*)Uf + (wave * 4 + f) * 64 + lane);
                const float* glp = glbuf + bh * 128 + c0;
                float eglr = glp[0];
                for (int n = 0; n < SEGC; ++n) {
                    SCAN_BAR();
                    const LAS unsigned char* Bf = lds + (n & 1) * OPS_BYTES + lane * 16;
#define FRAG(f_) (*(const LAS bf16x8*)(Bf + (f_) * 1024))
                    f32x16 VN[2], O[2];
#pragma unroll
                    for (int mt = 0; mt < 2; ++mt)
#pragma unroll
                        for (int q8 = 0; q8 < 2; ++q8) { const v4u u = Ur[mt * 2 + q8];
                            VN[mt][8 * q8 + 0] = bflo(u.x); VN[mt][8 * q8 + 1] = bfhi(u.x); VN[mt][8 * q8 + 2] = bflo(u.y); VN[mt][8 * q8 + 3] = bfhi(u.y);
                            VN[mt][8 * q8 + 4] = bflo(u.z); VN[mt][8 * q8 + 5] = bfhi(u.z); VN[mt][8 * q8 + 6] = bflo(u.w); VN[mt][8 * q8 + 7] = bfhi(u.w); }
                    const float egl = eglr;
                    if (n + 1 < SEGC) {
                        const v4u* up = (const v4u*)((const unsigned char*)Uf + (size_t)(n + 1) * 16384) + (wave * 4) * 64 + lane;
#pragma unroll
                        for (int f = 0; f < 4; ++f) Ur[f] = up[f * 64];
                        eglr = glp[n + 1];
                    }
#pragma unroll
                    for (int mt = 0; mt < 2; ++mt)
#pragma unroll
                        for (int q = 0; q < 16; ++q) O[mt][q] = 0.f;
#pragma unroll
                    for (int t2 = 0; t2 < 4; ++t2)
#pragma unroll
                        for (int s2 = 0; s2 < 2; ++s2) {
                            const bf16x8 sb = pack8(S[t2], s2);
#pragma unroll
                            for (int mt = 0; mt < 2; ++mt) {
                                VN[mt] = MFMA32(FRAG((mt * 4 + t2) * 2 + s2), sb, VN[mt]);
                                O[mt] = MFMA32(FRAG(16 + (mt * 4 + t2) * 2 + s2), sb, O[mt]);
                            }
                        }
                    bf16x8 vb[2][2];
#pragma unroll
                    for (int mt = 0; mt < 2; ++mt)
#pragma unroll
                        for (int s2 = 0; s2 < 2; ++s2) vb[mt][s2] = pack8(VN[mt], s2);
#pragma unroll
                    for (int s2 = 0; s2 < 2; ++s2) {
                        O[0] = MFMA32(FRAG(48 + 0 * 2 + s2), vb[0][s2], O[0]);
                        O[1] = MFMA32(FRAG(48 + 2 * 2 + s2), vb[0][s2], O[1]);
                        O[1] = MFMA32(FRAG(48 + 3 * 2 + s2), vb[1][s2], O[1]);
                    }
                    {
                        LAS unsigned short* sp = (LAS unsigned short*)(lds + STG_OFF + (n & 1) * STG_BYTES) + 32 * wave + r;
#pragma unroll
                        for (int mt = 0; mt < 2; ++mt)
#pragma unroll
                            for (int q = 0; q < 16; q += 2) { const unsigned w = cvtpk(O[mt][q], O[mt][q + 1]);
                                sp[(32 * mt + crow(q, h)) * (STG_ROW / 2)] = (unsigned short)(w & 0xffffu); sp[(32 * mt + crow(q + 1, h)) * (STG_ROW / 2)] = (unsigned short)(w >> 16); }
                    }
                    SCAN_BAR();
#pragma unroll
                    for (int t2 = 0; t2 < 4; ++t2) {
#pragma unroll
                        for (int q = 0; q < 16; ++q) S[t2][q] *= egl;
#pragma unroll
                        for (int mt = 0; mt < 2; ++mt)
#pragma unroll
                            for (int s2 = 0; s2 < 2; ++s2) S[t2] = MFMA32(FRAG(32 + (t2 * 2 + mt) * 2 + s2), vb[mt][s2], S[t2]);
                    }
#undef FRAG
                }
                SCAN_BAR();
            } else {
                const int w4 = wave - 4, row = 16 * w4 + (lane >> 2), qt = lane & 3;
                const bf16* zp = zsb + ((size_t)b * T + c0 * 64 + row) * 512 + hh * 128 + qt * 32;
                bf16* op = omix + ((size_t)b * T + c0 * 64 + row) * D + hh * 128 + qt * 32;
                SCAN_DMA(0, 0);
                asm volatile("s_waitcnt vmcnt(0)" ::: "memory");
                v4u zr[4];
#pragma unroll
                for (int k = 0; k < 4; ++k) zr[k] = *(const v4u*)(zp + 8 * k);
                unsigned pfacc = 0u, pf0 = 0u, pf1 = 0u;
                for (int n = 0; n <= SEGC; ++n) {
                    SCAN_BAR();
                    if (n < SEGC - 1) SCAN_DMA(n + 1, (n + 1) & 1);
                    asm volatile("" ::: "memory");
                    if (n < SEGC - 2) {
                        const unsigned char* pf = ops + (size_t)(n + 2) * OPS_BYTES + (w4 * 112 + lane) * 128;
                        pfacc += pf0 + pf1; pf0 = *(const unsigned*)pf; pf1 = (lane < 48) ? *(const unsigned*)(pf + 64 * 128) : 0u;
                    }
                    asm volatile("" ::: "memory");
                    if (n < SEGC) SCAN_BAR();
                    if (n > 0) {
                        const LAS unsigned char* sp = lds + STG_OFF + ((n - 1) & 1) * STG_BYTES + row * STG_ROW + qt * 64;
                        v4u ov[4]; float ss = 0.f;
#pragma unroll
                        for (int k = 0; k < 4; ++k) { ov[k] = *(const LAS v4u*)(sp + 16 * k);
                            const float a0 = bflo(ov[k].x), a1 = bfhi(ov[k].x), a2 = bflo(ov[k].y), a3 = bfhi(ov[k].y), a4 = bflo(ov[k].z), a5 = bfhi(ov[k].z), a6 = bflo(ov[k].w), a7 = bfhi(ov[k].w);
                            ss += (a0 * a0 + a1 * a1) + (a2 * a2 + a3 * a3) + (a4 * a4 + a5 * a5) + (a6 * a6 + a7 * a7); }
                        ss += __shfl_xor(ss, 1); ss += __shfl_xor(ss, 2);
                        const float rstd = rsqrtf(ss * (1.0f / 128.0f) + EPS);
                        bf16* o2 = op + (size_t)(n - 1) * 64 * D;
#pragma unroll
                        for (int k = 0; k < 4; ++k) {
                            v4u w;
                            w.x = cvtpk(bflo(ov[k].x) * rstd * bflo(zr[k].x), bfhi(ov[k].x) * rstd * bfhi(zr[k].x));
                            w.y = cvtpk(bflo(ov[k].y) * rstd * bflo(zr[k].y), bfhi(ov[k].y) * rstd * bfhi(zr[k].y));
                            w.z = cvtpk(bflo(ov[k].z) * rstd * bflo(zr[k].z), bfhi(ov[k].z) * rstd * bfhi(zr[k].z));
                            w.w = cvtpk(bflo(ov[k].w) * rstd * bflo(zr[k].w), bfhi(ov[k].w) * rstd * bfhi(zr[k].w));
                            *(v4u*)(o2 + 8 * k) = w;
                        }
                    }
                    asm volatile("" ::: "memory");
                    if (n >= 1 && n < SEGC) {
#pragma unroll
                        for (int k = 0; k < 4; ++k) zr[k] = *(const v4u*)(zp + (size_t)n * 64 * 512 + 8 * k);
                    }
                    asm volatile("" ::: "memory");
                    if (n < SEGC) { if (n == 0 || n >= SEGC - 2) asm volatile("s_waitcnt vmcnt(0)" ::: "memory"); else asm volatile("s_waitcnt vmcnt(10)" ::: "memory"); }
                }
                if (pfacc == 0x12345679u) glbuf[1024 + lane] = 1.0f;
            }
#undef SCAN_DMA
#undef SCAN_BAR
        } else {
            const float* relb = args.in[I_RELB];
            ldsf* rbl = (ldsf*)lds;
            for (int idx = tid; idx < 8 * 257; idx += NTHR) rbl[idx] = relb[idx] * 1.4426950408889634f;
            __syncthreads();
            const int r = lane & 31, h = lane >> 5;
            const int AW = (G - 64) * NWAVES, aw = (bx - 64) * NWAVES + wave;
            for (int task = aw; task < 4096; task += AW) {
                const int qh = task & 1, hh = (task >> 1) & 7, n = (task >> 4) & 127, b = task >> 11;
                const int bhc = (b * 8 + hh) * 128;
                bf16x8 qf[4];
#pragma unroll
                for (int ks = 0; ks < 4; ++ks) qf[ks] = *(const bf16x8*)(qfb + (size_t)(bhc + n) * 8192 + (qh * 4 + ks) * 1024 + lane * 16);
                f32x16 OT[2];
#pragma unroll
                for (int dt = 0; dt < 2; ++dt)
#pragma unroll
                    for (int q = 0; q < 16; ++q) OT[dt][q] = 0.f;
                float m = -1e30f, l = 0.f;
                const float c0 = rbl[hh * 257 + 256];
                const int iq = 32 * qh + r;
                const int cb0 = (n >= 8) ? 0 : 8 - n;
                for (int blk = cb0 * 2; blk < 18; ++blk) {
                    const int cb = blk >> 1, kb2 = blk & 1, cidx = n - 8 + cb;
                    const unsigned char* kp = kfb + (size_t)(bhc + cidx) * 8192 + (kb2 * 4) * 1024 + lane * 16;
                    const unsigned char* vp = vtfb + (size_t)(bhc + cidx) * 8192 + lane * 16;
                    bf16x8 kf[4], vf[2][2];
#pragma unroll
                    for (int ks = 0; ks < 4; ++ks) kf[ks] = *(const bf16x8*)(kp + ks * 1024);
#pragma unroll
                    for (int dt = 0; dt < 2; ++dt)
#pragma unroll
                        for (int s2 = 0; s2 < 2; ++s2) vf[dt][s2] = *(const bf16x8*)(vp + ((dt * 2 + kb2) * 2 + s2) * 1024);
                    f32x16 st;
#pragma unroll
                    for (int q = 0; q < 16; ++q) st[q] = 0.f;
#pragma unroll
                    for (int ks = 0; ks < 4; ++ks) st = MFMA32(kf[ks], qf[ks], st);
                    if (cb >= 6) {
                        const int kpos0 = cb * 64 + 32 * kb2;
#pragma unroll
                        for (int q = 0; q < 16; ++q) { int rel = iq + 512 - (kpos0 + crow(q, h)); rel = rel > 128 ? 128 : rel; st[q] = st[q] * 0.18033688011112042f + rbl[hh * 257 + rel + 128]; }
                    } else {
#pragma unroll
                        for (int q = 0; q < 16; ++q) st[q] = st[q] * 0.18033688011112042f + c0;
                    }
                    float bm = st[0];
#pragma unroll
                    for (int q = 1; q < 16; ++q) bm = fmaxf(bm, st[q]);
                    bm = fmaxf(bm, __shfl_xor(bm, 32));
                    const float mn = fmaxf(m, bm);
                    if (__any(mn > m)) {
                        const float corr = __builtin_amdgcn_exp2f(m - mn);
                        l *= corr;
#pragma unroll
                        for (int dt = 0; dt < 2; ++dt)
#pragma unroll
                            for (int q = 0; q < 16; ++q) OT[dt][q] *= corr;
                        m = mn;
                    }
                    float ps = 0.f;
#pragma unroll
                    for (int q = 0; q < 16; ++q) { st[q] = __builtin_amdgcn_exp2f(st[q] - m); ps += st[q]; }
                    ps += __shfl_xor(ps, 32);
                    l += ps;
                    const bf16x8 p0 = pack8(st, 0), p1 = pack8(st, 1);
#pragma unroll
                    for (int dt = 0; dt < 2; ++dt) { OT[dt] = MFMA32(vf[dt][0], p0, OT[dt]); OT[dt] = MFMA32(vf[dt][1], p1, OT[dt]); }
                }
                const float inv = 1.0f / l;
                bf16* op = omix + ((size_t)b * T + n * 64 + iq) * D + 512 + hh * 64;
#pragma unroll
                for (int dt = 0; dt < 2; ++dt)
#pragma unroll
                    for (int q4 = 0; q4 < 4; ++q4) {
                        v2u w; w.x = cvtpk(OT[dt][4 * q4] * inv, OT[dt][4 * q4 + 1] * inv); w.y = cvtpk(OT[dt][4 * q4 + 2] * inv, OT[dt][4 * q4 + 3] * inv);
                        *(v2u*)(op + 32 * dt + 8 * q4 + 4 * h) = w;
                    }
            }
            __syncthreads();
            {
                ldsf* scr = (ldsf*)(lds + wave * 16384);
                constexpr int I_UP1 = 16 * 64, I_DN1 = 16 * 32;
                for (int it = aw; it < NE * (I_UP1 + I_DN1); it += AW) {
                    int r2 = it;
                    if (r2 < NE * I_UP1) { const int e = r2 / I_UP1; transpose_item8(args.in[I_WUP] + (size_t)e * D * 2048, D, 2048, (unsigned char*)WupT + (size_t)e * 2048 * D, 2, scr, r2 % I_UP1, lane); continue; } r2 -= NE * I_UP1;
                    { const int e = r2 / I_DN1; transpose_item8(args.in[I_WDN] + (size_t)e * D * D, D, D, (unsigned char*)WdnT + (size_t)e * D * D, 1, scr, r2 % I_DN1, lane); }
                }
            }
        }
        if (BOTH(4)) GRID_BAR();
    }


    if (IN(6)) {
        const int lane = (int)__builtin_amdgcn_mbcnt_hi(~0u, __builtin_amdgcn_mbcnt_lo(~0u, 0u)), tid = wave * 64 + lane; const kargp_t ap_ = karg_ptr();
        pg8::Gemm g{omix, WoutT, NTOK, D, D}; pg8::StaticOrder S; S.init(NTOK, D, G, bx);
        pg8::EpiBf16 E{ybuf, D, nullptr, nullptr, 0, 1.0f};
        pg8::gemm_phase<pg8::EpiBf16, pg8::StaticOrder, true, true>(lds, g, S, E, tid);
        if (BOTH(6)) GRID_BAR();
    }

    if (IN(7)) {
        const int lane = (int)__builtin_amdgcn_mbcnt_hi(~0u, __builtin_amdgcn_mbcnt_lo(~0u, 0u)), tid = wave * 64 + lane; const kargp_t ap_ = karg_ptr();
        ldsf* wrT = (ldsf*)lds;
        { const char* src = (const char*)(P_WS + WS_WR) + (size_t)wave * 16384 + lane * 16;
#pragma unroll
          for (int p = 0; p < 16; ++p) __builtin_amdgcn_global_load_lds((const unsigned*)(src + p * 1024), (LAS unsigned*)(lds + wave * 16384 + p * 1024), 16, 0, 0); }
        LAS int* lcnt = (LAS int*)(lds + 131072);
        if (tid < 32) lcnt[tid] = 0;
        asm volatile("s_waitcnt vmcnt(0)" ::: "memory");
        __syncthreads();
        const float* nw1 = args.in[I_NORMW] + 1024; const float* nw2 = args.in[I_NORMW] + 2048; const float* b_r = args.in[I_BR];
        typedef unsigned u32x2_t __attribute__((ext_vector_type(2)));
        u32x2_t ynx[4]; f32x4 xnx[4];
#pragma unroll
        for (int j = 0; j < 4; ++j) { ynx[j] = *((const u32x2_t*)(ybuf + (size_t)gw * D) + lane + 64 * j); xnx[j] = *((const f32x4*)(Xp + (size_t)gw * D) + lane + 64 * j); }
        for (int bb = 0; bb < BATCH; ++bb) {
        f32x4 g1v[4], a2v[4], sh2v[4];
#pragma unroll
        for (int j = 0; j < 4; ++j) { const int col = 4 * lane + 256 * j;
            const f32x4 n1 = *(const f32x4*)(nw1 + col), ga = *(const f32x4*)(MODp + bb * 6144 + 2048 + col), n2 = *(const f32x4*)(nw2 + col), sc = *(const f32x4*)(MODp + bb * 6144 + 4096 + col);
            sh2v[j] = *(const f32x4*)(MODp + bb * 6144 + 3072 + col);
#pragma unroll
            for (int e = 0; e < 4; ++e) { g1v[j][e] = ga[e] * n1[e]; a2v[j][e] = n2[e] * (1.0f + sc[e]); } }
        for (int r = gw + bb * (NTOK / BATCH); r < (bb + 1) * (NTOK / BATCH); r += NGW) {
            f32x4 v[4], xv4[4]; float ss = 0.f;
#pragma unroll
            for (int j = 0; j < 4; ++j) { v[j] = (f32x4){__uint_as_float(ynx[j].x << 16), __uint_as_float(ynx[j].x & 0xffff0000u), __uint_as_float(ynx[j].y << 16), __uint_as_float(ynx[j].y & 0xffff0000u)}; xv4[j] = xnx[j]; ss += (v[j].x * v[j].x + v[j].y * v[j].y) + (v[j].z * v[j].z + v[j].w * v[j].w); }
            __builtin_amdgcn_sched_barrier(0);
            if (r + NGW < NTOK) {
#pragma unroll
                for (int j = 0; j < 4; ++j) { ynx[j] = *((const u32x2_t*)(ybuf + (size_t)(r + NGW) * D) + lane + 64 * j); xnx[j] = *((const f32x4*)(Xp + (size_t)(r + NGW) * D) + lane + 64 * j); }
            }
            __builtin_amdgcn_sched_barrier(0);
            const float rstd1 = rsqrtf(wave_sum(ss) * (1.0f / D) + EPS);
            float ss2 = 0.f;
#pragma unroll
            for (int j = 0; j < 4; ++j) {
#pragma unroll
                for (int e = 0; e < 4; ++e) { v[j][e] = xv4[j][e] + g1v[j][e] * (v[j][e] * rstd1); ss2 += v[j][e] * v[j][e]; }
            }
            const float rstd2 = rsqrtf(wave_sum(ss2) * (1.0f / D) + EPS);
            f32x4 hv[4]; unsigned h8[4];
#pragma unroll
            for (int j = 0; j < 4; ++j) {
#pragma unroll
                for (int e = 0; e < 4; ++e) hv[j][e] = v[j][e] * rstd2 * a2v[j][e] + sh2v[j][e];
                h8[j] = pg8::pk4_fp8(hv[j][0], hv[j][1], hv[j][2], hv[j][3]);
            }
#pragma unroll
            for (int j = 0; j < 4; ++j) { const int col = 4 * lane + 256 * j; *(f32x4*)(OUTp + (size_t)r * D + col) = v[j]; *(unsigned*)((unsigned char*)hbuf + (size_t)r * D + col) = h8[j]; }
            float pe[32];
#pragma unroll
            for (int e = 0; e < 32; ++e) {
                typedef float f32x2_t __attribute__((ext_vector_type(2)));
                f32x2_t p2 = {0.f, 0.f};
#pragma unroll
                for (int j = 0; j < 4; ++j) { const f32x4 w = *(const LAS f32x4*)(wrT + e * 1024 + 4 * lane + 256 * j);
                    p2 += (f32x2_t){hv[j][0], hv[j][1]} * (f32x2_t){w[0], w[1]}; p2 += (f32x2_t){hv[j][2], hv[j][3]} * (f32x2_t){w[2], w[3]}; }
                pe[e] = p2.x + p2.y;
                if ((e & 1) == 1) asm volatile("" ::: "memory");
            }
            float r16[16];
            { const bool up = lane >= 32;
#pragma unroll
              for (int e = 0; e < 16; ++e) { const float send = up ? pe[e] : pe[e + 16], keep = up ? pe[e + 16] : pe[e]; r16[e] = keep + xchg32(send, lane); } }
            float r8[8];
            { const bool up = (lane & 16) != 0;
#pragma unroll
              for (int e = 0; e < 8; ++e) { const float send = up ? r16[e] : r16[e + 8], keep = up ? r16[e + 8] : r16[e]; r8[e] = keep + xchg16(send, lane); } }
            float r4[4];
            { const bool up = (lane & 8) != 0;
#pragma unroll
              for (int e = 0; e < 4; ++e) { const float send = up ? r8[e] : r8[e + 4], keep = up ? r8[e + 4] : r8[e]; r4[e] = keep + dppx<0x128>(send); } }
            float r2[2];
            { const bool up = (lane & 4) != 0;
#pragma unroll
              for (int e = 0; e < 2; ++e) { const float send = up ? r4[e] : r4[e + 2], keep = up ? r4[e + 2] : r4[e]; r2[e] = keep + __shfl_xor(send, 4); } }
            float r1;
            { const bool up = (lane & 2) != 0; const float send = up ? r2[0] : r2[1], keep = up ? r2[1] : r2[0]; r1 = keep + dppx<0x4E>(send); }
            r1 += dppx<0xB1>(r1);
            const int eid = ((lane >> 5) << 4) | (((lane >> 4) & 1) << 3) | (((lane >> 3) & 1) << 2) | (((lane >> 2) & 1) << 1) | ((lane >> 1) & 1);
            float mylg = r1 + b_r[eid];
            int se[4]; float sv[4];
#pragma unroll
            for (int k = 0; k < 4; ++k) {
                const float bv = wave_max(mylg); const int bi = wave_min_i(mylg == bv ? eid : 99);
                se[k] = bi; sv[k] = bv;
                if (eid == bi) mylg = -3.0e38f;
            }
            const float e1 = __expf(sv[1] - sv[0]), e2 = __expf(sv[2] - sv[0]), e3 = __expf(sv[3] - sv[0]);
            const float inv = 1.0f / (1.0f + e1 + e2 + e3);
            if (lane < 4 && !(args.pad & 32)) {
                const int mye = lane == 0 ? se[0] : (lane == 1 ? se[1] : (lane == 2 ? se[2] : se[3]));
                const float myg = (lane == 0 ? 1.0f : (lane == 1 ? e1 : (lane == 2 ? e2 : e3))) * inv;
                const unsigned pos = atomicAdd((unsigned*)lcnt + mye, 1u);
                asg_e[r * 4 + lane] = mye; asg_p[r * 4 + lane] = (int)pos; asg_g[r * 4 + lane] = myg;
            }
        }
        }
        __syncthreads();
        if (tid < 32) ((int*)(ctl + CW_HIST))[vcu * 32 + tid] = lcnt[tid];
        if (BOTH(7)) GRID_BAR();
    }

    LAS int* pst = (LAS int*)(lds + MISC_OFF + 512);
    LAS int* tile_e = (LAS int*)(lds + MISC_OFF + 768);
    LAS int* wbase = (LAS int*)(lds + MISC_OFF + 384);
    if (hi > 8 && lo <= 10) {
        const kargp_t ap_ = karg_ptr();
        const int tix = wave * 64 + (int)__builtin_amdgcn_mbcnt_hi(~0u, __builtin_amdgcn_mbcnt_lo(~0u, 0u));
        {
            LAS int* tmp = (LAS int*)lds;
            const int e = tix & 31, part = tix >> 5; int tot = 0, bef = 0;
            const int* hist = (const int*)(ctl + CW_HIST);
            for (int bb = part; bb < G; bb += 16) { const int c = hist[bb * 32 + e]; tot += c; bef += (bb < vcu) ? c : 0; }
            tmp[part * 32 + e] = tot; tmp[512 + part * 32 + e] = bef;
            __syncthreads();
            if (tix < 32) { int t2 = 0, b2 = 0;
#pragma unroll
                for (int p = 0; p < 16; ++p) { t2 += tmp[p * 32 + tix]; b2 += tmp[512 + p * 32 + tix]; }
                tmp[1024 + tix] = t2; wbase[tix] = b2; ((LAS int*)(lds + MISC_OFF + 1920))[tix] = t2; }
            __syncthreads();
            if (tix == 0) { int run = 0, rt = 0;
                for (int e2 = 0; e2 < NE; ++e2) { pst[e2] = run; const int c = tmp[1024 + e2]; const int nt = (c + 255) >> 8; for (int t2 = 0; t2 < nt; ++t2) tile_e[rt++] = e2; run += nt * 256; }
                pst[32] = run; }
        }
        __syncthreads();
    }
    const int nslots = (hi > 8 && lo <= 10) ? pst[32] : 0;

    if (IN(8)) {
        const int lane = (int)__builtin_amdgcn_mbcnt_hi(~0u, __builtin_amdgcn_mbcnt_lo(~0u, 0u)), tid = wave * 64 + lane; const kargp_t ap_ = karg_ptr();
        {
            int* stok = (int*)(P_WS + WS_STOK);
            for (int r = gw; r < NTOK; r += NGW) {
                if (lane < 4) { const int a = r * 4 + lane; const int e = asg_e[a], pos = asg_p[a]; const int slot = pst[e] + wbase[e] + pos; asg_s[a] = slot; stok[slot] = r; }
            }
            if (bx < NE) {
                const int c = ((LAS int*)(lds + MISC_OFF + 1920))[bx], pad = (c + 255) & ~255;
                for (int s2 = c + tid; s2 < pad; s2 += NTHR) stok[pst[bx] + s2] = 0;
            }
        }
        if (BOTH(8)) GRID_BAR();
    }

    if (IN(9)) {
        const int lane = (int)__builtin_amdgcn_mbcnt_hi(~0u, __builtin_amdgcn_mbcnt_lo(~0u, 0u)), tid = wave * 64 + lane; const kargp_t ap_ = karg_ptr();
        pg8::Gemm g{hbuf, WupT, nslots, 2048, D}; pg8::MoeOrder S; S.init(nslots, 2048, G, bx); S.tile_e = tile_e; S.estride = (size_t)2048 * D; S.rowidx = (const int*)(P_WS + WS_STOK);
        pg8::EpiSwiGLU E{(unsigned char*)actb, args.in[I_BUP], tile_e, 1.0f / 32.0f};
        pg8::gemm_phase<pg8::EpiSwiGLU, pg8::MoeOrder, true, true, true, true>(lds, g, S, E, tid);
        if (BOTH(9)) GRID_BAR();
    }

    if (IN(10)) {
        const int lane = (int)__builtin_amdgcn_mbcnt_hi(~0u, __builtin_amdgcn_mbcnt_lo(~0u, 0u)), tid = wave * 64 + lane; const kargp_t ap_ = karg_ptr();
        pg8::Gemm g{actb, WdnT, nslots, D, D}; pg8::MoeOrder S; S.init(nslots, D, G, bx); S.tile_e = tile_e; S.estride = (size_t)D * D;
        pg8::EpiBf16 E{yslot, D, args.in[I_BDN], tile_e, D, 1.0f / 32.0f};
        pg8::gemm_phase<pg8::EpiBf16, pg8::MoeOrder, true, true, true>(lds, g, S, E, tid);
        if (BOTH(10)) GRID_BAR();
    }

    if (IN(11)) {
        const int lane = (int)__builtin_amdgcn_mbcnt_hi(~0u, __builtin_amdgcn_mbcnt_lo(~0u, 0u)), tid = wave * 64 + lane; const kargp_t ap_ = karg_ptr();
        const float* nw3 = args.in[I_NORMW] + 3072;
        int sln[4]; float gtn[4];
#pragma unroll
        for (int k = 0; k < 4; ++k) { sln[k] = asg_s[gw * 4 + k]; gtn[k] = asg_g[gw * 4 + k]; }
        v2u ywn[4][4]; f32x4 xon[4]; float gtc[4];
#pragma unroll
        for (int k = 0; k < 4; ++k) { gtc[k] = gtn[k];
#pragma unroll
            for (int j = 0; j < 4; ++j) ywn[k][j] = *(const v2u*)(yslot + (size_t)sln[k] * D + 4 * lane + 256 * j); }
#pragma unroll
        for (int j = 0; j < 4; ++j) xon[j] = *(const f32x4*)(OUTp + (size_t)gw * D + 4 * lane + 256 * j);
        if (gw + NGW < NTOK) {
#pragma unroll
            for (int k = 0; k < 4; ++k) { sln[k] = asg_s[(gw + NGW) * 4 + k]; gtn[k] = asg_g[(gw + NGW) * 4 + k]; }
        }
        for (int bb = 0; bb < BATCH; ++bb) {
        f32x4 g3v[4];
#pragma unroll
        for (int j = 0; j < 4; ++j) { const int col = 4 * lane + 256 * j; const f32x4 n3 = *(const f32x4*)(nw3 + col), ga = *(const f32x4*)(MODp + bb * 6144 + 5120 + col);
#pragma unroll
            for (int e = 0; e < 4; ++e) g3v[j][e] = ga[e] * n3[e]; }
        for (int r = gw + bb * (NTOK / BATCH); r < (bb + 1) * (NTOK / BATCH); r += NGW) {
            v2u yw[4][4]; f32x4 xo[4]; float gt[4];
#pragma unroll
            for (int k = 0; k < 4; ++k) { gt[k] = gtc[k];
#pragma unroll
                for (int j = 0; j < 4; ++j) yw[k][j] = ywn[k][j]; }
#pragma unroll
            for (int j = 0; j < 4; ++j) xo[j] = xon[j];
            __builtin_amdgcn_sched_barrier(0);
            if (r + NGW < NTOK) {
#pragma unroll
                for (int k = 0; k < 4; ++k) { gtc[k] = gtn[k];
#pragma unroll
                    for (int j = 0; j < 4; ++j) ywn[k][j] = *(const v2u*)(yslot + (size_t)sln[k] * D + 4 * lane + 256 * j); }
#pragma unroll
                for (int j = 0; j < 4; ++j) xon[j] = *(const f32x4*)(OUTp + (size_t)(r + NGW) * D + 4 * lane + 256 * j);
                if (r + 2 * NGW < NTOK) {
#pragma unroll
                    for (int k = 0; k < 4; ++k) { sln[k] = asg_s[(r + 2 * NGW) * 4 + k]; gtn[k] = asg_g[(r + 2 * NGW) * 4 + k]; }
                }
            }
            __builtin_amdgcn_sched_barrier(0);
            f32x4 acc[4];
#pragma unroll
            for (int j = 0; j < 4; ++j) { acc[j] = (f32x4){0.f, 0.f, 0.f, 0.f};
#pragma unroll
                for (int k = 0; k < 4; ++k) { acc[j][0] += gt[k] * bflo(yw[k][j].x); acc[j][1] += gt[k] * bfhi(yw[k][j].x); acc[j][2] += gt[k] * bflo(yw[k][j].y); acc[j][3] += gt[k] * bfhi(yw[k][j].y); } }
            float ss = 0.f;
#pragma unroll
            for (int j = 0; j < 4; ++j) ss += (acc[j][0] * acc[j][0] + acc[j][1] * acc[j][1]) + (acc[j][2] * acc[j][2] + acc[j][3] * acc[j][3]);
            const float rstd = rsqrtf(wave_sum(ss) * (1.0f / D) + EPS);
#pragma unroll
            for (int j = 0; j < 4; ++j) {
                const int col = 4 * lane + 256 * j;
                f32x4 xv = xo[j];
#pragma unroll
                for (int e = 0; e < 4; ++e) xv[e] += g3v[j][e] * (acc[j][e] * rstd);
                if (!(args.pad & 32)) *(f32x4*)(OUTp + (size_t)r * D + col) = xv;
            }
        }
        }
    }
#undef IN
#undef BOTH
}

#undef P_WS
#undef ctl
#undef Xp
#undef OUTp
#undef MODp
#undef gbuf
#undef betabuf
#undef glbuf
#undef asg_e
#undef asg_p
#undef asg_g
#undef asg_s
#undef WinT
#undef WoutT
#undef WupT
#undef WdnT
#undef hbuf
#undef projb
#undef Ub
#undef opsb
#undef zsb
#undef qfb
#undef kfb
#undef vtfb
#undef omix
#undef ybuf
#undef xg
#undef actb
#undef yslot
#undef args
constexpr int NPHASES = 12;

extern "C" void kernel_launch(void* const* d_in, const int* in_sizes, int n_in, void* d_out, int out_size, void* d_ws, size_t ws_size, hipStream_t stream) {
    static int grid = 0;
    if (grid == 0) {
        if (n_in != 18 || out_size != NTOK * D || ws_size < WS_END) { fprintf(stderr, "kernel_launch: unexpected shapes (n_in %d out %d ws %zu)\n", n_in, out_size, ws_size); grid = -1; return; }
        int dev = 0, cus = 0, per_cu = 0;
        if (hipGetDevice(&dev) != hipSuccess || hipDeviceGetAttribute(&cus, hipDeviceAttributeMultiprocessorCount, dev) != hipSuccess) { grid = -1; return; }
        if (hipFuncSetAttribute((const void*)mk_fwd, hipFuncAttributeMaxDynamicSharedMemorySize, LDS_BYTES) != hipSuccess) { fprintf(stderr, "kernel_launch: hipFuncSetAttribute failed\n"); grid = -1; return; }
        if (hipOccupancyMaxActiveBlocksPerMultiprocessor(&per_cu, (const void*)mk_fwd, NTHR, LDS_BYTES) != hipSuccess || per_cu < 1) { fprintf(stderr, "kernel_launch: occupancy query says %d blocks per CU\n", per_cu); grid = -1; return; }
        (void)hipGetLastError();
        grid = cus;
    }
    if (grid < 0) return;
    (void)hipMemsetAsync((char*)d_ws + WS_CTL, 0, CTL_ZERO_BYTES, stream);
    Args a{};
    for (int i = 0; i < 18; ++i) a.in[i] = (const float*)d_in[i];
    a.out = (float*)d_out; a.ws = (unsigned char*)d_ws;
#if MK_ONE_LAUNCH
#ifndef PROBE_PHASE
#define PROBE_PHASE -1
#endif
#ifndef PROBE_SUB
#define PROBE_SUB 0
#endif
    if (PROBE_PHASE >= 0) {
        const int k = PROBE_PHASE;
        a.ph_lo = 0; a.ph_hi = k + 1; a.li = 0; hipLaunchKernelGGL(mk_fwd, dim3(grid), dim3(NTHR), LDS_BYTES, stream, a);
        a.ph_lo = k; a.ph_hi = k + 1; a.li = 1; a.pad = (k == 7 || k == 11) ? 32 : PROBE_SUB; hipLaunchKernelGGL(mk_fwd, dim3(grid), dim3(NTHR), LDS_BYTES, stream, a); a.pad = 0;
        if (k + 1 < NPHASES) { a.ph_lo = k + 1; a.ph_hi = NPHASES; a.li = 2; hipLaunchKernelGGL(mk_fwd, dim3(grid), dim3(NTHR), LDS_BYTES, stream, a); }
        return;
    }
    a.ph_lo = 0; a.ph_hi = NPHASES; a.li = 0;
    hipLaunchKernelGGL(mk_fwd, dim3(grid), dim3(NTHR), LDS_BYTES, stream, a);
#else
    for (int p = 0; p < NPHASES; ++p) { a.ph_lo = p; a.ph_hi = p + 1; a.li = p; hipLaunchKernelGGL(mk_fwd, dim3(grid), dim3(NTHR), LDS_BYTES, stream, a); }
#endif
}
```
